# Optimizing an MI355X kernel written in HIP

```python
import math
import jax, jax.numpy as jnp
from jax import lax
import numpy as np

D_MODEL = 1024
BATCH = 8
SEQ = 4096
DEPTH = 2

N_MIXERS = 2
N_CONV_LAYERS = (DEPTH + 1) // 2
N_ATTN_LAYERS = DEPTH // 2
CONV_CH = D_MODEL
CONV_WIDTH = 31
DA_HEADS = D_MODEL // 128
DA_HEAD_DIM = 64
DA_V_DIM = 2 * DA_HEAD_DIM
ROPE_DIM = DA_HEAD_DIM // 4
ROPE_THETA = 500000.0
Q_BLOCK = 128
N_GROUPS = 4
EXPERTS_PER_GROUP = 8
N_EXPERTS = N_GROUPS * EXPERTS_PER_GROUP
TOP_K_IN_GROUP = 2
D_EXPERT = D_MODEL // 4
PLE_DIM = 256
EPS = 1e-6

kernel_name = "hybrid_conformer_diffattn_hmoe"


def rms_norm(x, g):
    xf = x.astype(jnp.float32)
    y = xf * lax.rsqrt(jnp.mean(xf * xf, axis=-1, keepdims=True) + EPS)
    return (y * g.astype(jnp.float32)).astype(x.dtype)


def layer_norm(x, g, b):
    xf = x.astype(jnp.float32)
    mu = jnp.mean(xf, axis=-1, keepdims=True)
    var = jnp.mean(jnp.square(xf - mu), axis=-1, keepdims=True)
    y = (xf - mu) * lax.rsqrt(var + EPS)
    return (y * g.astype(jnp.float32) + b.astype(jnp.float32)).astype(x.dtype)


def conformer_conv(h, w_pw1, b_pw1, w_dw, b_dw, ln_g, ln_b, w_pw2, b_pw2):
    u = h @ w_pw1 + b_pw1
    a, g = jnp.split(u, 2, axis=-1)
    v = a * jax.nn.sigmoid(g)
    v = lax.conv_general_dilated(
        v, w_dw[:, None, :], window_strides=(1,),
        padding=[(CONV_WIDTH - 1, 0)],
        dimension_numbers=("NWC", "WIO", "NWC"),
        feature_group_count=CONV_CH) + b_dw
    v = jax.nn.silu(layer_norm(v, ln_g, ln_b))
    return v @ w_pw2 + b_pw2


def rope_tables(positions):
    inv_freq = ROPE_THETA ** (-jnp.arange(0, ROPE_DIM, 2, dtype=jnp.float32) / ROPE_DIM)
    ang = positions.astype(jnp.float32)[..., None] * inv_freq
    return jnp.cos(ang)[:, :, None, None, :], jnp.sin(ang)[:, :, None, None, :]


def partial_rope(x, cos, sin):
    half = ROPE_DIM // 2
    x1 = x[..., :half].astype(jnp.float32)
    x2 = x[..., half:ROPE_DIM].astype(jnp.float32)
    rot = jnp.concatenate([x1 * cos - x2 * sin, x2 * cos + x1 * sin], axis=-1)
    return jnp.concatenate([rot.astype(x.dtype), x[..., ROPE_DIM:]], axis=-1)


def diff_attention(h, cos, sin, w_qkv, lam_params, subln_g, w_o, lam_init):
    B, S, _ = h.shape
    qkv = h @ w_qkv
    nq = DA_HEADS * 2 * DA_HEAD_DIM
    q = qkv[..., :nq].reshape(B, S, DA_HEADS, 2, DA_HEAD_DIM)
    k = qkv[..., nq:2 * nq].reshape(B, S, DA_HEADS, 2, DA_HEAD_DIM)
    v = qkv[..., 2 * nq:].reshape(B, S, DA_HEADS, DA_V_DIM)
    q = partial_rope(q, cos, sin)
    k = partial_rope(k, cos, sin)
    lp = lam_params.astype(jnp.float32)
    lam = jnp.exp(jnp.sum(lp[0] * lp[1])) - jnp.exp(jnp.sum(lp[2] * lp[3])) + lam_init
    scale = DA_HEAD_DIM ** -0.5
    neg = jnp.finfo(jnp.float32).min
    outs = []
    for blk in range(S // Q_BLOCK):
        q0 = blk * Q_BLOCK
        kend = q0 + Q_BLOCK
        qb = q[:, q0:kend]
        kb = k[:, :kend]
        vb = v[:, :kend]
        s = jnp.einsum("bqhcd,bkhcd->bhcqk", qb, kb).astype(jnp.float32) * scale
        mask = (q0 + jnp.arange(Q_BLOCK))[:, None] >= jnp.arange(kend)[None, :]
        a = jax.nn.softmax(jnp.where(mask, s, neg), axis=-1)
        wgt = (a[:, :, 0] - lam * a[:, :, 1]).astype(vb.dtype)
        outs.append(jnp.einsum("bhqk,bkhd->bqhd", wgt, vb))
    o = jnp.concatenate(outs, axis=1)
    o = rms_norm(o, subln_g) * (1.0 - lam_init)
    return o.reshape(B, S, DA_HEADS * DA_V_DIM) @ w_o


def hier_moe(h, w_rg, b_rg, w_re, b_re, w_gate, w_up, w_down):
    gl = (h @ w_rg).astype(jnp.float32) + b_rg
    g_idx = jnp.argmax(gl, axis=-1)
    g_oh = jax.nn.one_hot(g_idx, N_GROUPS, dtype=jnp.float32)
    g_w = jnp.sum(jax.nn.softmax(gl, axis=-1) * g_oh, axis=-1, keepdims=True)
    el = jnp.einsum("bsd,gde->bsge", h, w_re).astype(jnp.float32) + b_re
    el_sel = jnp.einsum("bsge,bsg->bse", el, g_oh)
    top_v, top_i = lax.top_k(el_sel, TOP_K_IN_GROUP)
    top_w = jax.nn.softmax(top_v, axis=-1) * g_w
    e_oh = jax.nn.one_hot(top_i, EXPERTS_PER_GROUP, dtype=jnp.float32)
    within = jnp.sum(e_oh * top_w[..., None], axis=-2)
    combine = (g_oh[..., :, None] * within[..., None, :]).astype(h.dtype)
    out = jnp.zeros_like(h)
    for g in range(N_GROUPS):
        hg = jnp.einsum("bsd,edf->bsef", h, w_gate[g])
        ug = jnp.einsum("bsd,edf->bsef", h, w_up[g])
        act = jax.nn.silu(hg) * ug * combine[:, :, g, :, None]
        out = out + jnp.einsum("bsef,efd->bsd", act, w_down[g])
    return out


def setup_inputs(seed: int = 0) -> dict:
    key = jax.random.key(seed)
    ks = iter(jax.random.split(key, 40))
    nrm = lambda shape, scale: jax.random.normal(next(ks), shape, jnp.float32) * scale
    gain = lambda shape: 1.0 + nrm(shape, 0.02)
    D, C = D_MODEL, CONV_CH
    nc, na = N_CONV_LAYERS, N_ATTN_LAYERS
    nq = DA_HEADS * 2 * DA_HEAD_DIM
    G, E, F = N_GROUPS, EXPERTS_PER_GROUP, D_EXPERT
    x = jax.random.normal(next(ks), (BATCH, SEQ, D), jnp.float32)
    p = jax.random.normal(next(ks), (DEPTH, BATCH, SEQ, PLE_DIM), jnp.float32)
    offs = jax.random.randint(next(ks), (BATCH, 1), 0, 1024, dtype=jnp.int32)
    positions = offs + jnp.arange(SEQ, dtype=jnp.int32)[None, :]
    return {
        "x": x, "p": p, "positions": positions,
        "norm_mix": gain((DEPTH, D)), "norm_ffn": gain((DEPTH, D)),
        "conv_w_pw1": nrm((nc, D, 2 * C), D ** -0.5), "conv_b_pw1": nrm((nc, 2 * C), 0.01),
        "conv_w_dw": nrm((nc, CONV_WIDTH, C), CONV_WIDTH ** -0.5), "conv_b_dw": nrm((nc, C), 0.01),
        "conv_ln_g": gain((nc, C)), "conv_ln_b": nrm((nc, C), 0.01),
        "conv_w_pw2": nrm((nc, C, D), C ** -0.5), "conv_b_pw2": nrm((nc, D), 0.01),
        "da_w_qkv": nrm((na, D, 2 * nq + DA_HEADS * DA_V_DIM), D ** -0.5),
        "da_lambda": nrm((na, 4, DA_HEAD_DIM), 0.1),
        "da_subln": gain((na, DA_V_DIM)),
        "da_w_o": nrm((na, DA_HEADS * DA_V_DIM, D), (DA_HEADS * DA_V_DIM) ** -0.5),
        "moe_w_rg": nrm((DEPTH, D, G), D ** -0.5), "moe_b_rg": nrm((DEPTH, G), 0.01),
        "moe_w_re": nrm((DEPTH, G, D, E), D ** -0.5), "moe_b_re": nrm((DEPTH, G, E), 0.01),
        "moe_w_gate": nrm((DEPTH, G, E, D, F), D ** -0.5),
        "moe_w_up": nrm((DEPTH, G, E, D, F), D ** -0.5),
        "moe_w_down": nrm((DEPTH, G, E, F, D), F ** -0.5),
        "ple_norm": gain((DEPTH, D)),
        "ple_w_gate": nrm((DEPTH, D, D), D ** -0.5),
        "ple_w_proj": nrm((DEPTH, PLE_DIM, D), PLE_DIM ** -0.5),
        "final_norm": gain((D,)),
    }


def reference(x, p, positions, norm_mix, norm_ffn,
              conv_w_pw1, conv_b_pw1, conv_w_dw, conv_b_dw, conv_ln_g, conv_ln_b,
              conv_w_pw2, conv_b_pw2,
              da_w_qkv, da_lambda, da_subln, da_w_o,
              moe_w_rg, moe_b_rg, moe_w_re, moe_b_re, moe_w_gate, moe_w_up, moe_w_down,
              ple_norm, ple_w_gate, ple_w_proj, final_norm):
    cos, sin = rope_tables(positions)
    for i in range(DEPTH):
        j = i // N_MIXERS
        h = rms_norm(x, norm_mix[i])
        if i % N_MIXERS == 0:
            y = conformer_conv(h, conv_w_pw1[j], conv_b_pw1[j], conv_w_dw[j], conv_b_dw[j],
                               conv_ln_g[j], conv_ln_b[j], conv_w_pw2[j], conv_b_pw2[j])
        else:
            lam_init = 0.8 - 0.6 * math.exp(-0.3 * i)
            y = diff_attention(h, cos, sin, da_w_qkv[j], da_lambda[j], da_subln[j],
                               da_w_o[j], lam_init)
        x = x + y
        h = rms_norm(x, norm_ffn[i])
        x = x + hier_moe(h, moe_w_rg[i], moe_b_rg[i], moe_w_re[i], moe_b_re[i],
                         moe_w_gate[i], moe_w_up[i], moe_w_down[i])
        gate = jax.nn.sigmoid(rms_norm(x, ple_norm[i]) @ ple_w_gate[i])
        x = x + gate * (p[i] @ ple_w_proj[i])
    return rms_norm(x, final_norm)
```

```cpp
#include <hip/hip_runtime.h>
#include <hip/hip_bf16.h>
#include <cstdio>
#include <cstdint>
#include <cmath>

#ifndef MK_SPLIT
#define MK_SPLIT 1
#endif

namespace pg8 {
#define PG8_LAS __attribute__((address_space(3)))
typedef unsigned short bf16_t;
typedef short bf16x8 __attribute__((ext_vector_type(8)));
typedef float f32x4 __attribute__((ext_vector_type(4)));
typedef unsigned u32x4 __attribute__((ext_vector_type(4)));
constexpr int BM = 256, BK = 64, HALF = 128, HTB = HALF * BK * 2  , STAGE_BYTES = 8 * HTB, NXCD = 8, WGM = 8;

__host__ __device__ __forceinline__ int lds_byte(int r, int c) { const int st = (r >> 4) * 2 + (c >> 5), rr = r & 15, cc = c & 31, ob = rr * 64 + cc * 2; return st * 1024 + (ob ^ (((ob >> 9) & 1) << 5)); }
__host__ __device__ __forceinline__ void stage_rc(int b, int& R, int& C) { const int st = b / 1024, sb = b % 1024, swz = sb ^ (((sb >> 9) & 1) << 5); R = (st >> 1) * 16 + swz / 64; C = (st & 1) * 32 + (swz % 64) / 2; }
__host__ __device__ __forceinline__ int perm32(int rho) { const int n = rho >> 4, i = rho & 15; return 8 * (i >> 2) + 4 * n + (i & 3); }

__device__ __forceinline__ int ltid(int wave) { int t = wave * 64 + (int)__builtin_amdgcn_mbcnt_hi(0xffffffffu, __builtin_amdgcn_mbcnt_lo(0xffffffffu, 0u)); asm volatile("" : "+v"(t)); return t; }
struct Unit { int pm, pn, pb; };
struct Gemm { const bf16_t* A; const bf16_t* Bt; int M, N, K; };

struct StaticOrder {
    int nM, nN, nwg, G, c;
    __host__ __device__ void init(int M, int N, int G_, int c_) { nM = M / BM; nN = N / BM; nwg = nM * nN; G = G_; c = c_; }
    __host__ __device__ bool next(int i, Unit& u) const {
        const long L = (long)i * G + c; if (L >= nwg) return false;
        int wgid = (int)L; { const int q = nwg / NXCD, r = nwg % NXCD, xcd = wgid % NXCD, off = wgid / NXCD; wgid = (xcd < r ? xcd * (q + 1) : r * (q + 1) + (xcd - r) * q) + off; }
        const int nig = WGM * nN, gid = wgid / nig, fm = gid * WGM, gsz = (nM - fm) < WGM ? (nM - fm) : WGM;
        u.pm = fm + ((wgid % nig) % gsz); u.pn = (wgid % nig) / gsz; u.pb = u.pn; return true;
    }
    __device__ __forceinline__ unsigned arow(int, int) const { return 0u; }
};

__device__ __forceinline__ unsigned cvt_pk_bf16(float lo, float hi) { unsigned r; asm volatile("v_cvt_pk_bf16_f32 %0, %1, %2" : "=v"(r) : "v"(lo), "v"(hi)); return r; }

struct EpiBf16 {
    static constexpr bool PERM = true;
    bf16_t* O; int ldc; const float* bias; int split_cols; size_t split_stride; float scale0;
    __device__ __forceinline__ void operator()(const f32x4 (&acc)[2][2][4][2], const Unit& u, int wr, int wc, int fr, int fq) const {
        const int row0 = u.pm * BM + wr * 64 + fr; int colt = u.pn * BM; bf16_t* base = O;
        float sc = 1.f; if (split_cols) { const int t = colt / split_cols; base += (size_t)t * split_stride; colt -= t * split_cols; if (t == 0) sc = scale0; }
        const int col0 = colt + wc * 32 + 8 * fq, bcol0 = u.pn * BM + wc * 32 + 8 * fq;
        f32x4 bv[2][2];
#pragma unroll
        for (int bj = 0; bj < 2; ++bj)
#pragma unroll
            for (int n = 0; n < 2; ++n) bv[bj][n] = bias ? *(const f32x4*)(bias + bcol0 + bj * HALF + 4 * n) : (f32x4){0.f, 0.f, 0.f, 0.f};
#pragma unroll
        for (int ai = 0; ai < 2; ++ai)
#pragma unroll
            for (int m = 0; m < 4; ++m) { bf16_t* rowp = base + (size_t)(row0 + ai * HALF + m * 16) * ldc + col0;
#pragma unroll
                for (int bj = 0; bj < 2; ++bj) { f32x4 v0 = acc[ai][bj][m][0] + bv[bj][0], v1 = acc[ai][bj][m][1] + bv[bj][1];
                    v0 = v0 * sc; v1 = v1 * sc; u32x4 w; w.x = cvt_pk_bf16(v0[0], v0[1]); w.y = cvt_pk_bf16(v0[2], v0[3]); w.z = cvt_pk_bf16(v1[0], v1[1]); w.w = cvt_pk_bf16(v1[2], v1[3]);
                    *(u32x4*)(rowp + bj * HALF) = w; } }
    }
};
struct EpiLogits {
    static constexpr bool PERM = false;
    float* O;
    __device__ __forceinline__ void operator()(const f32x4 (&acc)[2][2][4][2], const Unit& u, int wr, int wc, int fr, int fq) const {
        if (wc < 2) {
            const int row0 = u.pm * BM + wr * 64 + fr;
#pragma unroll
            for (int ai = 0; ai < 2; ++ai)
#pragma unroll
                for (int m = 0; m < 4; ++m)
#pragma unroll
                    for (int n = 0; n < 2; ++n) *(f32x4*)(O + (size_t)(row0 + ai * HALF + m * 16) * 64 + wc * 32 + n * 16 + 4 * fq) = acc[ai][0][m][n];
        }
    }
};
__device__ __forceinline__ float silu_f(float x) { return x * __builtin_amdgcn_rcpf(1.f + __expf(-x)); }
struct EpiGU {
    static constexpr bool PERM = true;
    bf16_t* O;
    __device__ __forceinline__ void operator()(const f32x4 (&acc)[2][2][4][2], const Unit& u, int wr, int wc, int fr, int fq) const {
        const int row0 = u.pm * BM + wr * 64 + fr, col0 = u.pn * HALF + wc * 32 + 8 * fq;
#pragma unroll
        for (int ai = 0; ai < 2; ++ai)
#pragma unroll
            for (int m = 0; m < 4; ++m) { bf16_t* rowp = O + (size_t)(row0 + ai * HALF + m * 16) * 256 + col0;
                const f32x4 g0 = acc[ai][0][m][0], g1 = acc[ai][0][m][1], u0 = acc[ai][1][m][0], u1 = acc[ai][1][m][1];
                u32x4 w; w.x = cvt_pk_bf16(silu_f(g0[0]) * u0[0], silu_f(g0[1]) * u0[1]); w.y = cvt_pk_bf16(silu_f(g0[2]) * u0[2], silu_f(g0[3]) * u0[3]);
                w.z = cvt_pk_bf16(silu_f(g1[0]) * u1[0], silu_f(g1[1]) * u1[1]); w.w = cvt_pk_bf16(silu_f(g1[2]) * u1[2], silu_f(g1[3]) * u1[3]);
                *(u32x4*)rowp = w; }
    }
};

template <class Epi, class Sched, bool ALIGN_EPI, bool GATHER>
__device__ __forceinline__ void gemm_phase(PG8_LAS unsigned char* lds, const Gemm g, const Sched& S, const Epi& E, int wave_) {
    const int tid = ltid(wave_), wid = wave_, lane = tid & 63, wr = wid >> 2, wc = wid & 3, fr = lane & 15, fq = lane >> 4;
    const int K = g.K, nt = K / BK;
    unsigned voffA[2], voffB[2]; int sR[2], sC[2];
#pragma unroll
    for (int i = 0; i < 2; ++i) { int R, C; stage_rc(tid * 16 + i * 8192, R, C); const int Rb = Epi::PERM ? ((R & ~31) + perm32(R & 31)) : R;
        sR[i] = R; sC[i] = C; voffA[i] = (unsigned)(R * K + C) * 2u; voffB[i] = (unsigned)(Rb * K + C) * 2u; }
    const size_t kstep = (size_t)(BK * 2);
    const size_t hstep = (size_t)HALF * K * 2;
    const size_t tstep = 2 * hstep;
    const unsigned ldsw = (unsigned)wid * 1024u;
    const int aoff = lds_byte(wr * 64 + fr, fq * 8), boff = lds_byte(wc * 32 + fr, fq * 8);
#define PG8_SA(b, h) (((b) * 2 + (h)) * HTB)
#define PG8_SB(b, h) ((4 + (b) * 2 + (h)) * HTB)
#define PG8_STAGE(bufoff, gbase, voff) do { _Pragma("unroll") for (int _i = 0; _i < 2; ++_i) \
        __builtin_amdgcn_global_load_lds((const unsigned*)((const char*)(gbase) + (voff)[_i]), (PG8_LAS unsigned*)(lds + (bufoff) + ldsw + _i * 8192), 16, 0, 0); } while (0)
#define PG8_STAGE_A(bufoff, base, kb, h, vv) do { _Pragma("unroll") for (int _i = 0; _i < 2; ++_i) { \
        const char* _p = GATHER ? ((const char*)g.A + (kb) + (vv)[h][_i]) : ((const char*)(base) + (kb) + (size_t)(h) * hstep + voffA[_i]); \
        __builtin_amdgcn_global_load_lds((const unsigned*)_p, (PG8_LAS unsigned*)(lds + (bufoff) + ldsw + _i * 8192), 16, 0, 0); } } while (0)
#define PG8_GOFF(vv, ord) do { _Pragma("unroll") for (int _h = 0; _h < 2; ++_h) _Pragma("unroll") for (int _i = 0; _i < 2; ++_i) \
        (vv)[_h][_i] = S.arow((ord), _h * HALF + sR[_i]) * (unsigned)(K * 2) + (unsigned)(sC[_i] * 2); } while (0)
#define PG8_LDA(dst, b, h) do { _Pragma("unroll") for (int m = 0; m < 4; ++m) _Pragma("unroll") for (int k = 0; k < 2; ++k) dst[m][k] = *(const PG8_LAS bf16x8*)(lds + PG8_SA(b, h) + aoff + m * 2048 + k * 1024); } while (0)
#define PG8_LDB(dst, b, h) do { _Pragma("unroll") for (int n = 0; n < 2; ++n) _Pragma("unroll") for (int k = 0; k < 2; ++k) dst[n][k] = *(const PG8_LAS bf16x8*)(lds + PG8_SB(b, h) + boff + n * 2048 + k * 1024); } while (0)
#define PG8_MMA(ai, bj, At, Bt) do { __builtin_amdgcn_s_setprio(1); _Pragma("unroll") for (int m = 0; m < 4; ++m) _Pragma("unroll") for (int n = 0; n < 2; ++n) _Pragma("unroll") for (int k = 0; k < 2; ++k) \
        acc[ai][bj][m][n] = __builtin_amdgcn_mfma_f32_16x16x32_bf16(Bt[n][k], At[m][k], acc[ai][bj][m][n], 0, 0, 0); __builtin_amdgcn_s_setprio(0); } while (0)
#define PG8_WAIT_V(n) asm volatile("s_waitcnt vmcnt(" #n ")" ::: "memory")
#define PG8_WAIT_L(n) asm volatile("s_waitcnt lgkmcnt(" #n ")" ::: "memory")
#define PG8_BAR __builtin_amdgcn_s_barrier()
#define PG8_SCHED __builtin_amdgcn_sched_barrier(0)
    Unit cur, nxt; int ui = 0;
    if (!S.next(0, cur)) return;
    f32x4 acc[2][2][4][2];
#pragma unroll
    for (int a = 0; a < 2; ++a)
#pragma unroll
        for (int b = 0; b < 2; ++b)
#pragma unroll
            for (int m = 0; m < 4; ++m)
#pragma unroll
                for (int n = 0; n < 2; ++n) acc[a][b][m][n] = (f32x4){0.f, 0.f, 0.f, 0.f};
    bf16x8 At[4][2], B0[2][2], B1[2][2];
    unsigned vA[2][2] = {{0u, 0u}, {0u, 0u}}, vN[2][2] = {{0u, 0u}, {0u, 0u}}, vS[2][2] = {{0u, 0u}, {0u, 0u}};
    if constexpr (GATHER) { PG8_GOFF(vA, 0); }
    const char* cA = GATHER ? (const char*)g.A : (const char*)g.A + (size_t)cur.pm * tstep; const char* cB = (const char*)g.Bt + (size_t)cur.pb * tstep;
    PG8_STAGE(PG8_SB(0, 0), cB, voffB); PG8_STAGE(PG8_SB(0, 1), cB + hstep, voffB); PG8_STAGE_A(PG8_SA(0, 0), cA, 0, 0, vA); PG8_STAGE_A(PG8_SA(0, 1), cA, 0, 1, vA);
    if (wr == 1) PG8_BAR;
    PG8_WAIT_V(2); PG8_BAR;
    PG8_STAGE(PG8_SB(1, 0), cB + kstep, voffB); PG8_STAGE_A(PG8_SA(1, 0), cA, kstep, 0, vA); PG8_STAGE(PG8_SB(1, 1), cB + hstep + kstep, voffB);
    PG8_WAIT_V(6); PG8_BAR;
    for (;;) {
        const bool has_next = S.next(ui + 1, nxt);
        if constexpr (GATHER) { if (has_next) { PG8_GOFF(vN, ui + 1); } else { _Pragma("unroll") for (int _h = 0; _h < 2; ++_h) _Pragma("unroll") for (int _i = 0; _i < 2; ++_i) vN[_h][_i] = vA[_h][_i]; } }
        const char* nA = (has_next && !GATHER) ? (const char*)g.A + (size_t)nxt.pm * tstep : cA; const char* nB = has_next ? (const char*)g.Bt + (size_t)nxt.pb * tstep : cB;
        for (int t = 0; t < nt; t += 2) {
            const bool last = (t == nt - 2);
            const size_t kb1 = (size_t)(t + 1) * kstep, kb2 = last ? (size_t)0 : (size_t)(t + 2) * kstep, kb3 = kb2 + kstep;
            const char* sA = last ? nA : cA; const char* b2 = last ? nB : cB + (size_t)(t + 2) * kstep; const char* b3 = b2 + kstep;
            if constexpr (GATHER) { _Pragma("unroll") for (int _h = 0; _h < 2; ++_h) _Pragma("unroll") for (int _i = 0; _i < 2; ++_i) vS[_h][_i] = last ? vN[_h][_i] : vA[_h][_i]; }
            PG8_LDB(B0, 0, 0); PG8_LDB(B1, 0, 1); PG8_SCHED; PG8_LDA(At, 0, 0); PG8_STAGE_A(PG8_SA(1, 1), cA, kb1, 1, vA);
            PG8_WAIT_V(8); PG8_WAIT_L(0); PG8_BAR; PG8_MMA(0, 0, At, B0); PG8_MMA(0, 1, At, B1); PG8_BAR; PG8_SCHED;
            PG8_LDA(At, 0, 1); PG8_STAGE(PG8_SB(0, 0), b2, voffB); PG8_STAGE(PG8_SB(0, 1), b2 + hstep, voffB); PG8_STAGE_A(PG8_SA(0, 0), sA, kb2, 0, vS);
            PG8_WAIT_V(8); PG8_WAIT_L(0); PG8_BAR; PG8_MMA(1, 0, At, B0); PG8_MMA(1, 1, At, B1); PG8_BAR; PG8_SCHED;
            PG8_LDB(B0, 1, 0); PG8_LDB(B1, 1, 1); PG8_SCHED; PG8_LDA(At, 1, 0); PG8_STAGE_A(PG8_SA(0, 1), sA, kb2, 1, vS);
            PG8_WAIT_V(8); PG8_WAIT_L(0); PG8_BAR; PG8_MMA(0, 0, At, B0); PG8_MMA(0, 1, At, B1); PG8_BAR; PG8_SCHED;
            PG8_LDA(At, 1, 1); PG8_STAGE(PG8_SB(1, 0), b3, voffB); PG8_STAGE(PG8_SB(1, 1), b3 + hstep, voffB); PG8_STAGE_A(PG8_SA(1, 0), sA, kb3, 0, vS);
            PG8_WAIT_V(8); PG8_WAIT_L(0); PG8_BAR; PG8_MMA(1, 0, At, B0); PG8_MMA(1, 1, At, B1); PG8_BAR; PG8_SCHED;
        }
        if constexpr (ALIGN_EPI) { if (wr == 0) PG8_BAR; }
        E(acc, cur, wr, wc, fr, fq);
        if (!has_next) break;
#pragma unroll
        for (int a = 0; a < 2; ++a)
#pragma unroll
            for (int b = 0; b < 2; ++b)
#pragma unroll
                for (int m = 0; m < 4; ++m)
#pragma unroll
                    for (int n = 0; n < 2; ++n) acc[a][b][m][n] = (f32x4){0.f, 0.f, 0.f, 0.f};
        cur = nxt; cA = nA; cB = nB; ++ui;
        if constexpr (GATHER) { _Pragma("unroll") for (int _h = 0; _h < 2; ++_h) _Pragma("unroll") for (int _i = 0; _i < 2; ++_i) vA[_h][_i] = vN[_h][_i]; }
        if constexpr (ALIGN_EPI) { if (wr == 1) PG8_BAR; }
    }
    PG8_WAIT_V(0);
    if constexpr (!ALIGN_EPI) { if (wr == 0) PG8_BAR; }
    PG8_BAR;
#undef PG8_SA
#undef PG8_SB
#undef PG8_STAGE
#undef PG8_STAGE_A
#undef PG8_GOFF
#undef PG8_LDA
#undef PG8_LDB
#undef PG8_MMA
#undef PG8_WAIT_V
#undef PG8_WAIT_L
#undef PG8_BAR
#undef PG8_SCHED
}
}

#include <hip/hip_bf16.h>
#include <cmath>
namespace attn_body {
using bf16=__hip_bfloat16;
using bf16x8=__attribute__((ext_vector_type(8)))short;
using s16x4=__attribute__((ext_vector_type(4)))short;
using f32x16=__attribute__((ext_vector_type(16)))float;
using u32x4=__attribute__((ext_vector_type(4)))unsigned;
constexpr int BATCH=8,NHEAD=16,SEQ=4096,D=64,DM=NHEAD*D;
constexpr int NW=8,QBLK=32,QB=QBLK*NW,KVBLK=64,NQB=SEQ/QB;
constexpr int ATTN_PITCH=DM, ATTN_UNIT_ROWS=QB;
__device__ __forceinline__ int crow(int r,int hi){return (r&3)+8*(r>>2)+4*hi;}
#define SBAR() __builtin_amdgcn_sched_barrier(0)
__device__ __forceinline__ void cmask(f32x16&p0,f32x16&p1,int jb,int qrel,int hi){
  const float NEG=-INFINITY; int kb=64*jb+4*hi;
  #pragma unroll
  for(int r=0;r<16;++r){int kv=kb+(r&3)+8*(r>>2); if(kv>qrel)p0[r]=NEG; if(kv+32>qrel)p1[r]=NEG;}
}

constexpr int NSLOT=3, SLOTB=8192;
constexpr int LDS_K=0, LDS_V=NSLOT*SLOTB, LDS_WS=2*NSLOT*SLOTB, LDS_OST=LDS_WS+NW*64*4, LDS_BYTES=LDS_OST+NW*4096;
constexpr float C2=0.125f*1.4426950408889634f;
__device__ __forceinline__ void glds16(const void*gsrc,unsigned lds_dst){unsigned keep;
  asm volatile("s_mov_b32 %0, m0\n\ts_mov_b32 m0, %2\n\ts_nop 0\n\tglobal_load_lds_dwordx4 %1, off\n\ts_mov_b32 m0, %0":"=&s"(keep):"v"(gsrc),"s"(lds_dst):"memory");}
__device__ __forceinline__ float max3f(float a,float b,float c){float r;asm("v_max3_f32 %0, %1, %2, %3":"=v"(r):"v"(a),"v"(b),"v"(c));return r;}
__device__ __forceinline__ float max2f(float a,float b){float r;asm("v_max_f32_e32 %0, %1, %2":"=v"(r):"v"(a),"v"(b));return r;}
__device__ __forceinline__ float fadd_s(float a,float b){float r;asm("v_add_f32_e32 %0, %1, %2":"=v"(r):"v"(a),"v"(b));return r;}
__device__ __forceinline__ float fsub_s(float a,float b){float r;asm("v_sub_f32_e32 %0, %1, %2":"=v"(r):"v"(a),"v"(b));return r;}
typedef float f32x2_t __attribute__((ext_vector_type(2))); typedef __bf16 bf16x2_t __attribute__((ext_vector_type(2)));
__device__ __forceinline__ unsigned cvtpk_s(float lo,float hi){f32x2_t v={lo,hi};bf16x2_t b=__builtin_convertvector(v,bf16x2_t);return __builtin_bit_cast(unsigned,b);}
#define WAIT_BAR(N) asm volatile("s_waitcnt vmcnt(" #N ") lgkmcnt(0)\n\ts_barrier":::"memory")

__device__ __forceinline__ void qkt(f32x16&p0,f32x16&p1,const char*Kslot,const bf16x8*qr,const f32x16&negm,int r32,int hi){
  const char*kb=Kslot+hi*1024+r32*16;
  #pragma unroll
  for(int d0=0;d0<4;++d0){
    const bf16x8 b0=*reinterpret_cast<const bf16x8*>(kb+d0*2048);
    const bf16x8 b1=*reinterpret_cast<const bf16x8*>(kb+d0*2048+512);
    if(d0==0){p0=__builtin_amdgcn_mfma_f32_32x32x16_bf16(b0,qr[0],negm,0,0,0);p1=__builtin_amdgcn_mfma_f32_32x32x16_bf16(b1,qr[0],negm,0,0,0);}
    else{p0=__builtin_amdgcn_mfma_f32_32x32x16_bf16(b0,qr[d0],p0,0,0,0);p1=__builtin_amdgcn_mfma_f32_32x32x16_bf16(b1,qr[d0],p1,0,0,0);}}
}
typedef __attribute__((address_space(3))) const char* lds_cptr;
typedef short v4i16_t __attribute__((ext_vector_type(4)));
__device__ __forceinline__ void kload8(bf16x8*kf,lds_cptr kp){
  kf[0]=*(const __attribute__((address_space(3))) bf16x8*)(kp);      kf[1]=*(const __attribute__((address_space(3))) bf16x8*)(kp+512);
  kf[2]=*(const __attribute__((address_space(3))) bf16x8*)(kp+2048); kf[3]=*(const __attribute__((address_space(3))) bf16x8*)(kp+2560);
  kf[4]=*(const __attribute__((address_space(3))) bf16x8*)(kp+4096); kf[5]=*(const __attribute__((address_space(3))) bf16x8*)(kp+4608);
  kf[6]=*(const __attribute__((address_space(3))) bf16x8*)(kp+6144); kf[7]=*(const __attribute__((address_space(3))) bf16x8*)(kp+6656);
}
__device__ __forceinline__ void kload2(bf16x8*kf,lds_cptr kp,int j){ kf[2*j]=*(const __attribute__((address_space(3))) bf16x8*)(kp+j*2048); kf[2*j+1]=*(const __attribute__((address_space(3))) bf16x8*)(kp+j*2048+512); }
__device__ __forceinline__ s16x4 vtr(lds_cptr p){ return __builtin_bit_cast(s16x4,__builtin_amdgcn_ds_read_tr16_b64_v4i16((__attribute__((address_space(3))) v4i16_t*)p)); }
__device__ __forceinline__ float rowmax(const f32x16&p0,const f32x16&p1){
  float a=max3f(p0[0],p0[1],p1[0]),b=max3f(p0[2],p0[3],p1[1]);a=max3f(a,p1[2],p1[3]);
  #pragma unroll
  for(int r=4;r<16;r+=4){a=max3f(a,p0[r],p0[r+1]);b=max3f(b,p0[r+2],p0[r+3]);a=max3f(a,p1[r],p1[r+1]);b=max3f(b,p1[r+2],p1[r+3]);}
  const float m=max2f(a,b);
  auto rr=__builtin_amdgcn_permlane32_swap(__float_as_uint(m),__float_as_uint(m),false,false);
  return max2f(__uint_as_float(rr[0]),__uint_as_float(rr[1]));
}
__device__ __forceinline__ void pv(f32x16*o,int vb,bf16x8 pa0,bf16x8 pa1,bf16x8 pa2,bf16x8 pa3){
  #pragma unroll
  for(int d0=0;d0<2;++d0){s16x4 lo[4],hi[4];
    #pragma unroll
    for(int ks=0;ks<4;++ks){
      asm volatile("ds_read_b64_tr_b16 %0,%1 offset:%c2":"=&v"(lo[ks]):"v"(vb),"i"(d0*4096+ks*1024):"memory");
      asm volatile("ds_read_b64_tr_b16 %0,%1 offset:%c2":"=&v"(hi[ks]):"v"(vb),"i"(d0*4096+ks*1024+512):"memory");}
    asm volatile("s_waitcnt lgkmcnt(0)":::"memory");SBAR();
    #define PK(k) (bf16x8){lo[k][0],lo[k][1],lo[k][2],lo[k][3],hi[k][0],hi[k][1],hi[k][2],hi[k][3]}
    o[d0]=__builtin_amdgcn_mfma_f32_32x32x16_bf16(pa0,PK(0),o[d0],0,0,0);
    o[d0]=__builtin_amdgcn_mfma_f32_32x32x16_bf16(pa1,PK(1),o[d0],0,0,0);
    o[d0]=__builtin_amdgcn_mfma_f32_32x32x16_bf16(pa2,PK(2),o[d0],0,0,0);
    o[d0]=__builtin_amdgcn_mfma_f32_32x32x16_bf16(pa3,PK(3),o[d0],0,0,0);
    #undef PK
  }
}

#ifndef ATTN_STORE16
#define ATTN_STORE16(p,v) (*(u32x4*)(p)=(v))
#endif
template<int THRL> __device__ __forceinline__ void attn_unit(int b,int h,int qb,const bf16*Q,const bf16*__restrict__ K,const bf16*__restrict__ V,bf16*O,char*shm,int wave_){
  const int wid=wave_; int tid=wid*64+(int)__builtin_amdgcn_mbcnt_hi(0xffffffffu,__builtin_amdgcn_mbcnt_lo(0xffffffffu,0u)); asm volatile("":"+v"(tid)); const int lane=tid&63,r32=lane&31,hi=lane>>5;
  const long rowbase=(long)b*SEQ; const int q0=qb*QB;
  const bf16*Qw=Q+(rowbase+q0+wid*QBLK)*DM+h*D;
  const bf16*Kh=K+rowbase*DM+h*D,*Vh=V+rowbase*DM+h*D;
  const unsigned lds0=(unsigned)(uintptr_t)shm;
  float*wsf=(float*)(shm+LDS_WS)+wid*64;
  const bf16*ksrc=Kh+(long)lane*DM+wid*8;
  const bf16*vsrc=Vh+(long)(16*(wid&3)+(lane>>2))*DM+(wid>>2)*32+(lane&3)*8;
  const unsigned kdst=lds0+LDS_K+wid*1024, vdst=lds0+LDS_V+wid*1024;
  #define DMA_K(t,slot) glds16(ksrc+(long)(t)*KVBLK*DM,(unsigned)__builtin_amdgcn_readfirstlane(kdst+(slot)))
  #define DMA_V(t,slot) glds16(vsrc+(long)(t)*KVBLK*DM,(unsigned)__builtin_amdgcn_readfirstlane(vdst+(slot)))
  const int vb0=(int)(lds0+LDS_V)+((lane>>4)&1)*32+(lane&3)*8+(4*hi+((lane&15)>>2))*64;
  const char*Kbase=shm+LDS_K; bf16x8 kf[8];
  const lds_cptr shm3=(lds_cptr)shm; const lds_cptr kp0=shm3+LDS_K+hi*1024+r32*16; const lds_cptr vp0=shm3+LDS_V+((lane>>4)&1)*32+(lane&3)*8+(4*hi+((lane&15)>>2))*64;
  const int NT=(q0+QB)/KVBLK;
  DMA_K(0,0);DMA_V(0,0);DMA_K(1,SLOTB);
  bf16x8 qr[4];
  #pragma unroll
  for(int d0=0;d0<4;++d0)qr[d0]=*reinterpret_cast<const bf16x8*>(&Qw[(long)r32*DM+d0*16+hi*8]);
  float mhat=0.f,l_reg=0.f;f32x16 o[2];o[0]=f32x16{};o[1]=f32x16{};f32x16 negm=f32x16{};asm volatile("":"+v"(negm));
  const int qrel=wid*QBLK+r32;
  #define CMASK(P0,P1,t) do{int jb_=(t)-(NT-4); if(jb_>=0)cmask(P0,P1,jb_,qrel,hi);}while(0)
  bool resc=false;
  #define START(P0,P1) do{ const float rm=rowmax(P0,P1); resc=false; \
    { const float dl=rm; mhat=fadd_s(mhat,dl); \
      _Pragma("unroll") for(int r=0;r<16;++r){P0[r]=fsub_s(P0[r],dl);P1[r]=fsub_s(P1[r],dl);} \
      _Pragma("unroll") for(int r=0;r<16;++r)negm[r]=-mhat; asm volatile("":"+v"(negm)); } \
    _Pragma("unroll") for(int r=0;r<16;++r)P0[r]=__builtin_amdgcn_exp2f(P0[r]); }while(0)
  #define RESC() do{ if(resc){ asm volatile("s_waitcnt lgkmcnt(0)":::"memory"); \
      _Pragma("unroll") for(int d_=0;d_<2;++d_) _Pragma("unroll") for(int r=0;r<16;++r)o[d_][r]*=wsf[crow(r,hi)]; } }while(0)
  f32x16 pA0,pA1,pB0,pB1;
  int sl_prev=0,sl_cur=0,sl_next=SLOTB;
  #define ROT() do{sl_prev=sl_cur;sl_cur=sl_next;sl_next=(sl_next==(NSLOT-1)*SLOTB)?0:sl_next+SLOTB;}while(0)
  DMA_K(2,2*SLOTB);
  WAIT_BAR(3);
  qkt(pA0,pA1,Kbase,qr,negm,r32,hi);asm volatile("s_nop 15\n\ts_nop 7":"+v"(pA0),"+v"(pA1));CMASK(pA0,pA1,0);
  START(pA0,pA1);
  _Pragma("unroll") for(int r=0;r<16;++r)pA1[r]=__builtin_amdgcn_exp2f(pA1[r]);
  WAIT_BAR(0);
  DMA_K(3,0);DMA_V(1,SLOTB);
  ROT();
  kload8(kf,kp0+sl_cur);
  WAIT_BAR(2);
  s16x4 vlo[8],vhi[8]; u32x4 pw0,pw1,pw2,pw3;
  #define PKW(P,B) cvtpk_s(P[B],P[B+1])
  #define PAF(k) __builtin_bit_cast(bf16x8,pw##k)
  #define VFR(i) (bf16x8){vlo[i][0],vlo[i][1],vlo[i][2],vlo[i][3],vhi[i][0],vhi[i][1],vhi[i][2],vhi[i][3]}
  #define PIN(x) asm volatile("":"+v"(x))
  #define MX3(a,b,c) __builtin_fmaxf(__builtin_fmaxf((a),(b)),(c))
  #define GAPA(MF,A0,A1,A2,A3,W0,W1,PW) do{ MF; sacc+=A0; sacc+=A1; sacc+=A2; sacc+=A3; PIN(sacc); W0; W1; PIN(PW); SBAR(); }while(0)
  #define EX(v) __builtin_amdgcn_exp2f(v)
  #define GAPB(MF,X,B) do{ MF; X[B]=EX(X[B]); X[B+1]=EX(X[B+1]); X[B+2]=EX(X[B+2]); X[B+3]=EX(X[B+3]); PIN(X); SBAR(); }while(0)
  #define VRD(i) do{ vlo[i]=vtr(vp_+(((i)>>2)*4096+((i)&3)*1024)); vhi[i]=vtr(vp_+(((i)>>2)*4096+((i)&3)*1024+512)); }while(0)
  #define KRD(G,j) do{ if(G){ kload2(kf,kp0+sl_next,j); SBAR(); } }while(0)
  #define STEP(C0,C1,P0,P1,t,GK,GV,GL) do{ SBAR(); \
    const lds_cptr vp_=vp0+sl_prev; \
    VRD(0); SBAR(); float sacc=(P0[0]+P0[1]); \
    GAPA(C0=__builtin_amdgcn_mfma_f32_32x32x16_bf16(kf[0],qr[0],negm,0,0,0), P0[2],P0[3],P0[4],P0[5],     pw0[0]=PKW(P0,0), pw0[1]=PKW(P0,2), pw0); \
    VRD(4); SBAR(); GAPA(C1=__builtin_amdgcn_mfma_f32_32x32x16_bf16(kf[1],qr[0],negm,0,0,0), P0[6],P0[7],P0[8],P0[9],     pw0[2]=PKW(P0,4), pw0[3]=PKW(P0,6), pw0); \
    VRD(1); SBAR(); GAPA(C0=__builtin_amdgcn_mfma_f32_32x32x16_bf16(kf[2],qr[1],C0,0,0,0),   P0[10],P0[11],P0[12],P0[13], pw1[0]=PKW(P0,8), pw1[1]=PKW(P0,10), pw1); \
    VRD(5); SBAR(); GAPA(C1=__builtin_amdgcn_mfma_f32_32x32x16_bf16(kf[3],qr[1],C1,0,0,0),   P0[14],P0[15],P1[0],P1[1],   pw1[2]=PKW(P0,12),pw1[3]=PKW(P0,14), pw1); \
    VRD(2); SBAR(); GAPA(C0=__builtin_amdgcn_mfma_f32_32x32x16_bf16(kf[4],qr[2],C0,0,0,0),   P1[2],P1[3],P1[4],P1[5],     pw2[0]=PKW(P1,0), pw2[1]=PKW(P1,2), pw2); \
    VRD(6); SBAR(); GAPA(C1=__builtin_amdgcn_mfma_f32_32x32x16_bf16(kf[5],qr[2],C1,0,0,0),   P1[6],P1[7],P1[8],P1[9],     pw2[2]=PKW(P1,4), pw2[3]=PKW(P1,6), pw2); \
    VRD(3); SBAR(); GAPA(C0=__builtin_amdgcn_mfma_f32_32x32x16_bf16(kf[6],qr[3],C0,0,0,0),   P1[10],P1[11],P1[12],P1[13], pw3[0]=PKW(P1,8), pw3[1]=PKW(P1,10), pw3); \
    VRD(7); SBAR(); GAPA(C1=__builtin_amdgcn_mfma_f32_32x32x16_bf16(kf[7],qr[3],C1,0,0,0),   P1[14],P1[15],0.f,0.f,       pw3[2]=PKW(P1,12),pw3[3]=PKW(P1,14), pw3); \
    l_reg+=sacc; \
    if(GK){DMA_K((t)+3,sl_cur);} if(GV){DMA_V((t)+1,sl_next);} \
    CMASK(C0,C1,t); \
    { float a=MX3(C0[0],C0[1],C1[0]),b=MX3(C0[2],C0[3],C1[1]); a=MX3(a,C1[2],C1[3]); \
      _Pragma("unroll") for(int r=4;r<16;r+=4){a=MX3(a,C0[r],C0[r+1]);b=MX3(b,C0[r+2],C0[r+3]);a=MX3(a,C1[r],C1[r+1]);b=MX3(b,C1[r+2],C1[r+3]);} \
      float rm=__builtin_fmaxf(a,b); { auto rr=__builtin_amdgcn_permlane32_swap(__float_as_uint(rm),__float_as_uint(rm),false,false); rm=__builtin_fmaxf(__uint_as_float(rr[0]),__uint_as_float(rr[1])); } \
      resc=false; \
      if(__builtin_expect(__any(rm>(float)THRL),0)){ const float dl=__builtin_fmaxf(rm,0.f); mhat+=dl; \
        _Pragma("unroll") for(int r=0;r<16;++r){C0[r]-=dl;C1[r]-=dl;} \
        _Pragma("unroll") for(int r=0;r<16;++r)negm[r]=-mhat; asm volatile("":"+v"(negm)); \
        const float f=__builtin_amdgcn_exp2f(-dl); l_reg*=f; if(hi==0)wsf[r32]=f; resc=true; } } \
    SBAR(); \
    GAPB(o[0]=__builtin_amdgcn_mfma_f32_32x32x16_bf16(PAF(0),VFR(0),o[0],0,0,0), C0,0); \
    GAPB(o[1]=__builtin_amdgcn_mfma_f32_32x32x16_bf16(PAF(0),VFR(4),o[1],0,0,0), C0,4); \
    KRD(GL,0); GAPB(o[0]=__builtin_amdgcn_mfma_f32_32x32x16_bf16(PAF(1),VFR(1),o[0],0,0,0), C0,8); \
    KRD(GL,1); GAPB(o[1]=__builtin_amdgcn_mfma_f32_32x32x16_bf16(PAF(1),VFR(5),o[1],0,0,0), C0,12); \
    KRD(GL,2); GAPB(o[0]=__builtin_amdgcn_mfma_f32_32x32x16_bf16(PAF(2),VFR(2),o[0],0,0,0), C1,0); \
    KRD(GL,3); GAPB(o[1]=__builtin_amdgcn_mfma_f32_32x32x16_bf16(PAF(2),VFR(6),o[1],0,0,0), C1,4); \
    GAPB(o[0]=__builtin_amdgcn_mfma_f32_32x32x16_bf16(PAF(3),VFR(3),o[0],0,0,0), C1,8); \
    GAPB(o[1]=__builtin_amdgcn_mfma_f32_32x32x16_bf16(PAF(3),VFR(7),o[1],0,0,0), C1,12); \
    }while(0)
  int t=1;
  #undef CMASK
  #define CMASK(P0,P1,t) do{}while(0)
  for(;t+5<NT;t+=2){
    STEP(pB0,pB1,pA0,pA1,t,true,true,true);     WAIT_BAR(2); RESC(); ROT();
    STEP(pA0,pA1,pB0,pB1,t+1,true,true,true);   WAIT_BAR(2); RESC(); ROT();
  }
  #undef CMASK
  #define CMASK(P0,P1,t) do{int jb_=(t)-(NT-4); if(jb_>=0)cmask(P0,P1,jb_,qrel,hi);}while(0)
  #define ENDW(tt) do{ if((tt)+3<NT){WAIT_BAR(2);} else if((tt)+2<NT){WAIT_BAR(1);} else {WAIT_BAR(0);} }while(0)
  for(;t+1<NT;t+=2){
    STEP(pB0,pB1,pA0,pA1,t,(t+3<NT),(t+1<NT),(t+1<NT));       ENDW(t);   RESC(); ROT();
    STEP(pA0,pA1,pB0,pB1,t+1,(t+4<NT),(t+2<NT),(t+2<NT));     ENDW(t+1); RESC(); ROT();
  }
  STEP(pB0,pB1,pA0,pA1,NT-1,false,false,false); RESC();
  { float sacc=pB0[0]+pB0[1]; _Pragma("unroll") for(int r=2;r<16;++r)sacc+=pB0[r]; _Pragma("unroll") for(int r=0;r<16;++r)sacc+=pB1[r]; l_reg+=sacc;
    pw0=(u32x4){PKW(pB0,0),PKW(pB0,2),PKW(pB0,4),PKW(pB0,6)};pw1=(u32x4){PKW(pB0,8),PKW(pB0,10),PKW(pB0,12),PKW(pB0,14)};pw2=(u32x4){PKW(pB1,0),PKW(pB1,2),PKW(pB1,4),PKW(pB1,6)};pw3=(u32x4){PKW(pB1,8),PKW(pB1,10),PKW(pB1,12),PKW(pB1,14)};
    SBAR(); pv(o,vb0+sl_cur,PAF(0),PAF(1),PAF(2),PAF(3)); }
  #undef PKW
  #undef PAF
  #undef VFR
  #undef PIN
  #undef MX3
  #undef GAPA
  #undef GAPB
  #undef EX
  #undef VRD
  #undef KRD
  #undef STEP
  #undef ENDW
  {auto rr=__builtin_amdgcn_permlane32_swap(__float_as_uint(l_reg),__float_as_uint(l_reg),false,false);l_reg=__uint_as_float(rr[0])+__uint_as_float(rr[1]);}
  if(hi==0)wsf[32+r32]=l_reg;asm volatile("s_waitcnt lgkmcnt(0)":::"memory");
  float rli[16];
  #pragma unroll
  for(int r=0;r<16;++r)rli[r]=__builtin_amdgcn_rcpf(wsf[32+crow(r,hi)]);
  bf16*Ow=O+(rowbase+q0+wid*QBLK)*DM+h*D;
  { bf16*stg=(bf16*)(shm+LDS_OST)+wid*2048;
    #pragma unroll
    for(int r=0;r<16;++r){const int orow=crow(r,hi);
      #pragma unroll
      for(int d0=0;d0<2;++d0)stg[orow*64+d0*32+r32]=__float2bfloat16(o[d0][r]*rli[r]);}
    asm volatile("s_waitcnt lgkmcnt(0)":::"memory");
    #pragma unroll
    for(int i=0;i<4;++i){const int row=i*8+(lane>>3),ch=lane&7; const u32x4 v=*(const u32x4*)(stg+row*64+ch*8); ATTN_STORE16(Ow+(long)row*DM+ch*8,v);} }
  asm volatile("s_waitcnt lgkmcnt(0)\n\ts_barrier":::"memory");
  #undef DMA_K
  #undef DMA_V
  #undef CMASK
  #undef START
  #undef RESC
  #undef ROT
}
constexpr int ATTN_LDS_BYTES=LDS_BYTES;
struct AttnTensors { const bf16* Q; const bf16* K; const bf16* V; bf16* O0; bf16* O1; };
struct AttnUnit { int combo; int qb; };
struct ComboOrder {
  int vcu, G;
  __device__ __forceinline__ bool next(int i,AttnUnit&u)const{ const int combo=vcu+(i>>4)*G; if(combo>=BATCH*32)return false; u.combo=combo; u.qb=15-(i&15); return true; }
};
template<class Sched,int THRL=8> __device__ __forceinline__ void attn_phase(char*lds,const AttnTensors&T,const Sched&S,int wave_){
  AttnUnit u;
  for(int i=0;S.next(i,u);++i){ const int b=u.combo>>5, hc=(u.combo>>1)&15, vh=u.combo&1, hv=(hc&~1)|vh; const long sh=(long)(hv-hc)*D;
    attn_unit<THRL>(b,hc,u.qb,T.Q,T.K,T.V+sh,((hc&1)?T.O1:T.O0)+sh,lds,wave_); }
}
#undef SBAR
#undef WAIT_BAR
}

#define GAS __attribute__((address_space(1)))
#define LAS __attribute__((address_space(3)))
typedef unsigned short bf16;
typedef unsigned v4u __attribute__((ext_vector_type(4)));
typedef float f32x4 __attribute__((ext_vector_type(4)));
typedef short bf16x8 __attribute__((ext_vector_type(8)));
typedef GAS unsigned gu32;
typedef GAS unsigned long long gu64;
#define RLX_AGENT __ATOMIC_RELAXED, __HIP_MEMORY_SCOPE_AGENT
#define LDS_WAIT() asm volatile("s_waitcnt lgkmcnt(0)" ::: "memory")
#define VM_WAIT() asm volatile("s_waitcnt vmcnt(0)" ::: "memory")
__device__ __forceinline__ unsigned long long rt() { return __builtin_amdgcn_s_memrealtime(); }
__device__ __forceinline__ unsigned f2bf(float f) { unsigned u = __builtin_bit_cast(unsigned, f); return (u + 0x7fffu + ((u >> 16) & 1u)) >> 16; }
__device__ __forceinline__ unsigned pk2(float lo, float hi) { return f2bf(lo) | (f2bf(hi) << 16); }

#define XB_TMO      128
#define XB_XCNT(j)  (256  + 64 * (j))
#define XB_XSUB(j)  (1280 + 64 * (j))
#define XB_XGEN(j)  (2304 + 64 * (j))
#define XB_TOP      3328
#define XB_TOPGEN   3392
#define XCD_BAR_WORDS 3456
#define XB_SPIN_CAP (1u << 18)

__device__ __forceinline__ unsigned xb_ld(unsigned* p)              { return __hip_atomic_load(p, __ATOMIC_RELAXED, __HIP_MEMORY_SCOPE_AGENT); }
__device__ __forceinline__ unsigned xb_add(unsigned* p, unsigned v) { return __hip_atomic_fetch_add(p, v, __ATOMIC_RELAXED, __HIP_MEMORY_SCOPE_AGENT); }
__device__ __forceinline__ unsigned xb_xcc_id() { return (unsigned)__builtin_amdgcn_s_getreg((3 << 11) | 20) & 0xFu; }
#define XB_SPIN(cond, bar) do { unsigned _sp = 0; while (cond) { __builtin_amdgcn_s_sleep(1); \
    if ((++_sp & 255u) == 0u) { if (xb_ld(&(bar)[XB_TMO])) break; if (_sp > XB_SPIN_CAP) { atomicAdd(&(bar)[XB_TMO], 1u); break; } } } } while (0)

struct XcdBarrier {
    unsigned* bar; unsigned x;
    volatile LAS unsigned* st;
};

__device__ __forceinline__ XcdBarrier xcd_barrier_post(unsigned* bar, volatile LAS unsigned* st) {
    XcdBarrier b; b.bar = bar; b.x = xb_xcc_id(); b.st = st;
    if (threadIdx.x == 0) (void)xb_add(&bar[XB_XCNT(b.x)], 1u);
    return b;
}
__device__ __forceinline__ void xcd_barrier_complete(unsigned* bar, unsigned x, unsigned& nloc, unsigned& nx) {
    const unsigned G = gridDim.x * gridDim.y * gridDim.z;
    unsigned sum, cnt, mine, sp = 0u;
    for (;;) {
        sum = 0u; cnt = 0u; mine = 0u;
#pragma unroll
        for (unsigned j = 0; j < 16; ++j) { const unsigned c = xb_ld(&bar[XB_XCNT(j)]); sum += c; cnt += (c > 0u) ? 1u : 0u; mine = (j == x) ? c : mine; }
        if (sum == G) break;
        __builtin_amdgcn_s_sleep(1);
        if ((++sp & 255u) == 0u) { if (xb_ld(&bar[XB_TMO])) break; if (sp > XB_SPIN_CAP) { atomicAdd(&bar[XB_TMO], 1u); break; } }
    }
    nloc = mine > 0u ? mine : 1u; nx = cnt > 0u ? cnt : 1u;
}

__device__ __forceinline__ void xcd_barrier(const XcdBarrier& b) {
    asm volatile("s_waitcnt vmcnt(0)" ::: "memory");
    __syncthreads();
    if (threadIdx.x == 0) {
        unsigned* bar = b.bar;
        __builtin_amdgcn_s_waitcnt(0);
        unsigned nloc = b.st[0], nx = b.st[1];
        if (nloc == 0u) { xcd_barrier_complete(bar, b.x, nloc, nx); b.st[0] = nloc; b.st[1] = nx; }
        const unsigned old = xb_add(&bar[XB_XSUB(b.x)], 1u);
        const unsigned gen = old / nloc;
        if (old + 1u == (gen + 1u) * nloc) {
            __builtin_amdgcn_fence(__ATOMIC_RELEASE, "agent");
            asm volatile("s_waitcnt vmcnt(0)" ::: "memory");
            const unsigned og = xb_add(&bar[XB_TOP], 1u);
            const unsigned tg = og / nx;
            if (og + 1u == (tg + 1u) * nx) xb_add(&bar[XB_TOPGEN], 1u);
            else XB_SPIN(xb_ld(&bar[XB_TOPGEN]) == tg, bar);
            __builtin_amdgcn_fence(__ATOMIC_ACQUIRE, "agent");
            xb_add(&bar[XB_XGEN(b.x)], 1u);
            asm volatile("s_waitcnt vmcnt(0)" ::: "memory");
        } else {
            XB_SPIN(xb_ld(&bar[XB_XGEN(b.x)]) == gen, bar);
            __builtin_amdgcn_fence(__ATOMIC_ACQUIRE, "agent");
            asm volatile("s_waitcnt vmcnt(0)" ::: "memory");
        }
    }
    __syncthreads();
}

constexpr int NWAVES = 8;
constexpr int BATCH = 8, SEQ = 4096, D = 1024, M = BATCH * SEQ;
constexpr int NEXP = 32, FE = 256, PLED = 256, CWID = 31, NQKV = 3072;
constexpr float EPS = 1e-6f;
constexpr int NPHASE = 25;
constexpr int PADROWS = 73728;
constexpr float LAM_INIT = 0.35550906759096926f;

constexpr size_t MiB = 1u << 20;
constexpr size_t WS_CTL = 0, CTL_ZERO_BYTES = 1 * MiB;
constexpr size_t WS_TI = 1 * MiB, WS_TW = WS_TI + 512 * 1024;
constexpr size_t WS_LIST = 2 * MiB;
constexpr size_t WS_LOG = 6 * MiB;
constexpr size_t WS_WPW1 = 14 * MiB, WS_WPW2 = 18 * MiB, WS_WQKV = 20 * MiB, WS_WO = 26 * MiB, WS_WR = 28 * MiB, WS_WPG = 29 * MiB, WS_WPP = 33 * MiB;
constexpr size_t WS_WGU = 34 * MiB, WS_WD = 66 * MiB;
constexpr size_t WS_P16 = 82 * MiB;
constexpr size_t WS_H = 114 * MiB;
constexpr size_t WS_S0 = 178 * MiB, WS_SS = 64 * MiB;
constexpr size_t WS_END = WS_S0 + 5 * WS_SS;
constexpr int CW_BAR = 4096;
constexpr int CW_CNT = 8192;
constexpr int RING_OFF = 0, RING_BYTES = 131072;
constexpr int LDSCTL_OFF = RING_BYTES;
constexpr int L_MISC = LDSCTL_OFF, L_TS = LDSCTL_OFF + 128, L_NE = LDSCTL_OFF + 384, L_TE = LDSCTL_OFF + 512, L_TOK = LDSCTL_OFF + 2048, L_HIST = LDSCTL_OFF + 10240;
constexpr int MAXGU = 8;
constexpr int LDS_BYTES = 147456;


typedef float f32x2 __attribute__((ext_vector_type(2)));
typedef unsigned u32x2 __attribute__((ext_vector_type(2)));
typedef int i32x4 __attribute__((ext_vector_type(4)));
__device__ __forceinline__ float bflo(unsigned u) { return __builtin_bit_cast(float, u << 16); }
__device__ __forceinline__ float bfhi(unsigned u) { return __builtin_bit_cast(float, u & 0xffff0000u); }
__device__ __forceinline__ float sigmoid_f(float x) { return __builtin_amdgcn_rcpf(1.f + __expf(-x)); }
__device__ __forceinline__ float wave_sum(float v) {
#pragma unroll
    for (int o = 1; o < 64; o <<= 1) v += __shfl_xor(v, o);
    return v;
}
__device__ __forceinline__ void tr_item(const float* W, int N, bf16* WT, int Kd, int k0, int n0, int drow0, LAS float* scr, int lane) {
#pragma unroll 8
    for (int i = 0; i < 32; ++i) { const int kk = 2 * i + (lane >> 5); scr[kk * 33 + (lane & 31)] = W[(size_t)(k0 + kk) * N + n0 + (lane & 31)]; }
    LDS_WAIT(); asm volatile("" ::: "memory");
    const int c = lane & 7;
#pragma unroll
    for (int j = 0; j < 4; ++j) { const int n = (lane >> 3) + 8 * j; const LAS float* s = scr + (8 * c) * 33 + n;
        v4u o; o.x = pk2(s[0 * 33], s[1 * 33]); o.y = pk2(s[2 * 33], s[3 * 33]); o.z = pk2(s[4 * 33], s[5 * 33]); o.w = pk2(s[6 * 33], s[7 * 33]);
        *(GAS v4u*)(WT + (size_t)(drow0 + n) * Kd + k0 + 8 * c) = o; }
    LDS_WAIT(); asm volatile("" ::: "memory");
}
__device__ __forceinline__ void tr_plain(const float* W, int K, int N, bf16* WT, int item, LAS float* scr, int lane) {
    const int nblk = N / 32, kb = item / nblk, nb = item % nblk; tr_item(W, N, WT, K, 64 * kb, 32 * nb, 32 * nb, scr, lane);
}
constexpr int MOE_ITEMS = 32 * 384;
__device__ __forceinline__ void moe_item(const float* wg, const float* wu, const float* wd, int l, bf16* WGU, bf16* WD, int item, LAS float* scr, int lane) {
    const int ge = item / 384, r = item % 384, which = r / 128, sub = r % 128; const size_t eo = (size_t)(l * 32 + ge) * 262144;
    if (which < 2) { const int kb = sub / 8, nb = sub % 8, n0 = 32 * nb; const int drow0 = (n0 / 128) * 256 + (n0 % 128) + (which ? 128 : 0);
        tr_item((which ? wu : wg) + eo, 256, WGU + (size_t)ge * 512 * 1024, 1024, 64 * kb, n0, drow0, scr, lane); }
    else { const int kb = sub / 32, nb = sub % 32; tr_item(wd + eo, 1024, WD + (size_t)ge * 1024 * 256, 256, 64 * kb, 32 * nb, 32 * nb, scr, lane); }
}

template <int MODE>
__device__ __forceinline__ void rowpass(const float* xsrc, float* xdst, const float* gain, bf16* Hout, float* Fout, const bf16* Y, const bf16* Y2,
                                        const i32x4* TI, const f32x2* TW, const unsigned* cnt, int gw, int NGW, int lane) {
    f32x4 gv[4];
#pragma unroll
    for (int j = 0; j < 4; ++j) gv[j] = *((const f32x4*)gain + lane + 64 * j);
    int ts = 0;
    if (MODE == 2) {
        const unsigned n = lane < 32 ? __hip_atomic_load(cnt + lane * 64, RLX_AGENT) : 0u; const int tiles = (int)((n + 255u) >> 8); int incl = tiles;
#pragma unroll
        for (int o = 1; o < 32; o <<= 1) { const int t = __shfl_up(incl, o); if (lane >= o) incl += t; }
        ts = incl - tiles;
    }
    for (int m = gw; m < M; m += NGW) {
        const GAS f32x4* xr = (const GAS f32x4*)(xsrc + (size_t)m * D) + lane;
        f32x4 v[4];
#pragma unroll
        for (int j = 0; j < 4; ++j) v[j] = xr[64 * j];
        if (MODE == 1) { const GAS u32x2* yr = (const GAS u32x2*)(Y + (size_t)m * D) + lane;
#pragma unroll
            for (int j = 0; j < 4; ++j) { const u32x2 y = yr[64 * j]; v[j] += (f32x4){bflo(y.x), bfhi(y.x), bflo(y.y), bfhi(y.y)}; } }
        if (MODE == 2) { const i32x4 ti = TI[m]; const f32x2 tw = TW[m];
            const int r1 = __shfl(ts, ti.x) * 256 + ti.y, r2 = __shfl(ts, ti.z) * 256 + ti.w;
            const GAS u32x2* y1 = (const GAS u32x2*)(Y + (size_t)r1 * D) + lane; const GAS u32x2* y2 = (const GAS u32x2*)(Y + (size_t)r2 * D) + lane;
#pragma unroll
            for (int j = 0; j < 4; ++j) { const u32x2 a = y1[64 * j], b = y2[64 * j];
                v[j] += (f32x4){bflo(a.x), bfhi(a.x), bflo(a.y), bfhi(a.y)} * tw.x + (f32x4){bflo(b.x), bfhi(b.x), bflo(b.y), bfhi(b.y)} * tw.y; } }
        if (MODE == 3) { const GAS u32x2* gr = (const GAS u32x2*)(Y + (size_t)m * D) + lane; const GAS u32x2* pr = (const GAS u32x2*)(Y2 + (size_t)m * D) + lane;
#pragma unroll
            for (int j = 0; j < 4; ++j) { const u32x2 a = gr[64 * j], b = pr[64 * j];
                v[j] += (f32x4){sigmoid_f(bflo(a.x)) * bflo(b.x), sigmoid_f(bfhi(a.x)) * bfhi(b.x), sigmoid_f(bflo(a.y)) * bflo(b.y), sigmoid_f(bfhi(a.y)) * bfhi(b.y)}; } }
        if (xdst) { GAS f32x4* xo = (GAS f32x4*)(xdst + (size_t)m * D) + lane;
#pragma unroll
            for (int j = 0; j < 4; ++j) xo[64 * j] = v[j]; }
        float ss = 0.f;
#pragma unroll
        for (int j = 0; j < 4; ++j) ss += (v[j].x * v[j].x + v[j].y * v[j].y) + (v[j].z * v[j].z + v[j].w * v[j].w);
        const float r = 1.f / sqrtf(wave_sum(ss) * (1.f / D) + EPS);
        if (Fout) { GAS f32x4* fo = (GAS f32x4*)(Fout + (size_t)m * D) + lane;
#pragma unroll
            for (int j = 0; j < 4; ++j) fo[64 * j] = v[j] * r * gv[j]; }
        else { GAS u32x2* ho = (GAS u32x2*)(Hout + (size_t)m * D) + lane;
#pragma unroll
            for (int j = 0; j < 4; ++j) { const f32x4 o = v[j] * r * gv[j]; ho[64 * j] = (u32x2){pk2(o.x, o.y), pk2(o.z, o.w)}; } }
    }
}

__device__ __forceinline__ f32x2 glu2(unsigned ua, unsigned ug) { return (f32x2){bflo(ua) * sigmoid_f(bflo(ug)), bfhi(ua) * sigmoid_f(bfhi(ug))}; }
__device__ __forceinline__ void conv_phase(const bf16* U, bf16* C, const float* wdw, const float* bdw, const float* lng, const float* lnb, LAS unsigned char* lds, int vcu, int G, int tid, int lane, int wave) {
    const int c0 = 2 * tid;
    f32x2 w[CWID];
#pragma unroll
    for (int j = 0; j < CWID; ++j) w[j] = *(const f32x2*)(wdw + j * D + c0);
    const f32x2 bd = *(const f32x2*)(bdw + c0);
    LAS unsigned* yb = (LAS unsigned*)lds;
    for (int chunk = vcu; chunk < M / 32; chunk += G) {
        const int b = chunk >> 7, t0 = (chunk & 127) * 32; const size_t rb = (size_t)b * SEQ;
        const bf16* Ub = U + rb * 2048 + c0;
        f32x2 win[CWID];
#pragma unroll
        for (int s = 0; s < CWID; ++s) { const int tau = t0 - 30 + s; const int tc = tau < 0 ? 0 : tau;
            const unsigned ua = *(const GAS unsigned*)(Ub + (size_t)tc * 2048), ug = *(const GAS unsigned*)(Ub + (size_t)tc * 2048 + 1024);
            const f32x2 gl = glu2(ua, ug); win[s] = tau < 0 ? (f32x2){0.f, 0.f} : gl; }
        { f32x2 a = bd;
#pragma unroll
          for (int j = 0; j < CWID; ++j) a += w[j] * win[j];
          yb[tid] = pk2(a.x, a.y); }
#pragma unroll
        for (int s = 0; s < CWID; ++s) { const int tau = t0 + 1 + s;
            const unsigned ua = *(const GAS unsigned*)(Ub + (size_t)tau * 2048), ug = *(const GAS unsigned*)(Ub + (size_t)tau * 2048 + 1024);
            win[s] = glu2(ua, ug);
            f32x2 a = bd;
#pragma unroll
            for (int j = 0; j < CWID; ++j) a += w[j] * win[(s + 1 + j) % CWID];
            yb[(1 + s) * 512 + tid] = pk2(a.x, a.y); }
        LDS_WAIT(); __syncthreads();
#pragma unroll 1
        for (int rr = 0; rr < 4; ++rr) { const int r = wave * 4 + rr;
            const v4u p0 = *(const LAS v4u*)(lds + r * 2048 + lane * 16), p1 = *(const LAS v4u*)(lds + r * 2048 + 1024 + lane * 16);
            float x[16] = {bflo(p0.x), bfhi(p0.x), bflo(p0.y), bfhi(p0.y), bflo(p0.z), bfhi(p0.z), bflo(p0.w), bfhi(p0.w), bflo(p1.x), bfhi(p1.x), bflo(p1.y), bfhi(p1.y), bflo(p1.z), bfhi(p1.z), bflo(p1.w), bfhi(p1.w)};
            float s = 0.f;
#pragma unroll
            for (int i = 0; i < 16; ++i) s += x[i];
            const float mu = wave_sum(s) * (1.f / D); float q = 0.f;
#pragma unroll
            for (int i = 0; i < 16; ++i) { x[i] -= mu; q += x[i] * x[i]; }
            const float rs = 1.f / sqrtf(wave_sum(q) * (1.f / D) + EPS);
            unsigned o[8];
#pragma unroll
            for (int hh = 0; hh < 2; ++hh) { const f32x4 g0 = *(const f32x4*)(lng + hh * 512 + lane * 8), g1 = *(const f32x4*)(lng + hh * 512 + lane * 8 + 4), b0 = *(const f32x4*)(lnb + hh * 512 + lane * 8), b1 = *(const f32x4*)(lnb + hh * 512 + lane * 8 + 4);
                float y[8] = {x[hh * 8 + 0] * rs * g0.x + b0.x, x[hh * 8 + 1] * rs * g0.y + b0.y, x[hh * 8 + 2] * rs * g0.z + b0.z, x[hh * 8 + 3] * rs * g0.w + b0.w,
                              x[hh * 8 + 4] * rs * g1.x + b1.x, x[hh * 8 + 5] * rs * g1.y + b1.y, x[hh * 8 + 6] * rs * g1.z + b1.z, x[hh * 8 + 7] * rs * g1.w + b1.w};
#pragma unroll
                for (int i = 0; i < 4; ++i) o[hh * 4 + i] = pk2(y[2 * i] * sigmoid_f(y[2 * i]), y[2 * i + 1] * sigmoid_f(y[2 * i + 1])); }
            bf16* cr = C + (rb + t0 + r) * D;
            *(GAS v4u*)(cr + lane * 8) = (v4u){o[0], o[1], o[2], o[3]}; *(GAS v4u*)(cr + 512 + lane * 8) = (v4u){o[4], o[5], o[6], o[7]}; }
        LDS_WAIT(); __syncthreads();
    }
}

__device__ __forceinline__ void rope_phase(bf16* Q, bf16* K, const int* pos, int gtid, int NT) {
    for (int idx = gtid; idx < M * 32; idx += NT) {
        const int m = idx >> 5, sub = idx & 31; bf16* p = ((sub & 16) ? K : Q) + (size_t)m * D + (sub & 15) * 64;
        v4u a = *(GAS v4u*)p, b = *(GAS v4u*)(p + 8); const float fp = (float)pos[m];
        unsigned ua[4] = {a.x, a.y, a.z, a.w}, ub[4] = {b.x, b.y, b.z, b.w};
#pragma unroll
        for (int i2 = 0; i2 < 4; ++i2) { float n1[2], n2[2];
#pragma unroll
            for (int e = 0; e < 2; ++e) { const int i = 2 * i2 + e; const float invf = __builtin_powf(500000.0f, -(float)i / 8.0f);
                const float ang = fp * invf, rev = ang * 0.15915494309189535f, fr = rev - __builtin_floorf(rev);
                const float sn = __builtin_amdgcn_sinf(fr), cs = __builtin_amdgcn_cosf(fr);
                const float x1 = e ? bfhi(ua[i2]) : bflo(ua[i2]), x2 = e ? bfhi(ub[i2]) : bflo(ub[i2]);
                n1[e] = x1 * cs - x2 * sn; n2[e] = x2 * cs + x1 * sn; }
            ua[i2] = pk2(n1[0], n1[1]); ub[i2] = pk2(n2[0], n2[1]); }
        *(GAS v4u*)p = (v4u){ua[0], ua[1], ua[2], ua[3]}; *(GAS v4u*)(p + 8) = (v4u){ub[0], ub[1], ub[2], ub[3]};
    }
}

__device__ __forceinline__ void combine_phase(const bf16* O0, const bf16* O1, bf16* OC, const float* lamp, const float* subln, int gw, int NGW, int lane) {
    const float l1 = wave_sum(lamp[lane] * lamp[64 + lane]), l2 = wave_sum(lamp[128 + lane] * lamp[192 + lane]);
    const float lam = __expf(l1) - __expf(l2) + LAM_INIT;
    float gsc[16];
#pragma unroll
    for (int i = 0; i < 16; ++i) gsc[i] = subln[(lane & 7) * 16 + i] * (1.0f - LAM_INIT);
    for (int m = gw; m < M; m += NGW) {
        const v4u a0 = *(const GAS v4u*)(O0 + (size_t)m * D + lane * 16), a1 = *(const GAS v4u*)(O0 + (size_t)m * D + lane * 16 + 8);
        const v4u b0 = *(const GAS v4u*)(O1 + (size_t)m * D + lane * 16), b1 = *(const GAS v4u*)(O1 + (size_t)m * D + lane * 16 + 8);
        const unsigned ua[8] = {a0.x, a0.y, a0.z, a0.w, a1.x, a1.y, a1.z, a1.w}, ub[8] = {b0.x, b0.y, b0.z, b0.w, b1.x, b1.y, b1.z, b1.w};
        float o[16]; float ss = 0.f;
#pragma unroll
        for (int i = 0; i < 8; ++i) { o[2 * i] = bflo(ua[i]) - lam * bflo(ub[i]); o[2 * i + 1] = bfhi(ua[i]) - lam * bfhi(ub[i]); ss += o[2 * i] * o[2 * i] + o[2 * i + 1] * o[2 * i + 1]; }
        ss += __shfl_xor(ss, 1); ss += __shfl_xor(ss, 2); ss += __shfl_xor(ss, 4);
        const float r = 1.f / sqrtf(ss * (1.f / 128.f) + EPS);
        unsigned w[8];
#pragma unroll
        for (int i = 0; i < 8; ++i) w[i] = pk2(o[2 * i] * r * gsc[2 * i], o[2 * i + 1] * r * gsc[2 * i + 1]);
        *(GAS v4u*)(OC + (size_t)m * D + lane * 16) = (v4u){w[0], w[1], w[2], w[3]}; *(GAS v4u*)(OC + (size_t)m * D + lane * 16 + 8) = (v4u){w[4], w[5], w[6], w[7]};
    }
}

__device__ __forceinline__ void select_phase(const float* LOG, const float* brg, const float* bre, unsigned* cnt, int* list, i32x4* TI, f32x2* TW, LAS int* lh, int vcu, int G, int tid) {
    for (int base = vcu * 128; base < M; base += G * 128) {
        if (tid < 32) lh[tid] = 0;
        __syncthreads();
        const int t = base + tid; int E1 = 0, E2 = 0, r1 = 0, r2 = 0; float w1 = 0.f, w2 = 0.f;
        if (tid < 128) {
            const f32x4 g4 = *(const GAS f32x4*)(LOG + (size_t)t * 64);
            const float gl[4] = {g4.x + brg[0], g4.y + brg[1], g4.z + brg[2], g4.w + brg[3]};
            int gi = 0; float gm = gl[0];
#pragma unroll
            for (int j = 1; j < 4; ++j) if (gl[j] > gm) { gm = gl[j]; gi = j; }
            float den = 0.f;
#pragma unroll
            for (int j = 0; j < 4; ++j) den += __expf(gl[j] - gm);
            const float gw_ = 1.f / den;
            const f32x4 ea = *(const GAS f32x4*)(LOG + (size_t)t * 64 + 4 + gi * 8), eb = *(const GAS f32x4*)(LOG + (size_t)t * 64 + 8 + gi * 8);
            const f32x4 ba = *(const f32x4*)(bre + gi * 8), bb = *(const f32x4*)(bre + gi * 8 + 4);
            const float el[8] = {ea.x + ba.x, ea.y + ba.y, ea.z + ba.z, ea.w + ba.w, eb.x + bb.x, eb.y + bb.y, eb.z + bb.z, eb.w + bb.w};
            int i1 = 0; float v1 = el[0];
#pragma unroll
            for (int j = 1; j < 8; ++j) if (el[j] > v1) { v1 = el[j]; i1 = j; }
            int i2 = -1; float v2 = -INFINITY;
#pragma unroll
            for (int j = 0; j < 8; ++j) if (j != i1 && (i2 < 0 || el[j] > v2)) { v2 = el[j]; i2 = j; }
            const float e2 = __expf(v2 - v1); const float p1 = 1.f / (1.f + e2);
            w1 = p1 * gw_; w2 = (e2 * p1) * gw_; E1 = gi * 8 + i1; E2 = gi * 8 + i2;
            r1 = __hip_atomic_fetch_add(lh + E1, 1, __ATOMIC_RELAXED, __HIP_MEMORY_SCOPE_WORKGROUP); r2 = __hip_atomic_fetch_add(lh + E2, 1, __ATOMIC_RELAXED, __HIP_MEMORY_SCOPE_WORKGROUP);
        }
        __syncthreads();
        if (tid < 32) { const int c = lh[tid]; int bs = 0; if (c) bs = (int)__hip_atomic_fetch_add(cnt + tid * 64, (unsigned)c, RLX_AGENT); lh[32 + tid] = bs; }
        __syncthreads();
        if (tid < 128) { const int s1 = lh[32 + E1] + r1, s2 = lh[32 + E2] + r2;
            list[(size_t)E1 * M + s1] = t; list[(size_t)E2 * M + s2] = t; TI[t] = (i32x4){E1, s1, E2, s2}; TW[t] = (f32x2){w1, w2}; }
        __syncthreads();
    }
}

struct GroupedOrder {
    int nNs, G, c, ntu;
    const LAS int* tile_e; const LAS int* tokl;
    __device__ __forceinline__ bool next(int i, pg8::Unit& u) const { const int L = i * G + c; if (L >= ntu) return false; const int mt = L >> nNs, pn = L & ((1 << nNs) - 1);
        const int e = tile_e[mt]; u.pm = mt; u.pn = pn; u.pb = (e << nNs) + pn; return true; }
    __device__ __forceinline__ unsigned arow(int ord, int r) const { return (unsigned)tokl[ord * 256 + r]; }
};
__device__ __forceinline__ GroupedOrder grouped_setup(const unsigned* cnt, const int* list, LAS unsigned char* lds, bool need_tok, int nNs, int G, int c, int tid, int lane, int wave) {
    LAS int* ts = (LAS int*)(lds + L_TS); LAS int* ne = (LAS int*)(lds + L_NE); LAS int* te = (LAS int*)(lds + L_TE); LAS int* tokl = (LAS int*)(lds + L_TOK);
    __syncthreads();
    if (wave == 0) {
        const unsigned n = lane < 32 ? __hip_atomic_load(cnt + lane * 64, RLX_AGENT) : 0u; const int tiles = (int)((n + 255u) >> 8); int incl = tiles;
#pragma unroll
        for (int o = 1; o < 32; o <<= 1) { const int t = __shfl_up(incl, o); if (lane >= o) incl += t; }
        const int excl = incl - tiles;
        if (lane < 32) { ts[lane] = excl; ne[lane] = (int)n; for (int k = 0; k < tiles; ++k) te[excl + k] = lane; }
        if (lane == 31) ts[32] = incl;
    }
    __syncthreads();
    GroupedOrder S; S.nNs = nNs; S.G = G; S.c = c; S.ntu = ts[32] << nNs; S.tile_e = te; S.tokl = tokl;
    if (need_tok) {
        for (int i = 0; i < MAXGU; ++i) { const int L = i * G + c; if (L >= S.ntu) break; const int mt = L >> nNs, e = te[mt];
            if (tid < 256) { const int slot = (mt - ts[e]) * 256 + tid; tokl[i * 256 + tid] = slot < ne[e] ? list[(size_t)e * M + slot] : 0; } }
        if (S.ntu > MAXGU * G) S.ntu = MAXGU * G;
        __syncthreads();
    }
    return S;
}

enum { I_X = 0, I_P, I_POS, I_NMIX, I_NFFN, I_CW1, I_CB1, I_CDW, I_CBDW, I_CLNG, I_CLNB, I_CW2, I_CB2, I_WQKV, I_LAM, I_SUBLN, I_WO,
       I_WRG, I_BRG, I_WRE, I_BRE, I_WG, I_WU, I_WDN, I_PNORM, I_PWG, I_PWP, I_FNORM, N_IN };
struct Args { const void* in[N_IN]; float* out; unsigned char* ws; int ph_lo, ph_hi; };

typedef const __attribute__((address_space(4))) Args* KArgP;
#define PH_IDS() const int tid = pg8::ltid(wave), lane = tid & 63, gtid = vcu * (NWAVES * 64) + tid; (void)lane; (void)gtid
__device__ __forceinline__ KArgP kargs() { KArgP k = (KArgP)__builtin_amdgcn_kernarg_segment_ptr(); asm volatile("" : "+s"(k)); return k; }
#define IN_F(k) ((const float*)ka->in[k])
#define WSP(off) ((bf16*)(ka->ws + (off)))
#define SLOT(i) ((bf16*)(ka->ws + WS_S0 + (size_t)(i) * WS_SS))
#define IN(k) (lo <= (k) && (k) < hi)
#define SEAM(k) do { if (IN(k) && IN((k) + 1)) xcd_barrier(bar); } while (0)
template <int l>
__device__ __forceinline__ void layer_tail(LAS unsigned char* lds, const XcdBarrier& bar, int lo, int hi, int wave, int G, int bx, int vcu, int gw, int NGW, int NTHR) {
    constexpr int pb = l ? 17 : 4;
    LAS float* scr = (LAS float*)(lds + RING_OFF + wave * 16384);
    if (IN(pb)) { KArgP ka = kargs(); PH_IDS(); rowpass<1>(l ? ka->out : IN_F(I_X), ka->out, IN_F(I_NFFN) + l * D, WSP(WS_H), nullptr, l ? SLOT(1) : SLOT(3), nullptr, nullptr, nullptr, nullptr, gw, NGW, lane); }
    SEAM(pb);
    if (IN(pb + 1)) { KArgP ka = kargs(); PH_IDS(); pg8::Gemm g{WSP(WS_H), WSP(WS_WR) + (size_t)l * 256 * D, M, 256, D}; pg8::StaticOrder S; S.init(M, 256, G, bx);
        pg8::EpiLogits E{(float*)(ka->ws + WS_LOG)};
        pg8::gemm_phase<pg8::EpiLogits, pg8::StaticOrder, true, false>(lds + RING_OFF, g, S, E, wave); }
    SEAM(pb + 1);
    if (IN(pb + 2)) { KArgP ka = kargs(); PH_IDS(); select_phase((const float*)(ka->ws + WS_LOG), IN_F(I_BRG) + l * 4, IN_F(I_BRE) + l * 32, (unsigned*)(ka->ws + WS_CTL) + CW_CNT + l * 32 * 64,
                                   (int*)(ka->ws + WS_LIST), (i32x4*)(ka->ws + WS_TI), (f32x2*)(ka->ws + WS_TW), (LAS int*)(lds + L_HIST), vcu, G, tid); }
    SEAM(pb + 2);
    if (IN(pb + 3)) { KArgP ka = kargs(); PH_IDS(); const GroupedOrder S = grouped_setup((const unsigned*)(ka->ws + WS_CTL) + CW_CNT + l * 32 * 64, (const int*)(ka->ws + WS_LIST), lds, true, 1, G, bx, tid, lane, wave);
        pg8::Gemm g{WSP(WS_H), WSP(WS_WGU), M, 512, D}; pg8::EpiGU E{l ? SLOT(1) : SLOT(4)};
        pg8::gemm_phase<pg8::EpiGU, GroupedOrder, true, true>(lds + RING_OFF, g, S, E, wave); }
    SEAM(pb + 3);
    if (IN(pb + 4)) { KArgP ka = kargs(); PH_IDS(); const GroupedOrder S = grouped_setup((const unsigned*)(ka->ws + WS_CTL) + CW_CNT + l * 32 * 64, (const int*)(ka->ws + WS_LIST), lds, false, 2, G, bx, tid, lane, wave);
        pg8::Gemm g{l ? SLOT(1) : SLOT(4), WSP(WS_WD), PADROWS, D, FE}; pg8::EpiBf16 E{l ? SLOT(2) : SLOT(0), D, nullptr, 0, 0, 1.f};
        pg8::gemm_phase<pg8::EpiBf16, GroupedOrder, true, false>(lds + RING_OFF, g, S, E, wave); }
    SEAM(pb + 4);
    if (IN(pb + 5)) { KArgP ka = kargs(); PH_IDS(); rowpass<2>(ka->out, ka->out, IN_F(I_PNORM) + l * D, WSP(WS_H), nullptr, l ? SLOT(2) : SLOT(0), nullptr, (const i32x4*)(ka->ws + WS_TI), (const f32x2*)(ka->ws + WS_TW),
                                                    (const unsigned*)(ka->ws + WS_CTL) + CW_CNT + l * 32 * 64, gw, NGW, lane); }
    SEAM(pb + 5);
    if (IN(pb + 6)) {
        { KArgP ka = kargs(); PH_IDS(); pg8::Gemm g{WSP(WS_P16) + (size_t)l * M * PLED, WSP(WS_WPP) + (size_t)l * D * PLED, M, D, PLED}; pg8::StaticOrder S; S.init(M, D, G, bx);
          pg8::EpiBf16 E{l ? SLOT(0) : SLOT(3), D, nullptr, 0, 0, 1.f};
          pg8::gemm_phase<pg8::EpiBf16, pg8::StaticOrder, true, false>(lds + RING_OFF, g, S, E, wave); }
        { KArgP ka = kargs(); PH_IDS(); pg8::Gemm g{WSP(WS_H), WSP(WS_WPG) + (size_t)l * D * D, M, D, D}; pg8::StaticOrder S; S.init(M, D, G, bx);
          pg8::EpiBf16 E{l ? SLOT(1) : SLOT(4), D, nullptr, 0, 0, 1.f};
          pg8::gemm_phase<pg8::EpiBf16, pg8::StaticOrder, true, false>(lds + RING_OFF, g, S, E, wave); }
    }
    SEAM(pb + 6);
    if (IN(pb + 7)) {
        if (l == 0) { { KArgP ka = kargs(); PH_IDS(); rowpass<3>(ka->out, ka->out, IN_F(I_NMIX) + D, WSP(WS_H), nullptr, SLOT(4), SLOT(3), nullptr, nullptr, nullptr, gw, NGW, lane); }
            { KArgP ka = kargs(); PH_IDS(); for (int it = gw; it < MOE_ITEMS; it += NGW) moe_item(IN_F(I_WG), IN_F(I_WU), IN_F(I_WDN), 1, WSP(WS_WGU), WSP(WS_WD), it, scr, lane); } }
        else { KArgP ka = kargs(); PH_IDS(); rowpass<3>(ka->out, nullptr, IN_F(I_FNORM), nullptr, ka->out, SLOT(1), SLOT(0), nullptr, nullptr, nullptr, gw, NGW, lane); }
    }
    if (l == 0) SEAM(pb + 7);
}
__global__ void __launch_bounds__(NWAVES * 64, 2) mk_fwd(Args args) {
    extern __shared__ __attribute__((aligned(16))) unsigned char lds_raw[];
    LAS unsigned char* lds = (LAS unsigned char*)lds_raw;
    const int tid0 = threadIdx.x, wave = __builtin_amdgcn_readfirstlane(tid0 >> 6);
    const int G = gridDim.x; const int bx = blockIdx.x; const int vcu = (G % 8 == 0) ? (bx % 8) * (G / 8) + bx / 8 : bx;
    const int gw = vcu * NWAVES + wave, NGW = G * NWAVES, NTHR = G * NWAVES * 64;
    gu32* ctl = (gu32*)(args.ws + WS_CTL);
    for (int u = tid0; u < (LDS_BYTES - LDSCTL_OFF) / 4; u += NWAVES * 64) ((LAS unsigned*)(lds + LDSCTL_OFF))[u] = 0u;
    __syncthreads();
    XcdBarrier bar = xcd_barrier_post((unsigned*)ctl + CW_BAR, (volatile LAS unsigned*)(lds + L_MISC) + 8);
    const int lo = args.ph_lo, hi = args.ph_hi;

    LAS float* scr = (LAS float*)(lds + RING_OFF + wave * 16384);

    if (IN(0)) {
        constexpr int I1 = 16 * 64, I2 = 16 * 32, I3 = 16 * 96, I4 = 16 * 32, I5 = 16 * 32, I6 = 4 * 32;
        constexpr int NIT = I1 + I2 + I3 + I4 + 2 * I5 + 2 * I6;
        { KArgP ka = kargs(); PH_IDS();
          for (int it = gw; it < NIT + MOE_ITEMS; it += NGW) {
            int r = it;
            if (r < I1) { tr_plain(IN_F(I_CW1), D, 2048, WSP(WS_WPW1), r, scr, lane); continue; } r -= I1;
            if (r < I2) { tr_plain(IN_F(I_CW2), D, D, WSP(WS_WPW2), r, scr, lane); continue; } r -= I2;
            if (r < I3) { tr_plain(IN_F(I_WQKV), D, NQKV, WSP(WS_WQKV), r, scr, lane); continue; } r -= I3;
            if (r < I4) { tr_plain(IN_F(I_WO), D, D, WSP(WS_WO), r, scr, lane); continue; } r -= I4;
            if (r < 2 * I5) { const int l = r / I5; tr_plain(IN_F(I_PWG) + (size_t)l * D * D, D, D, WSP(WS_WPG) + (size_t)l * D * D, r % I5, scr, lane); continue; } r -= 2 * I5;
            if (r < 2 * I6) { const int l = r / I6; tr_plain(IN_F(I_PWP) + (size_t)l * PLED * D, PLED, D, WSP(WS_WPP) + (size_t)l * D * PLED, r % I6, scr, lane); continue; } r -= 2 * I6;
            moe_item(IN_F(I_WG), IN_F(I_WU), IN_F(I_WDN), 0, WSP(WS_WGU), WSP(WS_WD), r, scr, lane);
          } }
        { KArgP ka = kargs(); PH_IDS(); const float* wrg = IN_F(I_WRG); const float* wre = IN_F(I_WRE); bf16* Wr = WSP(WS_WR);
          for (int idx = gtid; idx < 2 * 256 * 1024; idx += NTHR) { const int l = idx >> 18, row = (idx >> 10) & 255, k = idx & 1023; float v = 0.f;
              if (row < 4) v = wrg[((size_t)l * D + k) * 4 + row]; else if (row < 36) { const int g = (row - 4) >> 3, e = (row - 4) & 7; v = wre[(((size_t)l * 4 + g) * D + k) * 8 + e]; }
              Wr[idx] = (bf16)f2bf(v); } }
        { KArgP ka = kargs(); PH_IDS(); const f32x4* p4 = (const f32x4*)ka->in[I_P]; u32x2* o = (u32x2*)WSP(WS_P16);
          for (int idx = gtid; idx < 2 * M * PLED / 4; idx += NTHR) { const f32x4 v = p4[idx]; o[idx] = (u32x2){pk2(v.x, v.y), pk2(v.z, v.w)}; } }
        { KArgP ka = kargs(); PH_IDS(); rowpass<0>(IN_F(I_X), nullptr, IN_F(I_NMIX), WSP(WS_H), nullptr, nullptr, nullptr, nullptr, nullptr, nullptr, gw, NGW, lane); }
    }
    SEAM(0);


    if (IN(1)) { KArgP ka = kargs(); PH_IDS(); pg8::Gemm g{WSP(WS_H), WSP(WS_WPW1), M, 2048, D}; pg8::StaticOrder S; S.init(M, 2048, G, bx);
        pg8::EpiBf16 E{SLOT(0), 2048, IN_F(I_CB1), 0, 0, 1.f};
        pg8::gemm_phase<pg8::EpiBf16, pg8::StaticOrder, true, false>(lds + RING_OFF, g, S, E, wave); }
    SEAM(1);
    if (IN(2)) { KArgP ka = kargs(); PH_IDS(); conv_phase(SLOT(0), SLOT(2), IN_F(I_CDW), IN_F(I_CBDW), IN_F(I_CLNG), IN_F(I_CLNB), lds + RING_OFF, vcu, G, tid, lane, wave); }
    SEAM(2);
    if (IN(3)) { KArgP ka = kargs(); PH_IDS(); pg8::Gemm g{SLOT(2), WSP(WS_WPW2), M, D, D}; pg8::StaticOrder S; S.init(M, D, G, bx);
        pg8::EpiBf16 E{SLOT(3), D, IN_F(I_CB2), 0, 0, 1.f};
        pg8::gemm_phase<pg8::EpiBf16, pg8::StaticOrder, true, false>(lds + RING_OFF, g, S, E, wave); }
    SEAM(3);
    layer_tail<0>(lds, bar, lo, hi, wave, G, bx, vcu, gw, NGW, NTHR);

    if (IN(12)) { KArgP ka = kargs(); PH_IDS(); pg8::Gemm g{WSP(WS_H), WSP(WS_WQKV), M, NQKV, D}; pg8::StaticOrder S; S.init(M, NQKV, G, bx);
        pg8::EpiBf16 E{SLOT(0), D, nullptr, D, (size_t)(WS_SS / 2), attn_body::C2};
        pg8::gemm_phase<pg8::EpiBf16, pg8::StaticOrder, true, false>(lds + RING_OFF, g, S, E, wave); }
    SEAM(12);
    if (IN(13)) { KArgP ka = kargs(); PH_IDS(); rope_phase(SLOT(0), SLOT(1), (const int*)ka->in[I_POS], gtid, NTHR); }
    SEAM(13);
    if (IN(14)) { KArgP ka = kargs(); PH_IDS(); const attn_body::AttnTensors AT{(const attn_body::bf16*)SLOT(0), (const attn_body::bf16*)SLOT(1), (const attn_body::bf16*)SLOT(2), (attn_body::bf16*)SLOT(3), (attn_body::bf16*)SLOT(4)};
        const attn_body::ComboOrder S{vcu, G};
        attn_body::attn_phase<attn_body::ComboOrder>((char*)lds_raw + RING_OFF, AT, S, wave); }
    SEAM(14);
    if (IN(15)) { KArgP ka = kargs(); PH_IDS(); combine_phase(SLOT(3), SLOT(4), SLOT(0), IN_F(I_LAM), IN_F(I_SUBLN), gw, NGW, lane); }
    SEAM(15);
    if (IN(16)) { KArgP ka = kargs(); PH_IDS(); pg8::Gemm g{SLOT(0), WSP(WS_WO), M, D, D}; pg8::StaticOrder S; S.init(M, D, G, bx);
        pg8::EpiBf16 E{SLOT(1), D, nullptr, 0, 0, 1.f};
        pg8::gemm_phase<pg8::EpiBf16, pg8::StaticOrder, true, false>(lds + RING_OFF, g, S, E, wave); }
    SEAM(16);
    layer_tail<1>(lds, bar, lo, hi, wave, G, bx, vcu, gw, NGW, NTHR);
#undef IN
#undef SEAM
}

extern "C" void kernel_launch(void* const* d_in, const int* in_sizes, int n_in, void* d_out, int out_size, void* d_ws, size_t ws_size, hipStream_t stream) {
    static int grid = 0;
    if (grid == 0) {
        if (n_in != N_IN || in_sizes[0] != M * D || out_size != M * D || ws_size < WS_END) { fprintf(stderr, "kernel_launch: unexpected problem: n_in %d in0 %d out %d ws %zu (need %zu); nothing launched\n", n_in, n_in > 0 ? in_sizes[0] : -1, out_size, ws_size, (size_t)WS_END); grid = -1; return; }
        int dev = 0, cus = 0, per_cu = 0;
        if (hipGetDevice(&dev) != hipSuccess || hipDeviceGetAttribute(&cus, hipDeviceAttributeMultiprocessorCount, dev) != hipSuccess) { grid = -1; return; }
        if (hipFuncSetAttribute((const void*)mk_fwd, hipFuncAttributeMaxDynamicSharedMemorySize, LDS_BYTES) != hipSuccess) { fprintf(stderr, "kernel_launch: hipFuncSetAttribute failed\n"); grid = -1; return; }
        if (hipOccupancyMaxActiveBlocksPerMultiprocessor(&per_cu, (const void*)mk_fwd, NWAVES * 64, LDS_BYTES) != hipSuccess || per_cu < 1) { fprintf(stderr, "kernel_launch: occupancy query says %d\n", per_cu); }
        (void)hipGetLastError();
        grid = cus;
        if (grid > 256) grid = 256;
    }
    if (grid < 0) return;
    if (hipMemsetAsync((char*)d_ws + WS_CTL, 0, CTL_ZERO_BYTES, stream) != hipSuccess) return;
    Args a{};
    for (int i = 0; i < N_IN; ++i) a.in[i] = d_in[i];
    a.out = (float*)d_out; a.ws = (unsigned char*)d_ws;
#if MK_SPLIT
    for (int ph = 0; ph < NPHASE; ++ph) { a.ph_lo = ph; a.ph_hi = ph + 1; hipLaunchKernelGGL(mk_fwd, dim3(grid), dim3(NWAVES * 64), LDS_BYTES, stream, a); }
#else
    a.ph_lo = 0; a.ph_hi = NPHASE; hipLaunchKernelGGL(mk_fwd, dim3(grid), dim3(NWAVES * 64), LDS_BYTES, stream, a);
#endif
}
```

```cpp
#include <hip/hip_runtime.h>
#include <hip/hip_bf16.h>
#include <cstdio>
#include <cstdint>
#include <cmath>

#ifndef MK_SPLIT
#define MK_SPLIT 0
#endif

namespace pg8 {
#define PG8_LAS __attribute__((address_space(3)))
typedef unsigned short bf16_t;
typedef short bf16x8 __attribute__((ext_vector_type(8)));
typedef float f32x4 __attribute__((ext_vector_type(4)));
typedef unsigned u32x4 __attribute__((ext_vector_type(4)));
constexpr int BM = 256, BK = 64, HALF = 128, HTB = HALF * BK * 2  , STAGE_BYTES = 8 * HTB, NXCD = 8, WGM = 8;

__host__ __device__ __forceinline__ int lds_byte(int r, int c) { const int st = (r >> 4) * 2 + (c >> 5), rr = r & 15, cc = c & 31, ob = rr * 64 + cc * 2; return st * 1024 + (ob ^ (((ob >> 9) & 1) << 5)); }
__host__ __device__ __forceinline__ void stage_rc(int b, int& R, int& C) { const int st = b / 1024, sb = b % 1024, swz = sb ^ (((sb >> 9) & 1) << 5); R = (st >> 1) * 16 + swz / 64; C = (st & 1) * 32 + (swz % 64) / 2; }
__host__ __device__ __forceinline__ int perm32(int rho) { const int n = rho >> 4, i = rho & 15; return 8 * (i >> 2) + 4 * n + (i & 3); }

__device__ __forceinline__ int ltid(int wave) { int t = wave * 64 + (int)__builtin_amdgcn_mbcnt_hi(0xffffffffu, __builtin_amdgcn_mbcnt_lo(0xffffffffu, 0u)); asm volatile("" : "+v"(t)); return t; }
struct Unit { int pm, pn, pb; };
struct Gemm { const bf16_t* A; const bf16_t* Bt; int M, N, K; };

struct StaticOrder {
    int nM, nN, nwg, G, c;
    __host__ __device__ void init(int M, int N, int G_, int c_) { nM = M / BM; nN = N / BM; nwg = nM * nN; G = G_; c = c_; }
    __host__ __device__ bool next(int i, Unit& u) const {
        const long L = (long)i * G + c; if (L >= nwg) return false;
        int wgid = (int)L; { const int q = nwg / NXCD, r = nwg % NXCD, xcd = wgid % NXCD, off = wgid / NXCD; wgid = (xcd < r ? xcd * (q + 1) : r * (q + 1) + (xcd - r) * q) + off; }
        const int nig = WGM * nN, gid = wgid / nig, fm = gid * WGM, gsz = (nM - fm) < WGM ? (nM - fm) : WGM;
        u.pm = fm + ((wgid % nig) % gsz); u.pn = (wgid % nig) / gsz; u.pb = u.pn; return true;
    }
    __device__ __forceinline__ unsigned arow(int, int) const { return 0u; }
};

__device__ __forceinline__ unsigned cvt_pk_bf16(float lo, float hi) { unsigned r; asm volatile("v_cvt_pk_bf16_f32 %0, %1, %2" : "=v"(r) : "v"(lo), "v"(hi)); return r; }

struct EpiBf16 {
    static constexpr bool PERM = true;
    bf16_t* O; int ldc; const float* bias; int split_cols; size_t split_stride; float scale0;
    __device__ __forceinline__ void operator()(const f32x4 (&acc)[2][2][4][2], const Unit& u, int wr, int wc, int fr, int fq) const {
        const int row0 = u.pm * BM + wr * 64 + fr; int colt = u.pn * BM; bf16_t* base = O;
        float sc = 1.f; if (split_cols) { const int t = colt / split_cols; base += (size_t)t * split_stride; colt -= t * split_cols; if (t == 0) sc = scale0; }
        const int col0 = colt + wc * 32 + 8 * fq, bcol0 = u.pn * BM + wc * 32 + 8 * fq;
        f32x4 bv[2][2];
#pragma unroll
        for (int bj = 0; bj < 2; ++bj)
#pragma unroll
            for (int n = 0; n < 2; ++n) bv[bj][n] = bias ? *(const f32x4*)(bias + bcol0 + bj * HALF + 4 * n) : (f32x4){0.f, 0.f, 0.f, 0.f};
#pragma unroll
        for (int ai = 0; ai < 2; ++ai)
#pragma unroll
            for (int m = 0; m < 4; ++m) { bf16_t* rowp = base + (size_t)(row0 + ai * HALF + m * 16) * ldc + col0;
#pragma unroll
                for (int bj = 0; bj < 2; ++bj) { f32x4 v0 = acc[ai][bj][m][0] + bv[bj][0], v1 = acc[ai][bj][m][1] + bv[bj][1];
                    v0 = v0 * sc; v1 = v1 * sc; u32x4 w; w.x = cvt_pk_bf16(v0[0], v0[1]); w.y = cvt_pk_bf16(v0[2], v0[3]); w.z = cvt_pk_bf16(v1[0], v1[1]); w.w = cvt_pk_bf16(v1[2], v1[3]);
                    *(u32x4*)(rowp + bj * HALF) = w; } }
    }
};
struct EpiLogits {
    static constexpr bool PERM = false;
    float* O;
    __device__ __forceinline__ void operator()(const f32x4 (&acc)[2][2][4][2], const Unit& u, int wr, int wc, int fr, int fq) const {
        if (wc < 2) {
            const int row0 = u.pm * BM + wr * 64 + fr;
#pragma unroll
            for (int ai = 0; ai < 2; ++ai)
#pragma unroll
                for (int m = 0; m < 4; ++m)
#pragma unroll
                    for (int n = 0; n < 2; ++n) *(f32x4*)(O + (size_t)(row0 + ai * HALF + m * 16) * 64 + wc * 32 + n * 16 + 4 * fq) = acc[ai][0][m][n];
        }
    }
};
__device__ __forceinline__ float silu_f(float x) { return x * __builtin_amdgcn_rcpf(1.f + __expf(-x)); }
struct EpiGU {
    static constexpr bool PERM = true;
    bf16_t* O;
    __device__ __forceinline__ void operator()(const f32x4 (&acc)[2][2][4][2], const Unit& u, int wr, int wc, int fr, int fq) const {
        const int row0 = u.pm * BM + wr * 64 + fr, col0 = u.pn * HALF + wc * 32 + 8 * fq;
#pragma unroll
        for (int ai = 0; ai < 2; ++ai)
#pragma unroll
            for (int m = 0; m < 4; ++m) { bf16_t* rowp = O + (size_t)(row0 + ai * HALF + m * 16) * 256 + col0;
                const f32x4 g0 = acc[ai][0][m][0], g1 = acc[ai][0][m][1], u0 = acc[ai][1][m][0], u1 = acc[ai][1][m][1];
                u32x4 w; w.x = cvt_pk_bf16(silu_f(g0[0]) * u0[0], silu_f(g0[1]) * u0[1]); w.y = cvt_pk_bf16(silu_f(g0[2]) * u0[2], silu_f(g0[3]) * u0[3]);
                w.z = cvt_pk_bf16(silu_f(g1[0]) * u1[0], silu_f(g1[1]) * u1[1]); w.w = cvt_pk_bf16(silu_f(g1[2]) * u1[2], silu_f(g1[3]) * u1[3]);
                *(u32x4*)rowp = w; }
    }
};

template <class Epi, class Sched, bool ALIGN_EPI, bool GATHER>
__device__ __forceinline__ void gemm_phase(PG8_LAS unsigned char* lds, const Gemm g, const Sched& S, const Epi& E, int wave_) {
    const int tid = ltid(wave_), wid = wave_, lane = tid & 63, wr = wid >> 2, wc = wid & 3, fr = lane & 15, fq = lane >> 4;
    const int K = g.K, nt = K / BK;
    unsigned voffA[2], voffB[2]; int sR[2], sC[2];
#pragma unroll
    for (int i = 0; i < 2; ++i) { int R, C; stage_rc(tid * 16 + i * 8192, R, C); const int Rb = Epi::PERM ? ((R & ~31) + perm32(R & 31)) : R;
        sR[i] = R; sC[i] = C; voffA[i] = (unsigned)(R * K + C) * 2u; voffB[i] = (unsigned)(Rb * K + C) * 2u; }
    const size_t kstep = (size_t)(BK * 2);
    const size_t hstep = (size_t)HALF * K * 2;
    const size_t tstep = 2 * hstep;
    const unsigned ldsw = (unsigned)wid * 1024u;
    const int aoff = lds_byte(wr * 64 + fr, fq * 8), boff = lds_byte(wc * 32 + fr, fq * 8);
#define PG8_SA(b, h) (((b) * 2 + (h)) * HTB)
#define PG8_SB(b, h) ((4 + (b) * 2 + (h)) * HTB)
#define PG8_STAGE(bufoff, gbase, voff) do { _Pragma("unroll") for (int _i = 0; _i < 2; ++_i) \
        __builtin_amdgcn_global_load_lds((const unsigned*)((const char*)(gbase) + (voff)[_i]), (PG8_LAS unsigned*)(lds + (bufoff) + ldsw + _i * 8192), 16, 0, 0); } while (0)
#define PG8_STAGE_A(bufoff, base, kb, h, vv) do { _Pragma("unroll") for (int _i = 0; _i < 2; ++_i) { \
        const char* _p = GATHER ? ((const char*)g.A + (kb) + (vv)[h][_i]) : ((const char*)(base) + (kb) + (size_t)(h) * hstep + voffA[_i]); \
        __builtin_amdgcn_global_load_lds((const unsigned*)_p, (PG8_LAS unsigned*)(lds + (bufoff) + ldsw + _i * 8192), 16, 0, 0); } } while (0)
#define PG8_GOFF(vv, ord) do { _Pragma("unroll") for (int _h = 0; _h < 2; ++_h) _Pragma("unroll") for (int _i = 0; _i < 2; ++_i) \
        (vv)[_h][_i] = S.arow((ord), _h * HALF + sR[_i]) * (unsigned)(K * 2) + (unsigned)(sC[_i] * 2); } while (0)
#define PG8_LDA(dst, b, h) do { _Pragma("unroll") for (int m = 0; m < 4; ++m) _Pragma("unroll") for (int k = 0; k < 2; ++k) dst[m][k] = *(const PG8_LAS bf16x8*)(lds + PG8_SA(b, h) + aoff + m * 2048 + k * 1024); } while (0)
#define PG8_LDB(dst, b, h) do { _Pragma("unroll") for (int n = 0; n < 2; ++n) _Pragma("unroll") for (int k = 0; k < 2; ++k) dst[n][k] = *(const PG8_LAS bf16x8*)(lds + PG8_SB(b, h) + boff + n * 2048 + k * 1024); } while (0)
#define PG8_MMA(ai, bj, At, Bt) do { __builtin_amdgcn_s_setprio(1); _Pragma("unroll") for (int m = 0; m < 4; ++m) _Pragma("unroll") for (int n = 0; n < 2; ++n) _Pragma("unroll") for (int k = 0; k < 2; ++k) \
        acc[ai][bj][m][n] = __builtin_amdgcn_mfma_f32_16x16x32_bf16(Bt[n][k], At[m][k], acc[ai][bj][m][n], 0, 0, 0); __builtin_amdgcn_s_setprio(0); } while (0)
#define PG8_WAIT_V(n) asm volatile("s_waitcnt vmcnt(" #n ")" ::: "memory")
#define PG8_WAIT_L(n) asm volatile("s_waitcnt lgkmcnt(" #n ")" ::: "memory")
#define PG8_BAR __builtin_amdgcn_s_barrier()
#define PG8_SCHED __builtin_amdgcn_sched_barrier(0)
    Unit cur, nxt; int ui = 0;
    if (!S.next(0, cur)) return;
    f32x4 acc[2][2][4][2];
#pragma unroll
    for (int a = 0; a < 2; ++a)
#pragma unroll
        for (int b = 0; b < 2; ++b)
#pragma unroll
            for (int m = 0; m < 4; ++m)
#pragma unroll
                for (int n = 0; n < 2; ++n) acc[a][b][m][n] = (f32x4){0.f, 0.f, 0.f, 0.f};
    bf16x8 At[4][2], B0[2][2], B1[2][2];
    unsigned vA[2][2] = {{0u, 0u}, {0u, 0u}}, vN[2][2] = {{0u, 0u}, {0u, 0u}}, vS[2][2] = {{0u, 0u}, {0u, 0u}};
    if constexpr (GATHER) { PG8_GOFF(vA, 0); }
    const char* cA = GATHER ? (const char*)g.A : (const char*)g.A + (size_t)cur.pm * tstep; const char* cB = (const char*)g.Bt + (size_t)cur.pb * tstep;
    PG8_STAGE(PG8_SB(0, 0), cB, voffB); PG8_STAGE(PG8_SB(0, 1), cB + hstep, voffB); PG8_STAGE_A(PG8_SA(0, 0), cA, 0, 0, vA); PG8_STAGE_A(PG8_SA(0, 1), cA, 0, 1, vA);
    if (wr == 1) PG8_BAR;
    PG8_WAIT_V(2); PG8_BAR;
    PG8_STAGE(PG8_SB(1, 0), cB + kstep, voffB); PG8_STAGE_A(PG8_SA(1, 0), cA, kstep, 0, vA); PG8_STAGE(PG8_SB(1, 1), cB + hstep + kstep, voffB);
    PG8_WAIT_V(6); PG8_BAR;
    for (;;) {
        const bool has_next = S.next(ui + 1, nxt);
        if constexpr (GATHER) { if (has_next) { PG8_GOFF(vN, ui + 1); } else { _Pragma("unroll") for (int _h = 0; _h < 2; ++_h) _Pragma("unroll") for (int _i = 0; _i < 2; ++_i) vN[_h][_i] = vA[_h][_i]; } }
        const char* nA = (has_next && !GATHER) ? (const char*)g.A + (size_t)nxt.pm * tstep : cA; const char* nB = has_next ? (const char*)g.Bt + (size_t)nxt.pb * tstep : cB;
        for (int t = 0; t < nt; t += 2) {
            const bool last = (t == nt - 2);
            const size_t kb1 = (size_t)(t + 1) * kstep, kb2 = last ? (size_t)0 : (size_t)(t + 2) * kstep, kb3 = kb2 + kstep;
            const char* sA = last ? nA : cA; const char* b2 = last ? nB : cB + (size_t)(t + 2) * kstep; const char* b3 = b2 + kstep;
            if constexpr (GATHER) { _Pragma("unroll") for (int _h = 0; _h < 2; ++_h) _Pragma("unroll") for (int _i = 0; _i < 2; ++_i) vS[_h][_i] = last ? vN[_h][_i] : vA[_h][_i]; }
            PG8_LDB(B0, 0, 0); PG8_LDB(B1, 0, 1); PG8_SCHED; PG8_LDA(At, 0, 0); PG8_STAGE_A(PG8_SA(1, 1), cA, kb1, 1, vA);
            PG8_WAIT_V(8); PG8_WAIT_L(0); PG8_BAR; PG8_MMA(0, 0, At, B0); PG8_MMA(0, 1, At, B1); PG8_BAR; PG8_SCHED;
            PG8_LDA(At, 0, 1); PG8_STAGE(PG8_SB(0, 0), b2, voffB); PG8_STAGE(PG8_SB(0, 1), b2 + hstep, voffB); PG8_STAGE_A(PG8_SA(0, 0), sA, kb2, 0, vS);
            PG8_WAIT_V(8); PG8_WAIT_L(0); PG8_BAR; PG8_MMA(1, 0, At, B0); PG8_MMA(1, 1, At, B1); PG8_BAR; PG8_SCHED;
            PG8_LDB(B0, 1, 0); PG8_LDB(B1, 1, 1); PG8_SCHED; PG8_LDA(At, 1, 0); PG8_STAGE_A(PG8_SA(0, 1), sA, kb2, 1, vS);
            PG8_WAIT_V(8); PG8_WAIT_L(0); PG8_BAR; PG8_MMA(0, 0, At, B0); PG8_MMA(0, 1, At, B1); PG8_BAR; PG8_SCHED;
            PG8_LDA(At, 1, 1); PG8_STAGE(PG8_SB(1, 0), b3, voffB); PG8_STAGE(PG8_SB(1, 1), b3 + hstep, voffB); PG8_STAGE_A(PG8_SA(1, 0), sA, kb3, 0, vS);
            PG8_WAIT_V(8); PG8_WAIT_L(0); PG8_BAR; PG8_MMA(1, 0, At, B0); PG8_MMA(1, 1, At, B1); PG8_BAR; PG8_SCHED;
        }
        if constexpr (ALIGN_EPI) { if (wr == 0) PG8_BAR; }
        E(acc, cur, wr, wc, fr, fq);
        if (!has_next) break;
#pragma unroll
        for (int a = 0; a < 2; ++a)
#pragma unroll
            for (int b = 0; b < 2; ++b)
#pragma unroll
                for (int m = 0; m < 4; ++m)
#pragma unroll
                    for (int n = 0; n < 2; ++n) acc[a][b][m][n] = (f32x4){0.f, 0.f, 0.f, 0.f};
        cur = nxt; cA = nA; cB = nB; ++ui;
        if constexpr (GATHER) { _Pragma("unroll") for (int _h = 0; _h < 2; ++_h) _Pragma("unroll") for (int _i = 0; _i < 2; ++_i) vA[_h][_i] = vN[_h][_i]; }
        if constexpr (ALIGN_EPI) { if (wr == 1) PG8_BAR; }
    }
    PG8_WAIT_V(0);
    if constexpr (!ALIGN_EPI) { if (wr == 0) PG8_BAR; }
    PG8_BAR;
#undef PG8_SA
#undef PG8_SB
#undef PG8_STAGE
#undef PG8_STAGE_A
#undef PG8_GOFF
#undef PG8_LDA
#undef PG8_LDB
#undef PG8_MMA
#undef PG8_WAIT_V
#undef PG8_WAIT_L
#undef PG8_BAR
#undef PG8_SCHED
}
}

#include <hip/hip_bf16.h>
#include <cmath>
namespace attn_body {
using bf16=__hip_bfloat16;
using bf16x8=__attribute__((ext_vector_type(8)))short;
using s16x4=__attribute__((ext_vector_type(4)))short;
using f32x16=__attribute__((ext_vector_type(16)))float;
using u32x4=__attribute__((ext_vector_type(4)))unsigned;
constexpr int BATCH=8,NHEAD=16,SEQ=4096,D=64,DM=NHEAD*D;
constexpr int NW=8,QBLK=32,QB=QBLK*NW,KVBLK=64,NQB=SEQ/QB;
constexpr int ATTN_PITCH=DM, ATTN_UNIT_ROWS=QB;
__device__ __forceinline__ int crow(int r,int hi){return (r&3)+8*(r>>2)+4*hi;}
#define SBAR() __builtin_amdgcn_sched_barrier(0)
__device__ __forceinline__ void cmask(f32x16&p0,f32x16&p1,int jb,int qrel,int hi){
  const float NEG=-INFINITY; int kb=64*jb+4*hi;
  #pragma unroll
  for(int r=0;r<16;++r){int kv=kb+(r&3)+8*(r>>2); if(kv>qrel)p0[r]=NEG; if(kv+32>qrel)p1[r]=NEG;}
}

constexpr int NSLOT=3, SLOTB=8192;
constexpr int LDS_K=0, LDS_V=NSLOT*SLOTB, LDS_WS=2*NSLOT*SLOTB, LDS_OST=LDS_WS+NW*64*4, LDS_BYTES=LDS_OST+NW*4096;
constexpr float C2=0.125f*1.4426950408889634f;
__device__ __forceinline__ void glds16(const void*gsrc,unsigned lds_dst){unsigned keep;
  asm volatile("s_mov_b32 %0, m0\n\ts_mov_b32 m0, %2\n\ts_nop 0\n\tglobal_load_lds_dwordx4 %1, off\n\ts_mov_b32 m0, %0":"=&s"(keep):"v"(gsrc),"s"(lds_dst):"memory");}
__device__ __forceinline__ float max3f(float a,float b,float c){float r;asm("v_max3_f32 %0, %1, %2, %3":"=v"(r):"v"(a),"v"(b),"v"(c));return r;}
__device__ __forceinline__ float max2f(float a,float b){float r;asm("v_max_f32_e32 %0, %1, %2":"=v"(r):"v"(a),"v"(b));return r;}
__device__ __forceinline__ float fadd_s(float a,float b){float r;asm("v_add_f32_e32 %0, %1, %2":"=v"(r):"v"(a),"v"(b));return r;}
__device__ __forceinline__ float fsub_s(float a,float b){float r;asm("v_sub_f32_e32 %0, %1, %2":"=v"(r):"v"(a),"v"(b));return r;}
typedef float f32x2_t __attribute__((ext_vector_type(2))); typedef __bf16 bf16x2_t __attribute__((ext_vector_type(2)));
__device__ __forceinline__ unsigned cvtpk_s(float lo,float hi){f32x2_t v={lo,hi};bf16x2_t b=__builtin_convertvector(v,bf16x2_t);return __builtin_bit_cast(unsigned,b);}
#define WAIT_BAR(N) asm volatile("s_waitcnt vmcnt(" #N ") lgkmcnt(0)\n\ts_barrier":::"memory")

__device__ __forceinline__ void qkt(f32x16&p0,f32x16&p1,const char*Kslot,const bf16x8*qr,const f32x16&negm,int r32,int hi){
  const char*kb=Kslot+hi*1024+r32*16;
  #pragma unroll
  for(int d0=0;d0<4;++d0){
    const bf16x8 b0=*reinterpret_cast<const bf16x8*>(kb+d0*2048);
    const bf16x8 b1=*reinterpret_cast<const bf16x8*>(kb+d0*2048+512);
    if(d0==0){p0=__builtin_amdgcn_mfma_f32_32x32x16_bf16(b0,qr[0],negm,0,0,0);p1=__builtin_amdgcn_mfma_f32_32x32x16_bf16(b1,qr[0],negm,0,0,0);}
    else{p0=__builtin_amdgcn_mfma_f32_32x32x16_bf16(b0,qr[d0],p0,0,0,0);p1=__builtin_amdgcn_mfma_f32_32x32x16_bf16(b1,qr[d0],p1,0,0,0);}}
}
typedef __attribute__((address_space(3))) const char* lds_cptr;
typedef short v4i16_t __attribute__((ext_vector_type(4)));
__device__ __forceinline__ void kload8(bf16x8*kf,lds_cptr kp){
  kf[0]=*(const __attribute__((address_space(3))) bf16x8*)(kp);      kf[1]=*(const __attribute__((address_space(3))) bf16x8*)(kp+512);
  kf[2]=*(const __attribute__((address_space(3))) bf16x8*)(kp+2048); kf[3]=*(const __attribute__((address_space(3))) bf16x8*)(kp+2560);
  kf[4]=*(const __attribute__((address_space(3))) bf16x8*)(kp+4096); kf[5]=*(const __attribute__((address_space(3))) bf16x8*)(kp+4608);
  kf[6]=*(const __attribute__((address_space(3))) bf16x8*)(kp+6144); kf[7]=*(const __attribute__((address_space(3))) bf16x8*)(kp+6656);
}
__device__ __forceinline__ void kload2(bf16x8*kf,lds_cptr kp,int j){ kf[2*j]=*(const __attribute__((address_space(3))) bf16x8*)(kp+j*2048); kf[2*j+1]=*(const __attribute__((address_space(3))) bf16x8*)(kp+j*2048+512); }
__device__ __forceinline__ s16x4 vtr(lds_cptr p){ return __builtin_bit_cast(s16x4,__builtin_amdgcn_ds_read_tr16_b64_v4i16((__attribute__((address_space(3))) v4i16_t*)p)); }
__device__ __forceinline__ float rowmax(const f32x16&p0,const f32x16&p1){
  float a=max3f(p0[0],p0[1],p1[0]),b=max3f(p0[2],p0[3],p1[1]);a=max3f(a,p1[2],p1[3]);
  #pragma unroll
  for(int r=4;r<16;r+=4){a=max3f(a,p0[r],p0[r+1]);b=max3f(b,p0[r+2],p0[r+3]);a=max3f(a,p1[r],p1[r+1]);b=max3f(b,p1[r+2],p1[r+3]);}
  const float m=max2f(a,b);
  auto rr=__builtin_amdgcn_permlane32_swap(__float_as_uint(m),__float_as_uint(m),false,false);
  return max2f(__uint_as_float(rr[0]),__uint_as_float(rr[1]));
}
__device__ __forceinline__ void pv(f32x16*o,int vb,bf16x8 pa0,bf16x8 pa1,bf16x8 pa2,bf16x8 pa3){
  #pragma unroll
  for(int d0=0;d0<2;++d0){s16x4 lo[4],hi[4];
    #pragma unroll
    for(int ks=0;ks<4;++ks){
      asm volatile("ds_read_b64_tr_b16 %0,%1 offset:%c2":"=&v"(lo[ks]):"v"(vb),"i"(d0*4096+ks*1024):"memory");
      asm volatile("ds_read_b64_tr_b16 %0,%1 offset:%c2":"=&v"(hi[ks]):"v"(vb),"i"(d0*4096+ks*1024+512):"memory");}
    asm volatile("s_waitcnt lgkmcnt(0)":::"memory");SBAR();
    #define PK(k) (bf16x8){lo[k][0],lo[k][1],lo[k][2],lo[k][3],hi[k][0],hi[k][1],hi[k][2],hi[k][3]}
    o[d0]=__builtin_amdgcn_mfma_f32_32x32x16_bf16(pa0,PK(0),o[d0],0,0,0);
    o[d0]=__builtin_amdgcn_mfma_f32_32x32x16_bf16(pa1,PK(1),o[d0],0,0,0);
    o[d0]=__builtin_amdgcn_mfma_f32_32x32x16_bf16(pa2,PK(2),o[d0],0,0,0);
    o[d0]=__builtin_amdgcn_mfma_f32_32x32x16_bf16(pa3,PK(3),o[d0],0,0,0);
    #undef PK
  }
}

#ifndef ATTN_STORE16
#define ATTN_STORE16(p,v) (*(u32x4*)(p)=(v))
#endif
template<int THRL> __device__ __forceinline__ void attn_unit(int b,int h,int qb,const bf16*Q,const bf16*__restrict__ K,const bf16*__restrict__ V,bf16*O,char*shm,int wave_){
  const int wid=wave_; int tid=wid*64+(int)__builtin_amdgcn_mbcnt_hi(0xffffffffu,__builtin_amdgcn_mbcnt_lo(0xffffffffu,0u)); asm volatile("":"+v"(tid)); const int lane=tid&63,r32=lane&31,hi=lane>>5;
  const long rowbase=(long)b*SEQ; const int q0=qb*QB;
  const bf16*Qw=Q+(rowbase+q0+wid*QBLK)*DM+h*D;
  const bf16*Kh=K+rowbase*DM+h*D,*Vh=V+rowbase*DM+h*D;
  const unsigned lds0=(unsigned)(uintptr_t)shm;
  float*wsf=(float*)(shm+LDS_WS)+wid*64;
  const bf16*ksrc=Kh+(long)lane*DM+wid*8;
  const bf16*vsrc=Vh+(long)(16*(wid&3)+(lane>>2))*DM+(wid>>2)*32+(lane&3)*8;
  const unsigned kdst=lds0+LDS_K+wid*1024, vdst=lds0+LDS_V+wid*1024;
  #define DMA_K(t,slot) glds16(ksrc+(long)(t)*KVBLK*DM,(unsigned)__builtin_amdgcn_readfirstlane(kdst+(slot)))
  #define DMA_V(t,slot) glds16(vsrc+(long)(t)*KVBLK*DM,(unsigned)__builtin_amdgcn_readfirstlane(vdst+(slot)))
  const int vb0=(int)(lds0+LDS_V)+((lane>>4)&1)*32+(lane&3)*8+(4*hi+((lane&15)>>2))*64;
  const char*Kbase=shm+LDS_K; bf16x8 kf[8];
  const lds_cptr shm3=(lds_cptr)shm; const lds_cptr kp0=shm3+LDS_K+hi*1024+r32*16; const lds_cptr vp0=shm3+LDS_V+((lane>>4)&1)*32+(lane&3)*8+(4*hi+((lane&15)>>2))*64;
  const int NT=(q0+QB)/KVBLK;
  DMA_K(0,0);DMA_V(0,0);DMA_K(1,SLOTB);
  bf16x8 qr[4];
  #pragma unroll
  for(int d0=0;d0<4;++d0)qr[d0]=*reinterpret_cast<const bf16x8*>(&Qw[(long)r32*DM+d0*16+hi*8]);
  float mhat=0.f,l_reg=0.f;f32x16 o[2];o[0]=f32x16{};o[1]=f32x16{};f32x16 negm=f32x16{};asm volatile("":"+v"(negm));
  const int qrel=wid*QBLK+r32;
  #define CMASK(P0,P1,t) do{int jb_=(t)-(NT-4); if(jb_>=0)cmask(P0,P1,jb_,qrel,hi);}while(0)
  bool resc=false;
  #define START(P0,P1) do{ const float rm=rowmax(P0,P1); resc=false; \
    { const float dl=rm; mhat=fadd_s(mhat,dl); \
      _Pragma("unroll") for(int r=0;r<16;++r){P0[r]=fsub_s(P0[r],dl);P1[r]=fsub_s(P1[r],dl);} \
      _Pragma("unroll") for(int r=0;r<16;++r)negm[r]=-mhat; asm volatile("":"+v"(negm)); } \
    _Pragma("unroll") for(int r=0;r<16;++r)P0[r]=__builtin_amdgcn_exp2f(P0[r]); }while(0)
  #define RESC() do{ if(resc){ asm volatile("s_waitcnt lgkmcnt(0)":::"memory"); \
      _Pragma("unroll") for(int d_=0;d_<2;++d_) _Pragma("unroll") for(int r=0;r<16;++r)o[d_][r]*=wsf[crow(r,hi)]; } }while(0)
  f32x16 pA0,pA1,pB0,pB1;
  int sl_prev=0,sl_cur=0,sl_next=SLOTB;
  #define ROT() do{sl_prev=sl_cur;sl_cur=sl_next;sl_next=(sl_next==(NSLOT-1)*SLOTB)?0:sl_next+SLOTB;}while(0)
  DMA_K(2,2*SLOTB);
  WAIT_BAR(3);
  qkt(pA0,pA1,Kbase,qr,negm,r32,hi);asm volatile("s_nop 15\n\ts_nop 7":"+v"(pA0),"+v"(pA1));CMASK(pA0,pA1,0);
  START(pA0,pA1);
  _Pragma("unroll") for(int r=0;r<16;++r)pA1[r]=__builtin_amdgcn_exp2f(pA1[r]);
  WAIT_BAR(0);
  DMA_K(3,0);DMA_V(1,SLOTB);
  ROT();
  kload8(kf,kp0+sl_cur);
  WAIT_BAR(2);
  s16x4 vlo[8],vhi[8]; u32x4 pw0,pw1,pw2,pw3;
  #define PKW(P,B) cvtpk_s(P[B],P[B+1])
  #define PAF(k) __builtin_bit_cast(bf16x8,pw##k)
  #define VFR(i) (bf16x8){vlo[i][0],vlo[i][1],vlo[i][2],vlo[i][3],vhi[i][0],vhi[i][1],vhi[i][2],vhi[i][3]}
  #define PIN(x) asm volatile("":"+v"(x))
  #define MX3(a,b,c) __builtin_fmaxf(__builtin_fmaxf((a),(b)),(c))
  #define GAPA(MF,A0,A1,A2,A3,W0,W1,PW) do{ MF; sacc+=A0; sacc+=A1; sacc+=A2; sacc+=A3; PIN(sacc); W0; W1; PIN(PW); SBAR(); }while(0)
  #define EX(v) __builtin_amdgcn_exp2f(v)
  #define GAPB(MF,X,B) do{ MF; X[B]=EX(X[B]); X[B+1]=EX(X[B+1]); X[B+2]=EX(X[B+2]); X[B+3]=EX(X[B+3]); PIN(X); SBAR(); }while(0)
  #define VRD(i) do{ vlo[i]=vtr(vp_+(((i)>>2)*4096+((i)&3)*1024)); vhi[i]=vtr(vp_+(((i)>>2)*4096+((i)&3)*1024+512)); }while(0)
  #define KRD(G,j) do{ if(G){ kload2(kf,kp0+sl_next,j); SBAR(); } }while(0)
  #define STEP(C0,C1,P0,P1,t,GK,GV,GL) do{ SBAR(); \
    const lds_cptr vp_=vp0+sl_prev; \
    VRD(0); SBAR(); float sacc=(P0[0]+P0[1]); \
    GAPA(C0=__builtin_amdgcn_mfma_f32_32x32x16_bf16(kf[0],qr[0],negm,0,0,0), P0[2],P0[3],P0[4],P0[5],     pw0[0]=PKW(P0,0), pw0[1]=PKW(P0,2), pw0); \
    VRD(4); SBAR(); GAPA(C1=__builtin_amdgcn_mfma_f32_32x32x16_bf16(kf[1],qr[0],negm,0,0,0), P0[6],P0[7],P0[8],P0[9],     pw0[2]=PKW(P0,4), pw0[3]=PKW(P0,6), pw0); \
    VRD(1); SBAR(); GAPA(C0=__builtin_amdgcn_mfma_f32_32x32x16_bf16(kf[2],qr[1],C0,0,0,0),   P0[10],P0[11],P0[12],P0[13], pw1[0]=PKW(P0,8), pw1[1]=PKW(P0,10), pw1); \
    VRD(5); SBAR(); GAPA(C1=__builtin_amdgcn_mfma_f32_32x32x16_bf16(kf[3],qr[1],C1,0,0,0),   P0[14],P0[15],P1[0],P1[1],   pw1[2]=PKW(P0,12),pw1[3]=PKW(P0,14), pw1); \
    VRD(2); SBAR(); GAPA(C0=__builtin_amdgcn_mfma_f32_32x32x16_bf16(kf[4],qr[2],C0,0,0,0),   P1[2],P1[3],P1[4],P1[5],     pw2[0]=PKW(P1,0), pw2[1]=PKW(P1,2), pw2); \
    VRD(6); SBAR(); GAPA(C1=__builtin_amdgcn_mfma_f32_32x32x16_bf16(kf[5],qr[2],C1,0,0,0),   P1[6],P1[7],P1[8],P1[9],     pw2[2]=PKW(P1,4), pw2[3]=PKW(P1,6), pw2); \
    VRD(3); SBAR(); GAPA(C0=__builtin_amdgcn_mfma_f32_32x32x16_bf16(kf[6],qr[3],C0,0,0,0),   P1[10],P1[11],P1[12],P1[13], pw3[0]=PKW(P1,8), pw3[1]=PKW(P1,10), pw3); \
    VRD(7); SBAR(); GAPA(C1=__builtin_amdgcn_mfma_f32_32x32x16_bf16(kf[7],qr[3],C1,0,0,0),   P1[14],P1[15],0.f,0.f,       pw3[2]=PKW(P1,12),pw3[3]=PKW(P1,14), pw3); \
    l_reg+=sacc; \
    if(GK){DMA_K((t)+3,sl_cur);} if(GV){DMA_V((t)+1,sl_next);} \
    CMASK(C0,C1,t); \
    { float a=MX3(C0[0],C0[1],C1[0]),b=MX3(C0[2],C0[3],C1[1]); a=MX3(a,C1[2],C1[3]); \
      _Pragma("unroll") for(int r=4;r<16;r+=4){a=MX3(a,C0[r],C0[r+1]);b=MX3(b,C0[r+2],C0[r+3]);a=MX3(a,C1[r],C1[r+1]);b=MX3(b,C1[r+2],C1[r+3]);} \
      float rm=__builtin_fmaxf(a,b); { auto rr=__builtin_amdgcn_permlane32_swap(__float_as_uint(rm),__float_as_uint(rm),false,false); rm=__builtin_fmaxf(__uint_as_float(rr[0]),__uint_as_float(rr[1])); } \
      resc=false; \
      if(__builtin_expect(__any(rm>(float)THRL),0)){ const float dl=__builtin_fmaxf(rm,0.f); mhat+=dl; \
        _Pragma("unroll") for(int r=0;r<16;++r){C0[r]-=dl;C1[r]-=dl;} \
        _Pragma("unroll") for(int r=0;r<16;++r)negm[r]=-mhat; asm volatile("":"+v"(negm)); \
        const float f=__builtin_amdgcn_exp2f(-dl); l_reg*=f; if(hi==0)wsf[r32]=f; resc=true; } } \
    SBAR(); \
    GAPB(o[0]=__builtin_amdgcn_mfma_f32_32x32x16_bf16(PAF(0),VFR(0),o[0],0,0,0), C0,0); \
    GAPB(o[1]=__builtin_amdgcn_mfma_f32_32x32x16_bf16(PAF(0),VFR(4),o[1],0,0,0), C0,4); \
    KRD(GL,0); GAPB(o[0]=__builtin_amdgcn_mfma_f32_32x32x16_bf16(PAF(1),VFR(1),o[0],0,0,0), C0,8); \
    KRD(GL,1); GAPB(o[1]=__builtin_amdgcn_mfma_f32_32x32x16_bf16(PAF(1),VFR(5),o[1],0,0,0), C0,12); \
    KRD(GL,2); GAPB(o[0]=__builtin_amdgcn_mfma_f32_32x32x16_bf16(PAF(2),VFR(2),o[0],0,0,0), C1,0); \
    KRD(GL,3); GAPB(o[1]=__builtin_amdgcn_mfma_f32_32x32x16_bf16(PAF(2),VFR(6),o[1],0,0,0), C1,4); \
    GAPB(o[0]=__builtin_amdgcn_mfma_f32_32x32x16_bf16(PAF(3),VFR(3),o[0],0,0,0), C1,8); \
    GAPB(o[1]=__builtin_amdgcn_mfma_f32_32x32x16_bf16(PAF(3),VFR(7),o[1],0,0,0), C1,12); \
    }while(0)
  int t=1;
  #undef CMASK
  #define CMASK(P0,P1,t) do{}while(0)
  for(;t+5<NT;t+=2){
    STEP(pB0,pB1,pA0,pA1,t,true,true,true);     WAIT_BAR(2); RESC(); ROT();
    STEP(pA0,pA1,pB0,pB1,t+1,true,true,true);   WAIT_BAR(2); RESC(); ROT();
  }
  #undef CMASK
  #define CMASK(P0,P1,t) do{int jb_=(t)-(NT-4); if(jb_>=0)cmask(P0,P1,jb_,qrel,hi);}while(0)
  #define ENDW(tt) do{ if((tt)+3<NT){WAIT_BAR(2);} else if((tt)+2<NT){WAIT_BAR(1);} else {WAIT_BAR(0);} }while(0)
  for(;t+1<NT;t+=2){
    STEP(pB0,pB1,pA0,pA1,t,(t+3<NT),(t+1<NT),(t+1<NT));       ENDW(t);   RESC(); ROT();
    STEP(pA0,pA1,pB0,pB1,t+1,(t+4<NT),(t+2<NT),(t+2<NT));     ENDW(t+1); RESC(); ROT();
  }
  STEP(pB0,pB1,pA0,pA1,NT-1,false,false,false); RESC();
  { float sacc=pB0[0]+pB0[1]; _Pragma("unroll") for(int r=2;r<16;++r)sacc+=pB0[r]; _Pragma("unroll") for(int r=0;r<16;++r)sacc+=pB1[r]; l_reg+=sacc;
    pw0=(u32x4){PKW(pB0,0),PKW(pB0,2),PKW(pB0,4),PKW(pB0,6)};pw1=(u32x4){PKW(pB0,8),PKW(pB0,10),PKW(pB0,12),PKW(pB0,14)};pw2=(u32x4){PKW(pB1,0),PKW(pB1,2),PKW(pB1,4),PKW(pB1,6)};pw3=(u32x4){PKW(pB1,8),PKW(pB1,10),PKW(pB1,12),PKW(pB1,14)};
    SBAR(); pv(o,vb0+sl_cur,PAF(0),PAF(1),PAF(2),PAF(3)); }
  #undef PKW
  #undef PAF
  #undef VFR
  #undef PIN
  #undef MX3
  #undef GAPA
  #undef GAPB
  #undef EX
  #undef VRD
  #undef KRD
  #undef STEP
  #undef ENDW
  {auto rr=__builtin_amdgcn_permlane32_swap(__float_as_uint(l_reg),__float_as_uint(l_reg),false,false);l_reg=__uint_as_float(rr[0])+__uint_as_float(rr[1]);}
  if(hi==0)wsf[32+r32]=l_reg;asm volatile("s_waitcnt lgkmcnt(0)":::"memory");
  float rli[16];
  #pragma unroll
  for(int r=0;r<16;++r)rli[r]=__builtin_amdgcn_rcpf(wsf[32+crow(r,hi)]);
  bf16*Ow=O+(rowbase+q0+wid*QBLK)*DM+h*D;
  { bf16*stg=(bf16*)(shm+LDS_OST)+wid*2048;
    #pragma unroll
    for(int r=0;r<16;++r){const int orow=crow(r,hi);
      #pragma unroll
      for(int d0=0;d0<2;++d0)stg[orow*64+d0*32+r32]=__float2bfloat16(o[d0][r]*rli[r]);}
    asm volatile("s_waitcnt lgkmcnt(0)":::"memory");
    #pragma unroll
    for(int i=0;i<4;++i){const int row=i*8+(lane>>3),ch=lane&7; const u32x4 v=*(const u32x4*)(stg+row*64+ch*8); ATTN_STORE16(Ow+(long)row*DM+ch*8,v);} }
  asm volatile("s_waitcnt lgkmcnt(0)\n\ts_barrier":::"memory");
  #undef DMA_K
  #undef DMA_V
  #undef CMASK
  #undef START
  #undef RESC
  #undef ROT
}
constexpr int ATTN_LDS_BYTES=LDS_BYTES;
struct AttnTensors { const bf16* Q; const bf16* K; const bf16* V; bf16* O0; bf16* O1; };
struct AttnUnit { int combo; int qb; };
struct ComboOrder {
  int vcu, G;
  __device__ __forceinline__ bool next(int i,AttnUnit&u)const{ const int combo=vcu+(i>>4)*G; if(combo>=BATCH*32)return false; u.combo=combo; u.qb=15-(i&15); return true; }
};
template<class Sched,int THRL=8> __device__ __forceinline__ void attn_phase(char*lds,const AttnTensors&T,const Sched&S,int wave_){
  AttnUnit u;
  for(int i=0;S.next(i,u);++i){ const int b=u.combo>>5, hc=(u.combo>>1)&15, vh=u.combo&1, hv=(hc&~1)|vh; const long sh=(long)(hv-hc)*D;
    attn_unit<THRL>(b,hc,u.qb,T.Q,T.K,T.V+sh,((hc&1)?T.O1:T.O0)+sh,lds,wave_); }
}
#undef SBAR
#undef WAIT_BAR
}

#define GAS __attribute__((address_space(1)))
#define LAS __attribute__((address_space(3)))
typedef unsigned short bf16;
typedef unsigned v4u __attribute__((ext_vector_type(4)));
typedef float f32x4 __attribute__((ext_vector_type(4)));
typedef short bf16x8 __attribute__((ext_vector_type(8)));
typedef GAS unsigned gu32;
typedef GAS unsigned long long gu64;
#define RLX_AGENT __ATOMIC_RELAXED, __HIP_MEMORY_SCOPE_AGENT
#define LDS_WAIT() asm volatile("s_waitcnt lgkmcnt(0)" ::: "memory")
#define VM_WAIT() asm volatile("s_waitcnt vmcnt(0)" ::: "memory")
__device__ __forceinline__ unsigned long long rt() { return __builtin_amdgcn_s_memrealtime(); }
__device__ __forceinline__ unsigned f2bf(float f) { unsigned u = __builtin_bit_cast(unsigned, f); return (u + 0x7fffu + ((u >> 16) & 1u)) >> 16; }
__device__ __forceinline__ unsigned pk2(float lo, float hi) { return f2bf(lo) | (f2bf(hi) << 16); }

#define XB_TMO      128
#define XB_XCNT(j)  (256  + 64 * (j))
#define XB_XSUB(j)  (1280 + 64 * (j))
#define XB_XGEN(j)  (2304 + 64 * (j))
#define XB_TOP      3328
#define XB_TOPGEN   3392
#define XCD_BAR_WORDS 3456
#define XB_SPIN_CAP (1u << 18)

__device__ __forceinline__ unsigned xb_ld(unsigned* p)              { return __hip_atomic_load(p, __ATOMIC_RELAXED, __HIP_MEMORY_SCOPE_AGENT); }
__device__ __forceinline__ unsigned xb_add(unsigned* p, unsigned v) { return __hip_atomic_fetch_add(p, v, __ATOMIC_RELAXED, __HIP_MEMORY_SCOPE_AGENT); }
__device__ __forceinline__ unsigned xb_xcc_id() { return (unsigned)__builtin_amdgcn_s_getreg((3 << 11) | 20) & 0xFu; }
#define XB_SPIN(cond, bar) do { unsigned _sp = 0; while (cond) { __builtin_amdgcn_s_sleep(1); \
    if ((++_sp & 255u) == 0u) { if (xb_ld(&(bar)[XB_TMO])) break; if (_sp > XB_SPIN_CAP) { atomicAdd(&(bar)[XB_TMO], 1u); break; } } } } while (0)

struct XcdBarrier {
    unsigned* bar; unsigned x;
    volatile LAS unsigned* st;
};

__device__ __forceinline__ XcdBarrier xcd_barrier_post(unsigned* bar, volatile LAS unsigned* st) {
    XcdBarrier b; b.bar = bar; b.x = xb_xcc_id(); b.st = st;
    if (threadIdx.x == 0) (void)xb_add(&bar[XB_XCNT(b.x)], 1u);
    return b;
}
__device__ __forceinline__ void xcd_barrier_complete(unsigned* bar, unsigned x, unsigned& nloc, unsigned& nx) {
    const unsigned G = gridDim.x * gridDim.y * gridDim.z;
    unsigned sum, cnt, mine, sp = 0u;
    for (;;) {
        sum = 0u; cnt = 0u; mine = 0u;
#pragma unroll
        for (unsigned j = 0; j < 16; ++j) { const unsigned c = xb_ld(&bar[XB_XCNT(j)]); sum += c; cnt += (c > 0u) ? 1u : 0u; mine = (j == x) ? c : mine; }
        if (sum == G) break;
        __builtin_amdgcn_s_sleep(1);
        if ((++sp & 255u) == 0u) { if (xb_ld(&bar[XB_TMO])) break; if (sp > XB_SPIN_CAP) { atomicAdd(&bar[XB_TMO], 1u); break; } }
    }
    nloc = mine > 0u ? mine : 1u; nx = cnt > 0u ? cnt : 1u;
}

__device__ __forceinline__ void xcd_barrier(const XcdBarrier& b) {
    asm volatile("s_waitcnt vmcnt(0)" ::: "memory");
    __syncthreads();
    if (threadIdx.x == 0) {
        unsigned* bar = b.bar;
        __builtin_amdgcn_s_waitcnt(0);
        unsigned nloc = b.st[0], nx = b.st[1];
        if (nloc == 0u) { xcd_barrier_complete(bar, b.x, nloc, nx); b.st[0] = nloc; b.st[1] = nx; }
        const unsigned old = xb_add(&bar[XB_XSUB(b.x)], 1u);
        const unsigned gen = old / nloc;
        if (old + 1u == (gen + 1u) * nloc) {
            __builtin_amdgcn_fence(__ATOMIC_RELEASE, "agent");
            asm volatile("s_waitcnt vmcnt(0)" ::: "memory");
            const unsigned og = xb_add(&bar[XB_TOP], 1u);
            const unsigned tg = og / nx;
            if (og + 1u == (tg + 1u) * nx) xb_add(&bar[XB_TOPGEN], 1u);
            else XB_SPIN(xb_ld(&bar[XB_TOPGEN]) == tg, bar);
            __builtin_amdgcn_fence(__ATOMIC_ACQUIRE, "agent");
            xb_add(&bar[XB_XGEN(b.x)], 1u);
            asm volatile("s_waitcnt vmcnt(0)" ::: "memory");
        } else {
            XB_SPIN(xb_ld(&bar[XB_XGEN(b.x)]) == gen, bar);
            __builtin_amdgcn_fence(__ATOMIC_ACQUIRE, "agent");
            asm volatile("s_waitcnt vmcnt(0)" ::: "memory");
        }
    }
    __syncthreads();
}

constexpr int NWAVES = 8;
constexpr int BATCH = 8, SEQ = 4096, D = 1024, M = BATCH * SEQ;
constexpr int NEXP = 32, FE = 256, PLED = 256, CWID = 31, NQKV = 3072;
constexpr float EPS = 1e-6f;
constexpr int NPHASE = 25;
constexpr int PADROWS = 73728;
constexpr float LAM_INIT = 0.35550906759096926f;

constexpr size_t MiB = 1u << 20;
constexpr size_t WS_CTL = 0, CTL_ZERO_BYTES = 1 * MiB;
constexpr size_t WS_TI = 1 * MiB, WS_TW = WS_TI + 512 * 1024;
constexpr size_t WS_LIST = 2 * MiB;
constexpr size_t WS_LOG = 6 * MiB;
constexpr size_t WS_WPW1 = 14 * MiB, WS_WPW2 = 18 * MiB, WS_WQKV = 20 * MiB, WS_WO = 26 * MiB, WS_WR = 28 * MiB, WS_WPG = 29 * MiB, WS_WPP = 33 * MiB;
constexpr size_t WS_WGU = 34 * MiB, WS_WD = 66 * MiB;
constexpr size_t WS_P16 = 82 * MiB;
constexpr size_t WS_H = 114 * MiB;
constexpr size_t WS_S0 = 178 * MiB, WS_SS = 64 * MiB;
constexpr size_t WS_END = WS_S0 + 5 * WS_SS;
constexpr int CW_BAR = 4096;
constexpr int CW_CNT = 8192;
constexpr int RING_OFF = 0, RING_BYTES = 131072;
constexpr int LDSCTL_OFF = RING_BYTES;
constexpr int L_MISC = LDSCTL_OFF, L_TS = LDSCTL_OFF + 128, L_NE = LDSCTL_OFF + 384, L_TE = LDSCTL_OFF + 512, L_TOK = LDSCTL_OFF + 2048, L_HIST = LDSCTL_OFF + 10240;
constexpr int MAXGU = 8;
constexpr int LDS_BYTES = 147456;


typedef float f32x2 __attribute__((ext_vector_type(2)));
typedef unsigned u32x2 __attribute__((ext_vector_type(2)));
typedef int i32x4 __attribute__((ext_vector_type(4)));
__device__ __forceinline__ float bflo(unsigned u) { return __builtin_bit_cast(float, u << 16); }
__device__ __forceinline__ float bfhi(unsigned u) { return __builtin_bit_cast(float, u & 0xffff0000u); }
__device__ __forceinline__ float sigmoid_f(float x) { return __builtin_amdgcn_rcpf(1.f + __expf(-x)); }
__device__ __forceinline__ float wave_sum(float v) {
#pragma unroll
    for (int o = 1; o < 64; o <<= 1) v += __shfl_xor(v, o);
    return v;
}
__device__ __forceinline__ void tr_item(const float* W, int N, bf16* WT, int Kd, int k0, int n0, int drow0, LAS float* scr, int lane) {
#pragma unroll 8
    for (int i = 0; i < 32; ++i) { const int kk = 2 * i + (lane >> 5); scr[kk * 33 + (lane & 31)] = W[(size_t)(k0 + kk) * N + n0 + (lane & 31)]; }
    LDS_WAIT(); asm volatile("" ::: "memory");
    const int c = lane & 7;
#pragma unroll
    for (int j = 0; j < 4; ++j) { const int n = (lane >> 3) + 8 * j; const LAS float* s = scr + (8 * c) * 33 + n;
        v4u o; o.x = pk2(s[0 * 33], s[1 * 33]); o.y = pk2(s[2 * 33], s[3 * 33]); o.z = pk2(s[4 * 33], s[5 * 33]); o.w = pk2(s[6 * 33], s[7 * 33]);
        *(GAS v4u*)(WT + (size_t)(drow0 + n) * Kd + k0 + 8 * c) = o; }
    LDS_WAIT(); asm volatile("" ::: "memory");
}
__device__ __forceinline__ void tr_plain(const float* W, int K, int N, bf16* WT, int item, LAS float* scr, int lane) {
    const int nblk = N / 32, kb = item / nblk, nb = item % nblk; tr_item(W, N, WT, K, 64 * kb, 32 * nb, 32 * nb, scr, lane);
}
constexpr int MOE_ITEMS = 32 * 384;
__device__ __forceinline__ void moe_item(const float* wg, const float* wu, const float* wd, int l, bf16* WGU, bf16* WD, int item, LAS float* scr, int lane) {
    const int ge = item / 384, r = item % 384, which = r / 128, sub = r % 128; const size_t eo = (size_t)(l * 32 + ge) * 262144;
    if (which < 2) { const int kb = sub / 8, nb = sub % 8, n0 = 32 * nb; const int drow0 = (n0 / 128) * 256 + (n0 % 128) + (which ? 128 : 0);
        tr_item((which ? wu : wg) + eo, 256, WGU + (size_t)ge * 512 * 1024, 1024, 64 * kb, n0, drow0, scr, lane); }
    else { const int kb = sub / 32, nb = sub % 32; tr_item(wd + eo, 1024, WD + (size_t)ge * 1024 * 256, 256, 64 * kb, 32 * nb, 32 * nb, scr, lane); }
}

template <int MODE>
__device__ __forceinline__ void rowpass(const float* xsrc, float* xdst, const float* gain, bf16* Hout, float* Fout, const bf16* Y, const bf16* Y2,
                                        const i32x4* TI, const f32x2* TW, const unsigned* cnt, int gw, int NGW, int lane) {
    f32x4 gv[4];
#pragma unroll
    for (int j = 0; j < 4; ++j) gv[j] = *((const f32x4*)gain + lane + 64 * j);
    int ts = 0;
    if (MODE == 2) {
        const unsigned n = lane < 32 ? __hip_atomic_load(cnt + lane * 64, RLX_AGENT) : 0u; const int tiles = (int)((n + 255u) >> 8); int incl = tiles;
#pragma unroll
        for (int o = 1; o < 32; o <<= 1) { const int t = __shfl_up(incl, o); if (lane >= o) incl += t; }
        ts = incl - tiles;
    }
    for (int m = gw; m < M; m += NGW) {
        const GAS f32x4* xr = (const GAS f32x4*)(xsrc + (size_t)m * D) + lane;
        f32x4 v[4];
#pragma unroll
        for (int j = 0; j < 4; ++j) v[j] = xr[64 * j];
        if (MODE == 1) { const GAS u32x2* yr = (const GAS u32x2*)(Y + (size_t)m * D) + lane;
#pragma unroll
            for (int j = 0; j < 4; ++j) { const u32x2 y = yr[64 * j]; v[j] += (f32x4){bflo(y.x), bfhi(y.x), bflo(y.y), bfhi(y.y)}; } }
        if (MODE == 2) { const i32x4 ti = TI[m]; const f32x2 tw = TW[m];
            const int r1 = __shfl(ts, ti.x) * 256 + ti.y, r2 = __shfl(ts, ti.z) * 256 + ti.w;
            const GAS u32x2* y1 = (const GAS u32x2*)(Y + (size_t)r1 * D) + lane; const GAS u32x2* y2 = (const GAS u32x2*)(Y + (size_t)r2 * D) + lane;
#pragma unroll
            for (int j = 0; j < 4; ++j) { const u32x2 a = y1[64 * j], b = y2[64 * j];
                v[j] += (f32x4){bflo(a.x), bfhi(a.x), bflo(a.y), bfhi(a.y)} * tw.x + (f32x4){bflo(b.x), bfhi(b.x), bflo(b.y), bfhi(b.y)} * tw.y; } }
        if (MODE == 3) { const GAS u32x2* gr = (const GAS u32x2*)(Y + (size_t)m * D) + lane; const GAS u32x2* pr = (const GAS u32x2*)(Y2 + (size_t)m * D) + lane;
#pragma unroll
            for (int j = 0; j < 4; ++j) { const u32x2 a = gr[64 * j], b = pr[64 * j];
                v[j] += (f32x4){sigmoid_f(bflo(a.x)) * bflo(b.x), sigmoid_f(bfhi(a.x)) * bfhi(b.x), sigmoid_f(bflo(a.y)) * bflo(b.y), sigmoid_f(bfhi(a.y)) * bfhi(b.y)}; } }
        if (xdst) { GAS f32x4* xo = (GAS f32x4*)(xdst + (size_t)m * D) + lane;
#pragma unroll
            for (int j = 0; j < 4; ++j) xo[64 * j] = v[j]; }
        float ss = 0.f;
#pragma unroll
        for (int j = 0; j < 4; ++j) ss += (v[j].x * v[j].x + v[j].y * v[j].y) + (v[j].z * v[j].z + v[j].w * v[j].w);
        const float r = 1.f / sqrtf(wave_sum(ss) * (1.f / D) + EPS);
        if (Fout) { GAS f32x4* fo = (GAS f32x4*)(Fout + (size_t)m * D) + lane;
#pragma unroll
            for (int j = 0; j < 4; ++j) fo[64 * j] = v[j] * r * gv[j]; }
        else { GAS u32x2* ho = (GAS u32x2*)(Hout + (size_t)m * D) + lane;
#pragma unroll
            for (int j = 0; j < 4; ++j) { const f32x4 o = v[j] * r * gv[j]; ho[64 * j] = (u32x2){pk2(o.x, o.y), pk2(o.z, o.w)}; } }
    }
}

__device__ __forceinline__ f32x2 glu2(unsigned ua, unsigned ug) { return (f32x2){bflo(ua) * sigmoid_f(bflo(ug)), bfhi(ua) * sigmoid_f(bfhi(ug))}; }
__device__ __forceinline__ void conv_phase(const bf16* U, bf16* C, const float* wdw, const float* bdw, const float* lng, const float* lnb, LAS unsigned char* lds, int vcu, int G, int tid, int lane, int wave) {
    const int c0 = 2 * tid;
    f32x2 w[CWID];
#pragma unroll
    for (int j = 0; j < CWID; ++j) w[j] = *(const f32x2*)(wdw + j * D + c0);
    const f32x2 bd = *(const f32x2*)(bdw + c0);
    LAS unsigned* yb = (LAS unsigned*)lds;
    for (int chunk = vcu; chunk < M / 32; chunk += G) {
        const int b = chunk >> 7, t0 = (chunk & 127) * 32; const size_t rb = (size_t)b * SEQ;
        const bf16* Ub = U + rb * 2048 + c0;
        f32x2 win[CWID];
#pragma unroll
        for (int s = 0; s < CWID; ++s) { const int tau = t0 - 30 + s; const int tc = tau < 0 ? 0 : tau;
            const unsigned ua = *(const GAS unsigned*)(Ub + (size_t)tc * 2048), ug = *(const GAS unsigned*)(Ub + (size_t)tc * 2048 + 1024);
            const f32x2 gl = glu2(ua, ug); win[s] = tau < 0 ? (f32x2){0.f, 0.f} : gl; }
        { f32x2 a = bd;
#pragma unroll
          for (int j = 0; j < CWID; ++j) a += w[j] * win[j];
          yb[tid] = pk2(a.x, a.y); }
#pragma unroll
        for (int s = 0; s < CWID; ++s) { const int tau = t0 + 1 + s;
            const unsigned ua = *(const GAS unsigned*)(Ub + (size_t)tau * 2048), ug = *(const GAS unsigned*)(Ub + (size_t)tau * 2048 + 1024);
            win[s] = glu2(ua, ug);
            f32x2 a = bd;
#pragma unroll
            for (int j = 0; j < CWID; ++j) a += w[j] * win[(s + 1 + j) % CWID];
            yb[(1 + s) * 512 + tid] = pk2(a.x, a.y); }
        LDS_WAIT(); __syncthreads();
#pragma unroll 1
        for (int rr = 0; rr < 4; ++rr) { const int r = wave * 4 + rr;
            const v4u p0 = *(const LAS v4u*)(lds + r * 2048 + lane * 16), p1 = *(const LAS v4u*)(lds + r * 2048 + 1024 + lane * 16);
            float x[16] = {bflo(p0.x), bfhi(p0.x), bflo(p0.y), bfhi(p0.y), bflo(p0.z), bfhi(p0.z), bflo(p0.w), bfhi(p0.w), bflo(p1.x), bfhi(p1.x), bflo(p1.y), bfhi(p1.y), bflo(p1.z), bfhi(p1.z), bflo(p1.w), bfhi(p1.w)};
            float s = 0.f;
#pragma unroll
            for (int i = 0; i < 16; ++i) s += x[i];
            const float mu = wave_sum(s) * (1.f / D); float q = 0.f;
#pragma unroll
            for (int i = 0; i < 16; ++i) { x[i] -= mu; q += x[i] * x[i]; }
            const float rs = 1.f / sqrtf(wave_sum(q) * (1.f / D) + EPS);
            unsigned o[8];
#pragma unroll
            for (int hh = 0; hh < 2; ++hh) { const f32x4 g0 = *(const f32x4*)(lng + hh * 512 + lane * 8), g1 = *(const f32x4*)(lng + hh * 512 + lane * 8 + 4), b0 = *(const f32x4*)(lnb + hh * 512 + lane * 8), b1 = *(const f32x4*)(lnb + hh * 512 + lane * 8 + 4);
                float y[8] = {x[hh * 8 + 0] * rs * g0.x + b0.x, x[hh * 8 + 1] * rs * g0.y + b0.y, x[hh * 8 + 2] * rs * g0.z + b0.z, x[hh * 8 + 3] * rs * g0.w + b0.w,
                              x[hh * 8 + 4] * rs * g1.x + b1.x, x[hh * 8 + 5] * rs * g1.y + b1.y, x[hh * 8 + 6] * rs * g1.z + b1.z, x[hh * 8 + 7] * rs * g1.w + b1.w};
#pragma unroll
                for (int i = 0; i < 4; ++i) o[hh * 4 + i] = pk2(y[2 * i] * sigmoid_f(y[2 * i]), y[2 * i + 1] * sigmoid_f(y[2 * i + 1])); }
            bf16* cr = C + (rb + t0 + r) * D;
            *(GAS v4u*)(cr + lane * 8) = (v4u){o[0], o[1], o[2], o[3]}; *(GAS v4u*)(cr + 512 + lane * 8) = (v4u){o[4], o[5], o[6], o[7]}; }
        LDS_WAIT(); __syncthreads();
    }
}

__device__ __forceinline__ void rope_phase(bf16* Q, bf16* K, const int* pos, int gtid, int NT) {
    for (int idx = gtid; idx < M * 32; idx += NT) {
        const int m = idx >> 5, sub = idx & 31; bf16* p = ((sub & 16) ? K : Q) + (size_t)m * D + (sub & 15) * 64;
        v4u a = *(GAS v4u*)p, b = *(GAS v4u*)(p + 8); const float fp = (float)pos[m];
        unsigned ua[4] = {a.x, a.y, a.z, a.w}, ub[4] = {b.x, b.y, b.z, b.w};
#pragma unroll
        for (int i2 = 0; i2 < 4; ++i2) { float n1[2], n2[2];
#pragma unroll
            for (int e = 0; e < 2; ++e) { const int i = 2 * i2 + e; const float invf = __builtin_powf(500000.0f, -(float)i / 8.0f);
                const float ang = fp * invf, rev = ang * 0.15915494309189535f, fr = rev - __builtin_floorf(rev);
                const float sn = __builtin_amdgcn_sinf(fr), cs = __builtin_amdgcn_cosf(fr);
                const float x1 = e ? bfhi(ua[i2]) : bflo(ua[i2]), x2 = e ? bfhi(ub[i2]) : bflo(ub[i2]);
                n1[e] = x1 * cs - x2 * sn; n2[e] = x2 * cs + x1 * sn; }
            ua[i2] = pk2(n1[0], n1[1]); ub[i2] = pk2(n2[0], n2[1]); }
        *(GAS v4u*)p = (v4u){ua[0], ua[1], ua[2], ua[3]}; *(GAS v4u*)(p + 8) = (v4u){ub[0], ub[1], ub[2], ub[3]};
    }
}

__device__ __forceinline__ void combine_phase(const bf16* O0, const bf16* O1, bf16* OC, const float* lamp, const float* subln, int gw, int NGW, int lane) {
    const float l1 = wave_sum(lamp[lane] * lamp[64 + lane]), l2 = wave_sum(lamp[128 + lane] * lamp[192 + lane]);
    const float lam = __expf(l1) - __expf(l2) + LAM_INIT;
    float gsc[16];
#pragma unroll
    for (int i = 0; i < 16; ++i) gsc[i] = subln[(lane & 7) * 16 + i] * (1.0f - LAM_INIT);
    for (int m = gw; m < M; m += NGW) {
        const v4u a0 = *(const GAS v4u*)(O0 + (size_t)m * D + lane * 16), a1 = *(const GAS v4u*)(O0 + (size_t)m * D + lane * 16 + 8);
        const v4u b0 = *(const GAS v4u*)(O1 + (size_t)m * D + lane * 16), b1 = *(const GAS v4u*)(O1 + (size_t)m * D + lane * 16 + 8);
        const unsigned ua[8] = {a0.x, a0.y, a0.z, a0.w, a1.x, a1.y, a1.z, a1.w}, ub[8] = {b0.x, b0.y, b0.z, b0.w, b1.x, b1.y, b1.z, b1.w};
        float o[16]; float ss = 0.f;
#pragma unroll
        for (int i = 0; i < 8; ++i) { o[2 * i] = bflo(ua[i]) - lam * bflo(ub[i]); o[2 * i + 1] = bfhi(ua[i]) - lam * bfhi(ub[i]); ss += o[2 * i] * o[2 * i] + o[2 * i + 1] * o[2 * i + 1]; }
        ss += __shfl_xor(ss, 1); ss += __shfl_xor(ss, 2); ss += __shfl_xor(ss, 4);
        const float r = 1.f / sqrtf(ss * (1.f / 128.f) + EPS);
        unsigned w[8];
#pragma unroll
        for (int i = 0; i < 8; ++i) w[i] = pk2(o[2 * i] * r * gsc[2 * i], o[2 * i + 1] * r * gsc[2 * i + 1]);
        *(GAS v4u*)(OC + (size_t)m * D + lane * 16) = (v4u){w[0], w[1], w[2], w[3]}; *(GAS v4u*)(OC + (size_t)m * D + lane * 16 + 8) = (v4u){w[4], w[5], w[6], w[7]};
    }
}

__device__ __forceinline__ void select_phase(const float* LOG, const float* brg, const float* bre, unsigned* cnt, int* list, i32x4* TI, f32x2* TW, LAS int* lh, int vcu, int G, int tid) {
    for (int base = vcu * 128; base < M; base += G * 128) {
        if (tid < 32) lh[tid] = 0;
        __syncthreads();
        const int t = base + tid; int E1 = 0, E2 = 0, r1 = 0, r2 = 0; float w1 = 0.f, w2 = 0.f;
        if (tid < 128) {
            const f32x4 g4 = *(const GAS f32x4*)(LOG + (size_t)t * 64);
            const float gl[4] = {g4.x + brg[0], g4.y + brg[1], g4.z + brg[2], g4.w + brg[3]};
            int gi = 0; float gm = gl[0];
#pragma unroll
            for (int j = 1; j < 4; ++j) if (gl[j] > gm) { gm = gl[j]; gi = j; }
            float den = 0.f;
#pragma unroll
            for (int j = 0; j < 4; ++j) den += __expf(gl[j] - gm);
            const float gw_ = 1.f / den;
            const f32x4 ea = *(const GAS f32x4*)(LOG + (size_t)t * 64 + 4 + gi * 8), eb = *(const GAS f32x4*)(LOG + (size_t)t * 64 + 8 + gi * 8);
            const f32x4 ba = *(const f32x4*)(bre + gi * 8), bb = *(const f32x4*)(bre + gi * 8 + 4);
            const float el[8] = {ea.x + ba.x, ea.y + ba.y, ea.z + ba.z, ea.w + ba.w, eb.x + bb.x, eb.y + bb.y, eb.z + bb.z, eb.w + bb.w};
            int i1 = 0; float v1 = el[0];
#pragma unroll
            for (int j = 1; j < 8; ++j) if (el[j] > v1) { v1 = el[j]; i1 = j; }
            int i2 = -1; float v2 = -INFINITY;
#pragma unroll
            for (int j = 0; j < 8; ++j) if (j != i1 && (i2 < 0 || el[j] > v2)) { v2 = el[j]; i2 = j; }
            const float e2 = __expf(v2 - v1); const float p1 = 1.f / (1.f + e2);
            w1 = p1 * gw_; w2 = (e2 * p1) * gw_; E1 = gi * 8 + i1; E2 = gi * 8 + i2;
            r1 = __hip_atomic_fetch_add(lh + E1, 1, __ATOMIC_RELAXED, __HIP_MEMORY_SCOPE_WORKGROUP); r2 = __hip_atomic_fetch_add(lh + E2, 1, __ATOMIC_RELAXED, __HIP_MEMORY_SCOPE_WORKGROUP);
        }
        __syncthreads();
        if (tid < 32) { const int c = lh[tid]; int bs = 0; if (c) bs = (int)__hip_atomic_fetch_add(cnt + tid * 64, (unsigned)c, RLX_AGENT); lh[32 + tid] = bs; }
        __syncthreads();
        if (tid < 128) { const int s1 = lh[32 + E1] + r1, s2 = lh[32 + E2] + r2;
            list[(size_t)E1 * M + s1] = t; list[(size_t)E2 * M + s2] = t; TI[t] = (i32x4){E1, s1, E2, s2}; TW[t] = (f32x2){w1, w2}; }
        __syncthreads();
    }
}

struct GroupedOrder {
    int nNs, G, c, ntu;
    const LAS int* tile_e; const LAS int* tokl;
    __device__ __forceinline__ bool next(int i, pg8::Unit& u) const { const int L = i * G + c; if (L >= ntu) return false; const int mt = L >> nNs, pn = L & ((1 << nNs) - 1);
        const int e = tile_e[mt]; u.pm = mt; u.pn = pn; u.pb = (e << nNs) + pn; return true; }
    __device__ __forceinline__ unsigned arow(int ord, int r) const { return (unsigned)tokl[ord * 256 + r]; }
};
__device__ __forceinline__ GroupedOrder grouped_setup(const unsigned* cnt, const int* list, LAS unsigned char* lds, bool need_tok, int nNs, int G, int c, int tid, int lane, int wave) {
    LAS int* ts = (LAS int*)(lds + L_TS); LAS int* ne = (LAS int*)(lds + L_NE); LAS int* te = (LAS int*)(lds + L_TE); LAS int* tokl = (LAS int*)(lds + L_TOK);
    __syncthreads();
    if (wave == 0) {
        const unsigned n = lane < 32 ? __hip_atomic_load(cnt + lane * 64, RLX_AGENT) : 0u; const int tiles = (int)((n + 255u) >> 8); int incl = tiles;
#pragma unroll
        for (int o = 1; o < 32; o <<= 1) { const int t = __shfl_up(incl, o); if (lane >= o) incl += t; }
        const int excl = incl - tiles;
        if (lane < 32) { ts[lane] = excl; ne[lane] = (int)n; for (int k = 0; k < tiles; ++k) te[excl + k] = lane; }
        if (lane == 31) ts[32] = incl;
    }
    __syncthreads();
    GroupedOrder S; S.nNs = nNs; S.G = G; S.c = c; S.ntu = ts[32] << nNs; S.tile_e = te; S.tokl = tokl;
    if (need_tok) {
        for (int i = 0; i < MAXGU; ++i) { const int L = i * G + c; if (L >= S.ntu) break; const int mt = L >> nNs, e = te[mt];
            if (tid < 256) { const int slot = (mt - ts[e]) * 256 + tid; tokl[i * 256 + tid] = slot < ne[e] ? list[(size_t)e * M + slot] : 0; } }
        if (S.ntu > MAXGU * G) S.ntu = MAXGU * G;
        __syncthreads();
    }
    return S;
}

enum { I_X = 0, I_P, I_POS, I_NMIX, I_NFFN, I_CW1, I_CB1, I_CDW, I_CBDW, I_CLNG, I_CLNB, I_CW2, I_CB2, I_WQKV, I_LAM, I_SUBLN, I_WO,
       I_WRG, I_BRG, I_WRE, I_BRE, I_WG, I_WU, I_WDN, I_PNORM, I_PWG, I_PWP, I_FNORM, N_IN };
struct Args { const void* in[N_IN]; float* out; unsigned char* ws; int ph_lo, ph_hi; };

typedef const __attribute__((address_space(4))) Args* KArgP;
#define PH_IDS() const int tid = pg8::ltid(wave), lane = tid & 63, gtid = vcu * (NWAVES * 64) + tid; (void)lane; (void)gtid
__device__ __forceinline__ KArgP kargs() { KArgP k = (KArgP)__builtin_amdgcn_kernarg_segment_ptr(); asm volatile("" : "+s"(k)); return k; }
#define IN_F(k) ((const float*)ka->in[k])
#define WSP(off) ((bf16*)(ka->ws + (off)))
#define SLOT(i) ((bf16*)(ka->ws + WS_S0 + (size_t)(i) * WS_SS))
#define IN(k) (lo <= (k) && (k) < hi)
#define SEAM(k) do { if (IN(k) && IN((k) + 1)) xcd_barrier(bar); } while (0)
template <int l>
__device__ __forceinline__ void layer_tail(LAS unsigned char* lds, const XcdBarrier& bar, int lo, int hi, int wave, int G, int bx, int vcu, int gw, int NGW, int NTHR) {
    constexpr int pb = l ? 17 : 4;
    LAS float* scr = (LAS float*)(lds + RING_OFF + wave * 16384);
    if (IN(pb)) { KArgP ka = kargs(); PH_IDS(); rowpass<1>(l ? ka->out : IN_F(I_X), ka->out, IN_F(I_NFFN) + l * D, WSP(WS_H), nullptr, l ? SLOT(1) : SLOT(3), nullptr, nullptr, nullptr, nullptr, gw, NGW, lane); }
    SEAM(pb);
    if (IN(pb + 1)) { KArgP ka = kargs(); PH_IDS(); pg8::Gemm g{WSP(WS_H), WSP(WS_WR) + (size_t)l * 256 * D, M, 256, D}; pg8::StaticOrder S; S.init(M, 256, G, bx);
        pg8::EpiLogits E{(float*)(ka->ws + WS_LOG)};
        pg8::gemm_phase<pg8::EpiLogits, pg8::StaticOrder, true, false>(lds + RING_OFF, g, S, E, wave); }
    SEAM(pb + 1);
    if (IN(pb + 2)) { KArgP ka = kargs(); PH_IDS(); select_phase((const float*)(ka->ws + WS_LOG), IN_F(I_BRG) + l * 4, IN_F(I_BRE) + l * 32, (unsigned*)(ka->ws + WS_CTL) + CW_CNT + l * 32 * 64,
                                   (int*)(ka->ws + WS_LIST), (i32x4*)(ka->ws + WS_TI), (f32x2*)(ka->ws + WS_TW), (LAS int*)(lds + L_HIST), vcu, G, tid); }
    SEAM(pb + 2);
    if (IN(pb + 3)) { KArgP ka = kargs(); PH_IDS(); const GroupedOrder S = grouped_setup((const unsigned*)(ka->ws + WS_CTL) + CW_CNT + l * 32 * 64, (const int*)(ka->ws + WS_LIST), lds, true, 1, G, bx, tid, lane, wave);
        pg8::Gemm g{WSP(WS_H), WSP(WS_WGU), M, 512, D}; pg8::EpiGU E{l ? SLOT(1) : SLOT(4)};
        pg8::gemm_phase<pg8::EpiGU, GroupedOrder, true, true>(lds + RING_OFF, g, S, E, wave); }
    SEAM(pb + 3);
    if (IN(pb + 4)) { KArgP ka = kargs(); PH_IDS(); const GroupedOrder S = grouped_setup((const unsigned*)(ka->ws + WS_CTL) + CW_CNT + l * 32 * 64, (const int*)(ka->ws + WS_LIST), lds, false, 2, G, bx, tid, lane, wave);
        pg8::Gemm g{l ? SLOT(1) : SLOT(4), WSP(WS_WD), PADROWS, D, FE}; pg8::EpiBf16 E{l ? SLOT(2) : SLOT(0), D, nullptr, 0, 0, 1.f};
        pg8::gemm_phase<pg8::EpiBf16, GroupedOrder, true, false>(lds + RING_OFF, g, S, E, wave); }
    SEAM(pb + 4);
    if (IN(pb + 5)) { KArgP ka = kargs(); PH_IDS(); rowpass<2>(ka->out, ka->out, IN_F(I_PNORM) + l * D, WSP(WS_H), nullptr, l ? SLOT(2) : SLOT(0), nullptr, (const i32x4*)(ka->ws + WS_TI), (const f32x2*)(ka->ws + WS_TW),
                                                    (const unsigned*)(ka->ws + WS_CTL) + CW_CNT + l * 32 * 64, gw, NGW, lane); }
    SEAM(pb + 5);
    if (IN(pb + 6)) {
        { KArgP ka = kargs(); PH_IDS(); pg8::Gemm g{WSP(WS_P16) + (size_t)l * M * PLED, WSP(WS_WPP) + (size_t)l * D * PLED, M, D, PLED}; pg8::StaticOrder S; S.init(M, D, G, bx);
          pg8::EpiBf16 E{l ? SLOT(0) : SLOT(3), D, nullptr, 0, 0, 1.f};
          pg8::gemm_phase<pg8::EpiBf16, pg8::StaticOrder, true, false>(lds + RING_OFF, g, S, E, wave); }
        { KArgP ka = kargs(); PH_IDS(); pg8::Gemm g{WSP(WS_H), WSP(WS_WPG) + (size_t)l * D * D, M, D, D}; pg8::StaticOrder S; S.init(M, D, G, bx);
          pg8::EpiBf16 E{l ? SLOT(1) : SLOT(4), D, nullptr, 0, 0, 1.f};
          pg8::gemm_phase<pg8::EpiBf16, pg8::StaticOrder, true, false>(lds + RING_OFF, g, S, E, wave); }
    }
    SEAM(pb + 6);
    if (IN(pb + 7)) {
        if (l == 0) { { KArgP ka = kargs(); PH_IDS(); rowpass<3>(ka->out, ka->out, IN_F(I_NMIX) + D, WSP(WS_H), nullptr, SLOT(4), SLOT(3), nullptr, nullptr, nullptr, gw, NGW, lane); }
            { KArgP ka = kargs(); PH_IDS(); for (int it = gw; it < MOE_ITEMS; it += NGW) moe_item(IN_F(I_WG), IN_F(I_WU), IN_F(I_WDN), 1, WSP(WS_WGU), WSP(WS_WD), it, scr, lane); } }
        else { KArgP ka = kargs(); PH_IDS(); rowpass<3>(ka->out, nullptr, IN_F(I_FNORM), nullptr, ka->out, SLOT(1), SLOT(0), nullptr, nullptr, nullptr, gw, NGW, lane); }
    }
    if (l == 0) SEAM(pb + 7);
}
__global__ void __launch_bounds__(NWAVES * 64, 2) mk_fwd(Args args) {
    extern __shared__ __attribute__((aligned(16))) unsigned char lds_raw[];
    LAS unsigned char* lds = (LAS unsigned char*)lds_raw;
    const int tid0 = threadIdx.x, wave = __builtin_amdgcn_readfirstlane(tid0 >> 6);
    const int G = gridDim.x; const int bx = blockIdx.x; const int vcu = (G % 8 == 0) ? (bx % 8) * (G / 8) + bx / 8 : bx;
    const int gw = vcu * NWAVES + wave, NGW = G * NWAVES, NTHR = G * NWAVES * 64;
    gu32* ctl = (gu32*)(args.ws + WS_CTL);
    for (int u = tid0; u < (LDS_BYTES - LDSCTL_OFF) / 4; u += NWAVES * 64) ((LAS unsigned*)(lds + LDSCTL_OFF))[u] = 0u;
    __syncthreads();
    XcdBarrier bar = xcd_barrier_post((unsigned*)ctl + CW_BAR, (volatile LAS unsigned*)(lds + L_MISC) + 8);
    const int lo = args.ph_lo, hi = args.ph_hi;

    LAS float* scr = (LAS float*)(lds + RING_OFF + wave * 16384);

    if (IN(0)) {
        constexpr int I1 = 16 * 64, I2 = 16 * 32, I3 = 16 * 96, I4 = 16 * 32, I5 = 16 * 32, I6 = 4 * 32;
        constexpr int NIT = I1 + I2 + I3 + I4 + 2 * I5 + 2 * I6;
        { KArgP ka = kargs(); PH_IDS();
          for (int it = gw; it < NIT + MOE_ITEMS; it += NGW) {
            int r = it;
            if (r < I1) { tr_plain(IN_F(I_CW1), D, 2048, WSP(WS_WPW1), r, scr, lane); continue; } r -= I1;
            if (r < I2) { tr_plain(IN_F(I_CW2), D, D, WSP(WS_WPW2), r, scr, lane); continue; } r -= I2;
            if (r < I3) { tr_plain(IN_F(I_WQKV), D, NQKV, WSP(WS_WQKV), r, scr, lane); continue; } r -= I3;
            if (r < I4) { tr_plain(IN_F(I_WO), D, D, WSP(WS_WO), r, scr, lane); continue; } r -= I4;
            if (r < 2 * I5) { const int l = r / I5; tr_plain(IN_F(I_PWG) + (size_t)l * D * D, D, D, WSP(WS_WPG) + (size_t)l * D * D, r % I5, scr, lane); continue; } r -= 2 * I5;
            if (r < 2 * I6) { const int l = r / I6; tr_plain(IN_F(I_PWP) + (size_t)l * PLED * D, PLED, D, WSP(WS_WPP) + (size_t)l * D * PLED, r % I6, scr, lane); continue; } r -= 2 * I6;
            moe_item(IN_F(I_WG), IN_F(I_WU), IN_F(I_WDN), 0, WSP(WS_WGU), WSP(WS_WD), r, scr, lane);
          } }
        { KArgP ka = kargs(); PH_IDS(); const float* wrg = IN_F(I_WRG); const float* wre = IN_F(I_WRE); bf16* Wr = WSP(WS_WR);
          for (int idx = gtid; idx < 2 * 256 * 1024; idx += NTHR) { const int l = idx >> 18, row = (idx >> 10) & 255, k = idx & 1023; float v = 0.f;
              if (row < 4) v = wrg[((size_t)l * D + k) * 4 + row]; else if (row < 36) { const int g = (row - 4) >> 3, e = (row - 4) & 7; v = wre[(((size_t)l * 4 + g) * D + k) * 8 + e]; }
              Wr[idx] = (bf16)f2bf(v); } }
        { KArgP ka = kargs(); PH_IDS(); const f32x4* p4 = (const f32x4*)ka->in[I_P]; u32x2* o = (u32x2*)WSP(WS_P16);
          for (int idx = gtid; idx < 2 * M * PLED / 4; idx += NTHR) { const f32x4 v = p4[idx]; o[idx] = (u32x2){pk2(v.x, v.y), pk2(v.z, v.w)}; } }
        { KArgP ka = kargs(); PH_IDS(); rowpass<0>(IN_F(I_X), nullptr, IN_F(I_NMIX), WSP(WS_H), nullptr, nullptr, nullptr, nullptr, nullptr, nullptr, gw, NGW, lane); }
    }
    SEAM(0);


    if (IN(1)) { KArgP ka = kargs(); PH_IDS(); pg8::Gemm g{WSP(WS_H), WSP(WS_WPW1), M, 2048, D}; pg8::StaticOrder S; S.init(M, 2048, G, bx);
        pg8::EpiBf16 E{SLOT(0), 2048, IN_F(I_CB1), 0, 0, 1.f};
        pg8::gemm_phase<pg8::EpiBf16, pg8::StaticOrder, true, false>(lds + RING_OFF, g, S, E, wave); }
    SEAM(1);
    if (IN(2)) { KArgP ka = kargs(); PH_IDS(); conv_phase(SLOT(0), SLOT(2), IN_F(I_CDW), IN_F(I_CBDW), IN_F(I_CLNG), IN_F(I_CLNB), lds + RING_OFF, vcu, G, tid, lane, wave); }
    SEAM(2);
    if (IN(3)) { KArgP ka = kargs(); PH_IDS(); pg8::Gemm g{SLOT(2), WSP(WS_WPW2), M, D, D}; pg8::StaticOrder S; S.init(M, D, G, bx);
        pg8::EpiBf16 E{SLOT(3), D, IN_F(I_CB2), 0, 0, 1.f};
        pg8::gemm_phase<pg8::EpiBf16, pg8::StaticOrder, true, false>(lds + RING_OFF, g, S, E, wave); }
    SEAM(3);
    layer_tail<0>(lds, bar, lo, hi, wave, G, bx, vcu, gw, NGW, NTHR);

    if (IN(12)) { KArgP ka = kargs(); PH_IDS(); pg8::Gemm g{WSP(WS_H), WSP(WS_WQKV), M, NQKV, D}; pg8::StaticOrder S; S.init(M, NQKV, G, bx);
        pg8::EpiBf16 E{SLOT(0), D, nullptr, D, (size_t)(WS_SS / 2), attn_body::C2};
        pg8::gemm_phase<pg8::EpiBf16, pg8::StaticOrder, true, false>(lds + RING_OFF, g, S, E, wave); }
    SEAM(12);
    if (IN(13)) { KArgP ka = kargs(); PH_IDS(); rope_phase(SLOT(0), SLOT(1), (const int*)ka->in[I_POS], gtid, NTHR); }
    SEAM(13);
    if (IN(14)) { KArgP ka = kargs(); PH_IDS(); const attn_body::AttnTensors AT{(const attn_body::bf16*)SLOT(0), (const attn_body::bf16*)SLOT(1), (const attn_body::bf16*)SLOT(2), (attn_body::bf16*)SLOT(3), (attn_body::bf16*)SLOT(4)};
        const attn_body::ComboOrder S{vcu, G};
        attn_body::attn_phase<attn_body::ComboOrder>((char*)lds_raw + RING_OFF, AT, S, wave); }
    SEAM(14);
    if (IN(15)) { KArgP ka = kargs(); PH_IDS(); combine_phase(SLOT(3), SLOT(4), SLOT(0), IN_F(I_LAM), IN_F(I_SUBLN), gw, NGW, lane); }
    SEAM(15);
    if (IN(16)) { KArgP ka = kargs(); PH_IDS(); pg8::Gemm g{SLOT(0), WSP(WS_WO), M, D, D}; pg8::StaticOrder S; S.init(M, D, G, bx);
        pg8::EpiBf16 E{SLOT(1), D, nullptr, 0, 0, 1.f};
        pg8::gemm_phase<pg8::EpiBf16, pg8::StaticOrder, true, false>(lds + RING_OFF, g, S, E, wave); }
    SEAM(16);
    layer_tail<1>(lds, bar, lo, hi, wave, G, bx, vcu, gw, NGW, NTHR);
#undef IN
#undef SEAM
}

extern "C" void kernel_launch(void* const* d_in, const int* in_sizes, int n_in, void* d_out, int out_size, void* d_ws, size_t ws_size, hipStream_t stream) {
    static int grid = 0;
    if (grid == 0) {
        if (n_in != N_IN || in_sizes[0] != M * D || out_size != M * D || ws_size < WS_END) { fprintf(stderr, "kernel_launch: unexpected problem: n_in %d in0 %d out %d ws %zu (need %zu); nothing launched\n", n_in, n_in > 0 ? in_sizes[0] : -1, out_size, ws_size, (size_t)WS_END); grid = -1; return; }
        int dev = 0, cus = 0, per_cu = 0;
        if (hipGetDevice(&dev) != hipSuccess || hipDeviceGetAttribute(&cus, hipDeviceAttributeMultiprocessorCount, dev) != hipSuccess) { grid = -1; return; }
        if (hipFuncSetAttribute((const void*)mk_fwd, hipFuncAttributeMaxDynamicSharedMemorySize, LDS_BYTES) != hipSuccess) { fprintf(stderr, "kernel_launch: hipFuncSetAttribute failed\n"); grid = -1; return; }
        if (hipOccupancyMaxActiveBlocksPerMultiprocessor(&per_cu, (const void*)mk_fwd, NWAVES * 64, LDS_BYTES) != hipSuccess || per_cu < 1) { fprintf(stderr, "kernel_launch: occupancy query says %d\n", per_cu); }
        (void)hipGetLastError();
        grid = cus;
        if (grid > 256) grid = 256;
    }
    if (grid < 0) return;
    if (hipMemsetAsync((char*)d_ws + WS_CTL, 0, CTL_ZERO_BYTES, stream) != hipSuccess) return;
    Args a{};
    for (int i = 0; i < N_IN; ++i) a.in[i] = d_in[i];
    a.out = (float*)d_out; a.ws = (unsigned char*)d_ws;
#if MK_SPLIT
    for (int ph = 0; ph < NPHASE; ++ph) { a.ph_lo = ph; a.ph_hi = ph + 1; hipLaunchKernelGGL(mk_fwd, dim3(grid), dim3(NWAVES * 64), LDS_BYTES, stream, a); }
#else
    a.ph_lo = 0; a.ph_hi = NPHASE; hipLaunchKernelGGL(mk_fwd, dim3(grid), dim3(NWAVES * 64), LDS_BYTES, stream, a);
#endif
}
```

```cpp
#include <hip/hip_runtime.h>
#include <hip/hip_bf16.h>
#include <cstdio>
#include <cstdint>
#include <cmath>

#ifndef MK_SPLIT
#define MK_SPLIT 0
#endif

namespace pg8 {
#define PG8_LAS __attribute__((address_space(3)))
typedef unsigned short bf16_t;
typedef short bf16x8 __attribute__((ext_vector_type(8)));
typedef float f32x4 __attribute__((ext_vector_type(4)));
typedef unsigned u32x4 __attribute__((ext_vector_type(4)));
constexpr int BM = 256, BK = 64, HALF = 128, HTB = HALF * BK * 2  , STAGE_BYTES = 8 * HTB, NXCD = 8, WGM = 8;

__host__ __device__ __forceinline__ int lds_byte(int r, int c) { const int st = (r >> 4) * 2 + (c >> 5), rr = r & 15, cc = c & 31, ob = rr * 64 + cc * 2; return st * 1024 + (ob ^ (((ob >> 9) & 1) << 5)); }
__host__ __device__ __forceinline__ void stage_rc(int b, int& R, int& C) { const int st = b / 1024, sb = b % 1024, swz = sb ^ (((sb >> 9) & 1) << 5); R = (st >> 1) * 16 + swz / 64; C = (st & 1) * 32 + (swz % 64) / 2; }
__host__ __device__ __forceinline__ int perm32(int rho) { const int n = rho >> 4, i = rho & 15; return 8 * (i >> 2) + 4 * n + (i & 3); }

__device__ __forceinline__ int ltid(int wave) { int t; asm volatile("v_mbcnt_lo_u32_b32 %0, -1, 0\n\tv_mbcnt_hi_u32_b32 %0, -1, %0" : "=&v"(t)); return wave * 64 + t; }
struct Unit { int pm, pn, pb, aux; };
struct Gemm { const bf16_t* A; const bf16_t* Bt; int M, N, K; };

struct StaticOrder {
    int nM, nN, nwg, G, c;
    __host__ __device__ void init(int M, int N, int G_, int c_) { nM = M / BM; nN = N / BM; nwg = nM * nN; G = G_; c = c_; }
    __host__ __device__ bool next(int i, Unit& u) const {
        const long L = (long)i * G + c; if (L >= nwg) return false;
        int wgid = (int)L; { const int q = nwg / NXCD, r = nwg % NXCD, xcd = wgid % NXCD, off = wgid / NXCD; wgid = (xcd < r ? xcd * (q + 1) : r * (q + 1) + (xcd - r) * q) + off; }
        const int nig = WGM * nN, gid = wgid / nig, fm = gid * WGM, gsz = (nM - fm) < WGM ? (nM - fm) : WGM;
        u.pm = fm + ((wgid % nig) % gsz); u.pn = (wgid % nig) / gsz; u.pb = u.pn; u.aux = 0; return true;
    }
    __device__ __forceinline__ unsigned arow(int, int) const { return 0u; }
};

__device__ __forceinline__ unsigned cvt_pk_bf16(float lo, float hi) { unsigned r; asm volatile("v_cvt_pk_bf16_f32 %0, %1, %2" : "=v"(r) : "v"(lo), "v"(hi)); return r; }

typedef float f32x2e __attribute__((ext_vector_type(2)));
__device__ __forceinline__ float bf_lo(unsigned u) { return __builtin_bit_cast(float, u << 16); }
__device__ __forceinline__ float bf_hi(unsigned u) { return __builtin_bit_cast(float, u & 0xffff0000u); }
__device__ __forceinline__ float sigm_f(float x) { return __builtin_amdgcn_rcpf(1.f + __expf(-x)); }
__device__ __forceinline__ float silu_f(float x) { return x * sigm_f(x); }
__device__ __forceinline__ float ss_sum(const float* ssp, int row) { const f32x4* p = (const f32x4*)(ssp + (size_t)row * 16); const f32x4 a = p[0], b = p[1], c = p[2], d = p[3];
    return (((a[0] + a[1]) + (a[2] + a[3])) + ((b[0] + b[1]) + (b[2] + b[3]))) + (((c[0] + c[1]) + (c[2] + c[3])) + ((d[0] + d[1]) + (d[2] + d[3]))); }
__device__ __forceinline__ float rs_of(const float* ssp, int row) { return 1.f / sqrtf(ss_sum(ssp, row) * (1.f / 1024.f) + 1e-6f); }
__device__ __forceinline__ u32x4 pack8(const f32x4& v0, const f32x4& v1) { u32x4 w; w.x = cvt_pk_bf16(v0[0], v0[1]); w.y = cvt_pk_bf16(v0[2], v0[3]); w.z = cvt_pk_bf16(v1[0], v1[1]); w.w = cvt_pk_bf16(v1[2], v1[3]); return w; }
__device__ __forceinline__ void unpack8(const u32x4& w, f32x4& v0, f32x4& v1) { v0 = (f32x4){bf_lo(w.x), bf_hi(w.x), bf_lo(w.y), bf_hi(w.y)}; v1 = (f32x4){bf_lo(w.z), bf_hi(w.z), bf_lo(w.w), bf_hi(w.w)}; }
__device__ __forceinline__ float sumsq8(const f32x4& a, const f32x4& b) { return (a[0] * a[0] + a[1] * a[1]) + (a[2] * a[2] + a[3] * a[3]) + (b[0] * b[0] + b[1] * b[1]) + (b[2] * b[2] + b[3] * b[3]); }
__device__ __forceinline__ void ss_put(float* ssp, int row, int slot, float part, int fq) { part += __shfl_xor(part, 16); part += __shfl_xor(part, 32); if (fq == 0) ssp[(size_t)row * 16 + slot] = part; }

struct EpiBf16 {
    static constexpr bool PERM = true;
    bf16_t* O; int ldc;
    __device__ __forceinline__ void operator()(const f32x4 (&acc)[2][2][4][2], const Unit& u, int wr, int wc, int fr, int fq) const {
        const int row0 = u.pm * BM + wr * 64 + fr, col0 = u.pn * BM + wc * 32 + 8 * fq;
#pragma unroll
        for (int ai = 0; ai < 2; ++ai)
#pragma unroll
            for (int m = 0; m < 4; ++m) { bf16_t* rowp = O + (size_t)(row0 + ai * HALF + m * 16) * ldc + col0;
#pragma unroll
                for (int bj = 0; bj < 2; ++bj) *(u32x4*)(rowp + bj * HALF) = pack8(acc[ai][bj][m][0], acc[ai][bj][m][1]); }
    }
};
struct EpiGLU {
    static constexpr bool PERM = true;
    bf16_t* O; const float* bias; const float* ss;
    __device__ __forceinline__ void operator()(const f32x4 (&acc)[2][2][4][2], const Unit& u, int wr, int wc, int fr, int fq) const {
        const int row0 = u.pm * BM + wr * 64 + fr, c0 = u.pn * HALF + wc * 32 + 8 * fq;
        const f32x4 ba0 = *(const f32x4*)(bias + c0), ba1 = *(const f32x4*)(bias + c0 + 4), bg0 = *(const f32x4*)(bias + 1024 + c0), bg1 = *(const f32x4*)(bias + 1024 + c0 + 4);
#pragma unroll
        for (int ai = 0; ai < 2; ++ai)
#pragma unroll
            for (int m = 0; m < 4; ++m) { const int row = row0 + ai * HALF + m * 16; const float r = rs_of(ss, row);
                const f32x4 a0 = acc[ai][0][m][0] * r + ba0, a1 = acc[ai][0][m][1] * r + ba1, g0 = acc[ai][1][m][0] * r + bg0, g1 = acc[ai][1][m][1] * r + bg1;
                const f32x4 v0 = {a0[0] * sigm_f(g0[0]), a0[1] * sigm_f(g0[1]), a0[2] * sigm_f(g0[2]), a0[3] * sigm_f(g0[3])}, v1 = {a1[0] * sigm_f(g1[0]), a1[1] * sigm_f(g1[1]), a1[2] * sigm_f(g1[2]), a1[3] * sigm_f(g1[3])};
                *(u32x4*)(O + (size_t)row * 1024 + c0) = pack8(v0, v1); }
    }
};
struct EpiRes {
    static constexpr bool PERM = true;
    bf16_t* X; const float* bias; float* ss;
    __device__ __forceinline__ void operator()(const f32x4 (&acc)[2][2][4][2], const Unit& u, int wr, int wc, int fr, int fq) const {
        const int row0 = u.pm * BM + wr * 64 + fr, col0 = u.pn * BM + wc * 32 + 8 * fq;
        f32x4 bv[2][2];
#pragma unroll
        for (int bj = 0; bj < 2; ++bj)
#pragma unroll
            for (int n = 0; n < 2; ++n) bv[bj][n] = bias ? *(const f32x4*)(bias + col0 + bj * HALF + 4 * n) : (f32x4){0.f, 0.f, 0.f, 0.f};
#pragma unroll
        for (int ai = 0; ai < 2; ++ai)
#pragma unroll
            for (int m = 0; m < 4; ++m) { const int row = row0 + ai * HALF + m * 16; bf16_t* rowp = X + (size_t)row * 1024 + col0; float part = 0.f;
#pragma unroll
                for (int bj = 0; bj < 2; ++bj) { f32x4 x0, x1; unpack8(*(const u32x4*)(rowp + bj * HALF), x0, x1);
                    const f32x4 v0 = acc[ai][bj][m][0] + bv[bj][0] + x0, v1 = acc[ai][bj][m][1] + bv[bj][1] + x1; part += sumsq8(v0, v1);
                    *(u32x4*)(rowp + bj * HALF) = pack8(v0, v1); }
                ss_put(ss, row, u.pn * 4 + wc, part, fq); }
    }
};
template <bool F32OUT> struct EpiPle {
    static constexpr bool PERM = true;
    const bf16_t* Xin; const bf16_t* P; bf16_t* Xo; float* Fo; const float* ssin; float* ssout;
    __device__ __forceinline__ void operator()(const f32x4 (&acc)[2][2][4][2], const Unit& u, int wr, int wc, int fr, int fq) const {
        const int row0 = u.pm * BM + wr * 64 + fr, col0 = u.pn * BM + wc * 32 + 8 * fq;
#pragma unroll
        for (int ai = 0; ai < 2; ++ai)
#pragma unroll
            for (int m = 0; m < 4; ++m) { const int row = row0 + ai * HALF + m * 16; const size_t off = (size_t)row * 1024 + col0; const float r = rs_of(ssin, row); float part = 0.f;
#pragma unroll
                for (int bj = 0; bj < 2; ++bj) { f32x4 x0, x1, p0, p1; unpack8(*(const u32x4*)(Xin + off + bj * HALF), x0, x1); unpack8(*(const u32x4*)(P + off + bj * HALF), p0, p1);
                    const f32x4 a0 = acc[ai][bj][m][0] * r, a1 = acc[ai][bj][m][1] * r;
                    const f32x4 v0 = {x0[0] + sigm_f(a0[0]) * p0[0], x0[1] + sigm_f(a0[1]) * p0[1], x0[2] + sigm_f(a0[2]) * p0[2], x0[3] + sigm_f(a0[3]) * p0[3]};
                    const f32x4 v1 = {x1[0] + sigm_f(a1[0]) * p1[0], x1[1] + sigm_f(a1[1]) * p1[1], x1[2] + sigm_f(a1[2]) * p1[2], x1[3] + sigm_f(a1[3]) * p1[3]};
                    part += sumsq8(v0, v1);
                    if (F32OUT) { *(f32x4*)(Fo + off + bj * HALF) = v0; *(f32x4*)(Fo + off + bj * HALF + 4) = v1; } else *(u32x4*)(Xo + off + bj * HALF) = pack8(v0, v1); }
                ss_put(ssout, row, u.pn * 4 + wc, part, fq); }
    }
};
struct EpiLogits {
    static constexpr bool PERM = false;
    float* O; const float* ss;
    __device__ __forceinline__ void operator()(const f32x4 (&acc)[2][2][4][2], const Unit& u, int wr, int wc, int fr, int fq) const {
        if (wc < 2) {
            const int row0 = u.pm * BM + wr * 64 + fr;
#pragma unroll
            for (int ai = 0; ai < 2; ++ai)
#pragma unroll
                for (int m = 0; m < 4; ++m) { const int row = row0 + ai * HALF + m * 16; const float r = rs_of(ss, row);
#pragma unroll
                    for (int n = 0; n < 2; ++n) *(f32x4*)(O + (size_t)row * 64 + wc * 32 + n * 16 + 4 * fq) = acc[ai][0][m][n] * r; }
        }
    }
};
struct EpiGU {
    static constexpr bool PERM = true;
    bf16_t* O; const float* rp;
    __device__ __forceinline__ void operator()(const f32x4 (&acc)[2][2][4][2], const Unit& u, int wr, int wc, int fr, int fq) const {
        const int trow0 = wr * 64 + fr, col0 = u.pn * HALF + wc * 32 + 8 * fq;
#pragma unroll
        for (int ai = 0; ai < 2; ++ai)
#pragma unroll
            for (int m = 0; m < 4; ++m) { const int trow = trow0 + ai * HALF + m * 16; const float r = rp[(size_t)u.aux + trow];
                const f32x4 g0 = acc[ai][0][m][0] * r, g1 = acc[ai][0][m][1] * r, u0 = acc[ai][1][m][0] * r, u1 = acc[ai][1][m][1] * r;
                const f32x4 v0 = {silu_f(g0[0]) * u0[0], silu_f(g0[1]) * u0[1], silu_f(g0[2]) * u0[2], silu_f(g0[3]) * u0[3]}, v1 = {silu_f(g1[0]) * u1[0], silu_f(g1[1]) * u1[1], silu_f(g1[2]) * u1[2], silu_f(g1[3]) * u1[3]};
                *(u32x4*)(O + (size_t)(u.pm * BM + trow) * 256 + col0) = pack8(v0, v1); }
    }
};
struct EpiQKV {
    static constexpr bool PERM = true;
    bf16_t* O; size_t stride; const float* ss; const int* pos; float scaleq;
    __device__ __forceinline__ void operator()(const f32x4 (&acc)[2][2][4][2], const Unit& u, int wr, int wc, int fr, int fq) const {
        const int t = (u.pn * BM) >> 10, colt = (u.pn * BM) & 1023, row0 = u.pm * BM + wr * 64 + fr, col0 = colt + wc * 32 + 8 * fq;
        bf16_t* base = O + (size_t)t * stride; const float sc = (t == 0) ? scaleq : 1.f; const bool roped = (t < 2) && ((wc & 1) == 0);
#pragma unroll
        for (int ai = 0; ai < 2; ++ai)
#pragma unroll
            for (int m = 0; m < 4; ++m) { const int row = row0 + ai * HALF + m * 16; const float r = rs_of(ss, row) * sc;
                float cs[8], sn[8];
                if (roped) { const float fp = (float)pos[row];
#pragma unroll
                    for (int i = 0; i < 8; ++i) { const float invf = __builtin_powf(500000.0f, -(float)i / 8.0f); const float ang = fp * invf, rev = ang * 0.15915494309189535f, fr_ = rev - __builtin_floorf(rev);
                        sn[i] = __builtin_amdgcn_sinf(fr_); cs[i] = __builtin_amdgcn_cosf(fr_); if (fq == 0) sn[i] = -sn[i]; } }
#pragma unroll
                for (int bj = 0; bj < 2; ++bj) { f32x4 v0 = acc[ai][bj][m][0] * r, v1 = acc[ai][bj][m][1] * r;
                    if (roped) { float pv[8];
#pragma unroll
                        for (int i = 0; i < 4; ++i) { pv[i] = __shfl_xor(v0[i], 16); pv[4 + i] = __shfl_xor(v1[i], 16); }
                        if (fq < 2) {
#pragma unroll
                            for (int i = 0; i < 4; ++i) { v0[i] = v0[i] * cs[i] + pv[i] * sn[i]; v1[i] = v1[i] * cs[4 + i] + pv[4 + i] * sn[4 + i]; } } }
                    *(u32x4*)(base + (size_t)row * 1024 + col0 + bj * HALF) = pack8(v0, v1); } }
    }
};

template <class Epi, class Sched, bool ALIGN_EPI, bool GATHER>
__device__ __forceinline__ void gemm_phase(PG8_LAS unsigned char* lds, const Gemm g, const Sched& S, const Epi& E, int wave_) {
    const int tid = ltid(wave_), wid = wave_, lane = tid & 63, wr = wid >> 2, wc = wid & 3, fr = lane & 15, fq = lane >> 4;
    const int K = g.K, nt = K / BK;
    unsigned voffA[2], voffB[2]; int sR[2], sC[2];
#pragma unroll
    for (int i = 0; i < 2; ++i) { int R, C; stage_rc(tid * 16 + i * 8192, R, C); const int Rb = Epi::PERM ? ((R & ~31) + perm32(R & 31)) : R;
        sR[i] = R; sC[i] = C; voffA[i] = (unsigned)(R * K + C) * 2u; voffB[i] = (unsigned)(Rb * K + C) * 2u; }
    const size_t kstep = (size_t)(BK * 2);
    const size_t hstep = (size_t)HALF * K * 2;
    const size_t tstep = 2 * hstep;
    const unsigned ldsw = (unsigned)wid * 1024u;
    const int aoff = lds_byte(wr * 64 + fr, fq * 8), boff = lds_byte(wc * 32 + fr, fq * 8);
#define PG8_SA(b, h) (((b) * 2 + (h)) * HTB)
#define PG8_SB(b, h) ((4 + (b) * 2 + (h)) * HTB)
#define PG8_STAGE(bufoff, gbase, voff) do { _Pragma("unroll") for (int _i = 0; _i < 2; ++_i) \
        __builtin_amdgcn_global_load_lds((const unsigned*)((const char*)(gbase) + (voff)[_i]), (PG8_LAS unsigned*)(lds + (bufoff) + ldsw + _i * 8192), 16, 0, 0); } while (0)
#define PG8_STAGE_A(bufoff, base, kb, h, vv) do { _Pragma("unroll") for (int _i = 0; _i < 2; ++_i) { \
        const char* _p = GATHER ? ((const char*)g.A + (kb) + (vv)[h][_i]) : ((const char*)(base) + (kb) + (size_t)(h) * hstep + voffA[_i]); \
        __builtin_amdgcn_global_load_lds((const unsigned*)_p, (PG8_LAS unsigned*)(lds + (bufoff) + ldsw + _i * 8192), 16, 0, 0); } } while (0)
#define PG8_GOFF(vv, ord) do { _Pragma("unroll") for (int _h = 0; _h < 2; ++_h) _Pragma("unroll") for (int _i = 0; _i < 2; ++_i) \
        (vv)[_h][_i] = S.arow((ord), _h * HALF + sR[_i]) * (unsigned)(K * 2) + (unsigned)(sC[_i] * 2); } while (0)
#define PG8_LDA(dst, b, h) do { _Pragma("unroll") for (int m = 0; m < 4; ++m) _Pragma("unroll") for (int k = 0; k < 2; ++k) dst[m][k] = *(const PG8_LAS bf16x8*)(lds + PG8_SA(b, h) + aoff + m * 2048 + k * 1024); } while (0)
#define PG8_LDB(dst, b, h) do { _Pragma("unroll") for (int n = 0; n < 2; ++n) _Pragma("unroll") for (int k = 0; k < 2; ++k) dst[n][k] = *(const PG8_LAS bf16x8*)(lds + PG8_SB(b, h) + boff + n * 2048 + k * 1024); } while (0)
#define PG8_MMA(ai, bj, At, Bt) do { __builtin_amdgcn_s_setprio(1); _Pragma("unroll") for (int m = 0; m < 4; ++m) _Pragma("unroll") for (int n = 0; n < 2; ++n) _Pragma("unroll") for (int k = 0; k < 2; ++k) \
        acc[ai][bj][m][n] = __builtin_amdgcn_mfma_f32_16x16x32_bf16(Bt[n][k], At[m][k], acc[ai][bj][m][n], 0, 0, 0); __builtin_amdgcn_s_setprio(0); } while (0)
#define PG8_WAIT_V(n) asm volatile("s_waitcnt vmcnt(" #n ")" ::: "memory")
#define PG8_WAIT_L(n) asm volatile("s_waitcnt lgkmcnt(" #n ")" ::: "memory")
#define PG8_BAR __builtin_amdgcn_s_barrier()
#define PG8_SCHED __builtin_amdgcn_sched_barrier(0)
    Unit cur, nxt; int ui = 0;
    if (!S.next(0, cur)) return;
    f32x4 acc[2][2][4][2];
#pragma unroll
    for (int a = 0; a < 2; ++a)
#pragma unroll
        for (int b = 0; b < 2; ++b)
#pragma unroll
            for (int m = 0; m < 4; ++m)
#pragma unroll
                for (int n = 0; n < 2; ++n) acc[a][b][m][n] = (f32x4){0.f, 0.f, 0.f, 0.f};
    bf16x8 At[4][2], B0[2][2], B1[2][2];
    unsigned vA[2][2] = {{0u, 0u}, {0u, 0u}}, vN[2][2] = {{0u, 0u}, {0u, 0u}}, vS[2][2] = {{0u, 0u}, {0u, 0u}};
    if constexpr (GATHER) { PG8_GOFF(vA, 0); }
    const char* cA = GATHER ? (const char*)g.A : (const char*)g.A + (size_t)cur.pm * tstep; const char* cB = (const char*)g.Bt + (size_t)cur.pb * tstep;
    PG8_STAGE(PG8_SB(0, 0), cB, voffB); PG8_STAGE(PG8_SB(0, 1), cB + hstep, voffB); PG8_STAGE_A(PG8_SA(0, 0), cA, 0, 0, vA); PG8_STAGE_A(PG8_SA(0, 1), cA, 0, 1, vA);
    if (wr == 1) PG8_BAR;
    PG8_WAIT_V(2); PG8_BAR;
    PG8_STAGE(PG8_SB(1, 0), cB + kstep, voffB); PG8_STAGE_A(PG8_SA(1, 0), cA, kstep, 0, vA); PG8_STAGE(PG8_SB(1, 1), cB + hstep + kstep, voffB);
    PG8_WAIT_V(6); PG8_BAR;
    for (;;) {
        const bool has_next = S.next(ui + 1, nxt);
        if constexpr (GATHER) { if (has_next) { PG8_GOFF(vN, ui + 1); } else { _Pragma("unroll") for (int _h = 0; _h < 2; ++_h) _Pragma("unroll") for (int _i = 0; _i < 2; ++_i) vN[_h][_i] = vA[_h][_i]; } }
        const char* nA = (has_next && !GATHER) ? (const char*)g.A + (size_t)nxt.pm * tstep : cA; const char* nB = has_next ? (const char*)g.Bt + (size_t)nxt.pb * tstep : cB;
        for (int t = 0; t < nt; t += 2) {
            const bool last = (t == nt - 2);
            const size_t kb1 = (size_t)(t + 1) * kstep, kb2 = last ? (size_t)0 : (size_t)(t + 2) * kstep, kb3 = kb2 + kstep;
            const char* sA = last ? nA : cA; const char* b2 = last ? nB : cB + (size_t)(t + 2) * kstep; const char* b3 = b2 + kstep;
            if constexpr (GATHER) { _Pragma("unroll") for (int _h = 0; _h < 2; ++_h) _Pragma("unroll") for (int _i = 0; _i < 2; ++_i) vS[_h][_i] = last ? vN[_h][_i] : vA[_h][_i]; }
            PG8_LDB(B0, 0, 0); PG8_LDB(B1, 0, 1); PG8_SCHED; PG8_LDA(At, 0, 0); PG8_STAGE_A(PG8_SA(1, 1), cA, kb1, 1, vA);
            PG8_WAIT_V(8); PG8_WAIT_L(0); PG8_BAR; PG8_MMA(0, 0, At, B0); PG8_MMA(0, 1, At, B1); PG8_BAR; PG8_SCHED;
            PG8_LDA(At, 0, 1); PG8_STAGE(PG8_SB(0, 0), b2, voffB); PG8_STAGE(PG8_SB(0, 1), b2 + hstep, voffB); PG8_STAGE_A(PG8_SA(0, 0), sA, kb2, 0, vS);
            PG8_WAIT_V(8); PG8_WAIT_L(0); PG8_BAR; PG8_MMA(1, 0, At, B0); PG8_MMA(1, 1, At, B1); PG8_BAR; PG8_SCHED;
            PG8_LDB(B0, 1, 0); PG8_LDB(B1, 1, 1); PG8_SCHED; PG8_LDA(At, 1, 0); PG8_STAGE_A(PG8_SA(0, 1), sA, kb2, 1, vS);
            PG8_WAIT_V(8); PG8_WAIT_L(0); PG8_BAR; PG8_MMA(0, 0, At, B0); PG8_MMA(0, 1, At, B1); PG8_BAR; PG8_SCHED;
            PG8_LDA(At, 1, 1); PG8_STAGE(PG8_SB(1, 0), b3, voffB); PG8_STAGE(PG8_SB(1, 1), b3 + hstep, voffB); PG8_STAGE_A(PG8_SA(1, 0), sA, kb3, 0, vS);
            PG8_WAIT_V(8); PG8_WAIT_L(0); PG8_BAR; PG8_MMA(1, 0, At, B0); PG8_MMA(1, 1, At, B1); PG8_BAR; PG8_SCHED;
        }
        if constexpr (ALIGN_EPI) { if (wr == 0) PG8_BAR; }
        E(acc, cur, wr, wc, fr, fq);
        if (!has_next) break;
#pragma unroll
        for (int a = 0; a < 2; ++a)
#pragma unroll
            for (int b = 0; b < 2; ++b)
#pragma unroll
                for (int m = 0; m < 4; ++m)
#pragma unroll
                    for (int n = 0; n < 2; ++n) acc[a][b][m][n] = (f32x4){0.f, 0.f, 0.f, 0.f};
        cur = nxt; cA = nA; cB = nB; ++ui;
        if constexpr (GATHER) { _Pragma("unroll") for (int _h = 0; _h < 2; ++_h) _Pragma("unroll") for (int _i = 0; _i < 2; ++_i) vA[_h][_i] = vN[_h][_i]; }
        if constexpr (ALIGN_EPI) { if (wr == 1) PG8_BAR; }
    }
    PG8_WAIT_V(0);
    if constexpr (!ALIGN_EPI) { if (wr == 0) PG8_BAR; }
    PG8_BAR;
#undef PG8_SA
#undef PG8_SB
#undef PG8_STAGE
#undef PG8_STAGE_A
#undef PG8_GOFF
#undef PG8_LDA
#undef PG8_LDB
#undef PG8_MMA
#undef PG8_WAIT_V
#undef PG8_WAIT_L
#undef PG8_BAR
#undef PG8_SCHED
}
}

#include <hip/hip_bf16.h>
#include <cmath>
namespace attn_body {
using bf16=__hip_bfloat16;
using bf16x8=__attribute__((ext_vector_type(8)))short;
using s16x4=__attribute__((ext_vector_type(4)))short;
using f32x16=__attribute__((ext_vector_type(16)))float;
using u32x4=__attribute__((ext_vector_type(4)))unsigned;
constexpr int BATCH=8,NHEAD=16,SEQ=4096,D=64,DM=NHEAD*D;
constexpr int NW=8,QBLK=32,QB=QBLK*NW,KVBLK=64,NQB=SEQ/QB;
constexpr int ATTN_PITCH=DM, ATTN_UNIT_ROWS=QB;
__device__ __forceinline__ int crow(int r,int hi){return (r&3)+8*(r>>2)+4*hi;}
#define SBAR() __builtin_amdgcn_sched_barrier(0)
__device__ __forceinline__ void cmask(f32x16&p0,f32x16&p1,int jb,int qrel,int hi){
  const float NEG=-INFINITY; int kb=64*jb+4*hi;
  #pragma unroll
  for(int r=0;r<16;++r){int kv=kb+(r&3)+8*(r>>2); if(kv>qrel)p0[r]=NEG; if(kv+32>qrel)p1[r]=NEG;}
}

constexpr int NSLOT=3, SLOTB=8192;
constexpr int LDS_K=0, LDS_V=NSLOT*SLOTB, LDS_WS=2*NSLOT*SLOTB, LDS_OST=LDS_WS+NW*64*4, LDS_BYTES=LDS_OST+NW*4096;
constexpr float C2=0.125f*1.4426950408889634f;
__device__ __forceinline__ void glds16(const void*gsrc,unsigned lds_dst){unsigned keep;
  asm volatile("s_mov_b32 %0, m0\n\ts_mov_b32 m0, %2\n\ts_nop 0\n\tglobal_load_lds_dwordx4 %1, off\n\ts_mov_b32 m0, %0":"=&s"(keep):"v"(gsrc),"s"(lds_dst):"memory");}
__device__ __forceinline__ float max3f(float a,float b,float c){float r;asm("v_max3_f32 %0, %1, %2, %3":"=v"(r):"v"(a),"v"(b),"v"(c));return r;}
__device__ __forceinline__ float max2f(float a,float b){float r;asm("v_max_f32_e32 %0, %1, %2":"=v"(r):"v"(a),"v"(b));return r;}
__device__ __forceinline__ float fadd_s(float a,float b){float r;asm("v_add_f32_e32 %0, %1, %2":"=v"(r):"v"(a),"v"(b));return r;}
__device__ __forceinline__ float fsub_s(float a,float b){float r;asm("v_sub_f32_e32 %0, %1, %2":"=v"(r):"v"(a),"v"(b));return r;}
typedef float f32x2_t __attribute__((ext_vector_type(2))); typedef __bf16 bf16x2_t __attribute__((ext_vector_type(2)));
__device__ __forceinline__ unsigned cvtpk_s(float lo,float hi){f32x2_t v={lo,hi};bf16x2_t b=__builtin_convertvector(v,bf16x2_t);return __builtin_bit_cast(unsigned,b);}
#define WAIT_BAR(N) asm volatile("s_waitcnt vmcnt(" #N ") lgkmcnt(0)\n\ts_barrier":::"memory")

__device__ __forceinline__ void qkt(f32x16&p0,f32x16&p1,const char*Kslot,const bf16x8*qr,const f32x16&negm,int r32,int hi){
  const char*kb=Kslot+hi*1024+r32*16;
  #pragma unroll
  for(int d0=0;d0<4;++d0){
    const bf16x8 b0=*reinterpret_cast<const bf16x8*>(kb+d0*2048);
    const bf16x8 b1=*reinterpret_cast<const bf16x8*>(kb+d0*2048+512);
    if(d0==0){p0=__builtin_amdgcn_mfma_f32_32x32x16_bf16(b0,qr[0],negm,0,0,0);p1=__builtin_amdgcn_mfma_f32_32x32x16_bf16(b1,qr[0],negm,0,0,0);}
    else{p0=__builtin_amdgcn_mfma_f32_32x32x16_bf16(b0,qr[d0],p0,0,0,0);p1=__builtin_amdgcn_mfma_f32_32x32x16_bf16(b1,qr[d0],p1,0,0,0);}}
}
typedef __attribute__((address_space(3))) const char* lds_cptr;
typedef short v4i16_t __attribute__((ext_vector_type(4)));
__device__ __forceinline__ void kload8(bf16x8*kf,lds_cptr kp){
  kf[0]=*(const __attribute__((address_space(3))) bf16x8*)(kp);      kf[1]=*(const __attribute__((address_space(3))) bf16x8*)(kp+512);
  kf[2]=*(const __attribute__((address_space(3))) bf16x8*)(kp+2048); kf[3]=*(const __attribute__((address_space(3))) bf16x8*)(kp+2560);
  kf[4]=*(const __attribute__((address_space(3))) bf16x8*)(kp+4096); kf[5]=*(const __attribute__((address_space(3))) bf16x8*)(kp+4608);
  kf[6]=*(const __attribute__((address_space(3))) bf16x8*)(kp+6144); kf[7]=*(const __attribute__((address_space(3))) bf16x8*)(kp+6656);
}
__device__ __forceinline__ void kload2(bf16x8*kf,lds_cptr kp,int j){ kf[2*j]=*(const __attribute__((address_space(3))) bf16x8*)(kp+j*2048); kf[2*j+1]=*(const __attribute__((address_space(3))) bf16x8*)(kp+j*2048+512); }
__device__ __forceinline__ s16x4 vtr(lds_cptr p){ return __builtin_bit_cast(s16x4,__builtin_amdgcn_ds_read_tr16_b64_v4i16((__attribute__((address_space(3))) v4i16_t*)p)); }
__device__ __forceinline__ float rowmax(const f32x16&p0,const f32x16&p1){
  float a=max3f(p0[0],p0[1],p1[0]),b=max3f(p0[2],p0[3],p1[1]);a=max3f(a,p1[2],p1[3]);
  #pragma unroll
  for(int r=4;r<16;r+=4){a=max3f(a,p0[r],p0[r+1]);b=max3f(b,p0[r+2],p0[r+3]);a=max3f(a,p1[r],p1[r+1]);b=max3f(b,p1[r+2],p1[r+3]);}
  const float m=max2f(a,b);
  auto rr=__builtin_amdgcn_permlane32_swap(__float_as_uint(m),__float_as_uint(m),false,false);
  return max2f(__uint_as_float(rr[0]),__uint_as_float(rr[1]));
}
__device__ __forceinline__ void pv(f32x16*o,int vb,bf16x8 pa0,bf16x8 pa1,bf16x8 pa2,bf16x8 pa3){
  #pragma unroll
  for(int d0=0;d0<2;++d0){s16x4 lo[4],hi[4];
    #pragma unroll
    for(int ks=0;ks<4;++ks){
      asm volatile("ds_read_b64_tr_b16 %0,%1 offset:%c2":"=&v"(lo[ks]):"v"(vb),"i"(d0*4096+ks*1024):"memory");
      asm volatile("ds_read_b64_tr_b16 %0,%1 offset:%c2":"=&v"(hi[ks]):"v"(vb),"i"(d0*4096+ks*1024+512):"memory");}
    asm volatile("s_waitcnt lgkmcnt(0)":::"memory");SBAR();
    #define PK(k) (bf16x8){lo[k][0],lo[k][1],lo[k][2],lo[k][3],hi[k][0],hi[k][1],hi[k][2],hi[k][3]}
    o[d0]=__builtin_amdgcn_mfma_f32_32x32x16_bf16(pa0,PK(0),o[d0],0,0,0);
    o[d0]=__builtin_amdgcn_mfma_f32_32x32x16_bf16(pa1,PK(1),o[d0],0,0,0);
    o[d0]=__builtin_amdgcn_mfma_f32_32x32x16_bf16(pa2,PK(2),o[d0],0,0,0);
    o[d0]=__builtin_amdgcn_mfma_f32_32x32x16_bf16(pa3,PK(3),o[d0],0,0,0);
    #undef PK
  }
}

#ifndef ATTN_STORE16
#define ATTN_STORE16(p,v) (*(u32x4*)(p)=(v))
#endif
template<int THRL> __device__ __forceinline__ void attn_unit(int b,int h,int qb,const bf16*Q,const bf16*__restrict__ K,const bf16*__restrict__ V,bf16*O,char*shm,int wave_){
  const int wid=wave_; const int tid=pg8::ltid(wid); const int lane=tid&63,r32=lane&31,hi=lane>>5;
  const long rowbase=(long)b*SEQ; const int q0=qb*QB;
  const bf16*Qw=Q+(rowbase+q0+wid*QBLK)*DM+h*D;
  const bf16*Kh=K+rowbase*DM+h*D,*Vh=V+rowbase*DM+h*D;
  const unsigned lds0=(unsigned)(uintptr_t)shm;
  float*wsf=(float*)(shm+LDS_WS)+wid*64;
  const bf16*ksrc=Kh+(long)lane*DM+wid*8;
  const bf16*vsrc=Vh+(long)(16*(wid&3)+(lane>>2))*DM+(wid>>2)*32+(lane&3)*8;
  const unsigned kdst=lds0+LDS_K+wid*1024, vdst=lds0+LDS_V+wid*1024;
  #define DMA_K(t,slot) glds16(ksrc+(long)(t)*KVBLK*DM,(unsigned)__builtin_amdgcn_readfirstlane(kdst+(slot)))
  #define DMA_V(t,slot) glds16(vsrc+(long)(t)*KVBLK*DM,(unsigned)__builtin_amdgcn_readfirstlane(vdst+(slot)))
  const int vb0=(int)(lds0+LDS_V)+((lane>>4)&1)*32+(lane&3)*8+(4*hi+((lane&15)>>2))*64;
  const char*Kbase=shm+LDS_K; bf16x8 kf[8];
  const lds_cptr shm3=(lds_cptr)shm; const lds_cptr kp0=shm3+LDS_K+hi*1024+r32*16; const lds_cptr vp0=shm3+LDS_V+((lane>>4)&1)*32+(lane&3)*8+(4*hi+((lane&15)>>2))*64;
  const int NT=(q0+QB)/KVBLK;
  DMA_K(0,0);DMA_V(0,0);DMA_K(1,SLOTB);
  bf16x8 qr[4];
  #pragma unroll
  for(int d0=0;d0<4;++d0)qr[d0]=*reinterpret_cast<const bf16x8*>(&Qw[(long)r32*DM+d0*16+hi*8]);
  float mhat=0.f,l_reg=0.f;f32x16 o[2];o[0]=f32x16{};o[1]=f32x16{};f32x16 negm=f32x16{};asm volatile("":"+v"(negm));
  const int qrel=wid*QBLK+r32;
  #define CMASK(P0,P1,t) do{int jb_=(t)-(NT-4); if(jb_>=0)cmask(P0,P1,jb_,qrel,hi);}while(0)
  bool resc=false;
  #define START(P0,P1) do{ const float rm=rowmax(P0,P1); resc=false; \
    { const float dl=rm; mhat=fadd_s(mhat,dl); \
      _Pragma("unroll") for(int r=0;r<16;++r){P0[r]=fsub_s(P0[r],dl);P1[r]=fsub_s(P1[r],dl);} \
      _Pragma("unroll") for(int r=0;r<16;++r)negm[r]=-mhat; asm volatile("":"+v"(negm)); } \
    _Pragma("unroll") for(int r=0;r<16;++r)P0[r]=__builtin_amdgcn_exp2f(P0[r]); }while(0)
  #define RESC() do{ if(resc){ asm volatile("s_waitcnt lgkmcnt(0)":::"memory"); \
      _Pragma("unroll") for(int d_=0;d_<2;++d_) _Pragma("unroll") for(int r=0;r<16;++r)o[d_][r]*=wsf[crow(r,hi)]; } }while(0)
  f32x16 pA0,pA1,pB0,pB1;
  int sl_prev=0,sl_cur=0,sl_next=SLOTB;
  #define ROT() do{sl_prev=sl_cur;sl_cur=sl_next;sl_next=(sl_next==(NSLOT-1)*SLOTB)?0:sl_next+SLOTB;}while(0)
  DMA_K(2,2*SLOTB);
  WAIT_BAR(3);
  qkt(pA0,pA1,Kbase,qr,negm,r32,hi);asm volatile("s_nop 15\n\ts_nop 7":"+v"(pA0),"+v"(pA1));CMASK(pA0,pA1,0);
  START(pA0,pA1);
  _Pragma("unroll") for(int r=0;r<16;++r)pA1[r]=__builtin_amdgcn_exp2f(pA1[r]);
  WAIT_BAR(0);
  DMA_K(3,0);DMA_V(1,SLOTB);
  ROT();
  kload8(kf,kp0+sl_cur);
  WAIT_BAR(2);
  s16x4 vlo[8],vhi[8]; u32x4 pw0,pw1,pw2,pw3;
  #define PKW(P,B) cvtpk_s(P[B],P[B+1])
  #define PAF(k) __builtin_bit_cast(bf16x8,pw##k)
  #define VFR(i) (bf16x8){vlo[i][0],vlo[i][1],vlo[i][2],vlo[i][3],vhi[i][0],vhi[i][1],vhi[i][2],vhi[i][3]}
  #define PIN(x) asm volatile("":"+v"(x))
  #define MX3(a,b,c) __builtin_fmaxf(__builtin_fmaxf((a),(b)),(c))
  #define GAPA(MF,A0,A1,A2,A3,W0,W1,PW) do{ MF; sacc+=A0; sacc+=A1; sacc+=A2; sacc+=A3; PIN(sacc); W0; W1; PIN(PW); SBAR(); }while(0)
  #define EX(v) __builtin_amdgcn_exp2f(v)
  #define GAPB(MF,X,B) do{ MF; X[B]=EX(X[B]); X[B+1]=EX(X[B+1]); X[B+2]=EX(X[B+2]); X[B+3]=EX(X[B+3]); PIN(X); SBAR(); }while(0)
  #define VRD(i) do{ vlo[i]=vtr(vp_+(((i)>>2)*4096+((i)&3)*1024)); vhi[i]=vtr(vp_+(((i)>>2)*4096+((i)&3)*1024+512)); }while(0)
  #define KRD(G,j) do{ if(G){ kload2(kf,kp0+sl_next,j); SBAR(); } }while(0)
  #define STEP(C0,C1,P0,P1,t,GK,GV,GL) do{ SBAR(); \
    const lds_cptr vp_=vp0+sl_prev; \
    VRD(0); SBAR(); float sacc=(P0[0]+P0[1]); \
    GAPA(C0=__builtin_amdgcn_mfma_f32_32x32x16_bf16(kf[0],qr[0],negm,0,0,0), P0[2],P0[3],P0[4],P0[5],     pw0[0]=PKW(P0,0), pw0[1]=PKW(P0,2), pw0); \
    VRD(4); SBAR(); GAPA(C1=__builtin_amdgcn_mfma_f32_32x32x16_bf16(kf[1],qr[0],negm,0,0,0), P0[6],P0[7],P0[8],P0[9],     pw0[2]=PKW(P0,4), pw0[3]=PKW(P0,6), pw0); \
    VRD(1); SBAR(); GAPA(C0=__builtin_amdgcn_mfma_f32_32x32x16_bf16(kf[2],qr[1],C0,0,0,0),   P0[10],P0[11],P0[12],P0[13], pw1[0]=PKW(P0,8), pw1[1]=PKW(P0,10), pw1); \
    VRD(5); SBAR(); GAPA(C1=__builtin_amdgcn_mfma_f32_32x32x16_bf16(kf[3],qr[1],C1,0,0,0),   P0[14],P0[15],P1[0],P1[1],   pw1[2]=PKW(P0,12),pw1[3]=PKW(P0,14), pw1); \
    VRD(2); SBAR(); GAPA(C0=__builtin_amdgcn_mfma_f32_32x32x16_bf16(kf[4],qr[2],C0,0,0,0),   P1[2],P1[3],P1[4],P1[5],     pw2[0]=PKW(P1,0), pw2[1]=PKW(P1,2), pw2); \
    VRD(6); SBAR(); GAPA(C1=__builtin_amdgcn_mfma_f32_32x32x16_bf16(kf[5],qr[2],C1,0,0,0),   P1[6],P1[7],P1[8],P1[9],     pw2[2]=PKW(P1,4), pw2[3]=PKW(P1,6), pw2); \
    VRD(3); SBAR(); GAPA(C0=__builtin_amdgcn_mfma_f32_32x32x16_bf16(kf[6],qr[3],C0,0,0,0),   P1[10],P1[11],P1[12],P1[13], pw3[0]=PKW(P1,8), pw3[1]=PKW(P1,10), pw3); \
    VRD(7); SBAR(); GAPA(C1=__builtin_amdgcn_mfma_f32_32x32x16_bf16(kf[7],qr[3],C1,0,0,0),   P1[14],P1[15],0.f,0.f,       pw3[2]=PKW(P1,12),pw3[3]=PKW(P1,14), pw3); \
    l_reg+=sacc; \
    if(GK){DMA_K((t)+3,sl_cur);} if(GV){DMA_V((t)+1,sl_next);} \
    CMASK(C0,C1,t); \
    { float a=MX3(C0[0],C0[1],C1[0]),b=MX3(C0[2],C0[3],C1[1]); a=MX3(a,C1[2],C1[3]); \
      _Pragma("unroll") for(int r=4;r<16;r+=4){a=MX3(a,C0[r],C0[r+1]);b=MX3(b,C0[r+2],C0[r+3]);a=MX3(a,C1[r],C1[r+1]);b=MX3(b,C1[r+2],C1[r+3]);} \
      float rm=__builtin_fmaxf(a,b); { auto rr=__builtin_amdgcn_permlane32_swap(__float_as_uint(rm),__float_as_uint(rm),false,false); rm=__builtin_fmaxf(__uint_as_float(rr[0]),__uint_as_float(rr[1])); } \
      resc=false; \
      if(__builtin_expect(__any(rm>(float)THRL),0)){ const float dl=__builtin_fmaxf(rm,0.f); mhat+=dl; \
        _Pragma("unroll") for(int r=0;r<16;++r){C0[r]-=dl;C1[r]-=dl;} \
        _Pragma("unroll") for(int r=0;r<16;++r)negm[r]=-mhat; asm volatile("":"+v"(negm)); \
        const float f=__builtin_amdgcn_exp2f(-dl); l_reg*=f; if(hi==0)wsf[r32]=f; resc=true; } } \
    SBAR(); \
    GAPB(o[0]=__builtin_amdgcn_mfma_f32_32x32x16_bf16(PAF(0),VFR(0),o[0],0,0,0), C0,0); \
    GAPB(o[1]=__builtin_amdgcn_mfma_f32_32x32x16_bf16(PAF(0),VFR(4),o[1],0,0,0), C0,4); \
    KRD(GL,0); GAPB(o[0]=__builtin_amdgcn_mfma_f32_32x32x16_bf16(PAF(1),VFR(1),o[0],0,0,0), C0,8); \
    KRD(GL,1); GAPB(o[1]=__builtin_amdgcn_mfma_f32_32x32x16_bf16(PAF(1),VFR(5),o[1],0,0,0), C0,12); \
    KRD(GL,2); GAPB(o[0]=__builtin_amdgcn_mfma_f32_32x32x16_bf16(PAF(2),VFR(2),o[0],0,0,0), C1,0); \
    KRD(GL,3); GAPB(o[1]=__builtin_amdgcn_mfma_f32_32x32x16_bf16(PAF(2),VFR(6),o[1],0,0,0), C1,4); \
    GAPB(o[0]=__builtin_amdgcn_mfma_f32_32x32x16_bf16(PAF(3),VFR(3),o[0],0,0,0), C1,8); \
    GAPB(o[1]=__builtin_amdgcn_mfma_f32_32x32x16_bf16(PAF(3),VFR(7),o[1],0,0,0), C1,12); \
    }while(0)
  int t=1;
  #undef CMASK
  #define CMASK(P0,P1,t) do{}while(0)
  for(;t+5<NT;t+=2){
    STEP(pB0,pB1,pA0,pA1,t,true,true,true);     WAIT_BAR(2); RESC(); ROT();
    STEP(pA0,pA1,pB0,pB1,t+1,true,true,true);   WAIT_BAR(2); RESC(); ROT();
  }
  #undef CMASK
  #define CMASK(P0,P1,t) do{int jb_=(t)-(NT-4); if(jb_>=0)cmask(P0,P1,jb_,qrel,hi);}while(0)
  #define ENDW(tt) do{ if((tt)+3<NT){WAIT_BAR(2);} else if((tt)+2<NT){WAIT_BAR(1);} else {WAIT_BAR(0);} }while(0)
  for(;t+1<NT;t+=2){
    STEP(pB0,pB1,pA0,pA1,t,(t+3<NT),(t+1<NT),(t+1<NT));       ENDW(t);   RESC(); ROT();
    STEP(pA0,pA1,pB0,pB1,t+1,(t+4<NT),(t+2<NT),(t+2<NT));     ENDW(t+1); RESC(); ROT();
  }
  STEP(pB0,pB1,pA0,pA1,NT-1,false,false,false); RESC();
  { float sacc=pB0[0]+pB0[1]; _Pragma("unroll") for(int r=2;r<16;++r)sacc+=pB0[r]; _Pragma("unroll") for(int r=0;r<16;++r)sacc+=pB1[r]; l_reg+=sacc;
    pw0=(u32x4){PKW(pB0,0),PKW(pB0,2),PKW(pB0,4),PKW(pB0,6)};pw1=(u32x4){PKW(pB0,8),PKW(pB0,10),PKW(pB0,12),PKW(pB0,14)};pw2=(u32x4){PKW(pB1,0),PKW(pB1,2),PKW(pB1,4),PKW(pB1,6)};pw3=(u32x4){PKW(pB1,8),PKW(pB1,10),PKW(pB1,12),PKW(pB1,14)};
    SBAR(); pv(o,vb0+sl_cur,PAF(0),PAF(1),PAF(2),PAF(3)); }
  #undef PKW
  #undef PAF
  #undef VFR
  #undef PIN
  #undef MX3
  #undef GAPA
  #undef GAPB
  #undef EX
  #undef VRD
  #undef KRD
  #undef STEP
  #undef ENDW
  {auto rr=__builtin_amdgcn_permlane32_swap(__float_as_uint(l_reg),__float_as_uint(l_reg),false,false);l_reg=__uint_as_float(rr[0])+__uint_as_float(rr[1]);}
  if(hi==0)wsf[32+r32]=l_reg;asm volatile("s_waitcnt lgkmcnt(0)":::"memory");
  float rli[16];
  #pragma unroll
  for(int r=0;r<16;++r)rli[r]=__builtin_amdgcn_rcpf(wsf[32+crow(r,hi)]);
  bf16*Ow=O+(rowbase+q0+wid*QBLK)*DM+h*D;
  { bf16*stg=(bf16*)(shm+LDS_OST)+wid*2048;
    #pragma unroll
    for(int r=0;r<16;++r){const int orow=crow(r,hi);
      #pragma unroll
      for(int d0=0;d0<2;++d0)stg[orow*64+d0*32+r32]=__float2bfloat16(o[d0][r]*rli[r]);}
    asm volatile("s_waitcnt lgkmcnt(0)":::"memory");
    #pragma unroll
    for(int i=0;i<4;++i){const int row=i*8+(lane>>3),ch=lane&7; const u32x4 v=*(const u32x4*)(stg+row*64+ch*8); ATTN_STORE16(Ow+(long)row*DM+ch*8,v);} }
  asm volatile("s_waitcnt lgkmcnt(0)\n\ts_barrier":::"memory");
  #undef DMA_K
  #undef DMA_V
  #undef CMASK
  #undef START
  #undef RESC
  #undef ROT
}
constexpr int ATTN_LDS_BYTES=LDS_BYTES;
struct AttnTensors { const bf16* Q; const bf16* K; const bf16* V; bf16* O0; bf16* O1; };
struct AttnUnit { int combo; int qb; };
struct ComboOrder {
  int vcu, G;
  __device__ __forceinline__ bool next(int i,AttnUnit&u)const{ const int combo=vcu+(i>>4)*G; if(combo>=BATCH*32)return false; u.combo=combo; u.qb=15-(i&15); return true; }
};
template<class Sched,int THRL=8> __device__ __forceinline__ void attn_phase(char*lds,const AttnTensors&T,const Sched&S,int wave_){
  AttnUnit u;
  for(int i=0;S.next(i,u);++i){ const int b=u.combo>>5, hc=(u.combo>>1)&15, vh=u.combo&1, hv=(hc&~1)|vh; const long sh=(long)(hv-hc)*D;
    attn_unit<THRL>(b,hc,u.qb,T.Q,T.K,T.V+sh,((hc&1)?T.O1:T.O0)+sh,lds,wave_); }
}
#undef SBAR
#undef WAIT_BAR
}

#define GAS __attribute__((address_space(1)))
#define LAS __attribute__((address_space(3)))
typedef unsigned short bf16;
typedef unsigned v4u __attribute__((ext_vector_type(4)));
typedef float f32x4 __attribute__((ext_vector_type(4)));
typedef short bf16x8 __attribute__((ext_vector_type(8)));
typedef GAS unsigned gu32;
typedef GAS unsigned long long gu64;
#define RLX_AGENT __ATOMIC_RELAXED, __HIP_MEMORY_SCOPE_AGENT
#define LDS_WAIT() asm volatile("s_waitcnt lgkmcnt(0)" ::: "memory")
#define VM_WAIT() asm volatile("s_waitcnt vmcnt(0)" ::: "memory")
__device__ __forceinline__ unsigned long long rt() { return __builtin_amdgcn_s_memrealtime(); }
__device__ __forceinline__ unsigned f2bf(float f) { unsigned u = __builtin_bit_cast(unsigned, f); return (u + 0x7fffu + ((u >> 16) & 1u)) >> 16; }
__device__ __forceinline__ unsigned pk2(float lo, float hi) { return f2bf(lo) | (f2bf(hi) << 16); }

#define XB_TMO      128
#define XB_XCNT(j)  (256  + 64 * (j))
#define XB_XSUB(j)  (1280 + 64 * (j))
#define XB_XGEN(j)  (2304 + 64 * (j))
#define XB_TOP      3328
#define XB_TOPGEN   3392
#define XCD_BAR_WORDS 3456
#define XB_SPIN_CAP (1u << 18)

__device__ __forceinline__ unsigned xb_ld(unsigned* p)              { return __hip_atomic_load(p, __ATOMIC_RELAXED, __HIP_MEMORY_SCOPE_AGENT); }
__device__ __forceinline__ unsigned xb_add(unsigned* p, unsigned v) { return __hip_atomic_fetch_add(p, v, __ATOMIC_RELAXED, __HIP_MEMORY_SCOPE_AGENT); }
__device__ __forceinline__ unsigned xb_xcc_id() { return (unsigned)__builtin_amdgcn_s_getreg((3 << 11) | 20) & 0xFu; }
#define XB_SPIN(cond, bar) do { unsigned _sp = 0; while (cond) { __builtin_amdgcn_s_sleep(1); \
    if ((++_sp & 255u) == 0u) { if (xb_ld(&(bar)[XB_TMO])) break; if (_sp > XB_SPIN_CAP) { atomicAdd(&(bar)[XB_TMO], 1u); break; } } } } while (0)

struct XcdBarrier {
    unsigned* bar; unsigned x;
    volatile LAS unsigned* st;
};

__device__ __forceinline__ XcdBarrier xcd_barrier_post(unsigned* bar, volatile LAS unsigned* st) {
    XcdBarrier b; b.bar = bar; b.x = xb_xcc_id(); b.st = st;
    if (threadIdx.x == 0) (void)xb_add(&bar[XB_XCNT(b.x)], 1u);
    return b;
}
__device__ __forceinline__ void xcd_barrier_complete(unsigned* bar, unsigned x, unsigned& nloc, unsigned& nx) {
    const unsigned G = gridDim.x * gridDim.y * gridDim.z;
    unsigned sum, cnt, mine, sp = 0u;
    for (;;) {
        sum = 0u; cnt = 0u; mine = 0u;
#pragma unroll
        for (unsigned j = 0; j < 16; ++j) { const unsigned c = xb_ld(&bar[XB_XCNT(j)]); sum += c; cnt += (c > 0u) ? 1u : 0u; mine = (j == x) ? c : mine; }
        if (sum == G) break;
        __builtin_amdgcn_s_sleep(1);
        if ((++sp & 255u) == 0u) { if (xb_ld(&bar[XB_TMO])) break; if (sp > XB_SPIN_CAP) { atomicAdd(&bar[XB_TMO], 1u); break; } }
    }
    nloc = mine > 0u ? mine : 1u; nx = cnt > 0u ? cnt : 1u;
}

__device__ __forceinline__ void xcd_barrier(const XcdBarrier& b) {
    asm volatile("s_waitcnt vmcnt(0)" ::: "memory");
    __syncthreads();
    if (threadIdx.x == 0) {
        unsigned* bar = b.bar;
        __builtin_amdgcn_s_waitcnt(0);
        unsigned nloc = b.st[0], nx = b.st[1];
        if (nloc == 0u) { xcd_barrier_complete(bar, b.x, nloc, nx); b.st[0] = nloc; b.st[1] = nx; }
        const unsigned old = xb_add(&bar[XB_XSUB(b.x)], 1u);
        const unsigned gen = old / nloc;
        if (old + 1u == (gen + 1u) * nloc) {
            __builtin_amdgcn_fence(__ATOMIC_RELEASE, "agent");
            asm volatile("s_waitcnt vmcnt(0)" ::: "memory");
            const unsigned og = xb_add(&bar[XB_TOP], 1u);
            const unsigned tg = og / nx;
            if (og + 1u == (tg + 1u) * nx) xb_add(&bar[XB_TOPGEN], 1u);
            else XB_SPIN(xb_ld(&bar[XB_TOPGEN]) == tg, bar);
            __builtin_amdgcn_fence(__ATOMIC_ACQUIRE, "agent");
            xb_add(&bar[XB_XGEN(b.x)], 1u);
            asm volatile("s_waitcnt vmcnt(0)" ::: "memory");
        } else {
            XB_SPIN(xb_ld(&bar[XB_XGEN(b.x)]) == gen, bar);
            __builtin_amdgcn_fence(__ATOMIC_ACQUIRE, "agent");
            asm volatile("s_waitcnt vmcnt(0)" ::: "memory");
        }
    }
    __syncthreads();
}

constexpr int NWAVES = 8;
constexpr int BATCH = 8, SEQ = 4096, D = 1024, M = BATCH * SEQ;
constexpr int NEXP = 32, FE = 256, PLED = 256, CWID = 31, NQKV = 3072;
constexpr float EPS = 1e-6f;
constexpr int NPHASE = 21;
constexpr int PADROWS = 73728;
constexpr float LAM_INIT = 0.35550906759096926f;

constexpr size_t MiB = 1u << 20;
constexpr size_t WS_CTL = 0, CTL_ZERO_BYTES = 1 * MiB;
constexpr size_t WS_SSQ = 439 * MiB;
constexpr size_t WS_TI = 2 * MiB, WS_TW = WS_TI + 512 * 1024;
constexpr size_t WS_LIST = 3 * MiB;
constexpr size_t WS_RP = 7 * MiB;
constexpr size_t WS_LOG = 11 * MiB;
constexpr size_t WS_WPW1 = 19 * MiB, WS_WPW2 = 23 * MiB, WS_WQKV = 25 * MiB, WS_WO = 31 * MiB, WS_WR = 33 * MiB, WS_WPG = 34 * MiB, WS_WPP = 38 * MiB;
constexpr size_t WS_WGU = 39 * MiB, WS_WD = 71 * MiB;
constexpr size_t WS_P16 = 87 * MiB;
constexpr size_t WS_S0 = 119 * MiB, WS_SS = 64 * MiB;
constexpr size_t WS_END = WS_SSQ + 14 * MiB;
static_assert(WS_S0 + 5 * WS_SS == WS_SSQ, "d_ws map");
constexpr int CW_BAR = 4096;
constexpr int CW_CNT = 8192;
constexpr int RING_OFF = 0, RING_BYTES = 131072;
constexpr int LDSCTL_OFF = RING_BYTES;
constexpr int L_MISC = LDSCTL_OFF, L_TS = LDSCTL_OFF + 128, L_NE = LDSCTL_OFF + 384, L_TE = LDSCTL_OFF + 512, L_TOK = LDSCTL_OFF + 2048, L_HIST = LDSCTL_OFF + 10240;
constexpr int MAXGU = 8;
constexpr int LDS_BYTES = 147456;


typedef float f32x2 __attribute__((ext_vector_type(2)));
typedef unsigned u32x2 __attribute__((ext_vector_type(2)));
typedef int i32x4 __attribute__((ext_vector_type(4)));
__device__ __forceinline__ float bflo(unsigned u) { return __builtin_bit_cast(float, u << 16); }
__device__ __forceinline__ float bfhi(unsigned u) { return __builtin_bit_cast(float, u & 0xffff0000u); }
__device__ __forceinline__ float sigmoid_f(float x) { return __builtin_amdgcn_rcpf(1.f + __expf(-x)); }
__device__ __forceinline__ float wave_sum(float v) {
#pragma unroll
    for (int o = 1; o < 64; o <<= 1) v += __shfl_xor(v, o);
    return v;
}
__device__ __forceinline__ void tr_item(const float* W, int N, bf16* WT, int Kd, int k0, int n0, int drow0, const float* gk, LAS float* scr, int lane) {
#pragma unroll 8
    for (int i = 0; i < 32; ++i) { const int kk = 2 * i + (lane >> 5); scr[kk * 33 + (lane & 31)] = W[(size_t)(k0 + kk) * N + n0 + (lane & 31)]; }
    LDS_WAIT(); asm volatile("" ::: "memory");
    const int c = lane & 7;
    f32x4 g0 = {1.f, 1.f, 1.f, 1.f}, g1 = {1.f, 1.f, 1.f, 1.f};
    if (gk) { g0 = *(const f32x4*)(gk + k0 + 8 * c); g1 = *(const f32x4*)(gk + k0 + 8 * c + 4); }
#pragma unroll
    for (int j = 0; j < 4; ++j) { const int n = (lane >> 3) + 8 * j; const LAS float* s = scr + (8 * c) * 33 + n;
        v4u o; o.x = pk2(s[0 * 33] * g0.x, s[1 * 33] * g0.y); o.y = pk2(s[2 * 33] * g0.z, s[3 * 33] * g0.w); o.z = pk2(s[4 * 33] * g1.x, s[5 * 33] * g1.y); o.w = pk2(s[6 * 33] * g1.z, s[7 * 33] * g1.w);
        *(GAS v4u*)(WT + (size_t)(drow0 + n) * Kd + k0 + 8 * c) = o; }
    LDS_WAIT(); asm volatile("" ::: "memory");
}
template <bool GLU_IL = false>
__device__ __forceinline__ void tr_plain(const float* W, int K, int N, bf16* WT, int item, const float* gk, LAS float* scr, int lane) {
    const int nblk = N / 32, kb = item / nblk, nb = item % nblk, n0 = 32 * nb; int drow0 = n0;
    if (GLU_IL) { const int h = n0 >> 10, c = n0 & 1023; drow0 = (c >> 7) * 256 + h * 128 + (c & 127); }
    tr_item(W, N, WT, K, 64 * kb, n0, drow0, gk, scr, lane);
}
constexpr int MOE_ITEMS = 32 * 384;
__device__ __forceinline__ void moe_item(const float* wg, const float* wu, const float* wd, const float* gk, int l, bf16* WGU, bf16* WD, int item, LAS float* scr, int lane) {
    const int ge = item / 384, r = item % 384, which = r / 128, sub = r % 128; const size_t eo = (size_t)(l * 32 + ge) * 262144;
    if (which < 2) { const int kb = sub / 8, nb = sub % 8, n0 = 32 * nb; const int drow0 = (n0 / 128) * 256 + (n0 % 128) + (which ? 128 : 0);
        tr_item((which ? wu : wg) + eo, 256, WGU + (size_t)ge * 512 * 1024, 1024, 64 * kb, n0, drow0, gk, scr, lane); }
    else { const int kb = sub / 32, nb = sub % 32; tr_item(wd + eo, 1024, WD + (size_t)ge * 1024 * 256, 256, 64 * kb, 32 * nb, 32 * nb, nullptr, scr, lane); }
}

__device__ __forceinline__ void row_cvt(const float* x, bf16* XB, float* ss, int gw, int NGW, int lane) {
    for (int m = gw; m < M; m += NGW) {
        const GAS f32x4* xr = (const GAS f32x4*)(x + (size_t)m * D) + lane; GAS u32x2* xo = (GAS u32x2*)(XB + (size_t)m * D) + lane;
        f32x4 v[4]; float s = 0.f;
#pragma unroll
        for (int j = 0; j < 4; ++j) v[j] = xr[64 * j];
#pragma unroll
        for (int j = 0; j < 4; ++j) { s += (v[j].x * v[j].x + v[j].y * v[j].y) + (v[j].z * v[j].z + v[j].w * v[j].w); xo[64 * j] = (u32x2){pk2(v[j].x, v[j].y), pk2(v[j].z, v[j].w)}; }
        s = wave_sum(s); if (lane < 16) ss[(size_t)m * 16 + lane] = lane ? 0.f : s;
    }
}
__device__ __forceinline__ void row_moe(const bf16* Xi, bf16* Xo, const bf16* YP, const i32x4* TI, const f32x2* TW, const unsigned* cnt, float* ss, int gw, int NGW, int lane) {
    int ts;
    { const unsigned n = lane < 32 ? __hip_atomic_load(cnt + lane * 64, RLX_AGENT) : 0u; const int tiles = (int)((n + 255u) >> 8); int incl = tiles;
#pragma unroll
      for (int o = 1; o < 32; o <<= 1) { const int t = __shfl_up(incl, o); if (lane >= o) incl += t; }
      ts = incl - tiles; }
    for (int m = gw; m < M; m += NGW) {
        const i32x4 ti = TI[m]; const f32x2 tw = TW[m];
        const int r1 = __shfl(ts, ti.x) * 256 + ti.y, r2 = __shfl(ts, ti.z) * 256 + ti.w;
        const GAS u32x2* xr = (const GAS u32x2*)(Xi + (size_t)m * D) + lane; GAS u32x2* xo = (GAS u32x2*)(Xo + (size_t)m * D) + lane;
        const GAS u32x2* y1 = (const GAS u32x2*)(YP + (size_t)r1 * D) + lane; const GAS u32x2* y2 = (const GAS u32x2*)(YP + (size_t)r2 * D) + lane;
        float s = 0.f;
#pragma unroll
        for (int j = 0; j < 4; ++j) { const u32x2 x = xr[64 * j], a = y1[64 * j], c = y2[64 * j];
            const f32x4 v = (f32x4){bflo(x.x), bfhi(x.x), bflo(x.y), bfhi(x.y)} + (f32x4){bflo(a.x), bfhi(a.x), bflo(a.y), bfhi(a.y)} * tw.x + (f32x4){bflo(c.x), bfhi(c.x), bflo(c.y), bfhi(c.y)} * tw.y;
            s += (v.x * v.x + v.y * v.y) + (v.z * v.z + v.w * v.w); xo[64 * j] = (u32x2){pk2(v.x, v.y), pk2(v.z, v.w)}; }
        s = wave_sum(s); if (lane < 16) ss[(size_t)m * 16 + lane] = lane ? 0.f : s;
    }
}
__device__ __forceinline__ void row_final(float* out, const float* ss, const float* gain, int gw, int NGW, int lane) {
    f32x4 gv[4];
#pragma unroll
    for (int j = 0; j < 4; ++j) gv[j] = *((const f32x4*)gain + lane + 64 * j);
    for (int m = gw; m < M; m += NGW) {
        GAS f32x4* xr = (GAS f32x4*)(out + (size_t)m * D) + lane; const float r = pg8::rs_of(ss, m);
        f32x4 v[4];
#pragma unroll
        for (int j = 0; j < 4; ++j) v[j] = xr[64 * j];
#pragma unroll
        for (int j = 0; j < 4; ++j) xr[64 * j] = v[j] * r * gv[j];
    }
}

__device__ __forceinline__ void conv_phase(const bf16* U, bf16* C, const float* wdw, const float* bdw, const float* lng, const float* lnb, LAS unsigned char* lds, int vcu, int G, int tid, int lane, int wave) {
    const int c0 = 2 * tid;
    f32x2 w[CWID];
#pragma unroll
    for (int j = 0; j < CWID; ++j) w[j] = *(const f32x2*)(wdw + j * D + c0);
    const f32x2 bd = *(const f32x2*)(bdw + c0);
    LAS unsigned* yb = (LAS unsigned*)lds;
    for (int chunk = vcu; chunk < M / 32; chunk += G) {
        const int b = chunk >> 7, t0 = (chunk & 127) * 32; const size_t rb = (size_t)b * SEQ;
        const bf16* Ub = U + rb * D + c0;
        f32x2 win[CWID];
#pragma unroll
        for (int s = 0; s < CWID; ++s) { const int tau = t0 - 30 + s; const int tc = tau < 0 ? 0 : tau;
            const unsigned ua = *(const GAS unsigned*)(Ub + (size_t)tc * D);
            win[s] = tau < 0 ? (f32x2){0.f, 0.f} : (f32x2){bflo(ua), bfhi(ua)}; }
        { f32x2 a = bd;
#pragma unroll
          for (int j = 0; j < CWID; ++j) a += w[j] * win[j];
          yb[tid] = pk2(a.x, a.y); }
#pragma unroll
        for (int s = 0; s < CWID; ++s) { const int tau = t0 + 1 + s;
            const unsigned ua = *(const GAS unsigned*)(Ub + (size_t)tau * D);
            win[s] = (f32x2){bflo(ua), bfhi(ua)};
            f32x2 a = bd;
#pragma unroll
            for (int j = 0; j < CWID; ++j) a += w[j] * win[(s + 1 + j) % CWID];
            yb[(1 + s) * 512 + tid] = pk2(a.x, a.y); }
        LDS_WAIT(); __syncthreads();
#pragma unroll 1
        for (int rr = 0; rr < 4; ++rr) { const int r = wave * 4 + rr;
            const v4u p0 = *(const LAS v4u*)(lds + r * 2048 + lane * 16), p1 = *(const LAS v4u*)(lds + r * 2048 + 1024 + lane * 16);
            float x[16] = {bflo(p0.x), bfhi(p0.x), bflo(p0.y), bfhi(p0.y), bflo(p0.z), bfhi(p0.z), bflo(p0.w), bfhi(p0.w), bflo(p1.x), bfhi(p1.x), bflo(p1.y), bfhi(p1.y), bflo(p1.z), bfhi(p1.z), bflo(p1.w), bfhi(p1.w)};
            float s = 0.f;
#pragma unroll
            for (int i = 0; i < 16; ++i) s += x[i];
            const float mu = wave_sum(s) * (1.f / D); float q = 0.f;
#pragma unroll
            for (int i = 0; i < 16; ++i) { x[i] -= mu; q += x[i] * x[i]; }
            const float rs = 1.f / sqrtf(wave_sum(q) * (1.f / D) + EPS);
            unsigned o[8];
#pragma unroll
            for (int hh = 0; hh < 2; ++hh) { const f32x4 g0 = *(const f32x4*)(lng + hh * 512 + lane * 8), g1 = *(const f32x4*)(lng + hh * 512 + lane * 8 + 4), b0 = *(const f32x4*)(lnb + hh * 512 + lane * 8), b1 = *(const f32x4*)(lnb + hh * 512 + lane * 8 + 4);
                float y[8] = {x[hh * 8 + 0] * rs * g0.x + b0.x, x[hh * 8 + 1] * rs * g0.y + b0.y, x[hh * 8 + 2] * rs * g0.z + b0.z, x[hh * 8 + 3] * rs * g0.w + b0.w,
                              x[hh * 8 + 4] * rs * g1.x + b1.x, x[hh * 8 + 5] * rs * g1.y + b1.y, x[hh * 8 + 6] * rs * g1.z + b1.z, x[hh * 8 + 7] * rs * g1.w + b1.w};
#pragma unroll
                for (int i = 0; i < 4; ++i) o[hh * 4 + i] = pk2(y[2 * i] * sigmoid_f(y[2 * i]), y[2 * i + 1] * sigmoid_f(y[2 * i + 1])); }
            bf16* cr = C + (rb + t0 + r) * D;
            *(GAS v4u*)(cr + lane * 8) = (v4u){o[0], o[1], o[2], o[3]}; *(GAS v4u*)(cr + 512 + lane * 8) = (v4u){o[4], o[5], o[6], o[7]}; }
        LDS_WAIT(); __syncthreads();
    }
}

__device__ __forceinline__ void combine_phase(const bf16* O0, const bf16* O1, bf16* OC, const float* lamp, const float* subln, int gw, int NGW, int lane) {
    const float l1 = wave_sum(lamp[lane] * lamp[64 + lane]), l2 = wave_sum(lamp[128 + lane] * lamp[192 + lane]);
    const float lam = __expf(l1) - __expf(l2) + LAM_INIT;
    float gsc[16];
#pragma unroll
    for (int i = 0; i < 16; ++i) gsc[i] = subln[(lane & 7) * 16 + i] * (1.0f - LAM_INIT);
    for (int m = gw; m < M; m += NGW) {
        const v4u a0 = *(const GAS v4u*)(O0 + (size_t)m * D + lane * 16), a1 = *(const GAS v4u*)(O0 + (size_t)m * D + lane * 16 + 8);
        const v4u b0 = *(const GAS v4u*)(O1 + (size_t)m * D + lane * 16), b1 = *(const GAS v4u*)(O1 + (size_t)m * D + lane * 16 + 8);
        const unsigned ua[8] = {a0.x, a0.y, a0.z, a0.w, a1.x, a1.y, a1.z, a1.w}, ub[8] = {b0.x, b0.y, b0.z, b0.w, b1.x, b1.y, b1.z, b1.w};
        float o[16]; float ss = 0.f;
#pragma unroll
        for (int i = 0; i < 8; ++i) { o[2 * i] = bflo(ua[i]) - lam * bflo(ub[i]); o[2 * i + 1] = bfhi(ua[i]) - lam * bfhi(ub[i]); ss += o[2 * i] * o[2 * i] + o[2 * i + 1] * o[2 * i + 1]; }
        ss += __shfl_xor(ss, 1); ss += __shfl_xor(ss, 2); ss += __shfl_xor(ss, 4);
        const float r = 1.f / sqrtf(ss * (1.f / 128.f) + EPS);
        unsigned w[8];
#pragma unroll
        for (int i = 0; i < 8; ++i) w[i] = pk2(o[2 * i] * r * gsc[2 * i], o[2 * i + 1] * r * gsc[2 * i + 1]);
        *(GAS v4u*)(OC + (size_t)m * D + lane * 16) = (v4u){w[0], w[1], w[2], w[3]}; *(GAS v4u*)(OC + (size_t)m * D + lane * 16 + 8) = (v4u){w[4], w[5], w[6], w[7]};
    }
}

__device__ __forceinline__ void select_phase(const float* LOG, const float* brg, const float* bre, const float* ss, unsigned* cnt, int* list, float* RP, i32x4* TI, f32x2* TW, LAS int* lh, int vcu, int G, int tid) {
    for (int base = vcu * 128; base < M; base += G * 128) {
        if (tid < 32) lh[tid] = 0;
        __syncthreads();
        const int t = base + tid; int E1 = 0, E2 = 0, r1 = 0, r2 = 0; float w1 = 0.f, w2 = 0.f;
        if (tid < 128) {
            const f32x4 g4 = *(const GAS f32x4*)(LOG + (size_t)t * 64);
            const float gl[4] = {g4.x + brg[0], g4.y + brg[1], g4.z + brg[2], g4.w + brg[3]};
            int gi = 0; float gm = gl[0];
#pragma unroll
            for (int j = 1; j < 4; ++j) if (gl[j] > gm) { gm = gl[j]; gi = j; }
            float den = 0.f;
#pragma unroll
            for (int j = 0; j < 4; ++j) den += __expf(gl[j] - gm);
            const float gw_ = 1.f / den;
            const f32x4 ea = *(const GAS f32x4*)(LOG + (size_t)t * 64 + 4 + gi * 8), eb = *(const GAS f32x4*)(LOG + (size_t)t * 64 + 8 + gi * 8);
            const f32x4 ba = *(const f32x4*)(bre + gi * 8), bb = *(const f32x4*)(bre + gi * 8 + 4);
            const float el[8] = {ea.x + ba.x, ea.y + ba.y, ea.z + ba.z, ea.w + ba.w, eb.x + bb.x, eb.y + bb.y, eb.z + bb.z, eb.w + bb.w};
            int i1 = 0; float v1 = el[0];
#pragma unroll
            for (int j = 1; j < 8; ++j) if (el[j] > v1) { v1 = el[j]; i1 = j; }
            int i2 = -1; float v2 = -INFINITY;
#pragma unroll
            for (int j = 0; j < 8; ++j) if (j != i1 && (i2 < 0 || el[j] > v2)) { v2 = el[j]; i2 = j; }
            const float e2 = __expf(v2 - v1); const float p1 = 1.f / (1.f + e2);
            w1 = p1 * gw_; w2 = (e2 * p1) * gw_; E1 = gi * 8 + i1; E2 = gi * 8 + i2;
            r1 = __hip_atomic_fetch_add(lh + E1, 1, __ATOMIC_RELAXED, __HIP_MEMORY_SCOPE_WORKGROUP); r2 = __hip_atomic_fetch_add(lh + E2, 1, __ATOMIC_RELAXED, __HIP_MEMORY_SCOPE_WORKGROUP);
        }
        __syncthreads();
        if (tid < 32) { const int c = lh[tid]; int bs = 0; if (c) bs = (int)__hip_atomic_fetch_add(cnt + tid * 64, (unsigned)c, RLX_AGENT); lh[32 + tid] = bs; }
        __syncthreads();
        if (tid < 128) { const int s1 = lh[32 + E1] + r1, s2 = lh[32 + E2] + r2;
            const float r = pg8::rs_of(ss, t);
            list[(size_t)E1 * M + s1] = t; list[(size_t)E2 * M + s2] = t; RP[(size_t)E1 * M + s1] = r; RP[(size_t)E2 * M + s2] = r; TI[t] = (i32x4){E1, s1, E2, s2}; TW[t] = (f32x2){w1, w2}; }
        __syncthreads();
    }
}

struct GroupedOrder {
    int nNs, G, c, ntu;
    const LAS int* tile_e; const LAS int* tokl; const LAS int* ts;
    __device__ __forceinline__ bool next(int i, pg8::Unit& u) const { const int L = i * G + c; if (L >= ntu) return false; const int mt = L >> nNs, pn = L & ((1 << nNs) - 1);
        const int e = tile_e[mt]; u.pm = mt; u.pn = pn; u.pb = (e << nNs) + pn; u.aux = e * M + (mt - ts[e]) * 256; return true; }
    __device__ __forceinline__ unsigned arow(int ord, int r) const { return (unsigned)tokl[ord * 256 + r]; }
};
__device__ __forceinline__ GroupedOrder grouped_setup(const unsigned* cnt, const int* list, LAS unsigned char* lds, bool need_tok, int nNs, int G, int c, int tid, int lane, int wave) {
    LAS int* ts = (LAS int*)(lds + L_TS); LAS int* ne = (LAS int*)(lds + L_NE); LAS int* te = (LAS int*)(lds + L_TE); LAS int* tokl = (LAS int*)(lds + L_TOK);
    __syncthreads();
    if (wave == 0) {
        const unsigned n = lane < 32 ? __hip_atomic_load(cnt + lane * 64, RLX_AGENT) : 0u; const int tiles = (int)((n + 255u) >> 8); int incl = tiles;
#pragma unroll
        for (int o = 1; o < 32; o <<= 1) { const int t = __shfl_up(incl, o); if (lane >= o) incl += t; }
        const int excl = incl - tiles;
        if (lane < 32) { ts[lane] = excl; ne[lane] = (int)n; for (int k = 0; k < tiles; ++k) te[excl + k] = lane; }
        if (lane == 31) ts[32] = incl;
    }
    __syncthreads();
    GroupedOrder S; S.nNs = nNs; S.G = G; S.c = c; S.ntu = ts[32] << nNs; S.tile_e = te; S.tokl = tokl; S.ts = ts;
    if (need_tok) {
        for (int i = 0; i < MAXGU; ++i) { const int L = i * G + c; if (L >= S.ntu) break; const int mt = L >> nNs, e = te[mt];
            if (tid < 256) { const int slot = (mt - ts[e]) * 256 + tid; tokl[i * 256 + tid] = slot < ne[e] ? list[(size_t)e * M + slot] : 0; } }
        if (S.ntu > MAXGU * G) S.ntu = MAXGU * G;
        __syncthreads();
    }
    return S;
}

enum { I_X = 0, I_P, I_POS, I_NMIX, I_NFFN, I_CW1, I_CB1, I_CDW, I_CBDW, I_CLNG, I_CLNB, I_CW2, I_CB2, I_WQKV, I_LAM, I_SUBLN, I_WO,
       I_WRG, I_BRG, I_WRE, I_BRE, I_WG, I_WU, I_WDN, I_PNORM, I_PWG, I_PWP, I_FNORM, N_IN };
struct Args { const void* in[N_IN]; float* out; unsigned char* ws; int ph_lo, ph_hi; };

typedef const __attribute__((address_space(4))) Args* KArgP;
#define PH_IDS() const int tid = pg8::ltid(wave), lane = tid & 63, gtid = vcu * (NWAVES * 64) + tid; (void)lane; (void)gtid
__device__ __forceinline__ KArgP kargs() { KArgP k = (KArgP)__builtin_amdgcn_kernarg_segment_ptr(); asm volatile("" : "+s"(k)); return k; }
#define IN_F(k) ((const float*)ka->in[k])
#define WSP(off) ((bf16*)(ka->ws + (off)))
#define SLOT(i) ((bf16*)(ka->ws + WS_S0 + (size_t)(i) * WS_SS))
#define IN(k) (lo <= (k) && (k) < hi)
#define SEAM(k) do { if (IN(k) && IN((k) + 1)) xcd_barrier(bar); } while (0)
#define XBA ((bf16*)ka->out)
#define XBB ((bf16*)ka->out + (size_t)M * D)
#define SSQ(k) ((float*)(ka->ws + WS_SSQ) + (size_t)(k) * M * 16)
#define CNT(l) ((unsigned*)(ka->ws + WS_CTL) + CW_CNT + (l) * 32 * 64)
template <int l>
__device__ __forceinline__ void layer_tail(LAS unsigned char* lds, const XcdBarrier& bar, int lo, int hi, int wave, int G, int bx, int vcu, int gw, int NGW, int NTHR) {
    constexpr int pb = l ? 14 : 4;
    LAS float* scr = (LAS float*)(lds + RING_OFF + wave * 16384);
    if (IN(pb)) { KArgP ka = kargs(); PH_IDS(); pg8::Gemm g{l ? XBB : XBA, WSP(WS_WR) + (size_t)l * 256 * D, M, 256, D}; pg8::StaticOrder S; S.init(M, 256, G, bx);
        pg8::EpiLogits E{(float*)(ka->ws + WS_LOG), SSQ(l ? 4 : 1)};
        pg8::gemm_phase<pg8::EpiLogits, pg8::StaticOrder, true, false>(lds + RING_OFF, g, S, E, wave); }
    SEAM(pb);
    if (IN(pb + 1)) { KArgP ka = kargs(); PH_IDS(); select_phase((const float*)(ka->ws + WS_LOG), IN_F(I_BRG) + l * 4, IN_F(I_BRE) + l * 32, SSQ(l ? 4 : 1), CNT(l),
                                   (int*)(ka->ws + WS_LIST), (float*)(ka->ws + WS_RP), (i32x4*)(ka->ws + WS_TI), (f32x2*)(ka->ws + WS_TW), (LAS int*)(lds + L_HIST), vcu, G, tid); }
    SEAM(pb + 1);
    if (IN(pb + 2)) { KArgP ka = kargs(); PH_IDS(); const GroupedOrder S = grouped_setup(CNT(l), (const int*)(ka->ws + WS_LIST), lds, true, 1, G, bx, tid, lane, wave);
        pg8::Gemm g{l ? XBB : XBA, WSP(WS_WGU), M, 512, D}; pg8::EpiGU E{SLOT(0), (const float*)(ka->ws + WS_RP)};
        pg8::gemm_phase<pg8::EpiGU, GroupedOrder, true, true>(lds + RING_OFF, g, S, E, wave); }
    SEAM(pb + 2);
    if (IN(pb + 3)) { KArgP ka = kargs(); PH_IDS(); const GroupedOrder S = grouped_setup(CNT(l), (const int*)(ka->ws + WS_LIST), lds, false, 2, G, bx, tid, lane, wave);
        pg8::Gemm g{SLOT(0), WSP(WS_WD), PADROWS, D, FE}; pg8::EpiBf16 E{SLOT(1), D};
        pg8::gemm_phase<pg8::EpiBf16, GroupedOrder, true, false>(lds + RING_OFF, g, S, E, wave); }
    SEAM(pb + 3);
    if (IN(pb + 4)) {
        { KArgP ka = kargs(); PH_IDS(); row_moe(l ? XBB : XBA, l ? SLOT(4) : XBA, SLOT(1), (const i32x4*)(ka->ws + WS_TI), (const f32x2*)(ka->ws + WS_TW), CNT(l), SSQ(l ? 5 : 2), gw, NGW, lane); }
        if (l == 0) { KArgP ka = kargs(); PH_IDS(); for (int it = gw; it < MOE_ITEMS; it += NGW) moe_item(IN_F(I_WG), IN_F(I_WU), IN_F(I_WDN), IN_F(I_NFFN) + D, 1, WSP(WS_WGU), WSP(WS_WD), it, scr, lane); }
    }
    SEAM(pb + 4);
    if (IN(pb + 5)) {
        { KArgP ka = kargs(); PH_IDS(); pg8::Gemm g{WSP(WS_P16) + (size_t)l * M * PLED, WSP(WS_WPP) + (size_t)l * D * PLED, M, D, PLED}; pg8::StaticOrder S; S.init(M, D, G, bx);
          pg8::EpiBf16 E{l ? SLOT(0) : SLOT(4), D};
          pg8::gemm_phase<pg8::EpiBf16, pg8::StaticOrder, true, false>(lds + RING_OFF, g, S, E, wave); }
        if (l == 0) { KArgP ka = kargs(); PH_IDS(); pg8::Gemm g{XBA, WSP(WS_WPG), M, D, D}; pg8::StaticOrder S; S.init(M, D, G, bx);
          pg8::EpiPle<false> E{XBA, SLOT(4), XBB, nullptr, SSQ(2), SSQ(3)};
          pg8::gemm_phase<pg8::EpiPle<false>, pg8::StaticOrder, true, false>(lds + RING_OFF, g, S, E, wave); }
        else { KArgP ka = kargs(); PH_IDS(); pg8::Gemm g{SLOT(4), WSP(WS_WPG) + (size_t)D * D, M, D, D}; pg8::StaticOrder S; S.init(M, D, G, bx);
          pg8::EpiPle<true> E{SLOT(4), SLOT(0), nullptr, ka->out, SSQ(5), SSQ(6)};
          pg8::gemm_phase<pg8::EpiPle<true>, pg8::StaticOrder, true, false>(lds + RING_OFF, g, S, E, wave); }
    }
    SEAM(pb + 5);
}
__global__ void __launch_bounds__(NWAVES * 64, 2) mk_fwd(Args args) {
    extern __shared__ __attribute__((aligned(16))) unsigned char lds_raw[];
    LAS unsigned char* lds = (LAS unsigned char*)lds_raw;
    const int tid0 = threadIdx.x, wave = __builtin_amdgcn_readfirstlane(tid0 >> 6);
    const int G = gridDim.x; const int bx = blockIdx.x; const int vcu = (G % 8 == 0) ? (bx % 8) * (G / 8) + bx / 8 : bx;
    const int gw = vcu * NWAVES + wave, NGW = G * NWAVES, NTHR = G * NWAVES * 64;
    gu32* ctl = (gu32*)(args.ws + WS_CTL);
    for (int u = tid0; u < (LDS_BYTES - LDSCTL_OFF) / 4; u += NWAVES * 64) ((LAS unsigned*)(lds + LDSCTL_OFF))[u] = 0u;
    __syncthreads();
    XcdBarrier bar = xcd_barrier_post((unsigned*)ctl + CW_BAR, (volatile LAS unsigned*)(lds + L_MISC) + 8);
    const int lo = args.ph_lo, hi = args.ph_hi;
    LAS float* scr = (LAS float*)(lds + RING_OFF + wave * 16384);

    if (IN(0)) {
        constexpr int I1 = 16 * 64, I2 = 16 * 32, I3 = 16 * 96, I4 = 16 * 32, I5 = 16 * 32, I6 = 4 * 32;
        constexpr int NIT = I1 + I2 + I3 + I4 + 2 * I5 + 2 * I6;
        { KArgP ka = kargs(); PH_IDS();
          for (int it = gw; it < NIT + MOE_ITEMS; it += NGW) {
            int r = it;
            if (r < I1) { tr_plain<true>(IN_F(I_CW1), D, 2048, WSP(WS_WPW1), r, IN_F(I_NMIX), scr, lane); continue; } r -= I1;
            if (r < I2) { tr_plain(IN_F(I_CW2), D, D, WSP(WS_WPW2), r, nullptr, scr, lane); continue; } r -= I2;
            if (r < I3) { tr_plain(IN_F(I_WQKV), D, NQKV, WSP(WS_WQKV), r, IN_F(I_NMIX) + D, scr, lane); continue; } r -= I3;
            if (r < I4) { tr_plain(IN_F(I_WO), D, D, WSP(WS_WO), r, nullptr, scr, lane); continue; } r -= I4;
            if (r < 2 * I5) { const int l = r / I5; tr_plain(IN_F(I_PWG) + (size_t)l * D * D, D, D, WSP(WS_WPG) + (size_t)l * D * D, r % I5, IN_F(I_PNORM) + l * D, scr, lane); continue; } r -= 2 * I5;
            if (r < 2 * I6) { const int l = r / I6; tr_plain(IN_F(I_PWP) + (size_t)l * PLED * D, PLED, D, WSP(WS_WPP) + (size_t)l * D * PLED, r % I6, nullptr, scr, lane); continue; } r -= 2 * I6;
            moe_item(IN_F(I_WG), IN_F(I_WU), IN_F(I_WDN), IN_F(I_NFFN), 0, WSP(WS_WGU), WSP(WS_WD), r, scr, lane);
          } }
        { KArgP ka = kargs(); PH_IDS(); const float* wrg = IN_F(I_WRG); const float* wre = IN_F(I_WRE); const float* gf = IN_F(I_NFFN); bf16* Wr = WSP(WS_WR);
          for (int idx = gtid; idx < 2 * 256 * 1024; idx += NTHR) { const int l = idx >> 18, row = (idx >> 10) & 255, k = idx & 1023; float v = 0.f;
              if (row < 4) v = wrg[((size_t)l * D + k) * 4 + row]; else if (row < 36) { const int g = (row - 4) >> 3, e = (row - 4) & 7; v = wre[(((size_t)l * 4 + g) * D + k) * 8 + e]; }
              Wr[idx] = (bf16)f2bf(v * gf[l * D + k]); } }
        { KArgP ka = kargs(); PH_IDS(); const f32x4* p4 = (const f32x4*)ka->in[I_P]; u32x2* o = (u32x2*)WSP(WS_P16);
          for (int idx = gtid; idx < 2 * M * PLED / 4; idx += NTHR) { const f32x4 v = p4[idx]; o[idx] = (u32x2){pk2(v.x, v.y), pk2(v.z, v.w)}; } }
        { KArgP ka = kargs(); PH_IDS(); row_cvt(IN_F(I_X), XBA, SSQ(0), gw, NGW, lane); }
    }
    SEAM(0);
    if (IN(1)) { KArgP ka = kargs(); PH_IDS(); pg8::Gemm g{XBA, WSP(WS_WPW1), M, 2048, D}; pg8::StaticOrder S; S.init(M, 2048, G, bx);
        pg8::EpiGLU E{SLOT(0), IN_F(I_CB1), SSQ(0)};
        pg8::gemm_phase<pg8::EpiGLU, pg8::StaticOrder, true, false>(lds + RING_OFF, g, S, E, wave); }
    SEAM(1);
    if (IN(2)) { KArgP ka = kargs(); PH_IDS(); conv_phase(SLOT(0), SLOT(1), IN_F(I_CDW), IN_F(I_CBDW), IN_F(I_CLNG), IN_F(I_CLNB), lds + RING_OFF, vcu, G, tid, lane, wave); }
    SEAM(2);
    if (IN(3)) { KArgP ka = kargs(); PH_IDS(); pg8::Gemm g{SLOT(1), WSP(WS_WPW2), M, D, D}; pg8::StaticOrder S; S.init(M, D, G, bx);
        pg8::EpiRes E{XBA, IN_F(I_CB2), SSQ(1)};
        pg8::gemm_phase<pg8::EpiRes, pg8::StaticOrder, true, false>(lds + RING_OFF, g, S, E, wave); }
    SEAM(3);
    layer_tail<0>(lds, bar, lo, hi, wave, G, bx, vcu, gw, NGW, NTHR);
    if (IN(10)) { KArgP ka = kargs(); PH_IDS(); pg8::Gemm g{XBB, WSP(WS_WQKV), M, NQKV, D}; pg8::StaticOrder S; S.init(M, NQKV, G, bx);
        pg8::EpiQKV E{SLOT(0), (size_t)(WS_SS / 2), SSQ(3), (const int*)ka->in[I_POS], attn_body::C2};
        pg8::gemm_phase<pg8::EpiQKV, pg8::StaticOrder, true, false>(lds + RING_OFF, g, S, E, wave); }
    SEAM(10);
    if (IN(11)) { KArgP ka = kargs(); PH_IDS(); const attn_body::AttnTensors AT{(const attn_body::bf16*)SLOT(0), (const attn_body::bf16*)SLOT(1), (const attn_body::bf16*)SLOT(2), (attn_body::bf16*)SLOT(3), (attn_body::bf16*)SLOT(4)};
        const attn_body::ComboOrder S{vcu, G};
        attn_body::attn_phase<attn_body::ComboOrder>((char*)lds_raw + RING_OFF, AT, S, wave); }
    SEAM(11);
    if (IN(12)) { KArgP ka = kargs(); PH_IDS(); combine_phase(SLOT(3), SLOT(4), SLOT(0), IN_F(I_LAM), IN_F(I_SUBLN), gw, NGW, lane); }
    SEAM(12);
    if (IN(13)) { KArgP ka = kargs(); PH_IDS(); pg8::Gemm g{SLOT(0), WSP(WS_WO), M, D, D}; pg8::StaticOrder S; S.init(M, D, G, bx);
        pg8::EpiRes E{XBB, nullptr, SSQ(4)};
        pg8::gemm_phase<pg8::EpiRes, pg8::StaticOrder, true, false>(lds + RING_OFF, g, S, E, wave); }
    SEAM(13);
    layer_tail<1>(lds, bar, lo, hi, wave, G, bx, vcu, gw, NGW, NTHR);
    if (IN(20)) { KArgP ka = kargs(); PH_IDS(); row_final(ka->out, SSQ(6), IN_F(I_FNORM), gw, NGW, lane); }
#undef IN
#undef SEAM
}

extern "C" void kernel_launch(void* const* d_in, const int* in_sizes, int n_in, void* d_out, int out_size, void* d_ws, size_t ws_size, hipStream_t stream) {
    static int grid = 0;
    if (grid == 0) {
        if (n_in != N_IN || in_sizes[0] != M * D || out_size != M * D || ws_size < WS_END) { fprintf(stderr, "kernel_launch: unexpected problem: n_in %d in0 %d out %d ws %zu (need %zu); nothing launched\n", n_in, n_in > 0 ? in_sizes[0] : -1, out_size, ws_size, (size_t)WS_END); grid = -1; return; }
        int dev = 0, cus = 0, per_cu = 0;
        if (hipGetDevice(&dev) != hipSuccess || hipDeviceGetAttribute(&cus, hipDeviceAttributeMultiprocessorCount, dev) != hipSuccess) { grid = -1; return; }
        if (hipFuncSetAttribute((const void*)mk_fwd, hipFuncAttributeMaxDynamicSharedMemorySize, LDS_BYTES) != hipSuccess) { fprintf(stderr, "kernel_launch: hipFuncSetAttribute failed\n"); grid = -1; return; }
        if (hipOccupancyMaxActiveBlocksPerMultiprocessor(&per_cu, (const void*)mk_fwd, NWAVES * 64, LDS_BYTES) != hipSuccess || per_cu < 1) { fprintf(stderr, "kernel_launch: occupancy query says %d\n", per_cu); }
        (void)hipGetLastError();
        grid = cus;
        if (grid > 256) grid = 256;
    }
    if (grid < 0) return;
    if (hipMemsetAsync((char*)d_ws + WS_CTL, 0, CTL_ZERO_BYTES, stream) != hipSuccess) return;
    Args a{};
    for (int i = 0; i < N_IN; ++i) a.in[i] = d_in[i];
    a.out = (float*)d_out; a.ws = (unsigned char*)d_ws;
#if MK_SPLIT
    for (int ph = 0; ph < NPHASE; ++ph) { a.ph_lo = ph; a.ph_hi = ph + 1; hipLaunchKernelGGL(mk_fwd, dim3(grid), dim3(NWAVES * 64), LDS_BYTES, stream, a); }
#else
    a.ph_lo = 0; a.ph_hi = NPHASE; hipLaunchKernelGGL(mk_fwd, dim3(grid), dim3(NWAVES * 64), LDS_BYTES, stream, a);
#endif
}
```

```cpp
#include <hip/hip_runtime.h>
#include <hip/hip_bf16.h>
#include <cstdio>
#include <cstdint>
#include <cmath>

#ifndef MK_SPLIT
#define MK_SPLIT 0
#endif

namespace pg8 {
#define PG8_LAS __attribute__((address_space(3)))
typedef unsigned short bf16_t;
typedef short bf16x8 __attribute__((ext_vector_type(8)));
typedef float f32x4 __attribute__((ext_vector_type(4)));
typedef unsigned u32x4 __attribute__((ext_vector_type(4)));
constexpr int BM = 256, BK = 64, HALF = 128, HTB = HALF * BK * 2  , STAGE_BYTES = 8 * HTB, NXCD = 8, WGM = 8;

__host__ __device__ __forceinline__ int lds_byte(int r, int c) { const int st = (r >> 4) * 2 + (c >> 5), rr = r & 15, cc = c & 31, ob = rr * 64 + cc * 2; return st * 1024 + (ob ^ (((ob >> 9) & 1) << 5)); }
__host__ __device__ __forceinline__ void stage_rc(int b, int& R, int& C) { const int st = b / 1024, sb = b % 1024, swz = sb ^ (((sb >> 9) & 1) << 5); R = (st >> 1) * 16 + swz / 64; C = (st & 1) * 32 + (swz % 64) / 2; }
__host__ __device__ __forceinline__ int perm32(int rho) { const int n = rho >> 4, i = rho & 15; return 8 * (i >> 2) + 4 * n + (i & 3); }

__device__ __forceinline__ int ltid(int wave) { int t; asm volatile("v_mbcnt_lo_u32_b32 %0, -1, 0\n\tv_mbcnt_hi_u32_b32 %0, -1, %0" : "=&v"(t)); return wave * 64 + t; }
struct Unit { int pm, pn, pb, aux; };
struct Gemm { const bf16_t* A; const bf16_t* Bt; int M, N, K; };

struct StaticOrder {
    int nM, nN, nwg, G, c;
    __host__ __device__ void init(int M, int N, int G_, int c_) { nM = M / BM; nN = N / BM; nwg = nM * nN; G = G_; c = c_; }
    __host__ __device__ bool next(int i, Unit& u) const {
        const long L = (long)i * G + c; if (L >= nwg) return false;
        int wgid = (int)L; { const int q = nwg / NXCD, r = nwg % NXCD, xcd = wgid % NXCD, off = wgid / NXCD; wgid = (xcd < r ? xcd * (q + 1) : r * (q + 1) + (xcd - r) * q) + off; }
        const int nig = WGM * nN, gid = wgid / nig, fm = gid * WGM, gsz = (nM - fm) < WGM ? (nM - fm) : WGM;
        u.pm = fm + ((wgid % nig) % gsz); u.pn = (wgid % nig) / gsz; u.pb = u.pn; u.aux = 0; return true;
    }
    __device__ __forceinline__ unsigned arow(int, int) const { return 0u; }
};

__device__ __forceinline__ unsigned cvt_pk_bf16(float lo, float hi) { unsigned r; asm volatile("v_cvt_pk_bf16_f32 %0, %1, %2" : "=v"(r) : "v"(lo), "v"(hi)); return r; }

typedef float f32x2e __attribute__((ext_vector_type(2)));
__device__ __forceinline__ float bf_lo(unsigned u) { return __builtin_bit_cast(float, u << 16); }
__device__ __forceinline__ float bf_hi(unsigned u) { return __builtin_bit_cast(float, u & 0xffff0000u); }
__device__ __forceinline__ float sigm_f(float x) { return __builtin_amdgcn_rcpf(1.f + __expf(-x)); }
__device__ __forceinline__ float silu_f(float x) { return x * sigm_f(x); }
__device__ __forceinline__ float ss_sum(const float* ssp, int row) { const f32x4* p = (const f32x4*)(ssp + (size_t)row * 16); const f32x4 a = p[0], b = p[1], c = p[2], d = p[3];
    return (((a[0] + a[1]) + (a[2] + a[3])) + ((b[0] + b[1]) + (b[2] + b[3]))) + (((c[0] + c[1]) + (c[2] + c[3])) + ((d[0] + d[1]) + (d[2] + d[3]))); }
__device__ __forceinline__ float rs_of(const float* ssp, int row) { return 1.f / sqrtf(ss_sum(ssp, row) * (1.f / 1024.f) + 1e-6f); }
__device__ __forceinline__ u32x4 pack8(const f32x4& v0, const f32x4& v1) { u32x4 w; w.x = cvt_pk_bf16(v0[0], v0[1]); w.y = cvt_pk_bf16(v0[2], v0[3]); w.z = cvt_pk_bf16(v1[0], v1[1]); w.w = cvt_pk_bf16(v1[2], v1[3]); return w; }
__device__ __forceinline__ void unpack8(const u32x4& w, f32x4& v0, f32x4& v1) { v0 = (f32x4){bf_lo(w.x), bf_hi(w.x), bf_lo(w.y), bf_hi(w.y)}; v1 = (f32x4){bf_lo(w.z), bf_hi(w.z), bf_lo(w.w), bf_hi(w.w)}; }
__device__ __forceinline__ float sumsq8(const f32x4& a, const f32x4& b) { return (a[0] * a[0] + a[1] * a[1]) + (a[2] * a[2] + a[3] * a[3]) + (b[0] * b[0] + b[1] * b[1]) + (b[2] * b[2] + b[3] * b[3]); }
__device__ __forceinline__ void ss_put(float* ssp, int row, int slot, float part, int fq) { part += __shfl_xor(part, 16); part += __shfl_xor(part, 32); if (fq == 0) ssp[(size_t)row * 16 + slot] = part; }

struct EpiBf16 {
    static constexpr bool PERM = true;
    bf16_t* O; int ldc;
    __device__ __forceinline__ void operator()(const f32x4 (&acc)[2][2][4][2], const Unit& u, int wr, int wc, int fr, int fq) const {
        const int row0 = u.pm * BM + wr * 64 + fr, col0 = u.pn * BM + wc * 32 + 8 * fq;
#pragma unroll
        for (int ai = 0; ai < 2; ++ai)
#pragma unroll
            for (int m = 0; m < 4; ++m) { bf16_t* rowp = O + (size_t)(row0 + ai * HALF + m * 16) * ldc + col0;
#pragma unroll
                for (int bj = 0; bj < 2; ++bj) *(u32x4*)(rowp + bj * HALF) = pack8(acc[ai][bj][m][0], acc[ai][bj][m][1]); }
    }
};
struct EpiGLU {
    static constexpr bool PERM = true;
    bf16_t* O; const float* bias; const float* ss;
    __device__ __forceinline__ void operator()(const f32x4 (&acc)[2][2][4][2], const Unit& u, int wr, int wc, int fr, int fq) const {
        const int row0 = u.pm * BM + wr * 64 + fr, c0 = u.pn * HALF + wc * 32 + 8 * fq;
        const f32x4 ba0 = *(const f32x4*)(bias + c0), ba1 = *(const f32x4*)(bias + c0 + 4), bg0 = *(const f32x4*)(bias + 1024 + c0), bg1 = *(const f32x4*)(bias + 1024 + c0 + 4);
#pragma unroll
        for (int ai = 0; ai < 2; ++ai)
#pragma unroll
            for (int m = 0; m < 4; ++m) { const int row = row0 + ai * HALF + m * 16; const float r = rs_of(ss, row);
                const f32x4 a0 = acc[ai][0][m][0] * r + ba0, a1 = acc[ai][0][m][1] * r + ba1, g0 = acc[ai][1][m][0] * r + bg0, g1 = acc[ai][1][m][1] * r + bg1;
                const f32x4 v0 = {a0[0] * sigm_f(g0[0]), a0[1] * sigm_f(g0[1]), a0[2] * sigm_f(g0[2]), a0[3] * sigm_f(g0[3])}, v1 = {a1[0] * sigm_f(g1[0]), a1[1] * sigm_f(g1[1]), a1[2] * sigm_f(g1[2]), a1[3] * sigm_f(g1[3])};
                *(u32x4*)(O + (size_t)row * 1024 + c0) = pack8(v0, v1); }
    }
};
struct EpiRes {
    static constexpr bool PERM = true;
    bf16_t* X; const float* bias; float* ss;
    __device__ __forceinline__ void operator()(const f32x4 (&acc)[2][2][4][2], const Unit& u, int wr, int wc, int fr, int fq) const {
        const int row0 = u.pm * BM + wr * 64 + fr, col0 = u.pn * BM + wc * 32 + 8 * fq;
        f32x4 bv[2][2];
#pragma unroll
        for (int bj = 0; bj < 2; ++bj)
#pragma unroll
            for (int n = 0; n < 2; ++n) bv[bj][n] = bias ? *(const f32x4*)(bias + col0 + bj * HALF + 4 * n) : (f32x4){0.f, 0.f, 0.f, 0.f};
#pragma unroll
        for (int ai = 0; ai < 2; ++ai)
#pragma unroll
            for (int m = 0; m < 4; ++m) { const int row = row0 + ai * HALF + m * 16; bf16_t* rowp = X + (size_t)row * 1024 + col0; float part = 0.f;
#pragma unroll
                for (int bj = 0; bj < 2; ++bj) { f32x4 x0, x1; unpack8(*(const u32x4*)(rowp + bj * HALF), x0, x1);
                    const f32x4 v0 = acc[ai][bj][m][0] + bv[bj][0] + x0, v1 = acc[ai][bj][m][1] + bv[bj][1] + x1; part += sumsq8(v0, v1);
                    *(u32x4*)(rowp + bj * HALF) = pack8(v0, v1); }
                ss_put(ss, row, u.pn * 4 + wc, part, fq); }
    }
};
template <bool F32OUT> struct EpiPle {
    static constexpr bool PERM = true;
    const bf16_t* Xin; const bf16_t* P; bf16_t* Xo; float* Fo; const float* ssin; float* ssout;
    __device__ __forceinline__ void operator()(const f32x4 (&acc)[2][2][4][2], const Unit& u, int wr, int wc, int fr, int fq) const {
        const int row0 = u.pm * BM + wr * 64 + fr, col0 = u.pn * BM + wc * 32 + 8 * fq;
#pragma unroll
        for (int ai = 0; ai < 2; ++ai)
#pragma unroll
            for (int m = 0; m < 4; ++m) { const int row = row0 + ai * HALF + m * 16; const size_t off = (size_t)row * 1024 + col0; const float r = rs_of(ssin, row); float part = 0.f;
#pragma unroll
                for (int bj = 0; bj < 2; ++bj) { f32x4 x0, x1, p0, p1; unpack8(*(const u32x4*)(Xin + off + bj * HALF), x0, x1); unpack8(*(const u32x4*)(P + off + bj * HALF), p0, p1);
                    const f32x4 a0 = acc[ai][bj][m][0] * r, a1 = acc[ai][bj][m][1] * r;
                    const f32x4 v0 = {x0[0] + sigm_f(a0[0]) * p0[0], x0[1] + sigm_f(a0[1]) * p0[1], x0[2] + sigm_f(a0[2]) * p0[2], x0[3] + sigm_f(a0[3]) * p0[3]};
                    const f32x4 v1 = {x1[0] + sigm_f(a1[0]) * p1[0], x1[1] + sigm_f(a1[1]) * p1[1], x1[2] + sigm_f(a1[2]) * p1[2], x1[3] + sigm_f(a1[3]) * p1[3]};
                    part += sumsq8(v0, v1);
                    if (F32OUT) { *(f32x4*)(Fo + off + bj * HALF) = v0; *(f32x4*)(Fo + off + bj * HALF + 4) = v1; } else *(u32x4*)(Xo + off + bj * HALF) = pack8(v0, v1); }
                ss_put(ssout, row, u.pn * 4 + wc, part, fq); }
    }
};
struct EpiLogits {
    static constexpr bool PERM = false;
    float* O; const float* ss;
    __device__ __forceinline__ void operator()(const f32x4 (&acc)[2][2][4][2], const Unit& u, int wr, int wc, int fr, int fq) const {
        if (wc < 2) {
            const int row0 = u.pm * BM + wr * 64 + fr;
#pragma unroll
            for (int ai = 0; ai < 2; ++ai)
#pragma unroll
                for (int m = 0; m < 4; ++m) { const int row = row0 + ai * HALF + m * 16; const float r = rs_of(ss, row);
#pragma unroll
                    for (int n = 0; n < 2; ++n) *(f32x4*)(O + (size_t)row * 64 + wc * 32 + n * 16 + 4 * fq) = acc[ai][0][m][n] * r; }
        }
    }
};
struct EpiGU {
    static constexpr bool PERM = true;
    bf16_t* O; const float* rp;
    __device__ __forceinline__ void operator()(const f32x4 (&acc)[2][2][4][2], const Unit& u, int wr, int wc, int fr, int fq) const {
        const int trow0 = wr * 64 + fr, col0 = u.pn * HALF + wc * 32 + 8 * fq;
#pragma unroll
        for (int ai = 0; ai < 2; ++ai)
#pragma unroll
            for (int m = 0; m < 4; ++m) { const int trow = trow0 + ai * HALF + m * 16; const float r = rp[(size_t)u.aux + trow];
                const f32x4 g0 = acc[ai][0][m][0] * r, g1 = acc[ai][0][m][1] * r, u0 = acc[ai][1][m][0] * r, u1 = acc[ai][1][m][1] * r;
                const f32x4 v0 = {silu_f(g0[0]) * u0[0], silu_f(g0[1]) * u0[1], silu_f(g0[2]) * u0[2], silu_f(g0[3]) * u0[3]}, v1 = {silu_f(g1[0]) * u1[0], silu_f(g1[1]) * u1[1], silu_f(g1[2]) * u1[2], silu_f(g1[3]) * u1[3]};
                *(u32x4*)(O + (size_t)(u.pm * BM + trow) * 256 + col0) = pack8(v0, v1); }
    }
};
struct EpiQKV {
    static constexpr bool PERM = true;
    bf16_t* O; size_t stride; const float* ss; const int* pos; float scaleq;
    __device__ __forceinline__ void operator()(const f32x4 (&acc)[2][2][4][2], const Unit& u, int wr, int wc, int fr, int fq) const {
        const int t = (u.pn * BM) >> 10, colt = (u.pn * BM) & 1023, row0 = u.pm * BM + wr * 64 + fr, col0 = colt + wc * 32 + 8 * fq;
        bf16_t* base = O + (size_t)t * stride; const float sc = (t == 0) ? scaleq : 1.f; const bool roped = (t < 2) && ((wc & 1) == 0);
#pragma unroll
        for (int ai = 0; ai < 2; ++ai)
#pragma unroll
            for (int m = 0; m < 4; ++m) { const int row = row0 + ai * HALF + m * 16; const float r = rs_of(ss, row) * sc;
                float cs[8], sn[8];
                if (roped) { const float fp = (float)pos[row];
#pragma unroll
                    for (int i = 0; i < 8; ++i) { const float invf = __builtin_powf(500000.0f, -(float)i / 8.0f); const float ang = fp * invf, rev = ang * 0.15915494309189535f, fr_ = rev - __builtin_floorf(rev);
                        sn[i] = __builtin_amdgcn_sinf(fr_); cs[i] = __builtin_amdgcn_cosf(fr_); if (fq == 0) sn[i] = -sn[i]; } }
#pragma unroll
                for (int bj = 0; bj < 2; ++bj) { f32x4 v0 = acc[ai][bj][m][0] * r, v1 = acc[ai][bj][m][1] * r;
                    if (roped) { float pv[8];
#pragma unroll
                        for (int i = 0; i < 4; ++i) { pv[i] = __shfl_xor(v0[i], 16); pv[4 + i] = __shfl_xor(v1[i], 16); }
                        if (fq < 2) {
#pragma unroll
                            for (int i = 0; i < 4; ++i) { v0[i] = v0[i] * cs[i] + pv[i] * sn[i]; v1[i] = v1[i] * cs[4 + i] + pv[4 + i] * sn[4 + i]; } } }
                    *(u32x4*)(base + (size_t)row * 1024 + col0 + bj * HALF) = pack8(v0, v1); } }
    }
};

template <class Epi, class Sched, bool ALIGN_EPI, bool GATHER>
__device__ __forceinline__ void gemm_phase(PG8_LAS unsigned char* lds, const Gemm g, const Sched& S, const Epi& E, int wave_) {
    const int tid = ltid(wave_), wid = wave_, lane = tid & 63, wr = wid >> 2, wc = wid & 3, fr = lane & 15, fq = lane >> 4;
    const int K = g.K, nt = K / BK;
    unsigned voffA[2], voffB[2]; int sR[2], sC[2];
#pragma unroll
    for (int i = 0; i < 2; ++i) { int R, C; stage_rc(tid * 16 + i * 8192, R, C); const int Rb = Epi::PERM ? ((R & ~31) + perm32(R & 31)) : R;
        sR[i] = R; sC[i] = C; voffA[i] = (unsigned)(R * K + C) * 2u; voffB[i] = (unsigned)(Rb * K + C) * 2u; }
    const size_t kstep = (size_t)(BK * 2);
    const size_t hstep = (size_t)HALF * K * 2;
    const size_t tstep = 2 * hstep;
    const unsigned ldsw = (unsigned)wid * 1024u;
    const int aoff = lds_byte(wr * 64 + fr, fq * 8), boff = lds_byte(wc * 32 + fr, fq * 8);
#define PG8_SA(b, h) (((b) * 2 + (h)) * HTB)
#define PG8_SB(b, h) ((4 + (b) * 2 + (h)) * HTB)
#define PG8_STAGE(bufoff, gbase, voff) do { _Pragma("unroll") for (int _i = 0; _i < 2; ++_i) \
        __builtin_amdgcn_global_load_lds((const unsigned*)((const char*)(gbase) + (voff)[_i]), (PG8_LAS unsigned*)(lds + (bufoff) + ldsw + _i * 8192), 16, 0, 0); } while (0)
#define PG8_STAGE_A(bufoff, base, kb, h, vv) do { _Pragma("unroll") for (int _i = 0; _i < 2; ++_i) { \
        const char* _p = GATHER ? ((const char*)g.A + (kb) + (vv)[h][_i]) : ((const char*)(base) + (kb) + (size_t)(h) * hstep + voffA[_i]); \
        __builtin_amdgcn_global_load_lds((const unsigned*)_p, (PG8_LAS unsigned*)(lds + (bufoff) + ldsw + _i * 8192), 16, 0, 0); } } while (0)
#define PG8_GOFF(vv, ord) do { _Pragma("unroll") for (int _h = 0; _h < 2; ++_h) _Pragma("unroll") for (int _i = 0; _i < 2; ++_i) \
        (vv)[_h][_i] = S.arow((ord), _h * HALF + sR[_i]) * (unsigned)(K * 2) + (unsigned)(sC[_i] * 2); } while (0)
#define PG8_LDA(dst, b, h) do { _Pragma("unroll") for (int m = 0; m < 4; ++m) _Pragma("unroll") for (int k = 0; k < 2; ++k) dst[m][k] = *(const PG8_LAS bf16x8*)(lds + PG8_SA(b, h) + aoff + m * 2048 + k * 1024); } while (0)
#define PG8_LDB(dst, b, h) do { _Pragma("unroll") for (int n = 0; n < 2; ++n) _Pragma("unroll") for (int k = 0; k < 2; ++k) dst[n][k] = *(const PG8_LAS bf16x8*)(lds + PG8_SB(b, h) + boff + n * 2048 + k * 1024); } while (0)
#define PG8_MMA(ai, bj, At, Bt) do { __builtin_amdgcn_s_setprio(1); _Pragma("unroll") for (int m = 0; m < 4; ++m) _Pragma("unroll") for (int n = 0; n < 2; ++n) _Pragma("unroll") for (int k = 0; k < 2; ++k) \
        acc[ai][bj][m][n] = __builtin_amdgcn_mfma_f32_16x16x32_bf16(Bt[n][k], At[m][k], acc[ai][bj][m][n], 0, 0, 0); __builtin_amdgcn_s_setprio(0); } while (0)
#define PG8_WAIT_V(n) asm volatile("s_waitcnt vmcnt(" #n ")" ::: "memory")
#define PG8_WAIT_L(n) asm volatile("s_waitcnt lgkmcnt(" #n ")" ::: "memory")
#define PG8_BAR __builtin_amdgcn_s_barrier()
#define PG8_SCHED __builtin_amdgcn_sched_barrier(0)
    Unit cur, nxt; int ui = 0;
    if (!S.next(0, cur)) return;
    f32x4 acc[2][2][4][2];
#pragma unroll
    for (int a = 0; a < 2; ++a)
#pragma unroll
        for (int b = 0; b < 2; ++b)
#pragma unroll
            for (int m = 0; m < 4; ++m)
#pragma unroll
                for (int n = 0; n < 2; ++n) acc[a][b][m][n] = (f32x4){0.f, 0.f, 0.f, 0.f};
    bf16x8 At[4][2], B0[2][2], B1[2][2];
    unsigned vA[2][2] = {{0u, 0u}, {0u, 0u}}, vN[2][2] = {{0u, 0u}, {0u, 0u}}, vS[2][2] = {{0u, 0u}, {0u, 0u}};
    if constexpr (GATHER) { PG8_GOFF(vA, 0); }
    const char* cA = GATHER ? (const char*)g.A : (const char*)g.A + (size_t)cur.pm * tstep; const char* cB = (const char*)g.Bt + (size_t)cur.pb * tstep;
    PG8_STAGE(PG8_SB(0, 0), cB, voffB); PG8_STAGE(PG8_SB(0, 1), cB + hstep, voffB); PG8_STAGE_A(PG8_SA(0, 0), cA, 0, 0, vA); PG8_STAGE_A(PG8_SA(0, 1), cA, 0, 1, vA);
    if (wr == 1) PG8_BAR;
    PG8_WAIT_V(2); PG8_BAR;
    PG8_STAGE(PG8_SB(1, 0), cB + kstep, voffB); PG8_STAGE_A(PG8_SA(1, 0), cA, kstep, 0, vA); PG8_STAGE(PG8_SB(1, 1), cB + hstep + kstep, voffB);
    PG8_WAIT_V(6); PG8_BAR;
    for (;;) {
        const bool has_next = S.next(ui + 1, nxt);
        if constexpr (GATHER) { if (has_next) { PG8_GOFF(vN, ui + 1); } else { _Pragma("unroll") for (int _h = 0; _h < 2; ++_h) _Pragma("unroll") for (int _i = 0; _i < 2; ++_i) vN[_h][_i] = vA[_h][_i]; } }
        const char* nA = (has_next && !GATHER) ? (const char*)g.A + (size_t)nxt.pm * tstep : cA; const char* nB = has_next ? (const char*)g.Bt + (size_t)nxt.pb * tstep : cB;
        for (int t = 0; t < nt; t += 2) {
            const bool last = (t == nt - 2);
            const size_t kb1 = (size_t)(t + 1) * kstep, kb2 = last ? (size_t)0 : (size_t)(t + 2) * kstep, kb3 = kb2 + kstep;
            const char* sA = last ? nA : cA; const char* b2 = last ? nB : cB + (size_t)(t + 2) * kstep; const char* b3 = b2 + kstep;
            if constexpr (GATHER) { _Pragma("unroll") for (int _h = 0; _h < 2; ++_h) _Pragma("unroll") for (int _i = 0; _i < 2; ++_i) vS[_h][_i] = last ? vN[_h][_i] : vA[_h][_i]; }
            PG8_LDB(B0, 0, 0); PG8_LDB(B1, 0, 1); PG8_SCHED; PG8_LDA(At, 0, 0); PG8_STAGE_A(PG8_SA(1, 1), cA, kb1, 1, vA);
            PG8_WAIT_V(8); PG8_WAIT_L(0); PG8_BAR; PG8_MMA(0, 0, At, B0); PG8_MMA(0, 1, At, B1); PG8_BAR; PG8_SCHED;
            PG8_LDA(At, 0, 1); PG8_STAGE(PG8_SB(0, 0), b2, voffB); PG8_STAGE(PG8_SB(0, 1), b2 + hstep, voffB); PG8_STAGE_A(PG8_SA(0, 0), sA, kb2, 0, vS);
            PG8_WAIT_V(8); PG8_WAIT_L(0); PG8_BAR; PG8_MMA(1, 0, At, B0); PG8_MMA(1, 1, At, B1); PG8_BAR; PG8_SCHED;
            PG8_LDB(B0, 1, 0); PG8_LDB(B1, 1, 1); PG8_SCHED; PG8_LDA(At, 1, 0); PG8_STAGE_A(PG8_SA(0, 1), sA, kb2, 1, vS);
            PG8_WAIT_V(8); PG8_WAIT_L(0); PG8_BAR; PG8_MMA(0, 0, At, B0); PG8_MMA(0, 1, At, B1); PG8_BAR; PG8_SCHED;
            PG8_LDA(At, 1, 1); PG8_STAGE(PG8_SB(1, 0), b3, voffB); PG8_STAGE(PG8_SB(1, 1), b3 + hstep, voffB); PG8_STAGE_A(PG8_SA(1, 0), sA, kb3, 0, vS);
            PG8_WAIT_V(8); PG8_WAIT_L(0); PG8_BAR; PG8_MMA(1, 0, At, B0); PG8_MMA(1, 1, At, B1); PG8_BAR; PG8_SCHED;
        }
        if constexpr (ALIGN_EPI) { if (wr == 0) PG8_BAR; }
        E(acc, cur, wr, wc, fr, fq);
        if (!has_next) break;
#pragma unroll
        for (int a = 0; a < 2; ++a)
#pragma unroll
            for (int b = 0; b < 2; ++b)
#pragma unroll
                for (int m = 0; m < 4; ++m)
#pragma unroll
                    for (int n = 0; n < 2; ++n) acc[a][b][m][n] = (f32x4){0.f, 0.f, 0.f, 0.f};
        cur = nxt; cA = nA; cB = nB; ++ui;
        if constexpr (GATHER) { _Pragma("unroll") for (int _h = 0; _h < 2; ++_h) _Pragma("unroll") for (int _i = 0; _i < 2; ++_i) vA[_h][_i] = vN[_h][_i]; }
        if constexpr (ALIGN_EPI) { if (wr == 1) PG8_BAR; }
    }
    PG8_WAIT_V(0);
    if constexpr (!ALIGN_EPI) { if (wr == 0) PG8_BAR; }
    PG8_BAR;
#undef PG8_SA
#undef PG8_SB
#undef PG8_STAGE
#undef PG8_STAGE_A
#undef PG8_GOFF
#undef PG8_LDA
#undef PG8_LDB
#undef PG8_MMA
#undef PG8_WAIT_V
#undef PG8_WAIT_L
#undef PG8_BAR
#undef PG8_SCHED
}
}

namespace attn2 {
constexpr int DK = 64, D = 128, PITCH = 1024, SKVC = 4096;
constexpr float SCALE = 0.125f;
constexpr float THR = 8.f;
constexpr bool WSKIP = false;
constexpr int NW = 8, QBLK = 32, KVBLK = 64, QB = NW * QBLK;
constexpr int SHM_V = KVBLK * D * 2, SHM_K = KVBLK * DK * 2;
constexpr int LDS_BYTES = 2 * SHM_V + 2 * SHM_K + NW * 64 * 4;
using bf16 = __hip_bfloat16;
typedef short bf16x8 __attribute__((ext_vector_type(8)));
typedef short s16x4 __attribute__((ext_vector_type(4)));
typedef float f32x16 __attribute__((ext_vector_type(16)));
typedef float f32x4 __attribute__((ext_vector_type(4)));
typedef unsigned u32x4 __attribute__((ext_vector_type(4)));
template <class A, class Bt> struct same_t { static constexpr bool v = false; };
template <class A> struct same_t<A, A> { static constexpr bool v = true; };

#define KSWZ(row, colB) ((row) * 128 + ((colB) ^ (((row) & 7) << 4)))
#define SBAR() __builtin_amdgcn_sched_barrier(0)
__device__ __forceinline__ int v_st(int k, int c) { const int kk = (k & ~0xC) | ((k & 4) << 1) | ((k & 8) >> 1); return ((kk >> 3) * 4 + (c >> 5)) * 512 + ((kk & 7) * 32 + (c & 31)) * 2; }
__device__ __forceinline__ int v_rd_base(int lane) { return ((lane & 3) << 3) | (((lane >> 2) & 3) << 6) | (((lane >> 4) & 1) << 5) | (((lane >> 5) & 1) << 8); }
constexpr int v_rd_off(int d0, int ks, int half) { return d0 * 512 + ks * 4096 + half * 2048; }
__device__ __forceinline__ int crow(int r, int hi) { return (r & 3) + 8 * (r >> 2) + 4 * hi; }
__device__ __forceinline__ unsigned cvtpk(float lo, float hi) {
    unsigned r; asm volatile("v_cvt_pk_bf16_f32 %0, %1, %2" : "=v"(r) : "v"(lo), "v"(hi)); return r;
}
__device__ __forceinline__ bf16x8 pack8(f32x4 a, f32x4 b) {
    u32x4 w = {cvtpk(a[0], a[1]), cvtpk(a[2], a[3]), cvtpk(b[0], b[1]), cvtpk(b[2], b[3])};
    return *reinterpret_cast<bf16x8*>(&w);
}
template <class T> __device__ __forceinline__ bf16x8 load8(const T* p) {
    if constexpr (same_t<T, float>::v) { return pack8(*(const f32x4*)p, *(const f32x4*)(p + 4)); }
    else { return *reinterpret_cast<const bf16x8*>(p); }
}
__device__ __forceinline__ void mask_tile(f32x16& p0, f32x16& p1, int dq, unsigned W) {
    const float NEG = -__builtin_inff();
#pragma unroll
    for (int r = 0; r < 16; ++r) {
        const int c = (r & 3) + 8 * (r >> 2);
        if ((unsigned)(dq - c) >= W) p0[r] = NEG;
        if ((unsigned)(dq - c - 32) >= W) p1[r] = NEG;
    }
}
__device__ __forceinline__ void partialSM(f32x16& p0, f32x16& p1, float& m_reg, float& mn, float& alpha) {
    float pmax = p0[0]; for (int r = 1; r < 16; ++r) pmax = fmaxf(pmax, p0[r]); for (int r = 0; r < 16; ++r) pmax = fmaxf(pmax, p1[r]);
    { auto rr = __builtin_amdgcn_permlane32_swap(__float_as_uint(pmax), __float_as_uint(pmax), false, false);
      pmax = fmaxf(__uint_as_float(rr[0]), __uint_as_float(rr[1])); }
    constexpr float C2 = 1.4426950408889634f * SCALE;
    if (__builtin_expect(__all((pmax - m_reg) * SCALE <= THR), 1)) { mn = m_reg; alpha = 1.f; }
    else { mn = fmaxf(m_reg, pmax); alpha = __builtin_amdgcn_exp2f((m_reg - mn) * C2); m_reg = mn; }
    const float mnL = -mn * C2;
    for (int r = 0; r < 16; ++r) p0[r] = fmaf(p0[r], C2, mnL); for (int r = 0; r < 16; ++r) p1[r] = fmaf(p1[r], C2, mnL);
    for (int r = 0; r < 16; ++r) p0[r] = __builtin_amdgcn_exp2f(p0[r]);
}
__device__ __forceinline__ void finishSM(f32x16& p0, f32x16& p1, float alpha, float& l_reg, bf16x8& pa0, bf16x8& pa1, bf16x8& pa2, bf16x8& pa3) {
    for (int r = 0; r < 16; ++r) p1[r] = __builtin_amdgcn_exp2f(p1[r]);
    float ps = 0; for (int r = 0; r < 16; ++r) ps += p0[r]; for (int r = 0; r < 16; ++r) ps += p1[r];
    { auto rr = __builtin_amdgcn_permlane32_swap(__float_as_uint(ps), __float_as_uint(ps), false, false);
      ps = __uint_as_float(rr[0]) + __uint_as_float(rr[1]); }
    l_reg = l_reg * alpha + ps;
#define PK4(P, B_, OUT) do { unsigned a0 = cvtpk(P[B_+0], P[B_+1]), a1 = cvtpk(P[B_+2], P[B_+3]);                          \
        unsigned b0 = cvtpk(P[B_+4], P[B_+5]), b1 = cvtpk(P[B_+6], P[B_+7]);                                             \
        auto r0 = __builtin_amdgcn_permlane32_swap(a0, b0, false, false); auto r1 = __builtin_amdgcn_permlane32_swap(a1, b1, false, false); \
        u32x4 w = {r0[0], r1[0], r0[1], r1[1]}; OUT = *reinterpret_cast<bf16x8*>(&w); } while (0)
    PK4(p0, 0, pa0); PK4(p0, 8, pa1); PK4(p1, 0, pa2); PK4(p1, 8, pa3);
#undef PK4
}
template <int KB, bool SK>
__device__ __forceinline__ void qkt(f32x16& p0, f32x16& p1, const char* K_lds, int r32, int hi, const bf16x8* qr, bool act) {
    if (SK && !act) { const float NEG = -__builtin_inff();
#pragma unroll
        for (int r = 0; r < 16; ++r) { p0[r] = NEG; p1[r] = NEG; } return; }
    p0 = f32x16{}; p1 = f32x16{};
#pragma unroll
    for (int d0 = 0; d0 < 4; ++d0) { const char* a = K_lds + KB * SHM_K + KSWZ(r32, (d0 * 16 + hi * 8) * 2);
        bf16x8 b0 = *reinterpret_cast<const bf16x8*>(a);
        bf16x8 b1 = *reinterpret_cast<const bf16x8*>(a + 32 * 128);
        p0 = __builtin_amdgcn_mfma_f32_32x32x16_bf16(b0, qr[d0], p0, 0, 0, 0);
        p1 = __builtin_amdgcn_mfma_f32_32x32x16_bf16(b1, qr[d0], p1, 0, 0, 0); }
}
template <int VB, bool SK>
__device__ __forceinline__ void pv_tile(f32x16* o, int vb0, bf16x8 pa0, bf16x8 pa1, bf16x8 pa2, bf16x8 pa3, bool act) {
    if (SK && !act) return;
#define TRRD(dst, off) asm volatile("ds_read_b64_tr_b16 %0, %1 offset:%2" : "=&v"(dst) : "v"(vb0), "i"(off) : "memory")
#define PV_D0(d0) do { s16x4 l0, l1, l2, l3, h0, h1, h2, h3; constexpr int b_ = VB * SHM_V + v_rd_off(d0, 0, 0);     \
        TRRD(l0, b_); TRRD(h0, b_ + 2048); TRRD(l1, b_ + 4096); TRRD(h1, b_ + 6144); TRRD(l2, b_ + 8192); TRRD(h2, b_ + 10240); TRRD(l3, b_ + 12288); TRRD(h3, b_ + 14336); \
        asm volatile("s_waitcnt lgkmcnt(0)" ::: "memory"); SBAR();                 \
        o[d0] = __builtin_amdgcn_mfma_f32_32x32x16_bf16(pa0, (bf16x8){l0[0], l0[1], l0[2], l0[3], h0[0], h0[1], h0[2], h0[3]}, o[d0], 0, 0, 0);   \
        o[d0] = __builtin_amdgcn_mfma_f32_32x32x16_bf16(pa1, (bf16x8){l1[0], l1[1], l1[2], l1[3], h1[0], h1[1], h1[2], h1[3]}, o[d0], 0, 0, 0);   \
        o[d0] = __builtin_amdgcn_mfma_f32_32x32x16_bf16(pa2, (bf16x8){l2[0], l2[1], l2[2], l2[3], h2[0], h2[1], h2[2], h2[3]}, o[d0], 0, 0, 0);   \
        o[d0] = __builtin_amdgcn_mfma_f32_32x32x16_bf16(pa3, (bf16x8){l3[0], l3[1], l3[2], l3[3], h3[0], h3[1], h3[2], h3[3]}, o[d0], 0, 0, 0); } while (0)
    PV_D0(0); PV_D0(1); PV_D0(2); PV_D0(3);
#undef PV_D0
#undef TRRD
}

template <class TIn, class TOut> struct BlockRef { const TIn* Q; const TIn* K; const TIn* V; TOut* O; int P0; };
template <class TIn> struct Seam {
    bf16x8 qr[4];
    bf16x8 st_v0, st_v1, st_k0;
};
__device__ __forceinline__ int swa_jlo(int P0, int W) { const int lowk = P0 - W + 1; return lowk > 0 ? lowk / KVBLK : 0; }
#define ROW(p, k0, rr) ((p) + (size_t)((k0) + (rr)) * PITCH + sc)
#define VMW() asm volatile("s_waitcnt vmcnt(0)" ::: "memory")
#define VMWN(n) asm volatile("s_waitcnt vmcnt(%0)" :: "i"(n) : "memory")
#define SLOAD_H(Kp, Vp, k0) do { S.st_v0 = load8<TIn>(ROW(Vp, k0, sr)); S.st_v1 = load8<TIn>(ROW(Vp, k0, 32 + sr));              \
                         S.st_k0 = load8<TIn>((Kp) + (size_t)((k0) + kr) * PITCH + kc); } while (0)
#define SWRITE_HK(bf) do { *(bf16x8*)(K_lds + (bf) * SHM_K + kws) = S.st_k0; } while (0)
#define SWRITE_HV(bf) do { *(bf16x8*)(V_lds + (bf) * SHM_V + vst0) = S.st_v0; *(bf16x8*)(V_lds + (bf) * SHM_V + vst1) = S.st_v1; } while (0)
#define SWRITE_H(bf) do { SWRITE_HV(bf); SWRITE_HK(bf); } while (0)
template <class TIn, class TOut>
__device__ __forceinline__ void causal_swa_prime(const BlockRef<TIn, TOut>& cur, int W, char* lds, Seam<TIn>& S, int wave_) {
    const int wid = wave_, tid = pg8::ltid(wid), lane = tid & 63, r32 = lane & 31, hi = lane >> 5;
    const int sr = tid >> 4, sc = (tid & 15) * 8, kr = tid >> 3, kc = (tid & 7) * 8, kws = KSWZ(kr, kc * 2); char* K_lds = lds + 2 * SHM_V;
    const int kb0 = swa_jlo(cur.P0, W) * KVBLK;
    for (int d0 = 0; d0 < 4; ++d0) S.qr[d0] = load8<TIn>(cur.Q + (size_t)(wid * QBLK + r32) * PITCH + d0 * 16 + hi * 8);
    SLOAD_H(cur.K, cur.V, kb0); VMW(); SWRITE_HK(0);
    __syncthreads();
}
template <class TIn, class TOut>
__device__ __forceinline__ void causal_swa_block(const BlockRef<TIn, TOut>& cur, const BlockRef<TIn, TOut>& nxt, int skv, int W, char* lds, Seam<TIn>& S, int wave_) {
    const int wid = wave_, tid = pg8::ltid(wid), lane = tid & 63, r32 = lane & 31, hi = lane >> 5;
    const int j_lo = swa_jlo(cur.P0, W);
    int j_hi = (cur.P0 + QB - 1) / KVBLK + 1; if (j_hi > skv / KVBLK) j_hi = skv / KVBLK;
    const int NT = j_hi - j_lo;
    const int kbn = swa_jlo(nxt.P0, W) * KVBLK;
    const int qlo = cur.P0 + wid * QBLK, qm = qlo + r32 - 4 * hi;
    char* V_lds = lds; char* K_lds = lds + 2 * SHM_V;
    float* ws = (float*)(lds + 2 * SHM_V + 2 * SHM_K) + wid * 64; float* li_l = ws, * al_l = ws + 32;
    float m_reg = -1e30f, l_reg = 0; f32x16 o[4] = {};
    const int sr = tid >> 4, sc = (tid & 15) * 8, vst0 = v_st(sr, sc), vst1 = v_st(32 + sr, sc), kr = tid >> 3, kc = (tid & 7) * 8, kws = KSWZ(kr, kc * 2);
    const int vb0 = (int)(uintptr_t)V_lds + v_rd_base(lane);
    const TIn* Kh = cur.K; const TIn* Vh = cur.V;
#define RESC(a) do { if (__any((a) < 1.f)) { if (hi == 0) al_l[r32] = (a); asm volatile("s_waitcnt lgkmcnt(0)" ::: "memory");              \
                     for (int d_ = 0; d_ < 4; ++d_) for (int r = 0; r < 16; ++r) o[d_][r] *= al_l[crow(r, hi)]; } } while (0)
#define KBASE(t) ((j_lo + (t)) * KVBLK)
#define ACT(t) (KBASE(t) <= qlo + QBLK - 1 && KBASE(t) + KVBLK - 1 >= qlo - W + 1)
#define MASKT(P0_, P1_, t) do { const int kb_ = KBASE(t); if ((!SK || ACT(t)) && (kb_ + KVBLK - 1 > qlo || kb_ <= qlo + QBLK - 1 - W)) mask_tile(P0_, P1_, qm - kb_, (unsigned)W); } while (0)
    constexpr int NQL = 4;
    constexpr bool SK = WSKIP;
#define SEAM_K0() do { VMWN(NQL); SWRITE_HK(0); SBAR(); } while (0)
    f32x16 pA0, pA1, pB0, pB1; float mnA, mnB, alA, alB; bf16x8 pa0, pa1, pa2, pa3;
    SWRITE_HV(0); SBAR();
    if (NT > 1) { SLOAD_H(Kh, Vh, KBASE(1)); }
    SBAR(); qkt<0, SK>(pA0, pA1, K_lds, r32, hi, S.qr, ACT(0));
    MASKT(pA0, pA1, 0); partialSM(pA0, pA1, m_reg, mnA, alA);
    if (NT > 1) { VMW(); SWRITE_H(1); }
    __syncthreads();
#define HALF_STEP(PX0, PX1, mnX, alX, PY0, PY1, alY, t, KB, VB, SB) do {                                                      \
        SBAR(); qkt<KB, SK>(PX0, PX1, K_lds, r32, hi, S.qr, ACT(t));                                             \
        finishSM(PY0, PY1, alY, l_reg, pa0, pa1, pa2, pa3); SBAR();                                                           \
        if ((t) + 1 < NT) { SLOAD_H(Kh, Vh, KBASE((t) + 1)); SBAR(); }                                                        \
        pv_tile<VB, SK>(o, vb0, pa0, pa1, pa2, pa3, ACT((t) - 1)); MASKT(PX0, PX1, (t)); partialSM(PX0, PX1, m_reg, mnX, alX);                                        \
        __syncthreads();                                                                                                      \
        if ((t) + 1 < NT) { VMW(); SWRITE_H(SB); }                                                                            \
        RESC(alX); __syncthreads(); } while (0)
    for (int t = 1; t + 1 < NT; t += 2) {
        HALF_STEP(pB0, pB1, mnB, alB, pA0, pA1, alA, t, 1, 0, 0);
        HALF_STEP(pA0, pA1, mnA, alA, pB0, pB1, alB, t + 1, 0, 1, 1);
    }
    const bool even = (NT & 1) == 0;
    if (even) { SBAR(); qkt<1, SK>(pB0, pB1, K_lds, r32, hi, S.qr, ACT(NT - 1)); SBAR(); }
    { SLOAD_H(nxt.K, nxt.V, kbn); SBAR();
#pragma unroll
        for (int d0 = 0; d0 < 4; ++d0) S.qr[d0] = load8<TIn>(nxt.Q + (size_t)(wid * QBLK + r32) * PITCH + d0 * 16 + hi * 8); }
    SBAR();
    finishSM(pA0, pA1, alA, l_reg, pa0, pa1, pa2, pa3); SBAR();
    pv_tile<0, SK>(o, vb0, pa0, pa1, pa2, pa3, ACT(even ? NT - 2 : NT - 1));
    if (even) { MASKT(pB0, pB1, NT - 1); partialSM(pB0, pB1, m_reg, mnB, alB); __syncthreads(); RESC(alB);
        finishSM(pB0, pB1, alB, l_reg, pa0, pa1, pa2, pa3); SBAR(); pv_tile<1, SK>(o, vb0, pa0, pa1, pa2, pa3, ACT(NT - 1)); }
    SBAR(); SEAM_K0();
    if (hi == 0) li_l[r32] = l_reg; asm volatile("s_waitcnt lgkmcnt(0)" ::: "memory");
    float rli[16];
#pragma unroll
    for (int r = 0; r < 16; ++r) rli[r] = __builtin_amdgcn_rcpf(li_l[crow(r, hi)]);
    TOut* Ow = cur.O + (size_t)(wid * QBLK) * PITCH;
#pragma unroll
    for (int r = 0; r < 16; ++r) { const int orow = crow(r, hi);
#pragma unroll
        for (int d0 = 0; d0 < 4; ++d0) { const float v = o[d0][r] * rli[r];
            if constexpr (same_t<TOut, float>::v) { Ow[(size_t)orow * PITCH + d0 * 32 + r32] = v; }
            else { const float vn = __shfl_xor(v, 1);
                   if ((r32 & 1) == 0) *(unsigned*)(Ow + (size_t)orow * PITCH + d0 * 32 + r32) = cvtpk(v, vn); } } }
    __syncthreads();
#undef RESC
#undef KBASE
#undef ACT
#undef MASKT
#undef SEAM_K0
#undef HALF_STEP
}
#undef ROW
#undef VMW
#undef VMWN
#undef SLOAD_H
#undef SWRITE_HK
#undef SWRITE_HV
#undef SWRITE_H
#undef KSWZ
#undef SBAR
struct Tensors { const bf16* Q; const bf16* K; const bf16* V; bf16* O0; bf16* O1; };
__device__ __forceinline__ BlockRef<bf16, bf16> blk_ref(const Tensors& T, int L, int pass) {
    const int bh = L >> 3, p = L & 7, b = bh >> 4, hc = bh & 15, qb = pass ? 15 - p : p; const size_t rowb = (size_t)b * SKVC;
    BlockRef<bf16, bf16> r;
    r.Q = T.Q + (rowb + (size_t)qb * QB) * PITCH + hc * DK; r.K = T.K + rowb * PITCH + hc * DK; r.V = T.V + rowb * PITCH + (hc >> 1) * D;
    r.O = ((hc & 1) ? T.O1 : T.O0) + (rowb + (size_t)qb * QB) * PITCH + (hc >> 1) * D; r.P0 = qb * QB;
    return r;
}
__device__ __forceinline__ void attn_phase(char* lds, const Tensors& T, int vcu, int G, int wave_) {
    constexpr int TOTAL = 8 * 16 * 8, W = 1 << 20;
    int L = vcu; if (L >= TOTAL) return;
    int pass = 0;
    BlockRef<bf16, bf16> cur = blk_ref(T, L, 0);
    Seam<bf16> S;
    causal_swa_prime<bf16, bf16>(cur, W, lds, S, wave_);
    for (;;) {
        const bool more_pass = pass == 0, more_item = L + G < TOTAL, last = !more_pass && !more_item;
        int passn = pass + 1, Ln = L;
        if (!more_pass) { passn = 0; Ln = more_item ? L + G : L; }
        const BlockRef<bf16, bf16> nxt = last ? cur : blk_ref(T, Ln, passn);
        causal_swa_block<bf16, bf16>(cur, nxt, SKVC, W, lds, S, wave_);
        if (last) break;
        cur = nxt; pass = passn; L = Ln;
    }
}
}
#define GAS __attribute__((address_space(1)))
#define LAS __attribute__((address_space(3)))
typedef unsigned short bf16;
typedef unsigned v4u __attribute__((ext_vector_type(4)));
typedef float f32x4 __attribute__((ext_vector_type(4)));
typedef short bf16x8 __attribute__((ext_vector_type(8)));
typedef GAS unsigned gu32;
typedef GAS unsigned long long gu64;
#define RLX_AGENT __ATOMIC_RELAXED, __HIP_MEMORY_SCOPE_AGENT
#define LDS_WAIT() asm volatile("s_waitcnt lgkmcnt(0)" ::: "memory")
#define VM_WAIT() asm volatile("s_waitcnt vmcnt(0)" ::: "memory")
__device__ __forceinline__ unsigned long long rt() { return __builtin_amdgcn_s_memrealtime(); }
__device__ __forceinline__ unsigned f2bf(float f) { unsigned u = __builtin_bit_cast(unsigned, f); return (u + 0x7fffu + ((u >> 16) & 1u)) >> 16; }
__device__ __forceinline__ unsigned pk2(float lo, float hi) { return f2bf(lo) | (f2bf(hi) << 16); }

#define XB_TMO      128
#define XB_XCNT(j)  (256  + 64 * (j))
#define XB_XSUB(j)  (1280 + 64 * (j))
#define XB_XGEN(j)  (2304 + 64 * (j))
#define XB_TOP      3328
#define XB_TOPGEN   3392
#define XCD_BAR_WORDS 3456
#define XB_SPIN_CAP (1u << 18)

__device__ __forceinline__ unsigned xb_ld(unsigned* p)              { return __hip_atomic_load(p, __ATOMIC_RELAXED, __HIP_MEMORY_SCOPE_AGENT); }
__device__ __forceinline__ unsigned xb_add(unsigned* p, unsigned v) { return __hip_atomic_fetch_add(p, v, __ATOMIC_RELAXED, __HIP_MEMORY_SCOPE_AGENT); }
__device__ __forceinline__ unsigned xb_xcc_id() { return (unsigned)__builtin_amdgcn_s_getreg((3 << 11) | 20) & 0xFu; }
#define XB_SPIN(cond, bar) do { unsigned _sp = 0; while (cond) { __builtin_amdgcn_s_sleep(1); \
    if ((++_sp & 255u) == 0u) { if (xb_ld(&(bar)[XB_TMO])) break; if (_sp > XB_SPIN_CAP) { atomicAdd(&(bar)[XB_TMO], 1u); break; } } } } while (0)

struct XcdBarrier {
    unsigned* bar; unsigned x;
    volatile LAS unsigned* st;
};

__device__ __forceinline__ XcdBarrier xcd_barrier_post(unsigned* bar, volatile LAS unsigned* st) {
    XcdBarrier b; b.bar = bar; b.x = xb_xcc_id(); b.st = st;
    if (threadIdx.x == 0) (void)xb_add(&bar[XB_XCNT(b.x)], 1u);
    return b;
}
__device__ __forceinline__ void xcd_barrier_complete(unsigned* bar, unsigned x, unsigned& nloc, unsigned& nx) {
    const unsigned G = gridDim.x * gridDim.y * gridDim.z;
    unsigned sum, cnt, mine, sp = 0u;
    for (;;) {
        sum = 0u; cnt = 0u; mine = 0u;
#pragma unroll
        for (unsigned j = 0; j < 16; ++j) { const unsigned c = xb_ld(&bar[XB_XCNT(j)]); sum += c; cnt += (c > 0u) ? 1u : 0u; mine = (j == x) ? c : mine; }
        if (sum == G) break;
        __builtin_amdgcn_s_sleep(1);
        if ((++sp & 255u) == 0u) { if (xb_ld(&bar[XB_TMO])) break; if (sp > XB_SPIN_CAP) { atomicAdd(&bar[XB_TMO], 1u); break; } }
    }
    nloc = mine > 0u ? mine : 1u; nx = cnt > 0u ? cnt : 1u;
}

__device__ __forceinline__ void xcd_barrier(const XcdBarrier& b) {
    asm volatile("s_waitcnt vmcnt(0)" ::: "memory");
    __syncthreads();
    if (threadIdx.x == 0) {
        unsigned* bar = b.bar;
        __builtin_amdgcn_s_waitcnt(0);
        unsigned nloc = b.st[0], nx = b.st[1];
        if (nloc == 0u) { xcd_barrier_complete(bar, b.x, nloc, nx); b.st[0] = nloc; b.st[1] = nx; }
        const unsigned old = xb_add(&bar[XB_XSUB(b.x)], 1u);
        const unsigned gen = old / nloc;
        if (old + 1u == (gen + 1u) * nloc) {
            __builtin_amdgcn_fence(__ATOMIC_RELEASE, "agent");
            asm volatile("s_waitcnt vmcnt(0)" ::: "memory");
            const unsigned og = xb_add(&bar[XB_TOP], 1u);
            const unsigned tg = og / nx;
            if (og + 1u == (tg + 1u) * nx) xb_add(&bar[XB_TOPGEN], 1u);
            else XB_SPIN(xb_ld(&bar[XB_TOPGEN]) == tg, bar);
            __builtin_amdgcn_fence(__ATOMIC_ACQUIRE, "agent");
            xb_add(&bar[XB_XGEN(b.x)], 1u);
            asm volatile("s_waitcnt vmcnt(0)" ::: "memory");
        } else {
            XB_SPIN(xb_ld(&bar[XB_XGEN(b.x)]) == gen, bar);
            __builtin_amdgcn_fence(__ATOMIC_ACQUIRE, "agent");
            asm volatile("s_waitcnt vmcnt(0)" ::: "memory");
        }
    }
    __syncthreads();
}

constexpr int NWAVES = 8;
constexpr int BATCH = 8, SEQ = 4096, D = 1024, M = BATCH * SEQ;
constexpr int NEXP = 32, FE = 256, PLED = 256, CWID = 31, NQKV = 3072;
constexpr float EPS = 1e-6f;
constexpr int NPHASE = 21;
constexpr int PADROWS = 73728;
constexpr float LAM_INIT = 0.35550906759096926f;

constexpr size_t MiB = 1u << 20;
constexpr size_t WS_CTL = 0, CTL_ZERO_BYTES = 1 * MiB;
constexpr size_t WS_SSQ = 439 * MiB;
constexpr size_t WS_TI = 2 * MiB, WS_TW = WS_TI + 512 * 1024;
constexpr size_t WS_LIST = 3 * MiB;
constexpr size_t WS_RP = 7 * MiB;
constexpr size_t WS_LOG = 11 * MiB;
constexpr size_t WS_WPW1 = 19 * MiB, WS_WPW2 = 23 * MiB, WS_WQKV = 25 * MiB, WS_WO = 31 * MiB, WS_WR = 33 * MiB, WS_WPG = 34 * MiB, WS_WPP = 38 * MiB;
constexpr size_t WS_WGU = 39 * MiB, WS_WD = 71 * MiB;
constexpr size_t WS_P16 = 87 * MiB;
constexpr size_t WS_S0 = 119 * MiB, WS_SS = 64 * MiB;
constexpr size_t WS_END = WS_SSQ + 14 * MiB;
static_assert(WS_S0 + 5 * WS_SS == WS_SSQ, "d_ws map");
constexpr int CW_BAR = 4096;
constexpr int CW_CNT = 8192;
constexpr int RING_OFF = 0, RING_BYTES = 131072;
constexpr int LDSCTL_OFF = RING_BYTES;
constexpr int L_MISC = LDSCTL_OFF, L_TS = LDSCTL_OFF + 128, L_NE = LDSCTL_OFF + 384, L_TE = LDSCTL_OFF + 512, L_TOK = LDSCTL_OFF + 2048, L_HIST = LDSCTL_OFF + 10240;
constexpr int MAXGU = 8;
constexpr int LDS_BYTES = 147456;


typedef float f32x2 __attribute__((ext_vector_type(2)));
typedef unsigned u32x2 __attribute__((ext_vector_type(2)));
typedef int i32x4 __attribute__((ext_vector_type(4)));
__device__ __forceinline__ float bflo(unsigned u) { return __builtin_bit_cast(float, u << 16); }
__device__ __forceinline__ float bfhi(unsigned u) { return __builtin_bit_cast(float, u & 0xffff0000u); }
__device__ __forceinline__ float sigmoid_f(float x) { return __builtin_amdgcn_rcpf(1.f + __expf(-x)); }
__device__ __forceinline__ float wave_sum(float v) {
#pragma unroll
    for (int o = 1; o < 64; o <<= 1) v += __shfl_xor(v, o);
    return v;
}
__device__ __forceinline__ void tr_item(const float* W, int N, bf16* WT, int Kd, int k0, int n0, int drow0, const float* gk, LAS float* scr, int lane) {
#pragma unroll 8
    for (int i = 0; i < 32; ++i) { const int kk = 2 * i + (lane >> 5); scr[kk * 33 + (lane & 31)] = W[(size_t)(k0 + kk) * N + n0 + (lane & 31)]; }
    LDS_WAIT(); asm volatile("" ::: "memory");
    const int c = lane & 7;
    f32x4 g0 = {1.f, 1.f, 1.f, 1.f}, g1 = {1.f, 1.f, 1.f, 1.f};
    if (gk) { g0 = *(const f32x4*)(gk + k0 + 8 * c); g1 = *(const f32x4*)(gk + k0 + 8 * c + 4); }
#pragma unroll
    for (int j = 0; j < 4; ++j) { const int n = (lane >> 3) + 8 * j; const LAS float* s = scr + (8 * c) * 33 + n;
        v4u o; o.x = pk2(s[0 * 33] * g0.x, s[1 * 33] * g0.y); o.y = pk2(s[2 * 33] * g0.z, s[3 * 33] * g0.w); o.z = pk2(s[4 * 33] * g1.x, s[5 * 33] * g1.y); o.w = pk2(s[6 * 33] * g1.z, s[7 * 33] * g1.w);
        *(GAS v4u*)(WT + (size_t)(drow0 + n) * Kd + k0 + 8 * c) = o; }
    LDS_WAIT(); asm volatile("" ::: "memory");
}
template <bool GLU_IL = false>
__device__ __forceinline__ void tr_plain(const float* W, int K, int N, bf16* WT, int item, const float* gk, LAS float* scr, int lane) {
    const int nblk = N / 32, kb = item / nblk, nb = item % nblk, n0 = 32 * nb; int drow0 = n0;
    if (GLU_IL) { const int h = n0 >> 10, c = n0 & 1023; drow0 = (c >> 7) * 256 + h * 128 + (c & 127); }
    tr_item(W, N, WT, K, 64 * kb, n0, drow0, gk, scr, lane);
}
constexpr int MOE_ITEMS = 32 * 384;
__device__ __forceinline__ void moe_item(const float* wg, const float* wu, const float* wd, const float* gk, int l, bf16* WGU, bf16* WD, int item, LAS float* scr, int lane) {
    const int ge = item / 384, r = item % 384, which = r / 128, sub = r % 128; const size_t eo = (size_t)(l * 32 + ge) * 262144;
    if (which < 2) { const int kb = sub / 8, nb = sub % 8, n0 = 32 * nb; const int drow0 = (n0 / 128) * 256 + (n0 % 128) + (which ? 128 : 0);
        tr_item((which ? wu : wg) + eo, 256, WGU + (size_t)ge * 512 * 1024, 1024, 64 * kb, n0, drow0, gk, scr, lane); }
    else { const int kb = sub / 32, nb = sub % 32; tr_item(wd + eo, 1024, WD + (size_t)ge * 1024 * 256, 256, 64 * kb, 32 * nb, 32 * nb, nullptr, scr, lane); }
}

__device__ __forceinline__ void row_cvt(const float* x, bf16* XB, float* ss, int gw, int NGW, int lane) {
    for (int m = gw; m < M; m += NGW) {
        const GAS f32x4* xr = (const GAS f32x4*)(x + (size_t)m * D) + lane; GAS u32x2* xo = (GAS u32x2*)(XB + (size_t)m * D) + lane;
        f32x4 v[4]; float s = 0.f;
#pragma unroll
        for (int j = 0; j < 4; ++j) v[j] = xr[64 * j];
#pragma unroll
        for (int j = 0; j < 4; ++j) { s += (v[j].x * v[j].x + v[j].y * v[j].y) + (v[j].z * v[j].z + v[j].w * v[j].w); xo[64 * j] = (u32x2){pk2(v[j].x, v[j].y), pk2(v[j].z, v[j].w)}; }
        s = wave_sum(s); if (lane < 16) ss[(size_t)m * 16 + lane] = lane ? 0.f : s;
    }
}
__device__ __forceinline__ void row_moe(const bf16* Xi, bf16* Xo, const bf16* YP, const i32x4* TI, const f32x2* TW, const unsigned* cnt, float* ss, int gw, int NGW, int lane) {
    int ts;
    { const unsigned n = lane < 32 ? __hip_atomic_load(cnt + lane * 64, RLX_AGENT) : 0u; const int tiles = (int)((n + 255u) >> 8); int incl = tiles;
#pragma unroll
      for (int o = 1; o < 32; o <<= 1) { const int t = __shfl_up(incl, o); if (lane >= o) incl += t; }
      ts = incl - tiles; }
    for (int m = gw; m < M; m += NGW) {
        const i32x4 ti = TI[m]; const f32x2 tw = TW[m];
        const int r1 = __shfl(ts, ti.x) * 256 + ti.y, r2 = __shfl(ts, ti.z) * 256 + ti.w;
        const GAS u32x2* xr = (const GAS u32x2*)(Xi + (size_t)m * D) + lane; GAS u32x2* xo = (GAS u32x2*)(Xo + (size_t)m * D) + lane;
        const GAS u32x2* y1 = (const GAS u32x2*)(YP + (size_t)r1 * D) + lane; const GAS u32x2* y2 = (const GAS u32x2*)(YP + (size_t)r2 * D) + lane;
        float s = 0.f;
#pragma unroll
        for (int j = 0; j < 4; ++j) { const u32x2 x = xr[64 * j], a = y1[64 * j], c = y2[64 * j];
            const f32x4 v = (f32x4){bflo(x.x), bfhi(x.x), bflo(x.y), bfhi(x.y)} + (f32x4){bflo(a.x), bfhi(a.x), bflo(a.y), bfhi(a.y)} * tw.x + (f32x4){bflo(c.x), bfhi(c.x), bflo(c.y), bfhi(c.y)} * tw.y;
            s += (v.x * v.x + v.y * v.y) + (v.z * v.z + v.w * v.w); xo[64 * j] = (u32x2){pk2(v.x, v.y), pk2(v.z, v.w)}; }
        s = wave_sum(s); if (lane < 16) ss[(size_t)m * 16 + lane] = lane ? 0.f : s;
    }
}
__device__ __forceinline__ void row_final(float* out, const float* ss, const float* gain, int gw, int NGW, int lane) {
    f32x4 gv[4];
#pragma unroll
    for (int j = 0; j < 4; ++j) gv[j] = *((const f32x4*)gain + lane + 64 * j);
    for (int m = gw; m < M; m += NGW) {
        GAS f32x4* xr = (GAS f32x4*)(out + (size_t)m * D) + lane; const float r = pg8::rs_of(ss, m);
        f32x4 v[4];
#pragma unroll
        for (int j = 0; j < 4; ++j) v[j] = xr[64 * j];
#pragma unroll
        for (int j = 0; j < 4; ++j) xr[64 * j] = v[j] * r * gv[j];
    }
}

__device__ __forceinline__ void conv_phase(const bf16* U, bf16* C, const float* wdw, const float* bdw, const float* lng, const float* lnb, LAS unsigned char* lds, int vcu, int G, int tid, int lane, int wave) {
    const int c0 = 2 * tid;
    f32x2 w[CWID];
#pragma unroll
    for (int j = 0; j < CWID; ++j) w[j] = *(const f32x2*)(wdw + j * D + c0);
    const f32x2 bd = *(const f32x2*)(bdw + c0);
    LAS unsigned* yb = (LAS unsigned*)lds;
    for (int chunk = vcu; chunk < M / 32; chunk += G) {
        const int b = chunk >> 7, t0 = (chunk & 127) * 32; const size_t rb = (size_t)b * SEQ;
        const bf16* Ub = U + rb * D + c0;
        f32x2 win[CWID];
#pragma unroll
        for (int s = 0; s < CWID; ++s) { const int tau = t0 - 30 + s; const int tc = tau < 0 ? 0 : tau;
            const unsigned ua = *(const GAS unsigned*)(Ub + (size_t)tc * D);
            win[s] = tau < 0 ? (f32x2){0.f, 0.f} : (f32x2){bflo(ua), bfhi(ua)}; }
        { f32x2 a = bd;
#pragma unroll
          for (int j = 0; j < CWID; ++j) a += w[j] * win[j];
          yb[tid] = pk2(a.x, a.y); }
#pragma unroll
        for (int s = 0; s < CWID; ++s) { const int tau = t0 + 1 + s;
            const unsigned ua = *(const GAS unsigned*)(Ub + (size_t)tau * D);
            win[s] = (f32x2){bflo(ua), bfhi(ua)};
            f32x2 a = bd;
#pragma unroll
            for (int j = 0; j < CWID; ++j) a += w[j] * win[(s + 1 + j) % CWID];
            yb[(1 + s) * 512 + tid] = pk2(a.x, a.y); }
        LDS_WAIT(); __syncthreads();
#pragma unroll 1
        for (int rr = 0; rr < 4; ++rr) { const int r = wave * 4 + rr;
            const v4u p0 = *(const LAS v4u*)(lds + r * 2048 + lane * 16), p1 = *(const LAS v4u*)(lds + r * 2048 + 1024 + lane * 16);
            float x[16] = {bflo(p0.x), bfhi(p0.x), bflo(p0.y), bfhi(p0.y), bflo(p0.z), bfhi(p0.z), bflo(p0.w), bfhi(p0.w), bflo(p1.x), bfhi(p1.x), bflo(p1.y), bfhi(p1.y), bflo(p1.z), bfhi(p1.z), bflo(p1.w), bfhi(p1.w)};
            float s = 0.f;
#pragma unroll
            for (int i = 0; i < 16; ++i) s += x[i];
            const float mu = wave_sum(s) * (1.f / D); float q = 0.f;
#pragma unroll
            for (int i = 0; i < 16; ++i) { x[i] -= mu; q += x[i] * x[i]; }
            const float rs = 1.f / sqrtf(wave_sum(q) * (1.f / D) + EPS);
            unsigned o[8];
#pragma unroll
            for (int hh = 0; hh < 2; ++hh) { const f32x4 g0 = *(const f32x4*)(lng + hh * 512 + lane * 8), g1 = *(const f32x4*)(lng + hh * 512 + lane * 8 + 4), b0 = *(const f32x4*)(lnb + hh * 512 + lane * 8), b1 = *(const f32x4*)(lnb + hh * 512 + lane * 8 + 4);
                float y[8] = {x[hh * 8 + 0] * rs * g0.x + b0.x, x[hh * 8 + 1] * rs * g0.y + b0.y, x[hh * 8 + 2] * rs * g0.z + b0.z, x[hh * 8 + 3] * rs * g0.w + b0.w,
                              x[hh * 8 + 4] * rs * g1.x + b1.x, x[hh * 8 + 5] * rs * g1.y + b1.y, x[hh * 8 + 6] * rs * g1.z + b1.z, x[hh * 8 + 7] * rs * g1.w + b1.w};
#pragma unroll
                for (int i = 0; i < 4; ++i) o[hh * 4 + i] = pk2(y[2 * i] * sigmoid_f(y[2 * i]), y[2 * i + 1] * sigmoid_f(y[2 * i + 1])); }
            bf16* cr = C + (rb + t0 + r) * D;
            *(GAS v4u*)(cr + lane * 8) = (v4u){o[0], o[1], o[2], o[3]}; *(GAS v4u*)(cr + 512 + lane * 8) = (v4u){o[4], o[5], o[6], o[7]}; }
        LDS_WAIT(); __syncthreads();
    }
}

__device__ __forceinline__ void combine_phase(const bf16* O0, const bf16* O1, bf16* OC, const float* lamp, const float* subln, int gw, int NGW, int lane) {
    const float l1 = wave_sum(lamp[lane] * lamp[64 + lane]), l2 = wave_sum(lamp[128 + lane] * lamp[192 + lane]);
    const float lam = __expf(l1) - __expf(l2) + LAM_INIT;
    float gsc[16];
#pragma unroll
    for (int i = 0; i < 16; ++i) gsc[i] = subln[(lane & 7) * 16 + i] * (1.0f - LAM_INIT);
    for (int m = gw; m < M; m += NGW) {
        const v4u a0 = *(const GAS v4u*)(O0 + (size_t)m * D + lane * 16), a1 = *(const GAS v4u*)(O0 + (size_t)m * D + lane * 16 + 8);
        const v4u b0 = *(const GAS v4u*)(O1 + (size_t)m * D + lane * 16), b1 = *(const GAS v4u*)(O1 + (size_t)m * D + lane * 16 + 8);
        const unsigned ua[8] = {a0.x, a0.y, a0.z, a0.w, a1.x, a1.y, a1.z, a1.w}, ub[8] = {b0.x, b0.y, b0.z, b0.w, b1.x, b1.y, b1.z, b1.w};
        float o[16]; float ss = 0.f;
#pragma unroll
        for (int i = 0; i < 8; ++i) { o[2 * i] = bflo(ua[i]) - lam * bflo(ub[i]); o[2 * i + 1] = bfhi(ua[i]) - lam * bfhi(ub[i]); ss += o[2 * i] * o[2 * i] + o[2 * i + 1] * o[2 * i + 1]; }
        ss += __shfl_xor(ss, 1); ss += __shfl_xor(ss, 2); ss += __shfl_xor(ss, 4);
        const float r = 1.f / sqrtf(ss * (1.f / 128.f) + EPS);
        unsigned w[8];
#pragma unroll
        for (int i = 0; i < 8; ++i) w[i] = pk2(o[2 * i] * r * gsc[2 * i], o[2 * i + 1] * r * gsc[2 * i + 1]);
        *(GAS v4u*)(OC + (size_t)m * D + lane * 16) = (v4u){w[0], w[1], w[2], w[3]}; *(GAS v4u*)(OC + (size_t)m * D + lane * 16 + 8) = (v4u){w[4], w[5], w[6], w[7]};
    }
}

__device__ __forceinline__ void select_phase(const float* LOG, const float* brg, const float* bre, const float* ss, unsigned* cnt, int* list, float* RP, i32x4* TI, f32x2* TW, LAS int* lh, int vcu, int G, int tid) {
    for (int base = vcu * 128; base < M; base += G * 128) {
        if (tid < 32) lh[tid] = 0;
        __syncthreads();
        const int t = base + tid; int E1 = 0, E2 = 0, r1 = 0, r2 = 0; float w1 = 0.f, w2 = 0.f;
        if (tid < 128) {
            const f32x4 g4 = *(const GAS f32x4*)(LOG + (size_t)t * 64);
            const float gl[4] = {g4.x + brg[0], g4.y + brg[1], g4.z + brg[2], g4.w + brg[3]};
            int gi = 0; float gm = gl[0];
#pragma unroll
            for (int j = 1; j < 4; ++j) if (gl[j] > gm) { gm = gl[j]; gi = j; }
            float den = 0.f;
#pragma unroll
            for (int j = 0; j < 4; ++j) den += __expf(gl[j] - gm);
            const float gw_ = 1.f / den;
            const f32x4 ea = *(const GAS f32x4*)(LOG + (size_t)t * 64 + 4 + gi * 8), eb = *(const GAS f32x4*)(LOG + (size_t)t * 64 + 8 + gi * 8);
            const f32x4 ba = *(const f32x4*)(bre + gi * 8), bb = *(const f32x4*)(bre + gi * 8 + 4);
            const float el[8] = {ea.x + ba.x, ea.y + ba.y, ea.z + ba.z, ea.w + ba.w, eb.x + bb.x, eb.y + bb.y, eb.z + bb.z, eb.w + bb.w};
            int i1 = 0; float v1 = el[0];
#pragma unroll
            for (int j = 1; j < 8; ++j) if (el[j] > v1) { v1 = el[j]; i1 = j; }
            int i2 = -1; float v2 = -INFINITY;
#pragma unroll
            for (int j = 0; j < 8; ++j) if (j != i1 && (i2 < 0 || el[j] > v2)) { v2 = el[j]; i2 = j; }
            const float e2 = __expf(v2 - v1); const float p1 = 1.f / (1.f + e2);
            w1 = p1 * gw_; w2 = (e2 * p1) * gw_; E1 = gi * 8 + i1; E2 = gi * 8 + i2;
            r1 = __hip_atomic_fetch_add(lh + E1, 1, __ATOMIC_RELAXED, __HIP_MEMORY_SCOPE_WORKGROUP); r2 = __hip_atomic_fetch_add(lh + E2, 1, __ATOMIC_RELAXED, __HIP_MEMORY_SCOPE_WORKGROUP);
        }
        __syncthreads();
        if (tid < 32) { const int c = lh[tid]; int bs = 0; if (c) bs = (int)__hip_atomic_fetch_add(cnt + tid * 64, (unsigned)c, RLX_AGENT); lh[32 + tid] = bs; }
        __syncthreads();
        if (tid < 128) { const int s1 = lh[32 + E1] + r1, s2 = lh[32 + E2] + r2;
            const float r = pg8::rs_of(ss, t);
            list[(size_t)E1 * M + s1] = t; list[(size_t)E2 * M + s2] = t; RP[(size_t)E1 * M + s1] = r; RP[(size_t)E2 * M + s2] = r; TI[t] = (i32x4){E1, s1, E2, s2}; TW[t] = (f32x2){w1, w2}; }
        __syncthreads();
    }
}

struct GroupedOrder {
    int nNs, G, c, ntu;
    const LAS int* tile_e; const LAS int* tokl; const LAS int* ts;
    __device__ __forceinline__ bool next(int i, pg8::Unit& u) const { const int L = i * G + c; if (L >= ntu) return false; const int mt = L >> nNs, pn = L & ((1 << nNs) - 1);
        const int e = tile_e[mt]; u.pm = mt; u.pn = pn; u.pb = (e << nNs) + pn; u.aux = e * M + (mt - ts[e]) * 256; return true; }
    __device__ __forceinline__ unsigned arow(int ord, int r) const { return (unsigned)tokl[ord * 256 + r]; }
};
__device__ __forceinline__ GroupedOrder grouped_setup(const unsigned* cnt, const int* list, LAS unsigned char* lds, bool need_tok, int nNs, int G, int c, int tid, int lane, int wave) {
    LAS int* ts = (LAS int*)(lds + L_TS); LAS int* ne = (LAS int*)(lds + L_NE); LAS int* te = (LAS int*)(lds + L_TE); LAS int* tokl = (LAS int*)(lds + L_TOK);
    __syncthreads();
    if (wave == 0) {
        const unsigned n = lane < 32 ? __hip_atomic_load(cnt + lane * 64, RLX_AGENT) : 0u; const int tiles = (int)((n + 255u) >> 8); int incl = tiles;
#pragma unroll
        for (int o = 1; o < 32; o <<= 1) { const int t = __shfl_up(incl, o); if (lane >= o) incl += t; }
        const int excl = incl - tiles;
        if (lane < 32) { ts[lane] = excl; ne[lane] = (int)n; for (int k = 0; k < tiles; ++k) te[excl + k] = lane; }
        if (lane == 31) ts[32] = incl;
    }
    __syncthreads();
    GroupedOrder S; S.nNs = nNs; S.G = G; S.c = c; S.ntu = ts[32] << nNs; S.tile_e = te; S.tokl = tokl; S.ts = ts;
    if (need_tok) {
        for (int i = 0; i < MAXGU; ++i) { const int L = i * G + c; if (L >= S.ntu) break; const int mt = L >> nNs, e = te[mt];
            if (tid < 256) { const int slot = (mt - ts[e]) * 256 + tid; tokl[i * 256 + tid] = slot < ne[e] ? list[(size_t)e * M + slot] : 0; } }
        if (S.ntu > MAXGU * G) S.ntu = MAXGU * G;
        __syncthreads();
    }
    return S;
}

enum { I_X = 0, I_P, I_POS, I_NMIX, I_NFFN, I_CW1, I_CB1, I_CDW, I_CBDW, I_CLNG, I_CLNB, I_CW2, I_CB2, I_WQKV, I_LAM, I_SUBLN, I_WO,
       I_WRG, I_BRG, I_WRE, I_BRE, I_WG, I_WU, I_WDN, I_PNORM, I_PWG, I_PWP, I_FNORM, N_IN };
struct Args { const void* in[N_IN]; float* out; unsigned char* ws; int ph_lo, ph_hi; };

typedef const __attribute__((address_space(4))) Args* KArgP;
#define PH_IDS() const int tid = pg8::ltid(wave), lane = tid & 63, gtid = vcu * (NWAVES * 64) + tid; (void)lane; (void)gtid
__device__ __forceinline__ KArgP kargs() { KArgP k = (KArgP)__builtin_amdgcn_kernarg_segment_ptr(); asm volatile("" : "+s"(k)); return k; }
#define IN_F(k) ((const float*)ka->in[k])
#define WSP(off) ((bf16*)(ka->ws + (off)))
#define SLOT(i) ((bf16*)(ka->ws + WS_S0 + (size_t)(i) * WS_SS))
#define IN(k) (lo <= (k) && (k) < hi)
#ifndef MK_DUP
#define MK_DUP -1
#endif
#define DUPLOOP(k) _Pragma("nounroll") for (int rep_ = 0; rep_ < ((k) == MK_DUP ? 2 : 1); ++rep_)
#ifdef MK_PROBE
#define CW_TS 12288
#define SEAM(k) do { if (IN(k) && IN((k) + 1)) xcd_barrier(bar); if (blockIdx.x == 0 && threadIdx.x == 0) __hip_atomic_store((unsigned*)(kargs()->ws + WS_CTL) + CW_TS + (k) + 1, (unsigned)__builtin_amdgcn_s_memrealtime(), RLX_AGENT); } while (0)
#else
#define SEAM(k) do { if (IN(k) && IN((k) + 1)) xcd_barrier(bar); } while (0)
#endif
#define XBA ((bf16*)ka->out)
#define XBB ((bf16*)ka->out + (size_t)M * D)
#define SSQ(k) ((float*)(ka->ws + WS_SSQ) + (size_t)(k) * M * 16)
#define CNT(l) ((unsigned*)(ka->ws + WS_CTL) + CW_CNT + (l) * 32 * 64)
template <int l>
__device__ __forceinline__ void layer_tail(LAS unsigned char* lds, const XcdBarrier& bar, int lo, int hi, int wave, int G, int bx, int vcu, int gw, int NGW, int NTHR) {
    constexpr int pb = l ? 14 : 4;
    LAS float* scr = (LAS float*)(lds + RING_OFF + wave * 16384);
    if (IN(pb)) DUPLOOP(pb) { KArgP ka = kargs(); PH_IDS(); pg8::Gemm g{l ? XBB : XBA, WSP(WS_WR) + (size_t)l * 256 * D, M, 256, D}; pg8::StaticOrder S; S.init(M, 256, G, bx);
        pg8::EpiLogits E{(float*)(ka->ws + WS_LOG), SSQ(l ? 4 : 1)};
        pg8::gemm_phase<pg8::EpiLogits, pg8::StaticOrder, true, false>(lds + RING_OFF, g, S, E, wave); }
    SEAM(pb);
    if (IN(pb + 1)) { KArgP ka = kargs(); PH_IDS(); select_phase((const float*)(ka->ws + WS_LOG), IN_F(I_BRG) + l * 4, IN_F(I_BRE) + l * 32, SSQ(l ? 4 : 1), CNT(l),
                                   (int*)(ka->ws + WS_LIST), (float*)(ka->ws + WS_RP), (i32x4*)(ka->ws + WS_TI), (f32x2*)(ka->ws + WS_TW), (LAS int*)(lds + L_HIST), vcu, G, tid); }
    SEAM(pb + 1);
    if (IN(pb + 2)) DUPLOOP(pb + 2) { KArgP ka = kargs(); PH_IDS(); const GroupedOrder S = grouped_setup(CNT(l), (const int*)(ka->ws + WS_LIST), lds, true, 1, G, bx, tid, lane, wave);
        pg8::Gemm g{l ? XBB : XBA, WSP(WS_WGU), M, 512, D}; pg8::EpiGU E{SLOT(0), (const float*)(ka->ws + WS_RP)};
        pg8::gemm_phase<pg8::EpiGU, GroupedOrder, true, true>(lds + RING_OFF, g, S, E, wave); }
    SEAM(pb + 2);
    if (IN(pb + 3)) DUPLOOP(pb + 3) { KArgP ka = kargs(); PH_IDS(); const GroupedOrder S = grouped_setup(CNT(l), (const int*)(ka->ws + WS_LIST), lds, false, 2, G, bx, tid, lane, wave);
        pg8::Gemm g{SLOT(0), WSP(WS_WD), PADROWS, D, FE}; pg8::EpiBf16 E{SLOT(1), D};
        pg8::gemm_phase<pg8::EpiBf16, GroupedOrder, true, false>(lds + RING_OFF, g, S, E, wave); }
    SEAM(pb + 3);
    if (IN(pb + 4)) {
        { KArgP ka = kargs(); PH_IDS(); row_moe(l ? XBB : XBA, l ? SLOT(4) : XBA, SLOT(1), (const i32x4*)(ka->ws + WS_TI), (const f32x2*)(ka->ws + WS_TW), CNT(l), SSQ(l ? 5 : 2), gw, NGW, lane); }
        if (l == 0) { KArgP ka = kargs(); PH_IDS(); for (int it = gw; it < MOE_ITEMS; it += NGW) moe_item(IN_F(I_WG), IN_F(I_WU), IN_F(I_WDN), IN_F(I_NFFN) + D, 1, WSP(WS_WGU), WSP(WS_WD), it, scr, lane); }
    }
    SEAM(pb + 4);
    if (IN(pb + 5)) DUPLOOP(pb + 5) {
        { KArgP ka = kargs(); PH_IDS(); pg8::Gemm g{WSP(WS_P16) + (size_t)l * M * PLED, WSP(WS_WPP) + (size_t)l * D * PLED, M, D, PLED}; pg8::StaticOrder S; S.init(M, D, G, bx);
          pg8::EpiBf16 E{l ? SLOT(0) : SLOT(4), D};
          pg8::gemm_phase<pg8::EpiBf16, pg8::StaticOrder, true, false>(lds + RING_OFF, g, S, E, wave); }
        if (l == 0) { KArgP ka = kargs(); PH_IDS(); pg8::Gemm g{XBA, WSP(WS_WPG), M, D, D}; pg8::StaticOrder S; S.init(M, D, G, bx);
          pg8::EpiPle<false> E{XBA, SLOT(4), XBB, nullptr, SSQ(2), SSQ(3)};
          pg8::gemm_phase<pg8::EpiPle<false>, pg8::StaticOrder, true, false>(lds + RING_OFF, g, S, E, wave); }
        else { KArgP ka = kargs(); PH_IDS(); pg8::Gemm g{SLOT(4), WSP(WS_WPG) + (size_t)D * D, M, D, D}; pg8::StaticOrder S; S.init(M, D, G, bx);
          pg8::EpiPle<true> E{SLOT(4), SLOT(0), nullptr, ka->out, SSQ(5), SSQ(6)};
          pg8::gemm_phase<pg8::EpiPle<true>, pg8::StaticOrder, true, false>(lds + RING_OFF, g, S, E, wave); }
    }
    SEAM(pb + 5);
}
__global__ void __launch_bounds__(NWAVES * 64, 2) mk_fwd(Args args) {
    extern __shared__ __attribute__((aligned(16))) unsigned char lds_raw[];
    LAS unsigned char* lds = (LAS unsigned char*)lds_raw;
    const int tid0 = threadIdx.x, wave = __builtin_amdgcn_readfirstlane(tid0 >> 6);
    const int G = gridDim.x; const int bx = blockIdx.x; const int vcu = (G % 8 == 0) ? (bx % 8) * (G / 8) + bx / 8 : bx;
    const int gw = vcu * NWAVES + wave, NGW = G * NWAVES, NTHR = G * NWAVES * 64;
    gu32* ctl = (gu32*)(args.ws + WS_CTL);
    for (int u = tid0; u < (LDS_BYTES - LDSCTL_OFF) / 4; u += NWAVES * 64) ((LAS unsigned*)(lds + LDSCTL_OFF))[u] = 0u;
    __syncthreads();
    XcdBarrier bar = xcd_barrier_post((unsigned*)ctl + CW_BAR, (volatile LAS unsigned*)(lds + L_MISC) + 8);
    const int lo = args.ph_lo, hi = args.ph_hi;
#ifdef MK_PROBE
    if (blockIdx.x == 0 && threadIdx.x == 0) __hip_atomic_store((unsigned*)(args.ws + WS_CTL) + CW_TS, (unsigned)__builtin_amdgcn_s_memrealtime(), RLX_AGENT);
#endif
    LAS float* scr = (LAS float*)(lds + RING_OFF + wave * 16384);

    if (IN(0)) DUPLOOP(0) {
        constexpr int I1 = 16 * 64, I2 = 16 * 32, I3 = 16 * 96, I4 = 16 * 32, I5 = 16 * 32, I6 = 4 * 32;
        constexpr int NIT = I1 + I2 + I3 + I4 + 2 * I5 + 2 * I6;
        { KArgP ka = kargs(); PH_IDS();
          for (int it = gw; it < NIT + MOE_ITEMS; it += NGW) {
            int r = it;
            if (r < I1) { tr_plain<true>(IN_F(I_CW1), D, 2048, WSP(WS_WPW1), r, IN_F(I_NMIX), scr, lane); continue; } r -= I1;
            if (r < I2) { tr_plain(IN_F(I_CW2), D, D, WSP(WS_WPW2), r, nullptr, scr, lane); continue; } r -= I2;
            if (r < I3) { tr_plain(IN_F(I_WQKV), D, NQKV, WSP(WS_WQKV), r, IN_F(I_NMIX) + D, scr, lane); continue; } r -= I3;
            if (r < I4) { tr_plain(IN_F(I_WO), D, D, WSP(WS_WO), r, nullptr, scr, lane); continue; } r -= I4;
            if (r < 2 * I5) { const int l = r / I5; tr_plain(IN_F(I_PWG) + (size_t)l * D * D, D, D, WSP(WS_WPG) + (size_t)l * D * D, r % I5, IN_F(I_PNORM) + l * D, scr, lane); continue; } r -= 2 * I5;
            if (r < 2 * I6) { const int l = r / I6; tr_plain(IN_F(I_PWP) + (size_t)l * PLED * D, PLED, D, WSP(WS_WPP) + (size_t)l * D * PLED, r % I6, nullptr, scr, lane); continue; } r -= 2 * I6;
            moe_item(IN_F(I_WG), IN_F(I_WU), IN_F(I_WDN), IN_F(I_NFFN), 0, WSP(WS_WGU), WSP(WS_WD), r, scr, lane);
          } }
        { KArgP ka = kargs(); PH_IDS(); const float* wrg = IN_F(I_WRG); const float* wre = IN_F(I_WRE); const float* gf = IN_F(I_NFFN); bf16* Wr = WSP(WS_WR);
          for (int idx = gtid; idx < 2 * 256 * 1024; idx += NTHR) { const int l = idx >> 18, row = (idx >> 10) & 255, k = idx & 1023; float v = 0.f;
              if (row < 4) v = wrg[((size_t)l * D + k) * 4 + row]; else if (row < 36) { const int g = (row - 4) >> 3, e = (row - 4) & 7; v = wre[(((size_t)l * 4 + g) * D + k) * 8 + e]; }
              Wr[idx] = (bf16)f2bf(v * gf[l * D + k]); } }
        { KArgP ka = kargs(); PH_IDS(); const f32x4* p4 = (const f32x4*)ka->in[I_P]; u32x2* o = (u32x2*)WSP(WS_P16);
          for (int idx = gtid; idx < 2 * M * PLED / 4; idx += NTHR) { const f32x4 v = p4[idx]; o[idx] = (u32x2){pk2(v.x, v.y), pk2(v.z, v.w)}; } }
        { KArgP ka = kargs(); PH_IDS(); row_cvt(IN_F(I_X), XBA, SSQ(0), gw, NGW, lane); }
    }
    SEAM(0);
    if (IN(1)) DUPLOOP(1) { KArgP ka = kargs(); PH_IDS(); pg8::Gemm g{XBA, WSP(WS_WPW1), M, 2048, D}; pg8::StaticOrder S; S.init(M, 2048, G, bx);
        pg8::EpiGLU E{SLOT(0), IN_F(I_CB1), SSQ(0)};
        pg8::gemm_phase<pg8::EpiGLU, pg8::StaticOrder, true, false>(lds + RING_OFF, g, S, E, wave); }
    SEAM(1);
    if (IN(2)) DUPLOOP(2) { KArgP ka = kargs(); PH_IDS(); conv_phase(SLOT(0), SLOT(1), IN_F(I_CDW), IN_F(I_CBDW), IN_F(I_CLNG), IN_F(I_CLNB), lds + RING_OFF, vcu, G, tid, lane, wave); }
    SEAM(2);
    if (IN(3)) { KArgP ka = kargs(); PH_IDS(); pg8::Gemm g{SLOT(1), WSP(WS_WPW2), M, D, D}; pg8::StaticOrder S; S.init(M, D, G, bx);
        pg8::EpiRes E{XBA, IN_F(I_CB2), SSQ(1)};
        pg8::gemm_phase<pg8::EpiRes, pg8::StaticOrder, true, false>(lds + RING_OFF, g, S, E, wave); }
    SEAM(3);
    layer_tail<0>(lds, bar, lo, hi, wave, G, bx, vcu, gw, NGW, NTHR);
    if (IN(10)) DUPLOOP(10) { KArgP ka = kargs(); PH_IDS(); pg8::Gemm g{XBB, WSP(WS_WQKV), M, NQKV, D}; pg8::StaticOrder S; S.init(M, NQKV, G, bx);
        pg8::EpiQKV E{SLOT(0), (size_t)(WS_SS / 2), SSQ(3), (const int*)ka->in[I_POS], 1.0f};
        pg8::gemm_phase<pg8::EpiQKV, pg8::StaticOrder, true, false>(lds + RING_OFF, g, S, E, wave); }
    SEAM(10);
    if (IN(11)) DUPLOOP(11) { KArgP ka = kargs(); const attn2::Tensors AT{(const attn2::bf16*)SLOT(0), (const attn2::bf16*)SLOT(1), (const attn2::bf16*)SLOT(2), (attn2::bf16*)SLOT(3), (attn2::bf16*)SLOT(4)};
        attn2::attn_phase((char*)lds_raw + RING_OFF, AT, vcu, G, wave); }
    SEAM(11);
    if (IN(12)) DUPLOOP(12) { KArgP ka = kargs(); PH_IDS(); combine_phase(SLOT(3), SLOT(4), SLOT(0), IN_F(I_LAM), IN_F(I_SUBLN), gw, NGW, lane); }
    SEAM(12);
    if (IN(13)) { KArgP ka = kargs(); PH_IDS(); pg8::Gemm g{SLOT(0), WSP(WS_WO), M, D, D}; pg8::StaticOrder S; S.init(M, D, G, bx);
        pg8::EpiRes E{XBB, nullptr, SSQ(4)};
        pg8::gemm_phase<pg8::EpiRes, pg8::StaticOrder, true, false>(lds + RING_OFF, g, S, E, wave); }
    SEAM(13);
    layer_tail<1>(lds, bar, lo, hi, wave, G, bx, vcu, gw, NGW, NTHR);
    if (IN(20)) { KArgP ka = kargs(); PH_IDS(); row_final(ka->out, SSQ(6), IN_F(I_FNORM), gw, NGW, lane);
#ifdef MK_PROBE
        { __syncthreads(); const unsigned* ts = (const unsigned*)(ka->ws + WS_CTL) + CW_TS;
          const float us1 = (float)(__hip_atomic_load(ts + MK_PROBE_B1, RLX_AGENT) - __hip_atomic_load(ts + MK_PROBE_A1, RLX_AGENT)) * 0.01f, us2 = (float)(__hip_atomic_load(ts + MK_PROBE_B2, RLX_AGENT) - __hip_atomic_load(ts + MK_PROBE_A2, RLX_AGENT)) * 0.01f;
          const float sc = 1.f + us1 / (float)(MK_PROBE_S1);
          VM_WAIT(); __syncthreads();
          for (int m = gw; m < M; m += NGW) { GAS f32x4* xr = (GAS f32x4*)(ka->out + (size_t)m * D) + lane;
              for (int j = 0; j < 4; ++j) { f32x4 v = xr[64 * j]; v = v * sc; if (m == 0 && j == 0 && lane == 0) v.x = us2 * (float)(MK_PROBE_S2); xr[64 * j] = v; } } }
#endif
    }
#undef IN
#undef SEAM
}

extern "C" void kernel_launch(void* const* d_in, const int* in_sizes, int n_in, void* d_out, int out_size, void* d_ws, size_t ws_size, hipStream_t stream) {
    static int grid = 0;
    if (grid == 0) {
        if (n_in != N_IN || in_sizes[0] != M * D || out_size != M * D || ws_size < WS_END) { fprintf(stderr, "kernel_launch: unexpected problem: n_in %d in0 %d out %d ws %zu (need %zu); nothing launched\n", n_in, n_in > 0 ? in_sizes[0] : -1, out_size, ws_size, (size_t)WS_END); grid = -1; return; }
        int dev = 0, cus = 0, per_cu = 0;
        if (hipGetDevice(&dev) != hipSuccess || hipDeviceGetAttribute(&cus, hipDeviceAttributeMultiprocessorCount, dev) != hipSuccess) { grid = -1; return; }
        if (hipFuncSetAttribute((const void*)mk_fwd, hipFuncAttributeMaxDynamicSharedMemorySize, LDS_BYTES) != hipSuccess) { fprintf(stderr, "kernel_launch: hipFuncSetAttribute failed\n"); grid = -1; return; }
        if (hipOccupancyMaxActiveBlocksPerMultiprocessor(&per_cu, (const void*)mk_fwd, NWAVES * 64, LDS_BYTES) != hipSuccess || per_cu < 1) { fprintf(stderr, "kernel_launch: occupancy query says %d\n", per_cu); }
        (void)hipGetLastError();
        grid = cus;
        if (grid > 256) grid = 256;
    }
    if (grid < 0) return;
    if (hipMemsetAsync((char*)d_ws + WS_CTL, 0, CTL_ZERO_BYTES, stream) != hipSuccess) return;
    Args a{};
    for (int i = 0; i < N_IN; ++i) a.in[i] = d_in[i];
    a.out = (float*)d_out; a.ws = (unsigned char*)d_ws;
#if MK_SPLIT
    for (int ph = 0; ph < NPHASE; ++ph) { a.ph_lo = ph; a.ph_hi = ph + 1; hipLaunchKernelGGL(mk_fwd, dim3(grid), dim3(NWAVES * 64), LDS_BYTES, stream, a); }
#else
    a.ph_lo = 0; a.ph_hi = NPHASE; hipLaunchKernelGGL(mk_fwd, dim3(grid), dim3(NWAVES * 64), LDS_BYTES, stream, a);
#endif
}
```

```cpp
#include <hip/hip_runtime.h>
#include <hip/hip_bf16.h>
#include <cstdio>
#include <cstdint>
#include <cmath>

#ifndef MK_SPLIT
#define MK_SPLIT 0
#endif

namespace pg8 {
#define PG8_LAS __attribute__((address_space(3)))
typedef unsigned short bf16_t;
typedef short bf16x8 __attribute__((ext_vector_type(8)));
typedef float f32x4 __attribute__((ext_vector_type(4)));
typedef unsigned u32x4 __attribute__((ext_vector_type(4)));
constexpr int BM = 256, BK = 64, HALF = 128, HTB = HALF * BK * 2  , STAGE_BYTES = 8 * HTB, NXCD = 8, WGM = 8;

__host__ __device__ __forceinline__ int lds_byte(int r, int c) { const int st = (r >> 4) * 2 + (c >> 5), rr = r & 15, cc = c & 31, ob = rr * 64 + cc * 2; return st * 1024 + (ob ^ (((ob >> 9) & 1) << 5)); }
__host__ __device__ __forceinline__ void stage_rc(int b, int& R, int& C) { const int st = b / 1024, sb = b % 1024, swz = sb ^ (((sb >> 9) & 1) << 5); R = (st >> 1) * 16 + swz / 64; C = (st & 1) * 32 + (swz % 64) / 2; }
__host__ __device__ __forceinline__ int perm32(int rho) { const int n = rho >> 4, i = rho & 15; return 8 * (i >> 2) + 4 * n + (i & 3); }

__device__ __forceinline__ int ltid(int wave) { int t; asm volatile("v_mbcnt_lo_u32_b32 %0, -1, 0\n\tv_mbcnt_hi_u32_b32 %0, -1, %0" : "=&v"(t)); return wave * 64 + t; }
struct Unit { int pm, pn, pb, aux; };
struct Gemm { const bf16_t* A; const bf16_t* Bt; int M, N, K; };

struct StaticOrder {
    int nM, nN, nwg, G, c;
    __host__ __device__ void init(int M, int N, int G_, int c_) { nM = M / BM; nN = N / BM; nwg = nM * nN; G = G_; c = c_; }
    __host__ __device__ bool next(int i, Unit& u) const {
        const long L = (long)i * G + c; if (L >= nwg) return false;
        int wgid = (int)L; { const int q = nwg / NXCD, r = nwg % NXCD, xcd = wgid % NXCD, off = wgid / NXCD; wgid = (xcd < r ? xcd * (q + 1) : r * (q + 1) + (xcd - r) * q) + off; }
        const int nig = WGM * nN, gid = wgid / nig, fm = gid * WGM, gsz = (nM - fm) < WGM ? (nM - fm) : WGM;
        u.pm = fm + ((wgid % nig) % gsz); u.pn = (wgid % nig) / gsz; u.pb = u.pn; u.aux = 0; return true;
    }
    __device__ __forceinline__ unsigned arow(int, int) const { return 0u; }
};

__device__ __forceinline__ unsigned cvt_pk_bf16(float lo, float hi) { unsigned r; asm volatile("v_cvt_pk_bf16_f32 %0, %1, %2" : "=v"(r) : "v"(lo), "v"(hi)); return r; }

typedef float f32x2e __attribute__((ext_vector_type(2)));
__device__ __forceinline__ float bf_lo(unsigned u) { return __builtin_bit_cast(float, u << 16); }
__device__ __forceinline__ float bf_hi(unsigned u) { return __builtin_bit_cast(float, u & 0xffff0000u); }
__device__ __forceinline__ float sigm_f(float x) { return __builtin_amdgcn_rcpf(1.f + __expf(-x)); }
__device__ __forceinline__ float silu_f(float x) { return x * sigm_f(x); }
__device__ __forceinline__ float ss_sum(const float* ssp, int row) { const f32x4* p = (const f32x4*)(ssp + (size_t)row * 16); const f32x4 a = p[0], b = p[1], c = p[2], d = p[3];
    return (((a[0] + a[1]) + (a[2] + a[3])) + ((b[0] + b[1]) + (b[2] + b[3]))) + (((c[0] + c[1]) + (c[2] + c[3])) + ((d[0] + d[1]) + (d[2] + d[3]))); }
__device__ __forceinline__ float rs_of(const float* ssp, int row) { return 1.f / sqrtf(ss_sum(ssp, row) * (1.f / 1024.f) + 1e-6f); }
__device__ __forceinline__ u32x4 pack8(const f32x4& v0, const f32x4& v1) { u32x4 w; w.x = cvt_pk_bf16(v0[0], v0[1]); w.y = cvt_pk_bf16(v0[2], v0[3]); w.z = cvt_pk_bf16(v1[0], v1[1]); w.w = cvt_pk_bf16(v1[2], v1[3]); return w; }
__device__ __forceinline__ void unpack8(const u32x4& w, f32x4& v0, f32x4& v1) { v0 = (f32x4){bf_lo(w.x), bf_hi(w.x), bf_lo(w.y), bf_hi(w.y)}; v1 = (f32x4){bf_lo(w.z), bf_hi(w.z), bf_lo(w.w), bf_hi(w.w)}; }
__device__ __forceinline__ float sumsq8(const f32x4& a, const f32x4& b) { return (a[0] * a[0] + a[1] * a[1]) + (a[2] * a[2] + a[3] * a[3]) + (b[0] * b[0] + b[1] * b[1]) + (b[2] * b[2] + b[3] * b[3]); }
__device__ __forceinline__ void ss_put(float* ssp, int row, int slot, float part, int fq) { part += __shfl_xor(part, 16); part += __shfl_xor(part, 32); if (fq == 0) ssp[(size_t)row * 16 + slot] = part; }

struct EpiBf16 {
    static constexpr bool PERM = true;
    bf16_t* O; int ldc;
    __device__ __forceinline__ void operator()(const f32x4 (&acc)[2][2][4][2], const Unit& u, int wr, int wc, int fr, int fq) const {
        const int row0 = u.pm * BM + wr * 64 + fr, col0 = u.pn * BM + wc * 32 + 8 * fq;
#pragma unroll
        for (int ai = 0; ai < 2; ++ai)
#pragma unroll
            for (int m = 0; m < 4; ++m) { bf16_t* rowp = O + (size_t)(row0 + ai * HALF + m * 16) * ldc + col0;
#pragma unroll
                for (int bj = 0; bj < 2; ++bj) *(u32x4*)(rowp + bj * HALF) = pack8(acc[ai][bj][m][0], acc[ai][bj][m][1]); }
    }
};
struct EpiGLU {
    static constexpr bool PERM = true;
    bf16_t* O; const float* bias; const float* ss;
    __device__ __forceinline__ void operator()(const f32x4 (&acc)[2][2][4][2], const Unit& u, int wr, int wc, int fr, int fq) const {
        const int row0 = u.pm * BM + wr * 64 + fr, c0 = u.pn * HALF + wc * 32 + 8 * fq;
        const f32x4 ba0 = *(const f32x4*)(bias + c0), ba1 = *(const f32x4*)(bias + c0 + 4), bg0 = *(const f32x4*)(bias + 1024 + c0), bg1 = *(const f32x4*)(bias + 1024 + c0 + 4);
#pragma unroll
        for (int ai = 0; ai < 2; ++ai)
#pragma unroll
            for (int m = 0; m < 4; ++m) { const int row = row0 + ai * HALF + m * 16; const float r = rs_of(ss, row);
                const f32x4 a0 = acc[ai][0][m][0] * r + ba0, a1 = acc[ai][0][m][1] * r + ba1, g0 = acc[ai][1][m][0] * r + bg0, g1 = acc[ai][1][m][1] * r + bg1;
                const f32x4 v0 = {a0[0] * sigm_f(g0[0]), a0[1] * sigm_f(g0[1]), a0[2] * sigm_f(g0[2]), a0[3] * sigm_f(g0[3])}, v1 = {a1[0] * sigm_f(g1[0]), a1[1] * sigm_f(g1[1]), a1[2] * sigm_f(g1[2]), a1[3] * sigm_f(g1[3])};
                *(u32x4*)(O + (size_t)row * 1024 + c0) = pack8(v0, v1); }
    }
};
struct EpiRes {
    static constexpr bool PERM = true;
    bf16_t* X; const float* bias; float* ss;
    __device__ __forceinline__ void operator()(const f32x4 (&acc)[2][2][4][2], const Unit& u, int wr, int wc, int fr, int fq) const {
        const int row0 = u.pm * BM + wr * 64 + fr, col0 = u.pn * BM + wc * 32 + 8 * fq;
        f32x4 bv[2][2];
#pragma unroll
        for (int bj = 0; bj < 2; ++bj)
#pragma unroll
            for (int n = 0; n < 2; ++n) bv[bj][n] = bias ? *(const f32x4*)(bias + col0 + bj * HALF + 4 * n) : (f32x4){0.f, 0.f, 0.f, 0.f};
#pragma unroll
        for (int ai = 0; ai < 2; ++ai)
#pragma unroll
            for (int m = 0; m < 4; ++m) { const int row = row0 + ai * HALF + m * 16; bf16_t* rowp = X + (size_t)row * 1024 + col0; float part = 0.f;
#pragma unroll
                for (int bj = 0; bj < 2; ++bj) { f32x4 x0, x1; unpack8(*(const u32x4*)(rowp + bj * HALF), x0, x1);
                    const f32x4 v0 = acc[ai][bj][m][0] + bv[bj][0] + x0, v1 = acc[ai][bj][m][1] + bv[bj][1] + x1; part += sumsq8(v0, v1);
                    *(u32x4*)(rowp + bj * HALF) = pack8(v0, v1); }
                ss_put(ss, row, u.pn * 4 + wc, part, fq); }
    }
};
template <bool F32OUT> struct EpiPle {
    static constexpr bool PERM = true;
    const bf16_t* Xin; const bf16_t* P; bf16_t* Xo; float* Fo; const float* ssin; float* ssout;
    __device__ __forceinline__ void operator()(const f32x4 (&acc)[2][2][4][2], const Unit& u, int wr, int wc, int fr, int fq) const {
        const int row0 = u.pm * BM + wr * 64 + fr, col0 = u.pn * BM + wc * 32 + 8 * fq;
#pragma unroll
        for (int ai = 0; ai < 2; ++ai)
#pragma unroll
            for (int m = 0; m < 4; ++m) { const int row = row0 + ai * HALF + m * 16; const size_t off = (size_t)row * 1024 + col0; const float r = rs_of(ssin, row); float part = 0.f;
#pragma unroll
                for (int bj = 0; bj < 2; ++bj) { f32x4 x0, x1, p0, p1; unpack8(*(const u32x4*)(Xin + off + bj * HALF), x0, x1); unpack8(*(const u32x4*)(P + off + bj * HALF), p0, p1);
                    const f32x4 a0 = acc[ai][bj][m][0] * r, a1 = acc[ai][bj][m][1] * r;
                    const f32x4 v0 = {x0[0] + sigm_f(a0[0]) * p0[0], x0[1] + sigm_f(a0[1]) * p0[1], x0[2] + sigm_f(a0[2]) * p0[2], x0[3] + sigm_f(a0[3]) * p0[3]};
                    const f32x4 v1 = {x1[0] + sigm_f(a1[0]) * p1[0], x1[1] + sigm_f(a1[1]) * p1[1], x1[2] + sigm_f(a1[2]) * p1[2], x1[3] + sigm_f(a1[3]) * p1[3]};
                    part += sumsq8(v0, v1);
                    if (F32OUT) { *(f32x4*)(Fo + off + bj * HALF) = v0; *(f32x4*)(Fo + off + bj * HALF + 4) = v1; } else *(u32x4*)(Xo + off + bj * HALF) = pack8(v0, v1); }
                ss_put(ssout, row, u.pn * 4 + wc, part, fq); }
    }
};
struct EpiLogits {
    static constexpr bool PERM = false;
    float* O; const float* ss;
    __device__ __forceinline__ void operator()(const f32x4 (&acc)[2][2][4][2], const Unit& u, int wr, int wc, int fr, int fq) const {
        if (wc < 2) {
            const int row0 = u.pm * BM + wr * 64 + fr;
#pragma unroll
            for (int ai = 0; ai < 2; ++ai)
#pragma unroll
                for (int m = 0; m < 4; ++m) { const int row = row0 + ai * HALF + m * 16; const float r = rs_of(ss, row);
#pragma unroll
                    for (int n = 0; n < 2; ++n) *(f32x4*)(O + (size_t)row * 64 + wc * 32 + n * 16 + 4 * fq) = acc[ai][0][m][n] * r; }
        }
    }
};
struct EpiGU {
    static constexpr bool PERM = true;
    bf16_t* O; const float* rp;
    __device__ __forceinline__ void operator()(const f32x4 (&acc)[2][2][4][2], const Unit& u, int wr, int wc, int fr, int fq) const {
        const int trow0 = wr * 64 + fr, col0 = u.pn * HALF + wc * 32 + 8 * fq;
#pragma unroll
        for (int ai = 0; ai < 2; ++ai)
#pragma unroll
            for (int m = 0; m < 4; ++m) { const int trow = trow0 + ai * HALF + m * 16; const float r = rp[(size_t)u.aux + trow];
                const f32x4 g0 = acc[ai][0][m][0] * r, g1 = acc[ai][0][m][1] * r, u0 = acc[ai][1][m][0] * r, u1 = acc[ai][1][m][1] * r;
                const f32x4 v0 = {silu_f(g0[0]) * u0[0], silu_f(g0[1]) * u0[1], silu_f(g0[2]) * u0[2], silu_f(g0[3]) * u0[3]}, v1 = {silu_f(g1[0]) * u1[0], silu_f(g1[1]) * u1[1], silu_f(g1[2]) * u1[2], silu_f(g1[3]) * u1[3]};
                *(u32x4*)(O + (size_t)(u.pm * BM + trow) * 256 + col0) = pack8(v0, v1); }
    }
};
struct EpiQKV {
    static constexpr bool PERM = true;
    bf16_t* O; size_t stride; const float* ss; const int* pos; float scaleq;
    __device__ __forceinline__ void operator()(const f32x4 (&acc)[2][2][4][2], const Unit& u, int wr, int wc, int fr, int fq) const {
        const int t = (u.pn * BM) >> 10, colt = (u.pn * BM) & 1023, row0 = u.pm * BM + wr * 64 + fr, col0 = colt + wc * 32 + 8 * fq;
        bf16_t* base = O + (size_t)t * stride; const float sc = (t == 0) ? scaleq : 1.f; const bool roped = (t < 2) && ((wc & 1) == 0);
#pragma unroll
        for (int ai = 0; ai < 2; ++ai)
#pragma unroll
            for (int m = 0; m < 4; ++m) { const int row = row0 + ai * HALF + m * 16; const float r = rs_of(ss, row) * sc;
                float cs[8], sn[8];
                if (roped) { const float fp = (float)pos[row];
#pragma unroll
                    for (int i = 0; i < 8; ++i) { const float invf = __builtin_powf(500000.0f, -(float)i / 8.0f); const float ang = fp * invf, rev = ang * 0.15915494309189535f, fr_ = rev - __builtin_floorf(rev);
                        sn[i] = __builtin_amdgcn_sinf(fr_); cs[i] = __builtin_amdgcn_cosf(fr_); if (fq == 0) sn[i] = -sn[i]; } }
#pragma unroll
                for (int bj = 0; bj < 2; ++bj) { f32x4 v0 = acc[ai][bj][m][0] * r, v1 = acc[ai][bj][m][1] * r;
                    if (roped) { float pv[8];
#pragma unroll
                        for (int i = 0; i < 4; ++i) { pv[i] = __shfl_xor(v0[i], 16); pv[4 + i] = __shfl_xor(v1[i], 16); }
                        if (fq < 2) {
#pragma unroll
                            for (int i = 0; i < 4; ++i) { v0[i] = v0[i] * cs[i] + pv[i] * sn[i]; v1[i] = v1[i] * cs[4 + i] + pv[4 + i] * sn[4 + i]; } } }
                    *(u32x4*)(base + (size_t)row * 1024 + col0 + bj * HALF) = pack8(v0, v1); } }
    }
};

template <class Epi, class Sched, bool ALIGN_EPI, bool GATHER>
__device__ __forceinline__ void gemm_phase(PG8_LAS unsigned char* lds, const Gemm g, const Sched& S, const Epi& E, int wave_) {
    const int tid = ltid(wave_), wid = wave_, lane = tid & 63, wr = wid >> 2, wc = wid & 3, fr = lane & 15, fq = lane >> 4;
    const int K = g.K, nt = K / BK;
    unsigned voffA[2], voffB[2]; int sR[2], sC[2];
#pragma unroll
    for (int i = 0; i < 2; ++i) { int R, C; stage_rc(tid * 16 + i * 8192, R, C); const int Rb = Epi::PERM ? ((R & ~31) + perm32(R & 31)) : R;
        sR[i] = R; sC[i] = C; voffA[i] = (unsigned)(R * K + C) * 2u; voffB[i] = (unsigned)(Rb * K + C) * 2u; }
    const size_t kstep = (size_t)(BK * 2);
    const size_t hstep = (size_t)HALF * K * 2;
    const size_t tstep = 2 * hstep;
    const unsigned ldsw = (unsigned)wid * 1024u;
    const int aoff = lds_byte(wr * 64 + fr, fq * 8), boff = lds_byte(wc * 32 + fr, fq * 8);
#define PG8_SA(b, h) (((b) * 2 + (h)) * HTB)
#define PG8_SB(b, h) ((4 + (b) * 2 + (h)) * HTB)
#define PG8_STAGE(bufoff, gbase, voff) do { _Pragma("unroll") for (int _i = 0; _i < 2; ++_i) \
        __builtin_amdgcn_global_load_lds((const unsigned*)((const char*)(gbase) + (voff)[_i]), (PG8_LAS unsigned*)(lds + (bufoff) + ldsw + _i * 8192), 16, 0, 0); } while (0)
#define PG8_STAGE_A(bufoff, base, kb, h, vv) do { _Pragma("unroll") for (int _i = 0; _i < 2; ++_i) { \
        const char* _p = GATHER ? ((const char*)g.A + (kb) + (vv)[h][_i]) : ((const char*)(base) + (kb) + (size_t)(h) * hstep + voffA[_i]); \
        __builtin_amdgcn_global_load_lds((const unsigned*)_p, (PG8_LAS unsigned*)(lds + (bufoff) + ldsw + _i * 8192), 16, 0, 0); } } while (0)
#define PG8_GOFF(vv, ord) do { _Pragma("unroll") for (int _h = 0; _h < 2; ++_h) _Pragma("unroll") for (int _i = 0; _i < 2; ++_i) \
        (vv)[_h][_i] = S.arow((ord), _h * HALF + sR[_i]) * (unsigned)(K * 2) + (unsigned)(sC[_i] * 2); } while (0)
#define PG8_LDA(dst, b, h) do { _Pragma("unroll") for (int m = 0; m < 4; ++m) _Pragma("unroll") for (int k = 0; k < 2; ++k) dst[m][k] = *(const PG8_LAS bf16x8*)(lds + PG8_SA(b, h) + aoff + m * 2048 + k * 1024); } while (0)
#define PG8_LDB(dst, b, h) do { _Pragma("unroll") for (int n = 0; n < 2; ++n) _Pragma("unroll") for (int k = 0; k < 2; ++k) dst[n][k] = *(const PG8_LAS bf16x8*)(lds + PG8_SB(b, h) + boff + n * 2048 + k * 1024); } while (0)
#define PG8_MMA(ai, bj, At, Bt) do { __builtin_amdgcn_s_setprio(1); _Pragma("unroll") for (int m = 0; m < 4; ++m) _Pragma("unroll") for (int n = 0; n < 2; ++n) _Pragma("unroll") for (int k = 0; k < 2; ++k) \
        acc[ai][bj][m][n] = __builtin_amdgcn_mfma_f32_16x16x32_bf16(Bt[n][k], At[m][k], acc[ai][bj][m][n], 0, 0, 0); __builtin_amdgcn_s_setprio(0); } while (0)
#define PG8_WAIT_V(n) asm volatile("s_waitcnt vmcnt(" #n ")" ::: "memory")
#define PG8_WAIT_L(n) asm volatile("s_waitcnt lgkmcnt(" #n ")" ::: "memory")
#define PG8_BAR __builtin_amdgcn_s_barrier()
#define PG8_SCHED __builtin_amdgcn_sched_barrier(0)
    Unit cur, nxt; int ui = 0;
    if (!S.next(0, cur)) return;
    f32x4 acc[2][2][4][2];
#pragma unroll
    for (int a = 0; a < 2; ++a)
#pragma unroll
        for (int b = 0; b < 2; ++b)
#pragma unroll
            for (int m = 0; m < 4; ++m)
#pragma unroll
                for (int n = 0; n < 2; ++n) acc[a][b][m][n] = (f32x4){0.f, 0.f, 0.f, 0.f};
    bf16x8 At[4][2], B0[2][2], B1[2][2];
    unsigned vA[2][2] = {{0u, 0u}, {0u, 0u}}, vN[2][2] = {{0u, 0u}, {0u, 0u}}, vS[2][2] = {{0u, 0u}, {0u, 0u}};
    if constexpr (GATHER) { PG8_GOFF(vA, 0); }
    const char* cA = GATHER ? (const char*)g.A : (const char*)g.A + (size_t)cur.pm * tstep; const char* cB = (const char*)g.Bt + (size_t)cur.pb * tstep;
    PG8_STAGE(PG8_SB(0, 0), cB, voffB); PG8_STAGE(PG8_SB(0, 1), cB + hstep, voffB); PG8_STAGE_A(PG8_SA(0, 0), cA, 0, 0, vA); PG8_STAGE_A(PG8_SA(0, 1), cA, 0, 1, vA);
    if (wr == 1) PG8_BAR;
    PG8_WAIT_V(2); PG8_BAR;
    PG8_STAGE(PG8_SB(1, 0), cB + kstep, voffB); PG8_STAGE_A(PG8_SA(1, 0), cA, kstep, 0, vA); PG8_STAGE(PG8_SB(1, 1), cB + hstep + kstep, voffB);
    PG8_WAIT_V(6); PG8_BAR;
    for (;;) {
        const bool has_next = S.next(ui + 1, nxt);
        if constexpr (GATHER) { if (has_next) { PG8_GOFF(vN, ui + 1); } else { _Pragma("unroll") for (int _h = 0; _h < 2; ++_h) _Pragma("unroll") for (int _i = 0; _i < 2; ++_i) vN[_h][_i] = vA[_h][_i]; } }
        const char* nA = (has_next && !GATHER) ? (const char*)g.A + (size_t)nxt.pm * tstep : cA; const char* nB = has_next ? (const char*)g.Bt + (size_t)nxt.pb * tstep : cB;
        for (int t = 0; t < nt; t += 2) {
            const bool last = (t == nt - 2);
            const size_t kb1 = (size_t)(t + 1) * kstep, kb2 = last ? (size_t)0 : (size_t)(t + 2) * kstep, kb3 = kb2 + kstep;
            const char* sA = last ? nA : cA; const char* b2 = last ? nB : cB + (size_t)(t + 2) * kstep; const char* b3 = b2 + kstep;
            if constexpr (GATHER) { _Pragma("unroll") for (int _h = 0; _h < 2; ++_h) _Pragma("unroll") for (int _i = 0; _i < 2; ++_i) vS[_h][_i] = last ? vN[_h][_i] : vA[_h][_i]; }
            PG8_LDB(B0, 0, 0); PG8_LDB(B1, 0, 1); PG8_SCHED; PG8_LDA(At, 0, 0); PG8_STAGE_A(PG8_SA(1, 1), cA, kb1, 1, vA);
            PG8_WAIT_V(8); PG8_WAIT_L(0); PG8_BAR; PG8_MMA(0, 0, At, B0); PG8_MMA(0, 1, At, B1); PG8_BAR; PG8_SCHED;
            PG8_LDA(At, 0, 1); PG8_STAGE(PG8_SB(0, 0), b2, voffB); PG8_STAGE(PG8_SB(0, 1), b2 + hstep, voffB); PG8_STAGE_A(PG8_SA(0, 0), sA, kb2, 0, vS);
            PG8_WAIT_V(8); PG8_WAIT_L(0); PG8_BAR; PG8_MMA(1, 0, At, B0); PG8_MMA(1, 1, At, B1); PG8_BAR; PG8_SCHED;
            PG8_LDB(B0, 1, 0); PG8_LDB(B1, 1, 1); PG8_SCHED; PG8_LDA(At, 1, 0); PG8_STAGE_A(PG8_SA(0, 1), sA, kb2, 1, vS);
            PG8_WAIT_V(8); PG8_WAIT_L(0); PG8_BAR; PG8_MMA(0, 0, At, B0); PG8_MMA(0, 1, At, B1); PG8_BAR; PG8_SCHED;
            PG8_LDA(At, 1, 1); PG8_STAGE(PG8_SB(1, 0), b3, voffB); PG8_STAGE(PG8_SB(1, 1), b3 + hstep, voffB); PG8_STAGE_A(PG8_SA(1, 0), sA, kb3, 0, vS);
            PG8_WAIT_V(8); PG8_WAIT_L(0); PG8_BAR; PG8_MMA(1, 0, At, B0); PG8_MMA(1, 1, At, B1); PG8_BAR; PG8_SCHED;
        }
        if constexpr (ALIGN_EPI) { if (wr == 0) PG8_BAR; }
        E(acc, cur, wr, wc, fr, fq);
        if (!has_next) break;
#pragma unroll
        for (int a = 0; a < 2; ++a)
#pragma unroll
            for (int b = 0; b < 2; ++b)
#pragma unroll
                for (int m = 0; m < 4; ++m)
#pragma unroll
                    for (int n = 0; n < 2; ++n) acc[a][b][m][n] = (f32x4){0.f, 0.f, 0.f, 0.f};
        cur = nxt; cA = nA; cB = nB; ++ui;
        if constexpr (GATHER) { _Pragma("unroll") for (int _h = 0; _h < 2; ++_h) _Pragma("unroll") for (int _i = 0; _i < 2; ++_i) vA[_h][_i] = vN[_h][_i]; }
        if constexpr (ALIGN_EPI) { if (wr == 1) PG8_BAR; }
    }
    PG8_WAIT_V(0);
    if constexpr (!ALIGN_EPI) { if (wr == 0) PG8_BAR; }
    PG8_BAR;
#undef PG8_SA
#undef PG8_SB
#undef PG8_STAGE
#undef PG8_STAGE_A
#undef PG8_GOFF
#undef PG8_LDA
#undef PG8_LDB
#undef PG8_MMA
#undef PG8_WAIT_V
#undef PG8_WAIT_L
#undef PG8_BAR
#undef PG8_SCHED
}
}

namespace attn2 {
constexpr int DK = 64, D = 128, PITCH = 1024, SKVC = 4096;
constexpr float SCALE = 0.125f;
constexpr float THR = 8.f;
constexpr bool WSKIP = false;
constexpr int NW = 8, QBLK = 32, KVBLK = 64, QB = NW * QBLK;
constexpr int SHM_V = KVBLK * D * 2, SHM_K = KVBLK * DK * 2;
constexpr int LDS_BYTES = 2 * SHM_V + 2 * SHM_K + NW * 64 * 4;
using bf16 = __hip_bfloat16;
typedef short bf16x8 __attribute__((ext_vector_type(8)));
typedef short s16x4 __attribute__((ext_vector_type(4)));
typedef float f32x16 __attribute__((ext_vector_type(16)));
typedef float f32x4 __attribute__((ext_vector_type(4)));
typedef unsigned u32x4 __attribute__((ext_vector_type(4)));
template <class A, class Bt> struct same_t { static constexpr bool v = false; };
template <class A> struct same_t<A, A> { static constexpr bool v = true; };

#define KSWZ(row, colB) ((row) * 128 + ((colB) ^ (((row) & 7) << 4)))
#define SBAR() __builtin_amdgcn_sched_barrier(0)
__device__ __forceinline__ int v_st(int k, int c) { const int kk = (k & ~0xC) | ((k & 4) << 1) | ((k & 8) >> 1); return ((kk >> 3) * 4 + (c >> 5)) * 512 + ((kk & 7) * 32 + (c & 31)) * 2; }
__device__ __forceinline__ int v_rd_base(int lane) { return ((lane & 3) << 3) | (((lane >> 2) & 3) << 6) | (((lane >> 4) & 1) << 5) | (((lane >> 5) & 1) << 8); }
constexpr int v_rd_off(int d0, int ks, int half) { return d0 * 512 + ks * 4096 + half * 2048; }
__device__ __forceinline__ int crow(int r, int hi) { return (r & 3) + 8 * (r >> 2) + 4 * hi; }
__device__ __forceinline__ unsigned cvtpk(float lo, float hi) {
    unsigned r; asm volatile("v_cvt_pk_bf16_f32 %0, %1, %2" : "=v"(r) : "v"(lo), "v"(hi)); return r;
}
__device__ __forceinline__ bf16x8 pack8(f32x4 a, f32x4 b) {
    u32x4 w = {cvtpk(a[0], a[1]), cvtpk(a[2], a[3]), cvtpk(b[0], b[1]), cvtpk(b[2], b[3])};
    return *reinterpret_cast<bf16x8*>(&w);
}
template <class T> __device__ __forceinline__ bf16x8 load8(const T* p) {
    if constexpr (same_t<T, float>::v) { return pack8(*(const f32x4*)p, *(const f32x4*)(p + 4)); }
    else { return *reinterpret_cast<const bf16x8*>(p); }
}
__device__ __forceinline__ void mask_tile(f32x16& p0, f32x16& p1, int dq, unsigned W) {
    const float NEG = -__builtin_inff();
#pragma unroll
    for (int r = 0; r < 16; ++r) {
        const int c = (r & 3) + 8 * (r >> 2);
        if ((unsigned)(dq - c) >= W) p0[r] = NEG;
        if ((unsigned)(dq - c - 32) >= W) p1[r] = NEG;
    }
}
__device__ __forceinline__ void partialSM(f32x16& p0, f32x16& p1, float& m_reg, float& mn, float& alpha) {
    float pmax = p0[0]; for (int r = 1; r < 16; ++r) pmax = fmaxf(pmax, p0[r]); for (int r = 0; r < 16; ++r) pmax = fmaxf(pmax, p1[r]);
    { auto rr = __builtin_amdgcn_permlane32_swap(__float_as_uint(pmax), __float_as_uint(pmax), false, false);
      pmax = fmaxf(__uint_as_float(rr[0]), __uint_as_float(rr[1])); }
    constexpr float C2 = 1.4426950408889634f * SCALE;
    if (__builtin_expect(__all((pmax - m_reg) * SCALE <= THR), 1)) { mn = m_reg; alpha = 1.f; }
    else { mn = fmaxf(m_reg, pmax); alpha = __builtin_amdgcn_exp2f((m_reg - mn) * C2); m_reg = mn; }
    const float mnL = -mn * C2;
    for (int r = 0; r < 16; ++r) p0[r] = fmaf(p0[r], C2, mnL); for (int r = 0; r < 16; ++r) p1[r] = fmaf(p1[r], C2, mnL);
    for (int r = 0; r < 16; ++r) p0[r] = __builtin_amdgcn_exp2f(p0[r]);
}
__device__ __forceinline__ void finishSM(f32x16& p0, f32x16& p1, float alpha, float& l_reg, bf16x8& pa0, bf16x8& pa1, bf16x8& pa2, bf16x8& pa3) {
    for (int r = 0; r < 16; ++r) p1[r] = __builtin_amdgcn_exp2f(p1[r]);
    float ps = 0; for (int r = 0; r < 16; ++r) ps += p0[r]; for (int r = 0; r < 16; ++r) ps += p1[r];
    { auto rr = __builtin_amdgcn_permlane32_swap(__float_as_uint(ps), __float_as_uint(ps), false, false);
      ps = __uint_as_float(rr[0]) + __uint_as_float(rr[1]); }
    l_reg = l_reg * alpha + ps;
#define PK4(P, B_, OUT) do { unsigned a0 = cvtpk(P[B_+0], P[B_+1]), a1 = cvtpk(P[B_+2], P[B_+3]);                          \
        unsigned b0 = cvtpk(P[B_+4], P[B_+5]), b1 = cvtpk(P[B_+6], P[B_+7]);                                             \
        auto r0 = __builtin_amdgcn_permlane32_swap(a0, b0, false, false); auto r1 = __builtin_amdgcn_permlane32_swap(a1, b1, false, false); \
        u32x4 w = {r0[0], r1[0], r0[1], r1[1]}; OUT = *reinterpret_cast<bf16x8*>(&w); } while (0)
    PK4(p0, 0, pa0); PK4(p0, 8, pa1); PK4(p1, 0, pa2); PK4(p1, 8, pa3);
#undef PK4
}
template <int KB, bool SK>
__device__ __forceinline__ void qkt(f32x16& p0, f32x16& p1, const char* K_lds, int r32, int hi, const bf16x8* qr, bool act) {
    if (SK && !act) { const float NEG = -__builtin_inff();
#pragma unroll
        for (int r = 0; r < 16; ++r) { p0[r] = NEG; p1[r] = NEG; } return; }
    p0 = f32x16{}; p1 = f32x16{};
#pragma unroll
    for (int d0 = 0; d0 < 4; ++d0) { const char* a = K_lds + KB * SHM_K + KSWZ(r32, (d0 * 16 + hi * 8) * 2);
        bf16x8 b0 = *reinterpret_cast<const bf16x8*>(a);
        bf16x8 b1 = *reinterpret_cast<const bf16x8*>(a + 32 * 128);
        p0 = __builtin_amdgcn_mfma_f32_32x32x16_bf16(b0, qr[d0], p0, 0, 0, 0);
        p1 = __builtin_amdgcn_mfma_f32_32x32x16_bf16(b1, qr[d0], p1, 0, 0, 0); }
}
template <int VB, bool SK>
__device__ __forceinline__ void pv_tile(f32x16* o, int vb0, bf16x8 pa0, bf16x8 pa1, bf16x8 pa2, bf16x8 pa3, bool act) {
    if (SK && !act) return;
#define TRRD(dst, off) asm volatile("ds_read_b64_tr_b16 %0, %1 offset:%2" : "=&v"(dst) : "v"(vb0), "i"(off) : "memory")
#define PV_D0(d0) do { s16x4 l0, l1, l2, l3, h0, h1, h2, h3; constexpr int b_ = VB * SHM_V + v_rd_off(d0, 0, 0);     \
        TRRD(l0, b_); TRRD(h0, b_ + 2048); TRRD(l1, b_ + 4096); TRRD(h1, b_ + 6144); TRRD(l2, b_ + 8192); TRRD(h2, b_ + 10240); TRRD(l3, b_ + 12288); TRRD(h3, b_ + 14336); \
        asm volatile("s_waitcnt lgkmcnt(0)" ::: "memory"); SBAR();                 \
        o[d0] = __builtin_amdgcn_mfma_f32_32x32x16_bf16(pa0, (bf16x8){l0[0], l0[1], l0[2], l0[3], h0[0], h0[1], h0[2], h0[3]}, o[d0], 0, 0, 0);   \
        o[d0] = __builtin_amdgcn_mfma_f32_32x32x16_bf16(pa1, (bf16x8){l1[0], l1[1], l1[2], l1[3], h1[0], h1[1], h1[2], h1[3]}, o[d0], 0, 0, 0);   \
        o[d0] = __builtin_amdgcn_mfma_f32_32x32x16_bf16(pa2, (bf16x8){l2[0], l2[1], l2[2], l2[3], h2[0], h2[1], h2[2], h2[3]}, o[d0], 0, 0, 0);   \
        o[d0] = __builtin_amdgcn_mfma_f32_32x32x16_bf16(pa3, (bf16x8){l3[0], l3[1], l3[2], l3[3], h3[0], h3[1], h3[2], h3[3]}, o[d0], 0, 0, 0); } while (0)
    PV_D0(0); PV_D0(1); PV_D0(2); PV_D0(3);
#undef PV_D0
#undef TRRD
}

template <class TIn, class TOut> struct BlockRef { const TIn* Q; const TIn* K; const TIn* V; TOut* O; int P0; };
template <class TIn> struct Seam {
    bf16x8 qr[4];
    bf16x8 st_v0, st_v1, st_k0;
};
__device__ __forceinline__ int swa_jlo(int P0, int W) { const int lowk = P0 - W + 1; return lowk > 0 ? lowk / KVBLK : 0; }
#define ROW(p, k0, rr) ((p) + (size_t)((k0) + (rr)) * PITCH + sc)
#define VMW() asm volatile("s_waitcnt vmcnt(0)" ::: "memory")
#define VMWN(n) asm volatile("s_waitcnt vmcnt(%0)" :: "i"(n) : "memory")
#define SLOAD_H(Kp, Vp, k0) do { S.st_v0 = load8<TIn>(ROW(Vp, k0, sr)); S.st_v1 = load8<TIn>(ROW(Vp, k0, 32 + sr));              \
                         S.st_k0 = load8<TIn>((Kp) + (size_t)((k0) + kr) * PITCH + kc); } while (0)
#define SWRITE_HK(bf) do { *(bf16x8*)(K_lds + (bf) * SHM_K + kws) = S.st_k0; } while (0)
#define SWRITE_HV(bf) do { *(bf16x8*)(V_lds + (bf) * SHM_V + vst0) = S.st_v0; *(bf16x8*)(V_lds + (bf) * SHM_V + vst1) = S.st_v1; } while (0)
#define SWRITE_H(bf) do { SWRITE_HV(bf); SWRITE_HK(bf); } while (0)
template <class TIn, class TOut>
__device__ __forceinline__ void causal_swa_prime(const BlockRef<TIn, TOut>& cur, int W, char* lds, Seam<TIn>& S, int wave_) {
    const int wid = wave_, tid = pg8::ltid(wid), lane = tid & 63, r32 = lane & 31, hi = lane >> 5;
    const int sr = tid >> 4, sc = (tid & 15) * 8, kr = tid >> 3, kc = (tid & 7) * 8, kws = KSWZ(kr, kc * 2); char* K_lds = lds + 2 * SHM_V;
    const int kb0 = swa_jlo(cur.P0, W) * KVBLK;
    for (int d0 = 0; d0 < 4; ++d0) S.qr[d0] = load8<TIn>(cur.Q + (size_t)(wid * QBLK + r32) * PITCH + d0 * 16 + hi * 8);
    SLOAD_H(cur.K, cur.V, kb0); VMW(); SWRITE_HK(0);
    __syncthreads();
}
template <class TIn, class TOut>
__device__ __forceinline__ void causal_swa_block(const BlockRef<TIn, TOut>& cur, const BlockRef<TIn, TOut>& nxt, int skv, int W, char* lds, Seam<TIn>& S, int wave_) {
    const int wid = wave_, tid = pg8::ltid(wid), lane = tid & 63, r32 = lane & 31, hi = lane >> 5;
    const int j_lo = swa_jlo(cur.P0, W);
    int j_hi = (cur.P0 + QB - 1) / KVBLK + 1; if (j_hi > skv / KVBLK) j_hi = skv / KVBLK;
    const int NT = j_hi - j_lo;
    const int kbn = swa_jlo(nxt.P0, W) * KVBLK;
    const int qlo = cur.P0 + wid * QBLK, qm = qlo + r32 - 4 * hi;
    char* V_lds = lds; char* K_lds = lds + 2 * SHM_V;
    float* ws = (float*)(lds + 2 * SHM_V + 2 * SHM_K) + wid * 64; float* li_l = ws, * al_l = ws + 32;
    float m_reg = -1e30f, l_reg = 0; f32x16 o[4] = {};
    const int sr = tid >> 4, sc = (tid & 15) * 8, vst0 = v_st(sr, sc), vst1 = v_st(32 + sr, sc), kr = tid >> 3, kc = (tid & 7) * 8, kws = KSWZ(kr, kc * 2);
    const int vb0 = (int)(uintptr_t)V_lds + v_rd_base(lane);
    const TIn* Kh = cur.K; const TIn* Vh = cur.V;
#define RESC(a) do { if (__any((a) < 1.f)) { if (hi == 0) al_l[r32] = (a); asm volatile("s_waitcnt lgkmcnt(0)" ::: "memory");              \
                     for (int d_ = 0; d_ < 4; ++d_) for (int r = 0; r < 16; ++r) o[d_][r] *= al_l[crow(r, hi)]; } } while (0)
#define KBASE(t) ((j_lo + (t)) * KVBLK)
#define ACT(t) (KBASE(t) <= qlo + QBLK - 1 && KBASE(t) + KVBLK - 1 >= qlo - W + 1)
#define MASKT(P0_, P1_, t) do { const int kb_ = KBASE(t); if ((!SK || ACT(t)) && (kb_ + KVBLK - 1 > qlo || kb_ <= qlo + QBLK - 1 - W)) mask_tile(P0_, P1_, qm - kb_, (unsigned)W); } while (0)
    constexpr int NQL = 4;
    constexpr bool SK = WSKIP;
#define SEAM_K0() do { VMWN(NQL); SWRITE_HK(0); SBAR(); } while (0)
    f32x16 pA0, pA1, pB0, pB1; float mnA, mnB, alA, alB; bf16x8 pa0, pa1, pa2, pa3;
    SWRITE_HV(0); SBAR();
    if (NT > 1) { SLOAD_H(Kh, Vh, KBASE(1)); }
    SBAR(); qkt<0, SK>(pA0, pA1, K_lds, r32, hi, S.qr, ACT(0));
    MASKT(pA0, pA1, 0); partialSM(pA0, pA1, m_reg, mnA, alA);
    if (NT > 1) { VMW(); SWRITE_H(1); }
    __syncthreads();
#define HALF_STEP(PX0, PX1, mnX, alX, PY0, PY1, alY, t, KB, VB, SB) do {                                                      \
        SBAR(); qkt<KB, SK>(PX0, PX1, K_lds, r32, hi, S.qr, ACT(t));                                             \
        finishSM(PY0, PY1, alY, l_reg, pa0, pa1, pa2, pa3); SBAR();                                                           \
        if ((t) + 1 < NT) { SLOAD_H(Kh, Vh, KBASE((t) + 1)); SBAR(); }                                                        \
        pv_tile<VB, SK>(o, vb0, pa0, pa1, pa2, pa3, ACT((t) - 1)); MASKT(PX0, PX1, (t)); partialSM(PX0, PX1, m_reg, mnX, alX);                                        \
        __syncthreads();                                                                                                      \
        if ((t) + 1 < NT) { VMW(); SWRITE_H(SB); }                                                                            \
        RESC(alX); __syncthreads(); } while (0)
    for (int t = 1; t + 1 < NT; t += 2) {
        HALF_STEP(pB0, pB1, mnB, alB, pA0, pA1, alA, t, 1, 0, 0);
        HALF_STEP(pA0, pA1, mnA, alA, pB0, pB1, alB, t + 1, 0, 1, 1);
    }
    const bool even = (NT & 1) == 0;
    if (even) { SBAR(); qkt<1, SK>(pB0, pB1, K_lds, r32, hi, S.qr, ACT(NT - 1)); SBAR(); }
    { SLOAD_H(nxt.K, nxt.V, kbn); SBAR();
#pragma unroll
        for (int d0 = 0; d0 < 4; ++d0) S.qr[d0] = load8<TIn>(nxt.Q + (size_t)(wid * QBLK + r32) * PITCH + d0 * 16 + hi * 8); }
    SBAR();
    finishSM(pA0, pA1, alA, l_reg, pa0, pa1, pa2, pa3); SBAR();
    pv_tile<0, SK>(o, vb0, pa0, pa1, pa2, pa3, ACT(even ? NT - 2 : NT - 1));
    if (even) { MASKT(pB0, pB1, NT - 1); partialSM(pB0, pB1, m_reg, mnB, alB); __syncthreads(); RESC(alB);
        finishSM(pB0, pB1, alB, l_reg, pa0, pa1, pa2, pa3); SBAR(); pv_tile<1, SK>(o, vb0, pa0, pa1, pa2, pa3, ACT(NT - 1)); }
    SBAR(); SEAM_K0();
    if (hi == 0) li_l[r32] = l_reg; asm volatile("s_waitcnt lgkmcnt(0)" ::: "memory");
    float rli[16];
#pragma unroll
    for (int r = 0; r < 16; ++r) rli[r] = __builtin_amdgcn_rcpf(li_l[crow(r, hi)]);
    TOut* Ow = cur.O + (size_t)(wid * QBLK) * PITCH;
#pragma unroll
    for (int r = 0; r < 16; ++r) { const int orow = crow(r, hi);
#pragma unroll
        for (int d0 = 0; d0 < 4; ++d0) { const float v = o[d0][r] * rli[r];
            if constexpr (same_t<TOut, float>::v) { Ow[(size_t)orow * PITCH + d0 * 32 + r32] = v; }
            else { const float vn = __shfl_xor(v, 1);
                   if ((r32 & 1) == 0) *(unsigned*)(Ow + (size_t)orow * PITCH + d0 * 32 + r32) = cvtpk(v, vn); } } }
    __syncthreads();
#undef RESC
#undef KBASE
#undef ACT
#undef MASKT
#undef SEAM_K0
#undef HALF_STEP
}
#undef ROW
#undef VMW
#undef VMWN
#undef SLOAD_H
#undef SWRITE_HK
#undef SWRITE_HV
#undef SWRITE_H
#undef KSWZ
#undef SBAR
struct Tensors { const bf16* Q; const bf16* K; const bf16* V; bf16* O0; bf16* O1; };
__device__ __forceinline__ BlockRef<bf16, bf16> blk_ref(const Tensors& T, int L, int pass) {
    const int bh = L >> 3, p = L & 7, b = bh >> 4, hc = bh & 15, qb = pass ? 15 - p : p; const size_t rowb = (size_t)b * SKVC;
    BlockRef<bf16, bf16> r;
    r.Q = T.Q + (rowb + (size_t)qb * QB) * PITCH + hc * DK; r.K = T.K + rowb * PITCH + hc * DK; r.V = T.V + rowb * PITCH + (hc >> 1) * D;
    r.O = ((hc & 1) ? T.O1 : T.O0) + (rowb + (size_t)qb * QB) * PITCH + (hc >> 1) * D; r.P0 = qb * QB;
    return r;
}
__device__ __forceinline__ void attn_phase(char* lds, const Tensors& T, int vcu, int G, int wave_) {
    constexpr int TOTAL = 8 * 16 * 8, W = 1 << 20;
    int L = vcu; if (L >= TOTAL) return;
    int pass = 0;
    BlockRef<bf16, bf16> cur = blk_ref(T, L, 0);
    Seam<bf16> S;
    causal_swa_prime<bf16, bf16>(cur, W, lds, S, wave_);
    for (;;) {
        const bool more_pass = pass == 0, more_item = L + G < TOTAL, last = !more_pass && !more_item;
        int passn = pass + 1, Ln = L;
        if (!more_pass) { passn = 0; Ln = more_item ? L + G : L; }
        const BlockRef<bf16, bf16> nxt = last ? cur : blk_ref(T, Ln, passn);
        causal_swa_block<bf16, bf16>(cur, nxt, SKVC, W, lds, S, wave_);
        if (last) break;
        cur = nxt; pass = passn; L = Ln;
    }
}
}
#define GAS __attribute__((address_space(1)))
#define LAS __attribute__((address_space(3)))
typedef unsigned short bf16;
typedef unsigned v4u __attribute__((ext_vector_type(4)));
typedef float f32x4 __attribute__((ext_vector_type(4)));
typedef short bf16x8 __attribute__((ext_vector_type(8)));
typedef GAS unsigned gu32;
typedef GAS unsigned long long gu64;
#define RLX_AGENT __ATOMIC_RELAXED, __HIP_MEMORY_SCOPE_AGENT
#define LDS_WAIT() asm volatile("s_waitcnt lgkmcnt(0)" ::: "memory")
#define VM_WAIT() asm volatile("s_waitcnt vmcnt(0)" ::: "memory")
__device__ __forceinline__ unsigned long long rt() { return __builtin_amdgcn_s_memrealtime(); }
__device__ __forceinline__ unsigned f2bf(float f) { unsigned u = __builtin_bit_cast(unsigned, f); return (u + 0x7fffu + ((u >> 16) & 1u)) >> 16; }
__device__ __forceinline__ unsigned pk2(float lo, float hi) { return f2bf(lo) | (f2bf(hi) << 16); }

#define XB_TMO      128
#define XB_XCNT(j)  (256  + 64 * (j))
#define XB_XSUB(j)  (1280 + 64 * (j))
#define XB_XGEN(j)  (2304 + 64 * (j))
#define XB_TOP      3328
#define XB_TOPGEN   3392
#define XCD_BAR_WORDS 3456
#define XB_SPIN_CAP (1u << 18)

__device__ __forceinline__ unsigned xb_ld(unsigned* p)              { return __hip_atomic_load(p, __ATOMIC_RELAXED, __HIP_MEMORY_SCOPE_AGENT); }
__device__ __forceinline__ unsigned xb_add(unsigned* p, unsigned v) { return __hip_atomic_fetch_add(p, v, __ATOMIC_RELAXED, __HIP_MEMORY_SCOPE_AGENT); }
__device__ __forceinline__ unsigned xb_xcc_id() { return (unsigned)__builtin_amdgcn_s_getreg((3 << 11) | 20) & 0xFu; }
#define XB_SPIN(cond, bar) do { unsigned _sp = 0; while (cond) { __builtin_amdgcn_s_sleep(1); \
    if ((++_sp & 255u) == 0u) { if (xb_ld(&(bar)[XB_TMO])) break; if (_sp > XB_SPIN_CAP) { atomicAdd(&(bar)[XB_TMO], 1u); break; } } } } while (0)

struct XcdBarrier {
    unsigned* bar; unsigned x;
    volatile LAS unsigned* st;
};

__device__ __forceinline__ XcdBarrier xcd_barrier_post(unsigned* bar, volatile LAS unsigned* st) {
    XcdBarrier b; b.bar = bar; b.x = xb_xcc_id(); b.st = st;
    if (threadIdx.x == 0) (void)xb_add(&bar[XB_XCNT(b.x)], 1u);
    return b;
}
__device__ __forceinline__ void xcd_barrier_complete(unsigned* bar, unsigned x, unsigned& nloc, unsigned& nx) {
    const unsigned G = gridDim.x * gridDim.y * gridDim.z;
    unsigned sum, cnt, mine, sp = 0u;
    for (;;) {
        sum = 0u; cnt = 0u; mine = 0u;
#pragma unroll
        for (unsigned j = 0; j < 16; ++j) { const unsigned c = xb_ld(&bar[XB_XCNT(j)]); sum += c; cnt += (c > 0u) ? 1u : 0u; mine = (j == x) ? c : mine; }
        if (sum == G) break;
        __builtin_amdgcn_s_sleep(1);
        if ((++sp & 255u) == 0u) { if (xb_ld(&bar[XB_TMO])) break; if (sp > XB_SPIN_CAP) { atomicAdd(&bar[XB_TMO], 1u); break; } }
    }
    nloc = mine > 0u ? mine : 1u; nx = cnt > 0u ? cnt : 1u;
}

__device__ __forceinline__ void xcd_barrier(const XcdBarrier& b) {
    asm volatile("s_waitcnt vmcnt(0)" ::: "memory");
    __syncthreads();
    if (threadIdx.x == 0) {
        unsigned* bar = b.bar;
        __builtin_amdgcn_s_waitcnt(0);
        unsigned nloc = b.st[0], nx = b.st[1];
        if (nloc == 0u) { xcd_barrier_complete(bar, b.x, nloc, nx); b.st[0] = nloc; b.st[1] = nx; }
        const unsigned old = xb_add(&bar[XB_XSUB(b.x)], 1u);
        const unsigned gen = old / nloc;
        if (old + 1u == (gen + 1u) * nloc) {
            __builtin_amdgcn_fence(__ATOMIC_RELEASE, "agent");
            asm volatile("s_waitcnt vmcnt(0)" ::: "memory");
            const unsigned og = xb_add(&bar[XB_TOP], 1u);
            const unsigned tg = og / nx;
            if (og + 1u == (tg + 1u) * nx) xb_add(&bar[XB_TOPGEN], 1u);
            else XB_SPIN(xb_ld(&bar[XB_TOPGEN]) == tg, bar);
            __builtin_amdgcn_fence(__ATOMIC_ACQUIRE, "agent");
            xb_add(&bar[XB_XGEN(b.x)], 1u);
            asm volatile("s_waitcnt vmcnt(0)" ::: "memory");
        } else {
            XB_SPIN(xb_ld(&bar[XB_XGEN(b.x)]) == gen, bar);
            __builtin_amdgcn_fence(__ATOMIC_ACQUIRE, "agent");
            asm volatile("s_waitcnt vmcnt(0)" ::: "memory");
        }
    }
    __syncthreads();
}

constexpr int NWAVES = 8;
constexpr int BATCH = 8, SEQ = 4096, D = 1024, M = BATCH * SEQ;
constexpr int NEXP = 32, FE = 256, PLED = 256, CWID = 31, NQKV = 3072;
constexpr float EPS = 1e-6f;
constexpr int NPHASE = 21;
constexpr int PADROWS = 73728;
constexpr float LAM_INIT = 0.35550906759096926f;

constexpr size_t MiB = 1u << 20;
constexpr size_t WS_CTL = 0, CTL_ZERO_BYTES = 1 * MiB;
constexpr size_t WS_SSQ = 439 * MiB;
constexpr size_t WS_TI = 2 * MiB, WS_TW = WS_TI + 512 * 1024;
constexpr size_t WS_LIST = 3 * MiB;
constexpr size_t WS_RP = 7 * MiB;
constexpr size_t WS_LOG = 11 * MiB;
constexpr size_t WS_WPW1 = 19 * MiB, WS_WPW2 = 23 * MiB, WS_WQKV = 25 * MiB, WS_WO = 31 * MiB, WS_WR = 33 * MiB, WS_WPG = 34 * MiB, WS_WPP = 38 * MiB;
constexpr size_t WS_WGU = 39 * MiB, WS_WD = 71 * MiB;
constexpr size_t WS_P16 = 87 * MiB;
constexpr size_t WS_S0 = 119 * MiB, WS_SS = 64 * MiB;
constexpr size_t WS_WGU1 = WS_SSQ + 14 * MiB, WS_WD1 = WS_WGU1 + 32 * MiB;
constexpr size_t WS_END = WS_WD1 + 16 * MiB;
static_assert(WS_S0 + 5 * WS_SS == WS_SSQ, "d_ws map");
constexpr int CW_BAR = 4096;
constexpr int CW_CNT = 8192;
constexpr int RING_OFF = 0, RING_BYTES = 131072;
constexpr int LDSCTL_OFF = RING_BYTES;
constexpr int L_MISC = LDSCTL_OFF, L_TS = LDSCTL_OFF + 128, L_NE = LDSCTL_OFF + 384, L_TE = LDSCTL_OFF + 512, L_TOK = LDSCTL_OFF + 2048, L_HIST = LDSCTL_OFF + 10240;
constexpr int MAXGU = 8;
constexpr int LDS_BYTES = 147456;


typedef float f32x2 __attribute__((ext_vector_type(2)));
typedef unsigned u32x2 __attribute__((ext_vector_type(2)));
typedef int i32x4 __attribute__((ext_vector_type(4)));
__device__ __forceinline__ float bflo(unsigned u) { return __builtin_bit_cast(float, u << 16); }
__device__ __forceinline__ float bfhi(unsigned u) { return __builtin_bit_cast(float, u & 0xffff0000u); }
__device__ __forceinline__ float sigmoid_f(float x) { return __builtin_amdgcn_rcpf(1.f + __expf(-x)); }
__device__ __forceinline__ float wave_sum(float v) {
#pragma unroll
    for (int o = 1; o < 64; o <<= 1) v += __shfl_xor(v, o);
    return v;
}
__device__ __forceinline__ void tr_item(const float* W, int N, bf16* WT, int Kd, int k0, int n0, int drow0, const float* gk, LAS float* scr, int lane) {
#pragma unroll 8
    for (int i = 0; i < 32; ++i) { const int kk = 2 * i + (lane >> 5); scr[kk * 33 + (lane & 31)] = W[(size_t)(k0 + kk) * N + n0 + (lane & 31)]; }
    LDS_WAIT(); asm volatile("" ::: "memory");
    const int c = lane & 7;
    f32x4 g0 = {1.f, 1.f, 1.f, 1.f}, g1 = {1.f, 1.f, 1.f, 1.f};
    if (gk) { g0 = *(const f32x4*)(gk + k0 + 8 * c); g1 = *(const f32x4*)(gk + k0 + 8 * c + 4); }
#pragma unroll
    for (int j = 0; j < 4; ++j) { const int n = (lane >> 3) + 8 * j; const LAS float* s = scr + (8 * c) * 33 + n;
        v4u o; o.x = pk2(s[0 * 33] * g0.x, s[1 * 33] * g0.y); o.y = pk2(s[2 * 33] * g0.z, s[3 * 33] * g0.w); o.z = pk2(s[4 * 33] * g1.x, s[5 * 33] * g1.y); o.w = pk2(s[6 * 33] * g1.z, s[7 * 33] * g1.w);
        *(GAS v4u*)(WT + (size_t)(drow0 + n) * Kd + k0 + 8 * c) = o; }
    LDS_WAIT(); asm volatile("" ::: "memory");
}
template <bool GLU_IL = false>
__device__ __forceinline__ void tr_plain(const float* W, int K, int N, bf16* WT, int item, const float* gk, LAS float* scr, int lane) {
    const int nblk = N / 32, kb = item / nblk, nb = item % nblk, n0 = 32 * nb; int drow0 = n0;
    if (GLU_IL) { const int h = n0 >> 10, c = n0 & 1023; drow0 = (c >> 7) * 256 + h * 128 + (c & 127); }
    tr_item(W, N, WT, K, 64 * kb, n0, drow0, gk, scr, lane);
}
constexpr int MOE_ITEMS = 32 * 384;
__device__ __forceinline__ void moe_item(const float* wg, const float* wu, const float* wd, const float* gk, int l, bf16* WGU, bf16* WD, int item, LAS float* scr, int lane) {
    const int ge = item / 384, r = item % 384, which = r / 128, sub = r % 128; const size_t eo = (size_t)(l * 32 + ge) * 262144;
    if (which < 2) { const int kb = sub / 8, nb = sub % 8, n0 = 32 * nb; const int drow0 = (n0 / 128) * 256 + (n0 % 128) + (which ? 128 : 0);
        tr_item((which ? wu : wg) + eo, 256, WGU + (size_t)ge * 512 * 1024, 1024, 64 * kb, n0, drow0, gk, scr, lane); }
    else { const int kb = sub / 32, nb = sub % 32; tr_item(wd + eo, 1024, WD + (size_t)ge * 1024 * 256, 256, 64 * kb, 32 * nb, 32 * nb, nullptr, scr, lane); }
}

__device__ __forceinline__ void row_cvt(const float* x, bf16* XB, float* ss, int gw, int NGW, int lane) {
    for (int m = gw; m < M; m += NGW) {
        const GAS f32x4* xr = (const GAS f32x4*)(x + (size_t)m * D) + lane; GAS u32x2* xo = (GAS u32x2*)(XB + (size_t)m * D) + lane;
        f32x4 v[4]; float s = 0.f;
#pragma unroll
        for (int j = 0; j < 4; ++j) v[j] = xr[64 * j];
#pragma unroll
        for (int j = 0; j < 4; ++j) { s += (v[j].x * v[j].x + v[j].y * v[j].y) + (v[j].z * v[j].z + v[j].w * v[j].w); xo[64 * j] = (u32x2){pk2(v[j].x, v[j].y), pk2(v[j].z, v[j].w)}; }
        s = wave_sum(s); if (lane < 16) ss[(size_t)m * 16 + lane] = lane ? 0.f : s;
    }
}
__device__ __forceinline__ void row_moe(const bf16* Xi, bf16* Xo, const bf16* YP, const i32x4* TI, const f32x2* TW, const unsigned* cnt, float* ss, int gw, int NGW, int lane) {
    int ts;
    { const unsigned n = lane < 32 ? __hip_atomic_load(cnt + lane * 64, RLX_AGENT) : 0u; const int tiles = (int)((n + 255u) >> 8); int incl = tiles;
#pragma unroll
      for (int o = 1; o < 32; o <<= 1) { const int t = __shfl_up(incl, o); if (lane >= o) incl += t; }
      ts = incl - tiles; }
    for (int m = gw; m < M; m += NGW) {
        const i32x4 ti = TI[m]; const f32x2 tw = TW[m];
        const int r1 = __shfl(ts, ti.x) * 256 + ti.y, r2 = __shfl(ts, ti.z) * 256 + ti.w;
        const GAS u32x2* xr = (const GAS u32x2*)(Xi + (size_t)m * D) + lane; GAS u32x2* xo = (GAS u32x2*)(Xo + (size_t)m * D) + lane;
        const GAS u32x2* y1 = (const GAS u32x2*)(YP + (size_t)r1 * D) + lane; const GAS u32x2* y2 = (const GAS u32x2*)(YP + (size_t)r2 * D) + lane;
        float s = 0.f;
#pragma unroll
        for (int j = 0; j < 4; ++j) { const u32x2 x = xr[64 * j], a = y1[64 * j], c = y2[64 * j];
            const f32x4 v = (f32x4){bflo(x.x), bfhi(x.x), bflo(x.y), bfhi(x.y)} + (f32x4){bflo(a.x), bfhi(a.x), bflo(a.y), bfhi(a.y)} * tw.x + (f32x4){bflo(c.x), bfhi(c.x), bflo(c.y), bfhi(c.y)} * tw.y;
            s += (v.x * v.x + v.y * v.y) + (v.z * v.z + v.w * v.w); xo[64 * j] = (u32x2){pk2(v.x, v.y), pk2(v.z, v.w)}; }
        s = wave_sum(s); if (lane < 16) ss[(size_t)m * 16 + lane] = lane ? 0.f : s;
    }
}
__device__ __forceinline__ void row_final(float* out, const float* ss, const float* gain, int gw, int NGW, int lane) {
    f32x4 gv[4];
#pragma unroll
    for (int j = 0; j < 4; ++j) gv[j] = *((const f32x4*)gain + lane + 64 * j);
    for (int m = gw; m < M; m += NGW) {
        GAS f32x4* xr = (GAS f32x4*)(out + (size_t)m * D) + lane; const float r = pg8::rs_of(ss, m);
        f32x4 v[4];
#pragma unroll
        for (int j = 0; j < 4; ++j) v[j] = xr[64 * j];
#pragma unroll
        for (int j = 0; j < 4; ++j) xr[64 * j] = v[j] * r * gv[j];
    }
}

__device__ __forceinline__ void conv_phase(const bf16* U, bf16* C, const float* wdw, const float* bdw, const float* lng, const float* lnb, LAS unsigned char* lds, int vcu, int G, int tid, int lane, int wave) {
    constexpr int RUN = 128, NGRP = (RUN + CWID - 1) / CWID;
    const int c0 = 2 * tid;
    f32x2 w[CWID];
#pragma unroll
    for (int j = 0; j < CWID; ++j) w[j] = *(const f32x2*)(wdw + j * D + c0);
    const f32x2 bd = *(const f32x2*)(bdw + c0);
    LAS unsigned* yb = (LAS unsigned*)lds;
    for (int run = vcu; run < M / RUN; run += G) {
        const int b = run / (SEQ / RUN), t0 = (run % (SEQ / RUN)) * RUN; const size_t rb = (size_t)b * SEQ;
        const bf16* Ub = U + rb * D + c0;
        f32x2 win[CWID]; unsigned raw[CWID], rawn[CWID];
        win[0] = (f32x2){0.f, 0.f};
#pragma unroll
        for (int s = 1; s < CWID; ++s) { const int tau = t0 - CWID + s; const int tc = tau < 0 ? 0 : tau;
            const unsigned ua = *(const GAS unsigned*)(Ub + (size_t)tc * D);
            win[s] = tau < 0 ? (f32x2){0.f, 0.f} : (f32x2){bflo(ua), bfhi(ua)}; }
#pragma unroll
        for (int s = 0; s < CWID; ++s) raw[s] = *(const GAS unsigned*)(Ub + (size_t)(t0 + s) * D);
#pragma unroll 1
        for (int g = 0; g < NGRP; ++g) {
            const int tg = t0 + g * CWID, n = (RUN - g * CWID) < CWID ? (RUN - g * CWID) : CWID;
#pragma unroll
            for (int s = 0; s < CWID; ++s) { int tn = tg + CWID + s; tn = tn > t0 + RUN - 1 ? t0 + RUN - 1 : tn; rawn[s] = *(const GAS unsigned*)(Ub + (size_t)tn * D); }
#pragma unroll
            for (int s = 0; s < CWID; ++s) { if (s < n) {
                win[s] = (f32x2){bflo(raw[s]), bfhi(raw[s])};
                f32x2 a = bd;
#pragma unroll
                for (int j = 0; j < CWID; ++j) a += w[j] * win[(s + 1 + j) % CWID];
                yb[s * 512 + tid] = pk2(a.x, a.y); } }
            LDS_WAIT(); __syncthreads();
#pragma unroll 1
            for (int rr = 0; rr < 4; ++rr) { const int r = wave * 4 + rr; if (r < n) {
                const v4u p0 = *(const LAS v4u*)(lds + r * 2048 + lane * 16), p1 = *(const LAS v4u*)(lds + r * 2048 + 1024 + lane * 16);
                float x[16] = {bflo(p0.x), bfhi(p0.x), bflo(p0.y), bfhi(p0.y), bflo(p0.z), bfhi(p0.z), bflo(p0.w), bfhi(p0.w), bflo(p1.x), bfhi(p1.x), bflo(p1.y), bfhi(p1.y), bflo(p1.z), bfhi(p1.z), bflo(p1.w), bfhi(p1.w)};
                float s = 0.f;
#pragma unroll
                for (int i = 0; i < 16; ++i) s += x[i];
                const float mu = wave_sum(s) * (1.f / D); float q = 0.f;
#pragma unroll
                for (int i = 0; i < 16; ++i) { x[i] -= mu; q += x[i] * x[i]; }
                const float rs = 1.f / sqrtf(wave_sum(q) * (1.f / D) + EPS);
                unsigned o[8];
#pragma unroll
                for (int hh = 0; hh < 2; ++hh) { const f32x4 g0 = *(const f32x4*)(lng + hh * 512 + lane * 8), g1 = *(const f32x4*)(lng + hh * 512 + lane * 8 + 4), b0 = *(const f32x4*)(lnb + hh * 512 + lane * 8), b1 = *(const f32x4*)(lnb + hh * 512 + lane * 8 + 4);
                    float y[8] = {x[hh * 8 + 0] * rs * g0.x + b0.x, x[hh * 8 + 1] * rs * g0.y + b0.y, x[hh * 8 + 2] * rs * g0.z + b0.z, x[hh * 8 + 3] * rs * g0.w + b0.w,
                                  x[hh * 8 + 4] * rs * g1.x + b1.x, x[hh * 8 + 5] * rs * g1.y + b1.y, x[hh * 8 + 6] * rs * g1.z + b1.z, x[hh * 8 + 7] * rs * g1.w + b1.w};
#pragma unroll
                    for (int i = 0; i < 4; ++i) o[hh * 4 + i] = pk2(y[2 * i] * sigmoid_f(y[2 * i]), y[2 * i + 1] * sigmoid_f(y[2 * i + 1])); }
                bf16* cr = C + (rb + tg + r) * D;
                *(GAS v4u*)(cr + lane * 8) = (v4u){o[0], o[1], o[2], o[3]}; *(GAS v4u*)(cr + 512 + lane * 8) = (v4u){o[4], o[5], o[6], o[7]}; } }
            LDS_WAIT(); __syncthreads();
#pragma unroll
            for (int s = 0; s < CWID; ++s) raw[s] = rawn[s];
        }
    }
}

__device__ __forceinline__ void combine_phase(const bf16* O0, const bf16* O1, bf16* OC, const float* lamp, const float* subln, int gw, int NGW, int lane) {
    const float l1 = wave_sum(lamp[lane] * lamp[64 + lane]), l2 = wave_sum(lamp[128 + lane] * lamp[192 + lane]);
    const float lam = __expf(l1) - __expf(l2) + LAM_INIT;
    float gsc[16];
#pragma unroll
    for (int i = 0; i < 16; ++i) gsc[i] = subln[(lane & 7) * 16 + i] * (1.0f - LAM_INIT);
    for (int m = gw; m < M; m += NGW) {
        const v4u a0 = *(const GAS v4u*)(O0 + (size_t)m * D + lane * 16), a1 = *(const GAS v4u*)(O0 + (size_t)m * D + lane * 16 + 8);
        const v4u b0 = *(const GAS v4u*)(O1 + (size_t)m * D + lane * 16), b1 = *(const GAS v4u*)(O1 + (size_t)m * D + lane * 16 + 8);
        const unsigned ua[8] = {a0.x, a0.y, a0.z, a0.w, a1.x, a1.y, a1.z, a1.w}, ub[8] = {b0.x, b0.y, b0.z, b0.w, b1.x, b1.y, b1.z, b1.w};
        float o[16]; float ss = 0.f;
#pragma unroll
        for (int i = 0; i < 8; ++i) { o[2 * i] = bflo(ua[i]) - lam * bflo(ub[i]); o[2 * i + 1] = bfhi(ua[i]) - lam * bfhi(ub[i]); ss += o[2 * i] * o[2 * i] + o[2 * i + 1] * o[2 * i + 1]; }
        ss += __shfl_xor(ss, 1); ss += __shfl_xor(ss, 2); ss += __shfl_xor(ss, 4);
        const float r = 1.f / sqrtf(ss * (1.f / 128.f) + EPS);
        unsigned w[8];
#pragma unroll
        for (int i = 0; i < 8; ++i) w[i] = pk2(o[2 * i] * r * gsc[2 * i], o[2 * i + 1] * r * gsc[2 * i + 1]);
        *(GAS v4u*)(OC + (size_t)m * D + lane * 16) = (v4u){w[0], w[1], w[2], w[3]}; *(GAS v4u*)(OC + (size_t)m * D + lane * 16 + 8) = (v4u){w[4], w[5], w[6], w[7]};
    }
}

__device__ __forceinline__ void select_phase(const float* LOG, const float* brg, const float* bre, const float* ss, unsigned* cnt, int* list, float* RP, i32x4* TI, f32x2* TW, LAS int* lh, int vcu, int G, int tid) {
    for (int base = vcu * 128; base < M; base += G * 128) {
        if (tid < 32) lh[tid] = 0;
        __syncthreads();
        const int t = base + tid; int E1 = 0, E2 = 0, r1 = 0, r2 = 0; float w1 = 0.f, w2 = 0.f;
        if (tid < 128) {
            const f32x4 g4 = *(const GAS f32x4*)(LOG + (size_t)t * 64);
            const float gl[4] = {g4.x + brg[0], g4.y + brg[1], g4.z + brg[2], g4.w + brg[3]};
            int gi = 0; float gm = gl[0];
#pragma unroll
            for (int j = 1; j < 4; ++j) if (gl[j] > gm) { gm = gl[j]; gi = j; }
            float den = 0.f;
#pragma unroll
            for (int j = 0; j < 4; ++j) den += __expf(gl[j] - gm);
            const float gw_ = 1.f / den;
            const f32x4 ea = *(const GAS f32x4*)(LOG + (size_t)t * 64 + 4 + gi * 8), eb = *(const GAS f32x4*)(LOG + (size_t)t * 64 + 8 + gi * 8);
            const f32x4 ba = *(const f32x4*)(bre + gi * 8), bb = *(const f32x4*)(bre + gi * 8 + 4);
            const float el[8] = {ea.x + ba.x, ea.y + ba.y, ea.z + ba.z, ea.w + ba.w, eb.x + bb.x, eb.y + bb.y, eb.z + bb.z, eb.w + bb.w};
            int i1 = 0; float v1 = el[0];
#pragma unroll
            for (int j = 1; j < 8; ++j) if (el[j] > v1) { v1 = el[j]; i1 = j; }
            int i2 = -1; float v2 = -INFINITY;
#pragma unroll
            for (int j = 0; j < 8; ++j) if (j != i1 && (i2 < 0 || el[j] > v2)) { v2 = el[j]; i2 = j; }
            const float e2 = __expf(v2 - v1); const float p1 = 1.f / (1.f + e2);
            w1 = p1 * gw_; w2 = (e2 * p1) * gw_; E1 = gi * 8 + i1; E2 = gi * 8 + i2;
            r1 = __hip_atomic_fetch_add(lh + E1, 1, __ATOMIC_RELAXED, __HIP_MEMORY_SCOPE_WORKGROUP); r2 = __hip_atomic_fetch_add(lh + E2, 1, __ATOMIC_RELAXED, __HIP_MEMORY_SCOPE_WORKGROUP);
        }
        __syncthreads();
        if (tid < 32) { const int c = lh[tid]; int bs = 0; if (c) bs = (int)__hip_atomic_fetch_add(cnt + tid * 64, (unsigned)c, RLX_AGENT); lh[32 + tid] = bs; }
        __syncthreads();
        if (tid < 128) { const int s1 = lh[32 + E1] + r1, s2 = lh[32 + E2] + r2;
            const float r = pg8::rs_of(ss, t);
            list[(size_t)E1 * M + s1] = t; list[(size_t)E2 * M + s2] = t; RP[(size_t)E1 * M + s1] = r; RP[(size_t)E2 * M + s2] = r; TI[t] = (i32x4){E1, s1, E2, s2}; TW[t] = (f32x2){w1, w2}; }
        __syncthreads();
    }
}

struct GroupedOrder {
    int nNs, G, c, ntu;
    const LAS int* tile_e; const LAS int* tokl; const LAS int* ts;
    __device__ __forceinline__ bool next(int i, pg8::Unit& u) const { const int L = i * G + c; if (L >= ntu) return false; const int mt = L >> nNs, pn = L & ((1 << nNs) - 1);
        const int e = tile_e[mt]; u.pm = mt; u.pn = pn; u.pb = (e << nNs) + pn; u.aux = e * M + (mt - ts[e]) * 256; return true; }
    __device__ __forceinline__ unsigned arow(int ord, int r) const { return (unsigned)tokl[ord * 256 + r]; }
};
__device__ __forceinline__ GroupedOrder grouped_setup(const unsigned* cnt, const int* list, LAS unsigned char* lds, bool need_tok, int nNs, int G, int c, int tid, int lane, int wave) {
    LAS int* ts = (LAS int*)(lds + L_TS); LAS int* ne = (LAS int*)(lds + L_NE); LAS int* te = (LAS int*)(lds + L_TE); LAS int* tokl = (LAS int*)(lds + L_TOK);
    __syncthreads();
    if (wave == 0) {
        const unsigned n = lane < 32 ? __hip_atomic_load(cnt + lane * 64, RLX_AGENT) : 0u; const int tiles = (int)((n + 255u) >> 8); int incl = tiles;
#pragma unroll
        for (int o = 1; o < 32; o <<= 1) { const int t = __shfl_up(incl, o); if (lane >= o) incl += t; }
        const int excl = incl - tiles;
        if (lane < 32) { ts[lane] = excl; ne[lane] = (int)n; for (int k = 0; k < tiles; ++k) te[excl + k] = lane; }
        if (lane == 31) ts[32] = incl;
    }
    __syncthreads();
    GroupedOrder S; S.nNs = nNs; S.G = G; S.c = c; S.ntu = ts[32] << nNs; S.tile_e = te; S.tokl = tokl; S.ts = ts;
    if (need_tok) {
        for (int i = 0; i < MAXGU; ++i) { const int L = i * G + c; if (L >= S.ntu) break; const int mt = L >> nNs, e = te[mt];
            if (tid < 256) { const int slot = (mt - ts[e]) * 256 + tid; tokl[i * 256 + tid] = slot < ne[e] ? list[(size_t)e * M + slot] : 0; } }
        if (S.ntu > MAXGU * G) S.ntu = MAXGU * G;
        __syncthreads();
    }
    return S;
}

enum { I_X = 0, I_P, I_POS, I_NMIX, I_NFFN, I_CW1, I_CB1, I_CDW, I_CBDW, I_CLNG, I_CLNB, I_CW2, I_CB2, I_WQKV, I_LAM, I_SUBLN, I_WO,
       I_WRG, I_BRG, I_WRE, I_BRE, I_WG, I_WU, I_WDN, I_PNORM, I_PWG, I_PWP, I_FNORM, N_IN };
struct Args { const void* in[N_IN]; float* out; unsigned char* ws; int ph_lo, ph_hi; };

typedef const __attribute__((address_space(4))) Args* KArgP;
#define PH_IDS() const int tid = pg8::ltid(wave), lane = tid & 63, gtid = vcu * (NWAVES * 64) + tid; (void)lane; (void)gtid
__device__ __forceinline__ KArgP kargs() { KArgP k = (KArgP)__builtin_amdgcn_kernarg_segment_ptr(); asm volatile("" : "+s"(k)); return k; }
#define IN_F(k) ((const float*)ka->in[k])
#define WSP(off) ((bf16*)(ka->ws + (off)))
#define SLOT(i) ((bf16*)(ka->ws + WS_S0 + (size_t)(i) * WS_SS))
#define IN(k) (lo <= (k) && (k) < hi)
#ifndef MK_DUP
#define MK_DUP -1
#endif
#define DUPLOOP(k) _Pragma("nounroll") for (int rep_ = 0; rep_ < ((k) == MK_DUP ? 2 : 1); ++rep_)
#ifdef MK_PROBE
#define CW_TS 12288
#define SEAM(k) do { if (IN(k) && IN((k) + 1)) xcd_barrier(bar); if (blockIdx.x == 0 && threadIdx.x == 0) __hip_atomic_store((unsigned*)(kargs()->ws + WS_CTL) + CW_TS + (k) + 1, (unsigned)__builtin_amdgcn_s_memrealtime(), RLX_AGENT); } while (0)
#else
#define SEAM(k) do { if (IN(k) && IN((k) + 1)) xcd_barrier(bar); } while (0)
#endif
#define XBA ((bf16*)ka->out)
#define XBB ((bf16*)ka->out + (size_t)M * D)
#define SSQ(k) ((float*)(ka->ws + WS_SSQ) + (size_t)(k) * M * 16)
#define ACTB ((bf16*)(ka->ws + WS_S0 + 3 * WS_SS + 16 * MiB))
#define CNT(l) ((unsigned*)(ka->ws + WS_CTL) + CW_CNT + (l) * 32 * 64)
template <int l>
__device__ __forceinline__ void layer_tail(LAS unsigned char* lds, const XcdBarrier& bar, int lo, int hi, int wave, int G, int bx, int vcu, int gw, int NGW, int NTHR) {
    constexpr int pb = l ? 14 : 4;
    LAS float* scr = (LAS float*)(lds + RING_OFF + wave * 16384);
    if (IN(pb)) DUPLOOP(pb) {
        const bool split = (G == 256);
        if (!split || bx < 128) { KArgP ka = kargs(); pg8::Gemm g{l ? XBB : XBA, WSP(WS_WR) + (size_t)l * 256 * D, M, 256, D}; pg8::StaticOrder S; S.init(M, 256, G, bx);
            pg8::EpiLogits E{(float*)(ka->ws + WS_LOG), SSQ(l ? 4 : 1)};
            pg8::gemm_phase<pg8::EpiLogits, pg8::StaticOrder, true, false>(lds + RING_OFF, g, S, E, wave); }
        if (!split || bx >= 128) { KArgP ka = kargs(); pg8::Gemm g{WSP(WS_P16) + (size_t)l * M * PLED, WSP(WS_WPP) + (size_t)l * D * PLED, M, D, PLED}; pg8::StaticOrder S; S.init(M, D, split ? 128 : G, split ? bx - 128 : bx);
            pg8::EpiBf16 E{l ? SLOT(0) : SLOT(4), D};
            pg8::gemm_phase<pg8::EpiBf16, pg8::StaticOrder, true, false>(lds + RING_OFF, g, S, E, wave); }
    }
    SEAM(pb);
    if (IN(pb + 1)) { KArgP ka = kargs(); PH_IDS(); select_phase((const float*)(ka->ws + WS_LOG), IN_F(I_BRG) + l * 4, IN_F(I_BRE) + l * 32, SSQ(l ? 4 : 1), CNT(l),
                                   (int*)(ka->ws + WS_LIST), (float*)(ka->ws + WS_RP), (i32x4*)(ka->ws + WS_TI), (f32x2*)(ka->ws + WS_TW), (LAS int*)(lds + L_HIST), vcu, G, tid); }
    SEAM(pb + 1);
    if (IN(pb + 2)) DUPLOOP(pb + 2) { KArgP ka = kargs(); PH_IDS(); const GroupedOrder S = grouped_setup(CNT(l), (const int*)(ka->ws + WS_LIST), lds, true, 1, G, bx, tid, lane, wave);
        pg8::Gemm g{l ? XBB : XBA, WSP(l ? WS_WGU1 : WS_WGU), M, 512, D}; pg8::EpiGU E{ACTB, (const float*)(ka->ws + WS_RP)};
        pg8::gemm_phase<pg8::EpiGU, GroupedOrder, true, true>(lds + RING_OFF, g, S, E, wave);
        if (l == 0) {
            const int nbusy = S.ntu > 2 * G ? S.ntu - 2 * G : 0, nfree = G - nbusy;
            if (nfree <= 0 || bx >= nbusy) { const int w0 = (nfree > 0 ? bx - nbusy : bx) * NWAVES + wave, nw = (nfree > 0 ? nfree : G) * NWAVES;
                LAS float* scr2 = (LAS float*)(lds + RING_OFF + wave * 16384);
                for (int it = w0; it < MOE_ITEMS; it += nw) moe_item(IN_F(I_WG), IN_F(I_WU), IN_F(I_WDN), IN_F(I_NFFN) + D, 1, WSP(WS_WGU1), WSP(WS_WD1), it, scr2, lane); } }
    }
    SEAM(pb + 2);
    if (IN(pb + 3)) DUPLOOP(pb + 3) { KArgP ka = kargs(); PH_IDS(); const GroupedOrder S = grouped_setup(CNT(l), (const int*)(ka->ws + WS_LIST), lds, false, 2, G, bx, tid, lane, wave);
        pg8::Gemm g{ACTB, WSP(l ? WS_WD1 : WS_WD), PADROWS, D, FE}; pg8::EpiBf16 E{SLOT(1), D};
        pg8::gemm_phase<pg8::EpiBf16, GroupedOrder, true, false>(lds + RING_OFF, g, S, E, wave); }
    SEAM(pb + 3);
    if (IN(pb + 4)) {
        { KArgP ka = kargs(); PH_IDS(); row_moe(l ? XBB : XBA, l ? SLOT(4) : XBA, SLOT(1), (const i32x4*)(ka->ws + WS_TI), (const f32x2*)(ka->ws + WS_TW), CNT(l), SSQ(l ? 5 : 2), gw, NGW, lane); }
    }
    SEAM(pb + 4);
    if (IN(pb + 5)) {
        if (l == 0) { KArgP ka = kargs(); PH_IDS(); pg8::Gemm g{XBA, WSP(WS_WPG), M, D, D}; pg8::StaticOrder S; S.init(M, D, G, bx);
          pg8::EpiPle<false> E{XBA, SLOT(4), XBB, nullptr, SSQ(2), SSQ(3)};
          pg8::gemm_phase<pg8::EpiPle<false>, pg8::StaticOrder, true, false>(lds + RING_OFF, g, S, E, wave); }
        else { KArgP ka = kargs(); PH_IDS(); pg8::Gemm g{SLOT(4), WSP(WS_WPG) + (size_t)D * D, M, D, D}; pg8::StaticOrder S; S.init(M, D, G, bx);
          pg8::EpiPle<true> E{SLOT(4), SLOT(0), nullptr, ka->out, SSQ(5), SSQ(6)};
          pg8::gemm_phase<pg8::EpiPle<true>, pg8::StaticOrder, true, false>(lds + RING_OFF, g, S, E, wave); }
    }
    SEAM(pb + 5);
}
__global__ void __launch_bounds__(NWAVES * 64, 2) mk_fwd(Args args) {
    extern __shared__ __attribute__((aligned(16))) unsigned char lds_raw[];
    LAS unsigned char* lds = (LAS unsigned char*)lds_raw;
    const int tid0 = threadIdx.x, wave = __builtin_amdgcn_readfirstlane(tid0 >> 6);
    const int G = gridDim.x; const int bx = blockIdx.x; const int vcu = (G % 8 == 0) ? (bx % 8) * (G / 8) + bx / 8 : bx;
    const int gw = vcu * NWAVES + wave, NGW = G * NWAVES, NTHR = G * NWAVES * 64;
    gu32* ctl = (gu32*)(args.ws + WS_CTL);
    for (int u = tid0; u < (LDS_BYTES - LDSCTL_OFF) / 4; u += NWAVES * 64) ((LAS unsigned*)(lds + LDSCTL_OFF))[u] = 0u;
    __syncthreads();
    XcdBarrier bar = xcd_barrier_post((unsigned*)ctl + CW_BAR, (volatile LAS unsigned*)(lds + L_MISC) + 8);
    const int lo = args.ph_lo, hi = args.ph_hi;
#ifdef MK_PROBE
    if (blockIdx.x == 0 && threadIdx.x == 0) __hip_atomic_store((unsigned*)(args.ws + WS_CTL) + CW_TS, (unsigned)__builtin_amdgcn_s_memrealtime(), RLX_AGENT);
#endif
    LAS float* scr = (LAS float*)(lds + RING_OFF + wave * 16384);

    if (IN(0)) DUPLOOP(0) {
        constexpr int I1 = 16 * 64, I2 = 16 * 32, I3 = 16 * 96, I4 = 16 * 32, I5 = 16 * 32, I6 = 4 * 32;
        constexpr int NIT = I1 + I2 + I3 + I4 + 2 * I5 + 2 * I6;
        { KArgP ka = kargs(); PH_IDS();
          for (int it = gw; it < NIT + MOE_ITEMS; it += NGW) {
            int r = it;
            if (r < I1) { tr_plain<true>(IN_F(I_CW1), D, 2048, WSP(WS_WPW1), r, IN_F(I_NMIX), scr, lane); continue; } r -= I1;
            if (r < I2) { tr_plain(IN_F(I_CW2), D, D, WSP(WS_WPW2), r, nullptr, scr, lane); continue; } r -= I2;
            if (r < I3) { tr_plain(IN_F(I_WQKV), D, NQKV, WSP(WS_WQKV), r, IN_F(I_NMIX) + D, scr, lane); continue; } r -= I3;
            if (r < I4) { tr_plain(IN_F(I_WO), D, D, WSP(WS_WO), r, nullptr, scr, lane); continue; } r -= I4;
            if (r < 2 * I5) { const int l = r / I5; tr_plain(IN_F(I_PWG) + (size_t)l * D * D, D, D, WSP(WS_WPG) + (size_t)l * D * D, r % I5, IN_F(I_PNORM) + l * D, scr, lane); continue; } r -= 2 * I5;
            if (r < 2 * I6) { const int l = r / I6; tr_plain(IN_F(I_PWP) + (size_t)l * PLED * D, PLED, D, WSP(WS_WPP) + (size_t)l * D * PLED, r % I6, nullptr, scr, lane); continue; } r -= 2 * I6;
            moe_item(IN_F(I_WG), IN_F(I_WU), IN_F(I_WDN), IN_F(I_NFFN), 0, WSP(WS_WGU), WSP(WS_WD), r, scr, lane);
          } }
        { KArgP ka = kargs(); PH_IDS(); const float* wrg = IN_F(I_WRG); const float* wre = IN_F(I_WRE); const float* gf = IN_F(I_NFFN); bf16* Wr = WSP(WS_WR);
          for (int idx = gtid; idx < 2 * 256 * 1024; idx += NTHR) { const int l = idx >> 18, row = (idx >> 10) & 255, k = idx & 1023; float v = 0.f;
              if (row < 4) v = wrg[((size_t)l * D + k) * 4 + row]; else if (row < 36) { const int g = (row - 4) >> 3, e = (row - 4) & 7; v = wre[(((size_t)l * 4 + g) * D + k) * 8 + e]; }
              Wr[idx] = (bf16)f2bf(v * gf[l * D + k]); } }
        { KArgP ka = kargs(); PH_IDS(); const f32x4* p4 = (const f32x4*)ka->in[I_P]; u32x2* o = (u32x2*)WSP(WS_P16);
          for (int idx = gtid; idx < 2 * M * PLED / 4; idx += NTHR) { const f32x4 v = p4[idx]; o[idx] = (u32x2){pk2(v.x, v.y), pk2(v.z, v.w)}; } }
        { KArgP ka = kargs(); PH_IDS(); row_cvt(IN_F(I_X), XBA, SSQ(0), gw, NGW, lane); }
    }
    SEAM(0);
    if (IN(1)) DUPLOOP(1) { KArgP ka = kargs(); PH_IDS(); pg8::Gemm g{XBA, WSP(WS_WPW1), M, 2048, D}; pg8::StaticOrder S; S.init(M, 2048, G, bx);
        pg8::EpiGLU E{SLOT(0), IN_F(I_CB1), SSQ(0)};
        pg8::gemm_phase<pg8::EpiGLU, pg8::StaticOrder, true, false>(lds + RING_OFF, g, S, E, wave); }
    SEAM(1);
    if (IN(2)) DUPLOOP(2) { KArgP ka = kargs(); PH_IDS(); conv_phase(SLOT(0), SLOT(1), IN_F(I_CDW), IN_F(I_CBDW), IN_F(I_CLNG), IN_F(I_CLNB), lds + RING_OFF, vcu, G, tid, lane, wave); }
    SEAM(2);
    if (IN(3)) { KArgP ka = kargs(); PH_IDS(); pg8::Gemm g{SLOT(1), WSP(WS_WPW2), M, D, D}; pg8::StaticOrder S; S.init(M, D, G, bx);
        pg8::EpiRes E{XBA, IN_F(I_CB2), SSQ(1)};
        pg8::gemm_phase<pg8::EpiRes, pg8::StaticOrder, true, false>(lds + RING_OFF, g, S, E, wave); }
    SEAM(3);
#ifdef MK_XBAR
    xcd_barrier(bar); xcd_barrier(bar); xcd_barrier(bar); xcd_barrier(bar); xcd_barrier(bar); xcd_barrier(bar); xcd_barrier(bar); xcd_barrier(bar); xcd_barrier(bar); xcd_barrier(bar);
#endif
    layer_tail<0>(lds, bar, lo, hi, wave, G, bx, vcu, gw, NGW, NTHR);
    if (IN(10)) DUPLOOP(10) { KArgP ka = kargs(); PH_IDS(); pg8::Gemm g{XBB, WSP(WS_WQKV), M, NQKV, D}; pg8::StaticOrder S; S.init(M, NQKV, G, bx);
        pg8::EpiQKV E{SLOT(0), (size_t)(WS_SS / 2), SSQ(3), (const int*)ka->in[I_POS], 1.0f};
        pg8::gemm_phase<pg8::EpiQKV, pg8::StaticOrder, true, false>(lds + RING_OFF, g, S, E, wave); }
    SEAM(10);
    if (IN(11)) DUPLOOP(11) { KArgP ka = kargs(); const attn2::Tensors AT{(const attn2::bf16*)SLOT(0), (const attn2::bf16*)SLOT(1), (const attn2::bf16*)SLOT(2), (attn2::bf16*)SLOT(3), (attn2::bf16*)SLOT(4)};
        attn2::attn_phase((char*)lds_raw + RING_OFF, AT, vcu, G, wave); }
    SEAM(11);
    if (IN(12)) DUPLOOP(12) { KArgP ka = kargs(); PH_IDS(); combine_phase(SLOT(3), SLOT(4), SLOT(0), IN_F(I_LAM), IN_F(I_SUBLN), gw, NGW, lane); }
    SEAM(12);
    if (IN(13)) { KArgP ka = kargs(); PH_IDS(); pg8::Gemm g{SLOT(0), WSP(WS_WO), M, D, D}; pg8::StaticOrder S; S.init(M, D, G, bx);
        pg8::EpiRes E{XBB, nullptr, SSQ(4)};
        pg8::gemm_phase<pg8::EpiRes, pg8::StaticOrder, true, false>(lds + RING_OFF, g, S, E, wave); }
    SEAM(13);
    layer_tail<1>(lds, bar, lo, hi, wave, G, bx, vcu, gw, NGW, NTHR);
    if (IN(20)) { KArgP ka = kargs(); PH_IDS(); row_final(ka->out, SSQ(6), IN_F(I_FNORM), gw, NGW, lane);
#ifdef MK_PROBE
        { __syncthreads(); const unsigned* ts = (const unsigned*)(ka->ws + WS_CTL) + CW_TS;
          const float us1 = (float)(__hip_atomic_load(ts + MK_PROBE_B1, RLX_AGENT) - __hip_atomic_load(ts + MK_PROBE_A1, RLX_AGENT)) * 0.01f, us2 = (float)(__hip_atomic_load(ts + MK_PROBE_B2, RLX_AGENT) - __hip_atomic_load(ts + MK_PROBE_A2, RLX_AGENT)) * 0.01f;
          const float sc = 1.f + us1 / (float)(MK_PROBE_S1);
          VM_WAIT(); __syncthreads();
          for (int m = gw; m < M; m += NGW) { GAS f32x4* xr = (GAS f32x4*)(ka->out + (size_t)m * D) + lane;
              for (int j = 0; j < 4; ++j) { f32x4 v = xr[64 * j]; v = v * sc; if (m == 0 && j == 0 && lane == 0) v.x = us2 * (float)(MK_PROBE_S2); xr[64 * j] = v; } } }
#endif
    }
#undef IN
#undef SEAM
}

extern "C" void kernel_launch(void* const* d_in, const int* in_sizes, int n_in, void* d_out, int out_size, void* d_ws, size_t ws_size, hipStream_t stream) {
    static int grid = 0;
    if (grid == 0) {
        if (n_in != N_IN || in_sizes[0] != M * D || out_size != M * D || ws_size < WS_END) { fprintf(stderr, "kernel_launch: unexpected problem: n_in %d in0 %d out %d ws %zu (need %zu); nothing launched\n", n_in, n_in > 0 ? in_sizes[0] : -1, out_size, ws_size, (size_t)WS_END); grid = -1; return; }
        int dev = 0, cus = 0, per_cu = 0;
        if (hipGetDevice(&dev) != hipSuccess || hipDeviceGetAttribute(&cus, hipDeviceAttributeMultiprocessorCount, dev) != hipSuccess) { grid = -1; return; }
        if (hipFuncSetAttribute((const void*)mk_fwd, hipFuncAttributeMaxDynamicSharedMemorySize, LDS_BYTES) != hipSuccess) { fprintf(stderr, "kernel_launch: hipFuncSetAttribute failed\n"); grid = -1; return; }
        if (hipOccupancyMaxActiveBlocksPerMultiprocessor(&per_cu, (const void*)mk_fwd, NWAVES * 64, LDS_BYTES) != hipSuccess || per_cu < 1) { fprintf(stderr, "kernel_launch: occupancy query says %d\n", per_cu); }
        (void)hipGetLastError();
        grid = cus;
        if (grid > 256) grid = 256;
    }
    if (grid < 0) return;
    if (hipMemsetAsync((char*)d_ws + WS_CTL, 0, CTL_ZERO_BYTES, stream) != hipSuccess) return;
    Args a{};
    for (int i = 0; i < N_IN; ++i) a.in[i] = d_in[i];
    a.out = (float*)d_out; a.ws = (unsigned char*)d_ws;
#if MK_SPLIT
    for (int ph = 0; ph < NPHASE; ++ph) { a.ph_lo = ph; a.ph_hi = ph + 1; hipLaunchKernelGGL(mk_fwd, dim3(grid), dim3(NWAVES * 64), LDS_BYTES, stream, a); }
#else
    a.ph_lo = 0; a.ph_hi = NPHASE; hipLaunchKernelGGL(mk_fwd, dim3(grid), dim3(NWAVES * 64), LDS_BYTES, stream, a);
#endif
}
```

```cpp
#include <hip/hip_runtime.h>
#include <hip/hip_bf16.h>
#include <cstdio>
#include <cstdint>
#include <cmath>

#ifndef MK_SPLIT
#define MK_SPLIT 0
#endif

namespace pg8 {
#define PG8_LAS __attribute__((address_space(3)))
typedef unsigned short bf16_t;
typedef short bf16x8 __attribute__((ext_vector_type(8)));
typedef float f32x4 __attribute__((ext_vector_type(4)));
typedef unsigned u32x4 __attribute__((ext_vector_type(4)));
constexpr int BM = 256, BK = 64, HALF = 128, HTB = HALF * BK * 2  , STAGE_BYTES = 8 * HTB, NXCD = 8, WGM = 8;

__host__ __device__ __forceinline__ int lds_byte(int r, int c) { const int st = (r >> 4) * 2 + (c >> 5), rr = r & 15, cc = c & 31, ob = rr * 64 + cc * 2; return st * 1024 + (ob ^ (((ob >> 9) & 1) << 5)); }
__host__ __device__ __forceinline__ void stage_rc(int b, int& R, int& C) { const int st = b / 1024, sb = b % 1024, swz = sb ^ (((sb >> 9) & 1) << 5); R = (st >> 1) * 16 + swz / 64; C = (st & 1) * 32 + (swz % 64) / 2; }
__host__ __device__ __forceinline__ int perm32(int rho) { const int n = rho >> 4, i = rho & 15; return 8 * (i >> 2) + 4 * n + (i & 3); }

__device__ __forceinline__ int ltid(int wave) { int t; asm volatile("v_mbcnt_lo_u32_b32 %0, -1, 0\n\tv_mbcnt_hi_u32_b32 %0, -1, %0" : "=&v"(t)); return wave * 64 + t; }
struct Unit { int pm, pn, pb, aux; };
struct Gemm { const bf16_t* A; const bf16_t* Bt; int M, N, K; };

struct StaticOrder {
    int nM, nN, nwg, G, c;
    __host__ __device__ void init(int M, int N, int G_, int c_) { nM = M / BM; nN = N / BM; nwg = nM * nN; G = G_; c = c_; }
    __host__ __device__ bool next(int i, Unit& u) const {
        const long L = (long)i * G + c; if (L >= nwg) return false;
        int wgid = (int)L; { const int q = nwg / NXCD, r = nwg % NXCD, xcd = wgid % NXCD, off = wgid / NXCD; wgid = (xcd < r ? xcd * (q + 1) : r * (q + 1) + (xcd - r) * q) + off; }
        const int nig = WGM * nN, gid = wgid / nig, fm = gid * WGM, gsz = (nM - fm) < WGM ? (nM - fm) : WGM;
        u.pm = fm + ((wgid % nig) % gsz); u.pn = (wgid % nig) / gsz; u.pb = u.pn; u.aux = 0; return true;
    }
    __device__ __forceinline__ unsigned arow(int, int) const { return 0u; }
};

__device__ __forceinline__ unsigned cvt_pk_bf16(float lo, float hi) { unsigned r; asm volatile("v_cvt_pk_bf16_f32 %0, %1, %2" : "=v"(r) : "v"(lo), "v"(hi)); return r; }

typedef float f32x2e __attribute__((ext_vector_type(2)));
__device__ __forceinline__ float bf_lo(unsigned u) { return __builtin_bit_cast(float, u << 16); }
__device__ __forceinline__ float bf_hi(unsigned u) { return __builtin_bit_cast(float, u & 0xffff0000u); }
__device__ __forceinline__ float sigm_f(float x) { return __builtin_amdgcn_rcpf(1.f + __expf(-x)); }
__device__ __forceinline__ float silu_f(float x) { return x * sigm_f(x); }
__device__ __forceinline__ float ss_sum(const float* ssp, int row) { const f32x4* p = (const f32x4*)(ssp + (size_t)row * 16); const f32x4 a = p[0], b = p[1], c = p[2], d = p[3];
    return (((a[0] + a[1]) + (a[2] + a[3])) + ((b[0] + b[1]) + (b[2] + b[3]))) + (((c[0] + c[1]) + (c[2] + c[3])) + ((d[0] + d[1]) + (d[2] + d[3]))); }
__device__ __forceinline__ float rs_of(const float* ssp, int row) { return 1.f / sqrtf(ss_sum(ssp, row) * (1.f / 1024.f) + 1e-6f); }
__device__ __forceinline__ float rs_of_q(const float* ssp, int row, int fq) { const f32x4 a = *((const f32x4*)(ssp + (size_t)row * 16) + fq); float s = (a[0] + a[1]) + (a[2] + a[3]);
    s += __shfl_xor(s, 16); s += __shfl_xor(s, 32); return 1.f / sqrtf(s * (1.f / 1024.f) + 1e-6f); }
__device__ __forceinline__ u32x4 pack8(const f32x4& v0, const f32x4& v1) { u32x4 w; w.x = cvt_pk_bf16(v0[0], v0[1]); w.y = cvt_pk_bf16(v0[2], v0[3]); w.z = cvt_pk_bf16(v1[0], v1[1]); w.w = cvt_pk_bf16(v1[2], v1[3]); return w; }
__device__ __forceinline__ void unpack8(const u32x4& w, f32x4& v0, f32x4& v1) { v0 = (f32x4){bf_lo(w.x), bf_hi(w.x), bf_lo(w.y), bf_hi(w.y)}; v1 = (f32x4){bf_lo(w.z), bf_hi(w.z), bf_lo(w.w), bf_hi(w.w)}; }
__device__ __forceinline__ float sumsq8(const f32x4& a, const f32x4& b) { return (a[0] * a[0] + a[1] * a[1]) + (a[2] * a[2] + a[3] * a[3]) + (b[0] * b[0] + b[1] * b[1]) + (b[2] * b[2] + b[3] * b[3]); }
__device__ __forceinline__ void ss_put(float* ssp, int row, int slot, float part, int fq) { part += __shfl_xor(part, 16); part += __shfl_xor(part, 32); if (fq == 0) ssp[(size_t)row * 16 + slot] = part; }

struct EpiBf16 {
    static constexpr bool PERM = true;
    bf16_t* O; int ldc;
    __device__ __forceinline__ void operator()(const f32x4 (&acc)[2][2][4][2], const Unit& u, int wr, int wc, int fr, int fq) const {
        const int row0 = u.pm * BM + wr * 64 + fr, col0 = u.pn * BM + wc * 32 + 8 * fq;
#pragma unroll
        for (int ai = 0; ai < 2; ++ai)
#pragma unroll
            for (int m = 0; m < 4; ++m) { bf16_t* rowp = O + (size_t)(row0 + ai * HALF + m * 16) * ldc + col0;
#pragma unroll
                for (int bj = 0; bj < 2; ++bj) *(u32x4*)(rowp + bj * HALF) = pack8(acc[ai][bj][m][0], acc[ai][bj][m][1]); }
    }
};
struct EpiGLU {
    static constexpr bool PERM = true;
    bf16_t* O; const float* bias; const float* ss;
    __device__ __forceinline__ void operator()(const f32x4 (&acc)[2][2][4][2], const Unit& u, int wr, int wc, int fr, int fq) const {
        const int row0 = u.pm * BM + wr * 64 + fr, c0 = u.pn * HALF + wc * 32 + 8 * fq;
        const f32x4 ba0 = *(const f32x4*)(bias + c0), ba1 = *(const f32x4*)(bias + c0 + 4), bg0 = *(const f32x4*)(bias + 1024 + c0), bg1 = *(const f32x4*)(bias + 1024 + c0 + 4);
#pragma unroll
        for (int ai = 0; ai < 2; ++ai)
#pragma unroll
            for (int m = 0; m < 4; ++m) { const int row = row0 + ai * HALF + m * 16; const float r = rs_of_q(ss, row, fq);
                const f32x4 a0 = acc[ai][0][m][0] * r + ba0, a1 = acc[ai][0][m][1] * r + ba1, g0 = acc[ai][1][m][0] * r + bg0, g1 = acc[ai][1][m][1] * r + bg1;
                const f32x4 v0 = {a0[0] * sigm_f(g0[0]), a0[1] * sigm_f(g0[1]), a0[2] * sigm_f(g0[2]), a0[3] * sigm_f(g0[3])}, v1 = {a1[0] * sigm_f(g1[0]), a1[1] * sigm_f(g1[1]), a1[2] * sigm_f(g1[2]), a1[3] * sigm_f(g1[3])};
                *(u32x4*)(O + (size_t)row * 1024 + c0) = pack8(v0, v1); }
    }
};
struct EpiRes {
    static constexpr bool PERM = true;
    bf16_t* X; const float* bias; float* ss;
    __device__ __forceinline__ void operator()(const f32x4 (&acc)[2][2][4][2], const Unit& u, int wr, int wc, int fr, int fq) const {
        const int row0 = u.pm * BM + wr * 64 + fr, col0 = u.pn * BM + wc * 32 + 8 * fq;
        f32x4 bv[2][2];
#pragma unroll
        for (int bj = 0; bj < 2; ++bj)
#pragma unroll
            for (int n = 0; n < 2; ++n) bv[bj][n] = bias ? *(const f32x4*)(bias + col0 + bj * HALF + 4 * n) : (f32x4){0.f, 0.f, 0.f, 0.f};
#pragma unroll
        for (int ai = 0; ai < 2; ++ai)
#pragma unroll
            for (int m = 0; m < 4; ++m) { const int row = row0 + ai * HALF + m * 16; bf16_t* rowp = X + (size_t)row * 1024 + col0; float part = 0.f;
#pragma unroll
                for (int bj = 0; bj < 2; ++bj) { f32x4 x0, x1; unpack8(*(const u32x4*)(rowp + bj * HALF), x0, x1);
                    const f32x4 v0 = acc[ai][bj][m][0] + bv[bj][0] + x0, v1 = acc[ai][bj][m][1] + bv[bj][1] + x1; part += sumsq8(v0, v1);
                    *(u32x4*)(rowp + bj * HALF) = pack8(v0, v1); }
                ss_put(ss, row, u.pn * 4 + wc, part, fq); }
    }
};
template <bool F32OUT> struct EpiPle {
    static constexpr bool PERM = true;
    const bf16_t* Xin; const bf16_t* P; bf16_t* Xo; float* Fo; const float* ssin; float* ssout;
    __device__ __forceinline__ void operator()(const f32x4 (&acc)[2][2][4][2], const Unit& u, int wr, int wc, int fr, int fq) const {
        const int row0 = u.pm * BM + wr * 64 + fr, col0 = u.pn * BM + wc * 32 + 8 * fq;
#pragma unroll
        for (int ai = 0; ai < 2; ++ai)
#pragma unroll
            for (int m = 0; m < 4; ++m) { const int row = row0 + ai * HALF + m * 16; const size_t off = (size_t)row * 1024 + col0; const float r = rs_of_q(ssin, row, fq); float part = 0.f;
#pragma unroll
                for (int bj = 0; bj < 2; ++bj) { f32x4 x0, x1, p0, p1; unpack8(*(const u32x4*)(Xin + off + bj * HALF), x0, x1); unpack8(*(const u32x4*)(P + off + bj * HALF), p0, p1);
                    const f32x4 a0 = acc[ai][bj][m][0] * r, a1 = acc[ai][bj][m][1] * r;
                    const f32x4 v0 = {x0[0] + sigm_f(a0[0]) * p0[0], x0[1] + sigm_f(a0[1]) * p0[1], x0[2] + sigm_f(a0[2]) * p0[2], x0[3] + sigm_f(a0[3]) * p0[3]};
                    const f32x4 v1 = {x1[0] + sigm_f(a1[0]) * p1[0], x1[1] + sigm_f(a1[1]) * p1[1], x1[2] + sigm_f(a1[2]) * p1[2], x1[3] + sigm_f(a1[3]) * p1[3]};
                    part += sumsq8(v0, v1);
                    if (F32OUT) { *(f32x4*)(Fo + off + bj * HALF) = v0; *(f32x4*)(Fo + off + bj * HALF + 4) = v1; } else *(u32x4*)(Xo + off + bj * HALF) = pack8(v0, v1); }
                ss_put(ssout, row, u.pn * 4 + wc, part, fq); }
    }
};
struct EpiLogits {
    static constexpr bool PERM = false;
    float* O; const float* ss;
    __device__ __forceinline__ void operator()(const f32x4 (&acc)[2][2][4][2], const Unit& u, int wr, int wc, int fr, int fq) const {
        if (wc < 2) {
            const int row0 = u.pm * BM + wr * 64 + fr;
#pragma unroll
            for (int ai = 0; ai < 2; ++ai)
#pragma unroll
                for (int m = 0; m < 4; ++m) { const int row = row0 + ai * HALF + m * 16; const float r = rs_of_q(ss, row, fq);
#pragma unroll
                    for (int n = 0; n < 2; ++n) *(f32x4*)(O + (size_t)row * 64 + wc * 32 + n * 16 + 4 * fq) = acc[ai][0][m][n] * r; }
        }
    }
};
struct EpiGU {
    static constexpr bool PERM = true;
    bf16_t* O; const float* rp;
    __device__ __forceinline__ void operator()(const f32x4 (&acc)[2][2][4][2], const Unit& u, int wr, int wc, int fr, int fq) const {
        const int trow0 = wr * 64 + fr, col0 = u.pn * HALF + wc * 32 + 8 * fq;
#pragma unroll
        for (int ai = 0; ai < 2; ++ai)
#pragma unroll
            for (int m = 0; m < 4; ++m) { const int trow = trow0 + ai * HALF + m * 16; const float r = rp[(size_t)u.aux + trow];
                const f32x4 g0 = acc[ai][0][m][0] * r, g1 = acc[ai][0][m][1] * r, u0 = acc[ai][1][m][0] * r, u1 = acc[ai][1][m][1] * r;
                const f32x4 v0 = {silu_f(g0[0]) * u0[0], silu_f(g0[1]) * u0[1], silu_f(g0[2]) * u0[2], silu_f(g0[3]) * u0[3]}, v1 = {silu_f(g1[0]) * u1[0], silu_f(g1[1]) * u1[1], silu_f(g1[2]) * u1[2], silu_f(g1[3]) * u1[3]};
                *(u32x4*)(O + (size_t)(u.pm * BM + trow) * 256 + col0) = pack8(v0, v1); }
    }
};
struct EpiQKV {
    static constexpr bool PERM = true;
    bf16_t* O; size_t stride; const float* ss; const int* pos; float scaleq;
    __device__ __forceinline__ void operator()(const f32x4 (&acc)[2][2][4][2], const Unit& u, int wr, int wc, int fr, int fq) const {
        const int t = (u.pn * BM) >> 10, colt = (u.pn * BM) & 1023, row0 = u.pm * BM + wr * 64 + fr, col0 = colt + wc * 32 + 8 * fq;
        bf16_t* base = O + (size_t)t * stride; const float sc = (t == 0) ? scaleq : 1.f; const bool roped = (t < 2) && ((wc & 1) == 0);
#pragma unroll
        for (int ai = 0; ai < 2; ++ai)
#pragma unroll
            for (int m = 0; m < 4; ++m) { const int row = row0 + ai * HALF + m * 16; const float r = rs_of_q(ss, row, fq) * sc;
                float cs[8], sn[8];
                if (roped) { const float fp = (float)pos[row];
#pragma unroll
                    for (int i = 0; i < 8; ++i) { const float invf = __builtin_powf(500000.0f, -(float)i / 8.0f); const float ang = fp * invf, rev = ang * 0.15915494309189535f, fr_ = rev - __builtin_floorf(rev);
                        sn[i] = __builtin_amdgcn_sinf(fr_); cs[i] = __builtin_amdgcn_cosf(fr_); if (fq == 0) sn[i] = -sn[i]; } }
#pragma unroll
                for (int bj = 0; bj < 2; ++bj) { f32x4 v0 = acc[ai][bj][m][0] * r, v1 = acc[ai][bj][m][1] * r;
                    if (roped) { float pv[8];
#pragma unroll
                        for (int i = 0; i < 4; ++i) { pv[i] = __shfl_xor(v0[i], 16); pv[4 + i] = __shfl_xor(v1[i], 16); }
                        if (fq < 2) {
#pragma unroll
                            for (int i = 0; i < 4; ++i) { v0[i] = v0[i] * cs[i] + pv[i] * sn[i]; v1[i] = v1[i] * cs[4 + i] + pv[4 + i] * sn[4 + i]; } } }
                    *(u32x4*)(base + (size_t)row * 1024 + col0 + bj * HALF) = pack8(v0, v1); } }
    }
};

template <class Epi, class Sched, bool ALIGN_EPI, bool GATHER>
__device__ __forceinline__ void gemm_phase(PG8_LAS unsigned char* lds, const Gemm g, const Sched& S, const Epi& E, int wave_) {
    const int tid = ltid(wave_), wid = wave_, lane = tid & 63, wr = wid >> 2, wc = wid & 3, fr = lane & 15, fq = lane >> 4;
    const int K = g.K, nt = K / BK;
    unsigned voffA[2], voffB[2]; int sR[2], sC[2];
#pragma unroll
    for (int i = 0; i < 2; ++i) { int R, C; stage_rc(tid * 16 + i * 8192, R, C); const int Rb = Epi::PERM ? ((R & ~31) + perm32(R & 31)) : R;
        sR[i] = R; sC[i] = C; voffA[i] = (unsigned)(R * K + C) * 2u; voffB[i] = (unsigned)(Rb * K + C) * 2u; }
    const size_t kstep = (size_t)(BK * 2);
    const size_t hstep = (size_t)HALF * K * 2;
    const size_t tstep = 2 * hstep;
    const unsigned ldsw = (unsigned)wid * 1024u;
    const int aoff = lds_byte(wr * 64 + fr, fq * 8), boff = lds_byte(wc * 32 + fr, fq * 8);
#define PG8_SA(b, h) (((b) * 2 + (h)) * HTB)
#define PG8_SB(b, h) ((4 + (b) * 2 + (h)) * HTB)
#define PG8_STAGE(bufoff, gbase, voff) do { _Pragma("unroll") for (int _i = 0; _i < 2; ++_i) \
        __builtin_amdgcn_global_load_lds((const unsigned*)((const char*)(gbase) + (voff)[_i]), (PG8_LAS unsigned*)(lds + (bufoff) + ldsw + _i * 8192), 16, 0, 0); } while (0)
#define PG8_STAGE_A(bufoff, base, kb, h, vv) do { _Pragma("unroll") for (int _i = 0; _i < 2; ++_i) { \
        const char* _p = GATHER ? ((const char*)g.A + (kb) + (vv)[h][_i]) : ((const char*)(base) + (kb) + (size_t)(h) * hstep + voffA[_i]); \
        __builtin_amdgcn_global_load_lds((const unsigned*)_p, (PG8_LAS unsigned*)(lds + (bufoff) + ldsw + _i * 8192), 16, 0, 0); } } while (0)
#define PG8_GOFF(vv, ord) do { _Pragma("unroll") for (int _h = 0; _h < 2; ++_h) _Pragma("unroll") for (int _i = 0; _i < 2; ++_i) \
        (vv)[_h][_i] = S.arow((ord), _h * HALF + sR[_i]) * (unsigned)(K * 2) + (unsigned)(sC[_i] * 2); } while (0)
#define PG8_LDA(dst, b, h) do { _Pragma("unroll") for (int m = 0; m < 4; ++m) _Pragma("unroll") for (int k = 0; k < 2; ++k) dst[m][k] = *(const PG8_LAS bf16x8*)(lds + PG8_SA(b, h) + aoff + m * 2048 + k * 1024); } while (0)
#define PG8_LDB(dst, b, h) do { _Pragma("unroll") for (int n = 0; n < 2; ++n) _Pragma("unroll") for (int k = 0; k < 2; ++k) dst[n][k] = *(const PG8_LAS bf16x8*)(lds + PG8_SB(b, h) + boff + n * 2048 + k * 1024); } while (0)
#define PG8_MMA(ai, bj, At, Bt) do { __builtin_amdgcn_s_setprio(1); _Pragma("unroll") for (int m = 0; m < 4; ++m) _Pragma("unroll") for (int n = 0; n < 2; ++n) _Pragma("unroll") for (int k = 0; k < 2; ++k) \
        acc[ai][bj][m][n] = __builtin_amdgcn_mfma_f32_16x16x32_bf16(Bt[n][k], At[m][k], acc[ai][bj][m][n], 0, 0, 0); __builtin_amdgcn_s_setprio(0); } while (0)
#define PG8_WAIT_V(n) asm volatile("s_waitcnt vmcnt(" #n ")" ::: "memory")
#define PG8_WAIT_L(n) asm volatile("s_waitcnt lgkmcnt(" #n ")" ::: "memory")
#define PG8_BAR __builtin_amdgcn_s_barrier()
#define PG8_SCHED __builtin_amdgcn_sched_barrier(0)
    Unit cur, nxt; int ui = 0;
    if (!S.next(0, cur)) return;
    f32x4 acc[2][2][4][2];
#pragma unroll
    for (int a = 0; a < 2; ++a)
#pragma unroll
        for (int b = 0; b < 2; ++b)
#pragma unroll
            for (int m = 0; m < 4; ++m)
#pragma unroll
                for (int n = 0; n < 2; ++n) acc[a][b][m][n] = (f32x4){0.f, 0.f, 0.f, 0.f};
    bf16x8 At[4][2], B0[2][2], B1[2][2];
    unsigned vA[2][2] = {{0u, 0u}, {0u, 0u}}, vN[2][2] = {{0u, 0u}, {0u, 0u}}, vS[2][2] = {{0u, 0u}, {0u, 0u}};
    if constexpr (GATHER) { PG8_GOFF(vA, 0); }
    const char* cA = GATHER ? (const char*)g.A : (const char*)g.A + (size_t)cur.pm * tstep; const char* cB = (const char*)g.Bt + (size_t)cur.pb * tstep;
    PG8_STAGE(PG8_SB(0, 0), cB, voffB); PG8_STAGE(PG8_SB(0, 1), cB + hstep, voffB); PG8_STAGE_A(PG8_SA(0, 0), cA, 0, 0, vA); PG8_STAGE_A(PG8_SA(0, 1), cA, 0, 1, vA);
    if (wr == 1) PG8_BAR;
    PG8_WAIT_V(2); PG8_BAR;
    PG8_STAGE(PG8_SB(1, 0), cB + kstep, voffB); PG8_STAGE_A(PG8_SA(1, 0), cA, kstep, 0, vA); PG8_STAGE(PG8_SB(1, 1), cB + hstep + kstep, voffB);
    PG8_WAIT_V(6); PG8_BAR;
    for (;;) {
        const bool has_next = S.next(ui + 1, nxt);
        if constexpr (GATHER) { if (has_next) { PG8_GOFF(vN, ui + 1); } else { _Pragma("unroll") for (int _h = 0; _h < 2; ++_h) _Pragma("unroll") for (int _i = 0; _i < 2; ++_i) vN[_h][_i] = vA[_h][_i]; } }
        const char* nA = (has_next && !GATHER) ? (const char*)g.A + (size_t)nxt.pm * tstep : cA; const char* nB = has_next ? (const char*)g.Bt + (size_t)nxt.pb * tstep : cB;
        for (int t = 0; t < nt; t += 2) {
            const bool last = (t == nt - 2);
            const size_t kb1 = (size_t)(t + 1) * kstep, kb2 = last ? (size_t)0 : (size_t)(t + 2) * kstep, kb3 = kb2 + kstep;
            const char* sA = last ? nA : cA; const char* b2 = last ? nB : cB + (size_t)(t + 2) * kstep; const char* b3 = b2 + kstep;
            if constexpr (GATHER) { _Pragma("unroll") for (int _h = 0; _h < 2; ++_h) _Pragma("unroll") for (int _i = 0; _i < 2; ++_i) vS[_h][_i] = last ? vN[_h][_i] : vA[_h][_i]; }
            PG8_LDB(B0, 0, 0); PG8_LDB(B1, 0, 1); PG8_SCHED; PG8_LDA(At, 0, 0); PG8_STAGE_A(PG8_SA(1, 1), cA, kb1, 1, vA);
            PG8_WAIT_V(8); PG8_WAIT_L(0); PG8_BAR; PG8_MMA(0, 0, At, B0); PG8_MMA(0, 1, At, B1); PG8_BAR; PG8_SCHED;
            PG8_LDA(At, 0, 1); PG8_STAGE(PG8_SB(0, 0), b2, voffB); PG8_STAGE(PG8_SB(0, 1), b2 + hstep, voffB); PG8_STAGE_A(PG8_SA(0, 0), sA, kb2, 0, vS);
            PG8_WAIT_V(8); PG8_WAIT_L(0); PG8_BAR; PG8_MMA(1, 0, At, B0); PG8_MMA(1, 1, At, B1); PG8_BAR; PG8_SCHED;
            PG8_LDB(B0, 1, 0); PG8_LDB(B1, 1, 1); PG8_SCHED; PG8_LDA(At, 1, 0); PG8_STAGE_A(PG8_SA(0, 1), sA, kb2, 1, vS);
            PG8_WAIT_V(8); PG8_WAIT_L(0); PG8_BAR; PG8_MMA(0, 0, At, B0); PG8_MMA(0, 1, At, B1); PG8_BAR; PG8_SCHED;
            PG8_LDA(At, 1, 1); PG8_STAGE(PG8_SB(1, 0), b3, voffB); PG8_STAGE(PG8_SB(1, 1), b3 + hstep, voffB); PG8_STAGE_A(PG8_SA(1, 0), sA, kb3, 0, vS);
            PG8_WAIT_V(8); PG8_WAIT_L(0); PG8_BAR; PG8_MMA(1, 0, At, B0); PG8_MMA(1, 1, At, B1); PG8_BAR; PG8_SCHED;
        }
        if constexpr (ALIGN_EPI) { if (wr == 0) PG8_BAR; }
        E(acc, cur, wr, wc, fr, fq);
        if (!has_next) break;
#pragma unroll
        for (int a = 0; a < 2; ++a)
#pragma unroll
            for (int b = 0; b < 2; ++b)
#pragma unroll
                for (int m = 0; m < 4; ++m)
#pragma unroll
                    for (int n = 0; n < 2; ++n) acc[a][b][m][n] = (f32x4){0.f, 0.f, 0.f, 0.f};
        cur = nxt; cA = nA; cB = nB; ++ui;
        if constexpr (GATHER) { _Pragma("unroll") for (int _h = 0; _h < 2; ++_h) _Pragma("unroll") for (int _i = 0; _i < 2; ++_i) vA[_h][_i] = vN[_h][_i]; }
        if constexpr (ALIGN_EPI) { if (wr == 1) PG8_BAR; }
    }
    PG8_WAIT_V(0);
    if constexpr (!ALIGN_EPI) { if (wr == 0) PG8_BAR; }
    PG8_BAR;
#undef PG8_SA
#undef PG8_SB
#undef PG8_STAGE
#undef PG8_STAGE_A
#undef PG8_GOFF
#undef PG8_LDA
#undef PG8_LDB
#undef PG8_MMA
#undef PG8_WAIT_V
#undef PG8_WAIT_L
#undef PG8_BAR
#undef PG8_SCHED
}
}

#include <hip/hip_bf16.h>
#include <cmath>
namespace attn3 {
using bf16=__hip_bfloat16;
using bf16x8=__attribute__((ext_vector_type(8)))short;
using s16x4=__attribute__((ext_vector_type(4)))short;
using f32x16=__attribute__((ext_vector_type(16)))float;
using u32x4=__attribute__((ext_vector_type(4)))unsigned;
constexpr int BATCH=8,SEQ=4096,D=64,DV=128,DM=1024;
constexpr int NW=8,QBLK=32,QB=QBLK*NW,KVBLK=64,NQB=SEQ/QB;
__device__ __forceinline__ int crow(int r,int hi){return (r&3)+8*(r>>2)+4*hi;}
#define SBAR() __builtin_amdgcn_sched_barrier(0)
__device__ __forceinline__ void cmask(f32x16&p0,f32x16&p1,int jb,int qrel,int hi){
  const float NEG=-INFINITY; int kb=64*jb+4*hi;
  #pragma unroll
  for(int r=0;r<16;++r){int kv=kb+(r&3)+8*(r>>2); if(kv>qrel)p0[r]=NEG; if(kv+32>qrel)p1[r]=NEG;}
}

constexpr int NSLOT=3, SLOTB=8192;
constexpr int VSLOTB=2*SLOTB;
constexpr int LDS_K=0, LDS_V=NSLOT*SLOTB, LDS_WS=LDS_V+NSLOT*VSLOTB, LDS_OST=LDS_WS+NW*64*4, LDS_BYTES=LDS_OST+NW*4096;
constexpr float C2=0.125f*1.4426950408889634f;
__device__ __forceinline__ void glds16(const void*gsrc,unsigned lds_dst){unsigned keep;
  asm volatile("s_mov_b32 %0, m0\n\ts_mov_b32 m0, %2\n\ts_nop 0\n\tglobal_load_lds_dwordx4 %1, off\n\ts_mov_b32 m0, %0":"=&s"(keep):"v"(gsrc),"s"(lds_dst):"memory");}
__device__ __forceinline__ float max3f(float a,float b,float c){float r;asm("v_max3_f32 %0, %1, %2, %3":"=v"(r):"v"(a),"v"(b),"v"(c));return r;}
__device__ __forceinline__ float max2f(float a,float b){float r;asm("v_max_f32_e32 %0, %1, %2":"=v"(r):"v"(a),"v"(b));return r;}
__device__ __forceinline__ float fadd_s(float a,float b){float r;asm("v_add_f32_e32 %0, %1, %2":"=v"(r):"v"(a),"v"(b));return r;}
__device__ __forceinline__ float fsub_s(float a,float b){float r;asm("v_sub_f32_e32 %0, %1, %2":"=v"(r):"v"(a),"v"(b));return r;}
typedef float f32x2_t __attribute__((ext_vector_type(2))); typedef __bf16 bf16x2_t __attribute__((ext_vector_type(2)));
__device__ __forceinline__ unsigned cvtpk_s(float lo,float hi){f32x2_t v={lo,hi};bf16x2_t b=__builtin_convertvector(v,bf16x2_t);return __builtin_bit_cast(unsigned,b);}
#define WAIT_BAR(N) asm volatile("s_waitcnt vmcnt(" #N ") lgkmcnt(0)\n\ts_barrier":::"memory")

__device__ __forceinline__ void qkt(f32x16&p0,f32x16&p1,const char*Kslot,const bf16x8*qr,int r32,int hi){
  const char*kb=Kslot+hi*1024+r32*16; const f32x16 z=f32x16{};
  #pragma unroll
  for(int d0=0;d0<4;++d0){
    const bf16x8 b0=*reinterpret_cast<const bf16x8*>(kb+d0*2048);
    const bf16x8 b1=*reinterpret_cast<const bf16x8*>(kb+d0*2048+512);
    if(d0==0){p0=__builtin_amdgcn_mfma_f32_32x32x16_bf16(b0,qr[0],z,0,0,0);p1=__builtin_amdgcn_mfma_f32_32x32x16_bf16(b1,qr[0],z,0,0,0);}
    else{p0=__builtin_amdgcn_mfma_f32_32x32x16_bf16(b0,qr[d0],p0,0,0,0);p1=__builtin_amdgcn_mfma_f32_32x32x16_bf16(b1,qr[d0],p1,0,0,0);}}
}
typedef __attribute__((address_space(3))) const char* lds_cptr;
typedef short v4i16_t __attribute__((ext_vector_type(4)));
__device__ __forceinline__ void kload8(bf16x8*kf,lds_cptr kp){
  kf[0]=*(const __attribute__((address_space(3))) bf16x8*)(kp);      kf[1]=*(const __attribute__((address_space(3))) bf16x8*)(kp+512);
  kf[2]=*(const __attribute__((address_space(3))) bf16x8*)(kp+2048); kf[3]=*(const __attribute__((address_space(3))) bf16x8*)(kp+2560);
  kf[4]=*(const __attribute__((address_space(3))) bf16x8*)(kp+4096); kf[5]=*(const __attribute__((address_space(3))) bf16x8*)(kp+4608);
  kf[6]=*(const __attribute__((address_space(3))) bf16x8*)(kp+6144); kf[7]=*(const __attribute__((address_space(3))) bf16x8*)(kp+6656);
}
__device__ __forceinline__ void kload2(bf16x8*kf,lds_cptr kp,int j){ kf[2*j]=*(const __attribute__((address_space(3))) bf16x8*)(kp+j*2048); kf[2*j+1]=*(const __attribute__((address_space(3))) bf16x8*)(kp+j*2048+512); }
__device__ __forceinline__ s16x4 vtr(lds_cptr p){ return __builtin_bit_cast(s16x4,__builtin_amdgcn_ds_read_tr16_b64_v4i16((__attribute__((address_space(3))) v4i16_t*)p)); }
__device__ __forceinline__ float rowmax(const f32x16&p0,const f32x16&p1){
  float a=max3f(p0[0],p0[1],p1[0]),b=max3f(p0[2],p0[3],p1[1]);a=max3f(a,p1[2],p1[3]);
  #pragma unroll
  for(int r=4;r<16;r+=4){a=max3f(a,p0[r],p0[r+1]);b=max3f(b,p0[r+2],p0[r+3]);a=max3f(a,p1[r],p1[r+1]);b=max3f(b,p1[r+2],p1[r+3]);}
  const float m=max2f(a,b);
  auto rr=__builtin_amdgcn_permlane32_swap(__float_as_uint(m),__float_as_uint(m),false,false);
  return max2f(__uint_as_float(rr[0]),__uint_as_float(rr[1]));
}

#define ATTN_STORE16(p,v) (*(u32x4*)(p)=(v))
template<int THRL> __device__ __forceinline__ void attn_unit(int b,int hc,int qb,const bf16*Q,const bf16*__restrict__ K,const bf16*__restrict__ V,bf16*O,char*shm,int wave_){
  const int wid=wave_; const int tid=pg8::ltid(wid); const int lane=tid&63,r32=lane&31,hi=lane>>5;
  const long rowbase=(long)b*SEQ; const int q0=qb*QB;
  const bf16*Qw=Q+(rowbase+q0+wid*QBLK)*DM+hc*D;
  const bf16*Kh=K+rowbase*DM+hc*D,*Vh=V+rowbase*DM+(hc>>1)*DV;
  const unsigned lds0=(unsigned)(uintptr_t)shm;
  float*wsf=(float*)(shm+LDS_WS)+wid*64;
  const bf16*ksrc=Kh+(long)lane*DM+wid*8;
  const bf16*vsrc=Vh+(long)(16*(wid&3)+(lane>>2))*DM+(wid>>2)*32+(lane&3)*8;
  const unsigned kdst=lds0+LDS_K+wid*1024, vdst=lds0+LDS_V+wid*1024;
  #define DMA_K(t,slot) glds16(ksrc+(long)(t)*KVBLK*DM,(unsigned)__builtin_amdgcn_readfirstlane(kdst+(slot)))
  #define DMA_V(t,slot) do{ glds16(vsrc+(long)(t)*KVBLK*DM,(unsigned)__builtin_amdgcn_readfirstlane(vdst+2*(slot))); glds16(vsrc+(long)(t)*KVBLK*DM+64,(unsigned)__builtin_amdgcn_readfirstlane(vdst+2*(slot)+8192)); }while(0)
  const char*Kbase=shm+LDS_K; bf16x8 kf[8];
  const lds_cptr shm3=(lds_cptr)shm; const lds_cptr kp0=shm3+LDS_K+hi*1024+r32*16; const lds_cptr vp0=shm3+LDS_V+((lane>>4)&1)*32+(lane&3)*8+(4*hi+((lane&15)>>2))*64;
  const int NT=(q0+QB)/KVBLK;
  bf16x8 qr[4];
  #pragma unroll
  for(int d0=0;d0<4;++d0)qr[d0]=*reinterpret_cast<const bf16x8*>(&Qw[(long)r32*DM+d0*16+hi*8]);
  DMA_K(0,0);DMA_V(0,0);DMA_K(1,SLOTB);DMA_K(2,2*SLOTB);
  float mhat=0.f,l_reg=0.f;f32x16 o[4];o[0]=f32x16{};o[1]=f32x16{};o[2]=f32x16{};o[3]=f32x16{};
  const int qrel=wid*QBLK+r32;
  #define CMASK(P0,P1,t) do{int jb_=(t)-(NT-4); if(jb_>=0)cmask(P0,P1,jb_,qrel,hi);}while(0)
  bool resc=false;
  #define RESC() do{ if(resc){ asm volatile("s_waitcnt lgkmcnt(0)":::"memory"); \
      _Pragma("unroll") for(int d_=0;d_<4;++d_) _Pragma("unroll") for(int r=0;r<16;++r)o[d_][r]*=wsf[crow(r,hi)]; } }while(0)
  f32x16 pA0,pA1,pB0,pB1;
  int sl_prev=0,sl_cur=0,sl_next=SLOTB;
  #define ROT() do{sl_prev=sl_cur;sl_cur=sl_next;sl_next=(sl_next==(NSLOT-1)*SLOTB)?0:sl_next+SLOTB;}while(0)
  WAIT_BAR(4);
  qkt(pA0,pA1,Kbase,qr,r32,hi);asm volatile("s_nop 15\n\ts_nop 7":"+v"(pA0),"+v"(pA1));CMASK(pA0,pA1,0);
  { const float rm=rowmax(pA0,pA1); mhat=rm;
    _Pragma("unroll") for(int r=0;r<16;++r)pA0[r]=__builtin_amdgcn_exp2f(fsub_s(pA0[r],mhat));
    _Pragma("unroll") for(int r=0;r<16;++r)pA1[r]=__builtin_amdgcn_exp2f(fsub_s(pA1[r],mhat)); }
  WAIT_BAR(0);
  DMA_K(3,0);DMA_V(1,SLOTB);
  ROT();
  kload8(kf,kp0+sl_cur);
  WAIT_BAR(3);
  s16x4 vlo[8],vhi[8]; u32x4 pw0,pw1,pw2,pw3;
  #define PKW(P,B) cvtpk_s(P[B],P[B+1])
  #define PAF(k) __builtin_bit_cast(bf16x8,pw##k)
  #define VFS(i) (bf16x8){vlo[i][0],vlo[i][1],vlo[i][2],vlo[i][3],vhi[i][0],vhi[i][1],vhi[i][2],vhi[i][3]}
  #define PIN(x) asm volatile("":"+v"(x))
  #define MX3(a,b,c) __builtin_fmaxf(__builtin_fmaxf((a),(b)),(c))
  #define GAPA(MF,A0,A1,A2,A3,W0,W1,PW) do{ MF; sacc+=A0; sacc+=A1; sacc+=A2; sacc+=A3; PIN(sacc); W0; W1; PIN(PW); SBAR(); }while(0)
  #define EX(v) __builtin_amdgcn_exp2f(v)
  #define GAPB(MF,X,B) do{ MF; X[B]=EX(X[B]-mhat); X[B+1]=EX(X[B+1]-mhat); PIN(X); SBAR(); }while(0)
  #define VRDS(s,db,ks) do{ vlo[s]=vtr(vp_+((db)*4096+(ks)*1024)); vhi[s]=vtr(vp_+((db)*4096+(ks)*1024+512)); }while(0)
  #define KRD(G,j) do{ if(G){ kload2(kf,kp0+sl_next,j); SBAR(); } }while(0)
  #define MF32(a,b,c) __builtin_amdgcn_mfma_f32_32x32x16_bf16(a,b,c,0,0,0)
  #define STEP(C0,C1,P0,P1,t,GK,GV,GL) do{ SBAR(); \
    const lds_cptr vp_=vp0+2*sl_prev; const f32x16 z_=f32x16{}; \
    VRDS(0,0,0); SBAR(); float sacc=(P0[0]+P0[1]); \
    GAPA(C0=MF32(kf[0],qr[0],z_), P0[2],P0[3],P0[4],P0[5],     pw0[0]=PKW(P0,0), pw0[1]=PKW(P0,2), pw0); \
    VRDS(1,1,0); SBAR(); GAPA(C1=MF32(kf[1],qr[0],z_), P0[6],P0[7],P0[8],P0[9],     pw0[2]=PKW(P0,4), pw0[3]=PKW(P0,6), pw0); \
    VRDS(2,2,0); SBAR(); GAPA(C0=MF32(kf[2],qr[1],C0),   P0[10],P0[11],P0[12],P0[13], pw1[0]=PKW(P0,8), pw1[1]=PKW(P0,10), pw1); \
    VRDS(3,3,0); SBAR(); GAPA(C1=MF32(kf[3],qr[1],C1),   P0[14],P0[15],P1[0],P1[1],   pw1[2]=PKW(P0,12),pw1[3]=PKW(P0,14), pw1); \
    VRDS(4,0,1); SBAR(); GAPA(C0=MF32(kf[4],qr[2],C0),   P1[2],P1[3],P1[4],P1[5],     pw2[0]=PKW(P1,0), pw2[1]=PKW(P1,2), pw2); \
    VRDS(5,1,1); SBAR(); GAPA(C1=MF32(kf[5],qr[2],C1),   P1[6],P1[7],P1[8],P1[9],     pw2[2]=PKW(P1,4), pw2[3]=PKW(P1,6), pw2); \
    VRDS(6,2,1); SBAR(); GAPA(C0=MF32(kf[6],qr[3],C0),   P1[10],P1[11],P1[12],P1[13], pw3[0]=PKW(P1,8), pw3[1]=PKW(P1,10), pw3); \
    VRDS(7,3,1); SBAR(); GAPA(C1=MF32(kf[7],qr[3],C1),   P1[14],P1[15],0.f,0.f,       pw3[2]=PKW(P1,12),pw3[3]=PKW(P1,14), pw3); \
    l_reg+=sacc; \
    if(GK){DMA_K((t)+3,sl_cur);} if(GV){DMA_V((t)+1,sl_next);} \
    CMASK(C0,C1,t); \
    { float a=MX3(C0[0],C0[1],C1[0]),b=MX3(C0[2],C0[3],C1[1]); a=MX3(a,C1[2],C1[3]); \
      _Pragma("unroll") for(int r=4;r<16;r+=4){a=MX3(a,C0[r],C0[r+1]);b=MX3(b,C0[r+2],C0[r+3]);a=MX3(a,C1[r],C1[r+1]);b=MX3(b,C1[r+2],C1[r+3]);} \
      float rm=__builtin_fmaxf(a,b); { auto rr=__builtin_amdgcn_permlane32_swap(__float_as_uint(rm),__float_as_uint(rm),false,false); rm=__builtin_fmaxf(__uint_as_float(rr[0]),__uint_as_float(rr[1])); } \
      resc=false; const float dlt=rm-mhat; \
      if(__builtin_expect(__any(dlt>(float)THRL),0)){ const float dl=__builtin_fmaxf(dlt,0.f); mhat+=dl; \
        const float f=__builtin_amdgcn_exp2f(-dl); l_reg*=f; if(hi==0)wsf[r32]=f; resc=true; } } \
    SBAR(); \
    GAPB(o[0]=MF32(PAF(0),VFS(0),o[0]), C0,0); \
    VRDS(0,0,2); SBAR(); GAPB(o[1]=MF32(PAF(0),VFS(1),o[1]), C0,2); \
    VRDS(1,1,2); SBAR(); GAPB(o[2]=MF32(PAF(0),VFS(2),o[2]), C0,4); \
    VRDS(2,2,2); SBAR(); GAPB(o[3]=MF32(PAF(0),VFS(3),o[3]), C0,6); \
    VRDS(3,3,2); SBAR(); GAPB(o[0]=MF32(PAF(1),VFS(4),o[0]), C0,8); \
    VRDS(4,0,3); SBAR(); GAPB(o[1]=MF32(PAF(1),VFS(5),o[1]), C0,10); \
    VRDS(5,1,3); SBAR(); GAPB(o[2]=MF32(PAF(1),VFS(6),o[2]), C0,12); \
    VRDS(6,2,3); SBAR(); GAPB(o[3]=MF32(PAF(1),VFS(7),o[3]), C0,14); \
    VRDS(7,3,3); SBAR(); GAPB(o[0]=MF32(PAF(2),VFS(0),o[0]), C1,0); \
    KRD(GL,0); GAPB(o[1]=MF32(PAF(2),VFS(1),o[1]), C1,2); \
    KRD(GL,1); GAPB(o[2]=MF32(PAF(2),VFS(2),o[2]), C1,4); \
    KRD(GL,2); GAPB(o[3]=MF32(PAF(2),VFS(3),o[3]), C1,6); \
    KRD(GL,3); GAPB(o[0]=MF32(PAF(3),VFS(4),o[0]), C1,8); \
    GAPB(o[1]=MF32(PAF(3),VFS(5),o[1]), C1,10); \
    GAPB(o[2]=MF32(PAF(3),VFS(6),o[2]), C1,12); \
    GAPB(o[3]=MF32(PAF(3),VFS(7),o[3]), C1,14); \
    }while(0)
  int t=1;
  #undef CMASK
  #define CMASK(P0,P1,t) do{}while(0)
  for(;t+5<NT;t+=2){
    STEP(pB0,pB1,pA0,pA1,t,true,true,true);     WAIT_BAR(3); RESC(); ROT();
    STEP(pA0,pA1,pB0,pB1,t+1,true,true,true);   WAIT_BAR(3); RESC(); ROT();
  }
  #undef CMASK
  #define CMASK(P0,P1,t) do{int jb_=(t)-(NT-4); if(jb_>=0)cmask(P0,P1,jb_,qrel,hi);}while(0)
  #define ENDW(tt) do{ if((tt)+3<NT){WAIT_BAR(3);} else if((tt)+2<NT){WAIT_BAR(2);} else {WAIT_BAR(0);} }while(0)
  for(;t+1<NT;t+=2){
    STEP(pB0,pB1,pA0,pA1,t,(t+3<NT),(t+1<NT),(t+1<NT));       ENDW(t);   RESC(); ROT();
    STEP(pA0,pA1,pB0,pB1,t+1,(t+4<NT),(t+2<NT),(t+2<NT));     ENDW(t+1); RESC(); ROT();
  }
  STEP(pB0,pB1,pA0,pA1,NT-1,false,false,false); RESC();
  { float sacc=pB0[0]+pB0[1]; _Pragma("unroll") for(int r=2;r<16;++r)sacc+=pB0[r]; _Pragma("unroll") for(int r=0;r<16;++r)sacc+=pB1[r]; l_reg+=sacc;
    pw0=(u32x4){PKW(pB0,0),PKW(pB0,2),PKW(pB0,4),PKW(pB0,6)};pw1=(u32x4){PKW(pB0,8),PKW(pB0,10),PKW(pB0,12),PKW(pB0,14)};pw2=(u32x4){PKW(pB1,0),PKW(pB1,2),PKW(pB1,4),PKW(pB1,6)};pw3=(u32x4){PKW(pB1,8),PKW(pB1,10),PKW(pB1,12),PKW(pB1,14)};
    SBAR(); const lds_cptr vp_=vp0+2*sl_cur;
    #define DRAIN_KS(ks) do{ VRDS(0,0,ks); VRDS(1,1,ks); VRDS(2,2,ks); VRDS(3,3,ks); \
      o[0]=MF32(PAF(ks),VFS(0),o[0]); o[1]=MF32(PAF(ks),VFS(1),o[1]); o[2]=MF32(PAF(ks),VFS(2),o[2]); o[3]=MF32(PAF(ks),VFS(3),o[3]); SBAR(); }while(0)
    DRAIN_KS(0); DRAIN_KS(1); DRAIN_KS(2); DRAIN_KS(3);
    #undef DRAIN_KS
  }
  #undef PKW
  #undef PAF
  #undef VFS
  #undef PIN
  #undef MX3
  #undef GAPA
  #undef GAPB
  #undef EX
  #undef VRDS
  #undef KRD
  #undef MF32
  #undef STEP
  #undef ENDW
  {auto rr=__builtin_amdgcn_permlane32_swap(__float_as_uint(l_reg),__float_as_uint(l_reg),false,false);l_reg=__uint_as_float(rr[0])+__uint_as_float(rr[1]);}
  if(hi==0)wsf[32+r32]=l_reg;asm volatile("s_waitcnt lgkmcnt(0)":::"memory");
  float rli[16];
  #pragma unroll
  for(int r=0;r<16;++r)rli[r]=__builtin_amdgcn_rcpf(wsf[32+crow(r,hi)]);
  bf16*Ow=O+(rowbase+q0+wid*QBLK)*DM+(hc>>1)*DV;
  { bf16*stg=(bf16*)(shm+LDS_OST)+wid*2048;
    #pragma unroll
    for(int hh=0;hh<2;++hh){
      #pragma unroll
      for(int r=0;r<16;++r){const int orow=crow(r,hi);
        #pragma unroll
        for(int d0=0;d0<2;++d0)stg[orow*64+d0*32+r32]=__float2bfloat16(o[2*hh+d0][r]*rli[r]);}
      asm volatile("s_waitcnt lgkmcnt(0)":::"memory");
      #pragma unroll
      for(int i=0;i<4;++i){const int row=i*8+(lane>>3),ch=lane&7; const u32x4 v=*(const u32x4*)(stg+row*64+ch*8); ATTN_STORE16(Ow+(long)row*DM+hh*64+ch*8,v);}
      asm volatile("s_waitcnt lgkmcnt(0)":::"memory"); } }
  asm volatile("s_waitcnt lgkmcnt(0)\n\ts_barrier":::"memory");
  #undef DMA_K
  #undef DMA_V
  #undef CMASK
  #undef RESC
  #undef ROT
}
constexpr int ATTN_LDS_BYTES=LDS_BYTES;
struct Tensors { const bf16* Q; const bf16* K; const bf16* V; bf16* O0; bf16* O1; };
template<int THRL=8> __device__ __forceinline__ void attn_phase(char*lds,const Tensors&T,int vcu,int G,int wave_){
  for(int L=vcu;L<8*16*8;L+=G){ const int bh=L>>3,p=L&7,b=bh>>4,hc=bh&15; bf16*O=(hc&1)?T.O1:T.O0;
    attn_unit<THRL>(b,hc,p,T.Q,T.K,T.V,O,lds,wave_);
    attn_unit<THRL>(b,hc,15-p,T.Q,T.K,T.V,O,lds,wave_); }
}
#undef SBAR
#undef WAIT_BAR
}
#define GAS __attribute__((address_space(1)))
#define LAS __attribute__((address_space(3)))
typedef unsigned short bf16;
typedef unsigned v4u __attribute__((ext_vector_type(4)));
typedef float f32x4 __attribute__((ext_vector_type(4)));
typedef short bf16x8 __attribute__((ext_vector_type(8)));
typedef GAS unsigned gu32;
typedef GAS unsigned long long gu64;
#define RLX_AGENT __ATOMIC_RELAXED, __HIP_MEMORY_SCOPE_AGENT
#define LDS_WAIT() asm volatile("s_waitcnt lgkmcnt(0)" ::: "memory")
#define VM_WAIT() asm volatile("s_waitcnt vmcnt(0)" ::: "memory")
__device__ __forceinline__ unsigned long long rt() { return __builtin_amdgcn_s_memrealtime(); }
__device__ __forceinline__ unsigned f2bf(float f) { unsigned u = __builtin_bit_cast(unsigned, f); return (u + 0x7fffu + ((u >> 16) & 1u)) >> 16; }
__device__ __forceinline__ unsigned pk2(float lo, float hi) { return f2bf(lo) | (f2bf(hi) << 16); }

#define XB_TMO      128
#define XB_XCNT(j)  (256  + 64 * (j))
#define XB_XSUB(j)  (1280 + 64 * (j))
#define XB_XGEN(j)  (2304 + 64 * (j))
#define XB_TOP      3328
#define XB_TOPGEN   3392
#define XCD_BAR_WORDS 3456
#define XB_SPIN_CAP (1u << 18)

__device__ __forceinline__ unsigned xb_ld(unsigned* p)              { return __hip_atomic_load(p, __ATOMIC_RELAXED, __HIP_MEMORY_SCOPE_AGENT); }
__device__ __forceinline__ unsigned xb_add(unsigned* p, unsigned v) { return __hip_atomic_fetch_add(p, v, __ATOMIC_RELAXED, __HIP_MEMORY_SCOPE_AGENT); }
__device__ __forceinline__ unsigned xb_xcc_id() { return (unsigned)__builtin_amdgcn_s_getreg((3 << 11) | 20) & 0xFu; }
#define XB_SPIN(cond, bar) do { unsigned _sp = 0; while (cond) { __builtin_amdgcn_s_sleep(1); \
    if ((++_sp & 255u) == 0u) { if (xb_ld(&(bar)[XB_TMO])) break; if (_sp > XB_SPIN_CAP) { atomicAdd(&(bar)[XB_TMO], 1u); break; } } } } while (0)

struct XcdBarrier {
    unsigned* bar; unsigned x;
    volatile LAS unsigned* st;
};

__device__ __forceinline__ XcdBarrier xcd_barrier_post(unsigned* bar, volatile LAS unsigned* st) {
    XcdBarrier b; b.bar = bar; b.x = xb_xcc_id(); b.st = st;
    if (threadIdx.x == 0) (void)xb_add(&bar[XB_XCNT(b.x)], 1u);
    return b;
}
__device__ __forceinline__ void xcd_barrier_complete(unsigned* bar, unsigned x, unsigned& nloc, unsigned& nx) {
    const unsigned G = gridDim.x * gridDim.y * gridDim.z;
    unsigned sum, cnt, mine, sp = 0u;
    for (;;) {
        sum = 0u; cnt = 0u; mine = 0u;
#pragma unroll
        for (unsigned j = 0; j < 16; ++j) { const unsigned c = xb_ld(&bar[XB_XCNT(j)]); sum += c; cnt += (c > 0u) ? 1u : 0u; mine = (j == x) ? c : mine; }
        if (sum == G) break;
        __builtin_amdgcn_s_sleep(1);
        if ((++sp & 255u) == 0u) { if (xb_ld(&bar[XB_TMO])) break; if (sp > XB_SPIN_CAP) { atomicAdd(&bar[XB_TMO], 1u); break; } }
    }
    nloc = mine > 0u ? mine : 1u; nx = cnt > 0u ? cnt : 1u;
}

__device__ __forceinline__ void xcd_barrier(const XcdBarrier& b) {
    asm volatile("s_waitcnt vmcnt(0)" ::: "memory");
    __syncthreads();
    if (threadIdx.x == 0) {
        unsigned* bar = b.bar;
        __builtin_amdgcn_s_waitcnt(0);
        unsigned nloc = b.st[0], nx = b.st[1];
        if (nloc == 0u) { xcd_barrier_complete(bar, b.x, nloc, nx); b.st[0] = nloc; b.st[1] = nx; }
        const unsigned old = xb_add(&bar[XB_XSUB(b.x)], 1u);
        const unsigned gen = old / nloc;
        if (old + 1u == (gen + 1u) * nloc) {
            __builtin_amdgcn_fence(__ATOMIC_RELEASE, "agent");
            asm volatile("s_waitcnt vmcnt(0)" ::: "memory");
            const unsigned og = xb_add(&bar[XB_TOP], 1u);
            const unsigned tg = og / nx;
            if (og + 1u == (tg + 1u) * nx) xb_add(&bar[XB_TOPGEN], 1u);
            else XB_SPIN(xb_ld(&bar[XB_TOPGEN]) == tg, bar);
            __builtin_amdgcn_fence(__ATOMIC_ACQUIRE, "agent");
            xb_add(&bar[XB_XGEN(b.x)], 1u);
            asm volatile("s_waitcnt vmcnt(0)" ::: "memory");
        } else {
            XB_SPIN(xb_ld(&bar[XB_XGEN(b.x)]) == gen, bar);
            __builtin_amdgcn_fence(__ATOMIC_ACQUIRE, "agent");
            asm volatile("s_waitcnt vmcnt(0)" ::: "memory");
        }
    }
    __syncthreads();
}

constexpr int NWAVES = 8;
constexpr int BATCH = 8, SEQ = 4096, D = 1024, M = BATCH * SEQ;
constexpr int NEXP = 32, FE = 256, PLED = 256, CWID = 31, NQKV = 3072;
constexpr float EPS = 1e-6f;
constexpr int NPHASE = 21;
constexpr int PADROWS = 73728;
constexpr float LAM_INIT = 0.35550906759096926f;

constexpr size_t MiB = 1u << 20;
constexpr size_t WS_CTL = 0, CTL_ZERO_BYTES = 1 * MiB;
constexpr size_t WS_SSQ = 439 * MiB;
constexpr size_t WS_TI = 2 * MiB, WS_TW = WS_TI + 512 * 1024;
constexpr size_t WS_LIST = 3 * MiB;
constexpr size_t WS_RP = 7 * MiB;
constexpr size_t WS_LOG = 11 * MiB;
constexpr size_t WS_WPW1 = 19 * MiB, WS_WPW2 = 23 * MiB, WS_WQKV = 25 * MiB, WS_WO = 31 * MiB, WS_WR = 33 * MiB, WS_WPG = 34 * MiB, WS_WPP = 38 * MiB;
constexpr size_t WS_WGU = 39 * MiB, WS_WD = 71 * MiB;
constexpr size_t WS_P16 = 87 * MiB;
constexpr size_t WS_S0 = 119 * MiB, WS_SS = 64 * MiB;
constexpr size_t WS_WGU1 = WS_SSQ + 14 * MiB, WS_WD1 = WS_WGU1 + 32 * MiB;
constexpr size_t WS_END = WS_WD1 + 16 * MiB;
static_assert(WS_S0 + 5 * WS_SS == WS_SSQ, "d_ws map");
constexpr int CW_BAR = 4096;
constexpr int CW_CNT = 8192;
constexpr int RING_OFF = 0, RING_BYTES = 131072;
constexpr int LDSCTL_OFF = RING_BYTES;
constexpr int L_MISC = LDSCTL_OFF, L_TS = LDSCTL_OFF + 128, L_NE = LDSCTL_OFF + 384, L_TE = LDSCTL_OFF + 512, L_TOK = LDSCTL_OFF + 2048, L_HIST = LDSCTL_OFF + 10240;
constexpr int MAXGU = 8;
constexpr int LDS_BYTES = 147456;


typedef float f32x2 __attribute__((ext_vector_type(2)));
typedef unsigned u32x2 __attribute__((ext_vector_type(2)));
typedef int i32x4 __attribute__((ext_vector_type(4)));
__device__ __forceinline__ float bflo(unsigned u) { return __builtin_bit_cast(float, u << 16); }
__device__ __forceinline__ float bfhi(unsigned u) { return __builtin_bit_cast(float, u & 0xffff0000u); }
__device__ __forceinline__ float sigmoid_f(float x) { return __builtin_amdgcn_rcpf(1.f + __expf(-x)); }
__device__ __forceinline__ float wave_sum(float v) {
#pragma unroll
    for (int o = 1; o < 64; o <<= 1) v += __shfl_xor(v, o);
    return v;
}
__device__ __forceinline__ void tr_item(const float* W, int N, bf16* WT, int Kd, int k0, int n0, int drow0, const float* gk, LAS float* scr, int lane) {
#pragma unroll 8
    for (int i = 0; i < 32; ++i) { const int kk = 2 * i + (lane >> 5); scr[kk * 33 + (lane & 31)] = W[(size_t)(k0 + kk) * N + n0 + (lane & 31)]; }
    LDS_WAIT(); asm volatile("" ::: "memory");
    const int c = lane & 7;
    f32x4 g0 = {1.f, 1.f, 1.f, 1.f}, g1 = {1.f, 1.f, 1.f, 1.f};
    if (gk) { g0 = *(const f32x4*)(gk + k0 + 8 * c); g1 = *(const f32x4*)(gk + k0 + 8 * c + 4); }
#pragma unroll
    for (int j = 0; j < 4; ++j) { const int n = (lane >> 3) + 8 * j; const LAS float* s = scr + (8 * c) * 33 + n;
        v4u o; o.x = pk2(s[0 * 33] * g0.x, s[1 * 33] * g0.y); o.y = pk2(s[2 * 33] * g0.z, s[3 * 33] * g0.w); o.z = pk2(s[4 * 33] * g1.x, s[5 * 33] * g1.y); o.w = pk2(s[6 * 33] * g1.z, s[7 * 33] * g1.w);
        *(GAS v4u*)(WT + (size_t)(drow0 + n) * Kd + k0 + 8 * c) = o; }
    LDS_WAIT(); asm volatile("" ::: "memory");
}
template <bool GLU_IL = false>
__device__ __forceinline__ void tr_plain(const float* W, int K, int N, bf16* WT, int item, const float* gk, LAS float* scr, int lane) {
    const int nblk = N / 32, kb = item / nblk, nb = item % nblk, n0 = 32 * nb; int drow0 = n0;
    if (GLU_IL) { const int h = n0 >> 10, c = n0 & 1023; drow0 = (c >> 7) * 256 + h * 128 + (c & 127); }
    tr_item(W, N, WT, K, 64 * kb, n0, drow0, gk, scr, lane);
}
constexpr int MOE_ITEMS = 32 * 384;
__device__ __forceinline__ void moe_item(const float* wg, const float* wu, const float* wd, const float* gk, int l, bf16* WGU, bf16* WD, int item, LAS float* scr, int lane) {
    const int ge = item / 384, r = item % 384, which = r / 128, sub = r % 128; const size_t eo = (size_t)(l * 32 + ge) * 262144;
    if (which < 2) { const int kb = sub / 8, nb = sub % 8, n0 = 32 * nb; const int drow0 = (n0 / 128) * 256 + (n0 % 128) + (which ? 128 : 0);
        tr_item((which ? wu : wg) + eo, 256, WGU + (size_t)ge * 512 * 1024, 1024, 64 * kb, n0, drow0, gk, scr, lane); }
    else { const int kb = sub / 32, nb = sub % 32; tr_item(wd + eo, 1024, WD + (size_t)ge * 1024 * 256, 256, 64 * kb, 32 * nb, 32 * nb, nullptr, scr, lane); }
}

__device__ __forceinline__ void row_cvt(const float* x, bf16* XB, float* ss, int gw, int NGW, int lane) {
    for (int m0 = gw; m0 < M; m0 += 2 * NGW) {
        f32x4 v[2][4]; const bool two = m0 + NGW < M;
#pragma unroll
        for (int h = 0; h < 2; ++h) { const int m = (h && two) ? m0 + NGW : m0; const GAS f32x4* xr = (const GAS f32x4*)(x + (size_t)m * D) + lane;
#pragma unroll
            for (int j = 0; j < 4; ++j) v[h][j] = xr[64 * j]; }
#pragma unroll
        for (int h = 0; h < 2; ++h) { if (h && !two) break; const int m = h ? m0 + NGW : m0; GAS u32x2* xo = (GAS u32x2*)(XB + (size_t)m * D) + lane; float s = 0.f;
#pragma unroll
            for (int j = 0; j < 4; ++j) { s += (v[h][j].x * v[h][j].x + v[h][j].y * v[h][j].y) + (v[h][j].z * v[h][j].z + v[h][j].w * v[h][j].w); xo[64 * j] = (u32x2){pk2(v[h][j].x, v[h][j].y), pk2(v[h][j].z, v[h][j].w)}; }
            s = wave_sum(s); if (lane < 16) ss[(size_t)m * 16 + lane] = lane ? 0.f : s; }
    }
}
__device__ __forceinline__ void row_moe(const bf16* Xi, bf16* Xo, const bf16* YP, const i32x4* TI, const f32x2* TW, const unsigned* cnt, float* ss, int gw, int NGW, int lane) {
    int ts;
    { const unsigned n = lane < 32 ? __hip_atomic_load(cnt + lane * 64, RLX_AGENT) : 0u; const int tiles = (int)((n + 255u) >> 8); int incl = tiles;
#pragma unroll
      for (int o = 1; o < 32; o <<= 1) { const int t = __shfl_up(incl, o); if (lane >= o) incl += t; }
      ts = incl - tiles; }
    i32x4 ti[2]; f32x2 tw[2];
#pragma unroll
    for (int h = 0; h < 2; ++h) { int m = gw + h * NGW; m = m < M ? m : gw; ti[h] = TI[m]; tw[h] = TW[m]; }
    for (int m0 = gw; m0 < M; m0 += 2 * NGW) {
        const bool two = m0 + NGW < M;
        i32x4 tin[2]; f32x2 twn[2];
#pragma unroll
        for (int h = 0; h < 2; ++h) { int m = m0 + 2 * NGW + h * NGW; m = m < M ? m : gw; tin[h] = TI[m]; twn[h] = TW[m]; }
        u32x2 x[2][4], a[2][4], c[2][4];
#pragma unroll
        for (int h = 0; h < 2; ++h) { const int m = (h && two) ? m0 + NGW : m0;
            const int r1 = __shfl(ts, ti[h].x) * 256 + ti[h].y, r2 = __shfl(ts, ti[h].z) * 256 + ti[h].w;
            const GAS u32x2* xr = (const GAS u32x2*)(Xi + (size_t)m * D) + lane; const GAS u32x2* y1 = (const GAS u32x2*)(YP + (size_t)r1 * D) + lane; const GAS u32x2* y2 = (const GAS u32x2*)(YP + (size_t)r2 * D) + lane;
#pragma unroll
            for (int j = 0; j < 4; ++j) { x[h][j] = xr[64 * j]; a[h][j] = y1[64 * j]; c[h][j] = y2[64 * j]; } }
#pragma unroll
        for (int h = 0; h < 2; ++h) { if (h && !two) break; const int m = h ? m0 + NGW : m0; GAS u32x2* xo = (GAS u32x2*)(Xo + (size_t)m * D) + lane; float s = 0.f;
#pragma unroll
            for (int j = 0; j < 4; ++j) {
                const f32x4 v = (f32x4){bflo(x[h][j].x), bfhi(x[h][j].x), bflo(x[h][j].y), bfhi(x[h][j].y)} + (f32x4){bflo(a[h][j].x), bfhi(a[h][j].x), bflo(a[h][j].y), bfhi(a[h][j].y)} * tw[h].x
                              + (f32x4){bflo(c[h][j].x), bfhi(c[h][j].x), bflo(c[h][j].y), bfhi(c[h][j].y)} * tw[h].y;
                s += (v.x * v.x + v.y * v.y) + (v.z * v.z + v.w * v.w); xo[64 * j] = (u32x2){pk2(v.x, v.y), pk2(v.z, v.w)}; }
            s = wave_sum(s); if (lane < 16) ss[(size_t)m * 16 + lane] = lane ? 0.f : s; }
#pragma unroll
        for (int h = 0; h < 2; ++h) { ti[h] = tin[h]; tw[h] = twn[h]; }
    }
}
__device__ __forceinline__ void row_final(float* out, const float* ss, const float* gain, int gw, int NGW, int lane) {
    f32x4 gv[4];
#pragma unroll
    for (int j = 0; j < 4; ++j) gv[j] = *((const f32x4*)gain + lane + 64 * j);
    for (int m0 = gw; m0 < M; m0 += 2 * NGW) {
        const bool two = m0 + NGW < M; f32x4 v[2][4]; float r[2];
#pragma unroll
        for (int h = 0; h < 2; ++h) { const int m = (h && two) ? m0 + NGW : m0; const GAS f32x4* xr = (const GAS f32x4*)(out + (size_t)m * D) + lane; r[h] = pg8::rs_of(ss, m);
#pragma unroll
            for (int j = 0; j < 4; ++j) v[h][j] = xr[64 * j]; }
#pragma unroll
        for (int h = 0; h < 2; ++h) { if (h && !two) break; const int m = h ? m0 + NGW : m0; GAS f32x4* xo = (GAS f32x4*)(out + (size_t)m * D) + lane;
#pragma unroll
            for (int j = 0; j < 4; ++j) xo[64 * j] = v[h][j] * r[h] * gv[j]; }
    }
}

__device__ __forceinline__ void conv_phase(const bf16* U, bf16* C, const float* wdw, const float* bdw, const float* lng, const float* lnb, LAS unsigned char* lds, int vcu, int G, int tid, int lane, int wave) {
    constexpr int RUN = 128, NGRP = (RUN + CWID - 1) / CWID;
    const int c0 = 2 * tid;
    f32x2 w[CWID];
#pragma unroll
    for (int j = 0; j < CWID; ++j) w[j] = *(const f32x2*)(wdw + j * D + c0);
    const f32x2 bd = *(const f32x2*)(bdw + c0);
    LAS unsigned* yb = (LAS unsigned*)lds;
    for (int run = vcu; run < M / RUN; run += G) {
        const int b = run / (SEQ / RUN), t0 = (run % (SEQ / RUN)) * RUN; const size_t rb = (size_t)b * SEQ;
        const bf16* Ub = U + rb * D + c0;
        f32x2 win[CWID]; unsigned raw[CWID], rawn[CWID];
        win[0] = (f32x2){0.f, 0.f};
#pragma unroll
        for (int s = 1; s < CWID; ++s) { const int tau = t0 - CWID + s; const int tc = tau < 0 ? 0 : tau;
            const unsigned ua = *(const GAS unsigned*)(Ub + (size_t)tc * D);
            win[s] = tau < 0 ? (f32x2){0.f, 0.f} : (f32x2){bflo(ua), bfhi(ua)}; }
#pragma unroll
        for (int s = 0; s < CWID; ++s) raw[s] = *(const GAS unsigned*)(Ub + (size_t)(t0 + s) * D);
#pragma unroll 1
        for (int g = 0; g < NGRP; ++g) {
            const int tg = t0 + g * CWID, n = (RUN - g * CWID) < CWID ? (RUN - g * CWID) : CWID;
#pragma unroll
            for (int s = 0; s < CWID; ++s) { int tn = tg + CWID + s; tn = tn > t0 + RUN - 1 ? t0 + RUN - 1 : tn; rawn[s] = *(const GAS unsigned*)(Ub + (size_t)tn * D); }
#pragma unroll
            for (int s = 0; s < CWID; ++s) { if (s < n) {
                win[s] = (f32x2){bflo(raw[s]), bfhi(raw[s])};
                f32x2 a = bd;
#pragma unroll
                for (int j = 0; j < CWID; ++j) a += w[j] * win[(s + 1 + j) % CWID];
                yb[s * 512 + tid] = pk2(a.x, a.y); } }
            LDS_WAIT(); __syncthreads();
#pragma unroll 1
            for (int rr = 0; rr < 4; ++rr) { const int r = wave * 4 + rr; if (r < n) {
                const v4u p0 = *(const LAS v4u*)(lds + r * 2048 + lane * 16), p1 = *(const LAS v4u*)(lds + r * 2048 + 1024 + lane * 16);
                float x[16] = {bflo(p0.x), bfhi(p0.x), bflo(p0.y), bfhi(p0.y), bflo(p0.z), bfhi(p0.z), bflo(p0.w), bfhi(p0.w), bflo(p1.x), bfhi(p1.x), bflo(p1.y), bfhi(p1.y), bflo(p1.z), bfhi(p1.z), bflo(p1.w), bfhi(p1.w)};
                float s = 0.f;
#pragma unroll
                for (int i = 0; i < 16; ++i) s += x[i];
                const float mu = wave_sum(s) * (1.f / D); float q = 0.f;
#pragma unroll
                for (int i = 0; i < 16; ++i) { x[i] -= mu; q += x[i] * x[i]; }
                const float rs = 1.f / sqrtf(wave_sum(q) * (1.f / D) + EPS);
                unsigned o[8];
#pragma unroll
                for (int hh = 0; hh < 2; ++hh) { const f32x4 g0 = *(const f32x4*)(lng + hh * 512 + lane * 8), g1 = *(const f32x4*)(lng + hh * 512 + lane * 8 + 4), b0 = *(const f32x4*)(lnb + hh * 512 + lane * 8), b1 = *(const f32x4*)(lnb + hh * 512 + lane * 8 + 4);
                    float y[8] = {x[hh * 8 + 0] * rs * g0.x + b0.x, x[hh * 8 + 1] * rs * g0.y + b0.y, x[hh * 8 + 2] * rs * g0.z + b0.z, x[hh * 8 + 3] * rs * g0.w + b0.w,
                                  x[hh * 8 + 4] * rs * g1.x + b1.x, x[hh * 8 + 5] * rs * g1.y + b1.y, x[hh * 8 + 6] * rs * g1.z + b1.z, x[hh * 8 + 7] * rs * g1.w + b1.w};
#pragma unroll
                    for (int i = 0; i < 4; ++i) o[hh * 4 + i] = pk2(y[2 * i] * sigmoid_f(y[2 * i]), y[2 * i + 1] * sigmoid_f(y[2 * i + 1])); }
                bf16* cr = C + (rb + tg + r) * D;
                *(GAS v4u*)(cr + lane * 8) = (v4u){o[0], o[1], o[2], o[3]}; *(GAS v4u*)(cr + 512 + lane * 8) = (v4u){o[4], o[5], o[6], o[7]}; } }
            LDS_WAIT(); __syncthreads();
#pragma unroll
            for (int s = 0; s < CWID; ++s) raw[s] = rawn[s];
        }
    }
}

__device__ __forceinline__ void combine_phase(const bf16* O0, const bf16* O1, bf16* OC, const float* lamp, const float* subln, int gw, int NGW, int lane) {
    const float l1 = wave_sum(lamp[lane] * lamp[64 + lane]), l2 = wave_sum(lamp[128 + lane] * lamp[192 + lane]);
    const float lam = __expf(l1) - __expf(l2) + LAM_INIT;
    float gsc[16];
#pragma unroll
    for (int i = 0; i < 16; ++i) gsc[i] = subln[(lane & 7) * 16 + i] * (1.0f - LAM_INIT);
    for (int m0 = gw; m0 < M; m0 += 2 * NGW) {
        const bool two = m0 + NGW < M; v4u a0[2], a1[2], b0[2], b1[2];
#pragma unroll
        for (int h = 0; h < 2; ++h) { const int m = (h && two) ? m0 + NGW : m0;
            a0[h] = *(const GAS v4u*)(O0 + (size_t)m * D + lane * 16); a1[h] = *(const GAS v4u*)(O0 + (size_t)m * D + lane * 16 + 8);
            b0[h] = *(const GAS v4u*)(O1 + (size_t)m * D + lane * 16); b1[h] = *(const GAS v4u*)(O1 + (size_t)m * D + lane * 16 + 8); }
#pragma unroll
        for (int h = 0; h < 2; ++h) { if (h && !two) break; const int m = h ? m0 + NGW : m0;
            const unsigned ua[8] = {a0[h].x, a0[h].y, a0[h].z, a0[h].w, a1[h].x, a1[h].y, a1[h].z, a1[h].w}, ub[8] = {b0[h].x, b0[h].y, b0[h].z, b0[h].w, b1[h].x, b1[h].y, b1[h].z, b1[h].w};
            float o[16]; float ss = 0.f;
#pragma unroll
            for (int i = 0; i < 8; ++i) { o[2 * i] = bflo(ua[i]) - lam * bflo(ub[i]); o[2 * i + 1] = bfhi(ua[i]) - lam * bfhi(ub[i]); ss += o[2 * i] * o[2 * i] + o[2 * i + 1] * o[2 * i + 1]; }
            ss += __shfl_xor(ss, 1); ss += __shfl_xor(ss, 2); ss += __shfl_xor(ss, 4);
            const float r = 1.f / sqrtf(ss * (1.f / 128.f) + EPS);
            unsigned w[8];
#pragma unroll
            for (int i = 0; i < 8; ++i) w[i] = pk2(o[2 * i] * r * gsc[2 * i], o[2 * i + 1] * r * gsc[2 * i + 1]);
            *(GAS v4u*)(OC + (size_t)m * D + lane * 16) = (v4u){w[0], w[1], w[2], w[3]}; *(GAS v4u*)(OC + (size_t)m * D + lane * 16 + 8) = (v4u){w[4], w[5], w[6], w[7]}; }
    }
}

__device__ __forceinline__ void select_phase(const float* LOG, const float* brg, const float* bre, const float* ss, unsigned* cnt, int* list, float* RP, i32x4* TI, f32x2* TW, LAS int* lh, int vcu, int G, int tid) {
    for (int base = vcu * 128; base < M; base += G * 128) {
        if (tid < 32) lh[tid] = 0;
        __syncthreads();
        const int t = base + tid; int E1 = 0, E2 = 0, r1 = 0, r2 = 0; float w1 = 0.f, w2 = 0.f;
        if (tid < 128) {
            const f32x4 g4 = *(const GAS f32x4*)(LOG + (size_t)t * 64);
            const float gl[4] = {g4.x + brg[0], g4.y + brg[1], g4.z + brg[2], g4.w + brg[3]};
            int gi = 0; float gm = gl[0];
#pragma unroll
            for (int j = 1; j < 4; ++j) if (gl[j] > gm) { gm = gl[j]; gi = j; }
            float den = 0.f;
#pragma unroll
            for (int j = 0; j < 4; ++j) den += __expf(gl[j] - gm);
            const float gw_ = 1.f / den;
            const f32x4 ea = *(const GAS f32x4*)(LOG + (size_t)t * 64 + 4 + gi * 8), eb = *(const GAS f32x4*)(LOG + (size_t)t * 64 + 8 + gi * 8);
            const f32x4 ba = *(const f32x4*)(bre + gi * 8), bb = *(const f32x4*)(bre + gi * 8 + 4);
            const float el[8] = {ea.x + ba.x, ea.y + ba.y, ea.z + ba.z, ea.w + ba.w, eb.x + bb.x, eb.y + bb.y, eb.z + bb.z, eb.w + bb.w};
            int i1 = 0; float v1 = el[0];
#pragma unroll
            for (int j = 1; j < 8; ++j) if (el[j] > v1) { v1 = el[j]; i1 = j; }
            int i2 = -1; float v2 = -INFINITY;
#pragma unroll
            for (int j = 0; j < 8; ++j) if (j != i1 && (i2 < 0 || el[j] > v2)) { v2 = el[j]; i2 = j; }
            const float e2 = __expf(v2 - v1); const float p1 = 1.f / (1.f + e2);
            w1 = p1 * gw_; w2 = (e2 * p1) * gw_; E1 = gi * 8 + i1; E2 = gi * 8 + i2;
            r1 = __hip_atomic_fetch_add(lh + E1, 1, __ATOMIC_RELAXED, __HIP_MEMORY_SCOPE_WORKGROUP); r2 = __hip_atomic_fetch_add(lh + E2, 1, __ATOMIC_RELAXED, __HIP_MEMORY_SCOPE_WORKGROUP);
        }
        __syncthreads();
        if (tid < 32) { const int c = lh[tid]; int bs = 0; if (c) bs = (int)__hip_atomic_fetch_add(cnt + tid * 64, (unsigned)c, RLX_AGENT); lh[32 + tid] = bs; }
        __syncthreads();
        if (tid < 128) { const int s1 = lh[32 + E1] + r1, s2 = lh[32 + E2] + r2;
            const float r = pg8::rs_of(ss, t);
            list[(size_t)E1 * M + s1] = t; list[(size_t)E2 * M + s2] = t; RP[(size_t)E1 * M + s1] = r; RP[(size_t)E2 * M + s2] = r; TI[t] = (i32x4){E1, s1, E2, s2}; TW[t] = (f32x2){w1, w2}; }
        __syncthreads();
    }
}

struct GroupedOrder {
    int nNs, G, c, ntu;
    const LAS int* tile_e; const LAS int* tokl; const LAS int* ts;
    __device__ __forceinline__ bool next(int i, pg8::Unit& u) const { const int L = i * G + c; if (L >= ntu) return false; const int mt = L >> nNs, pn = L & ((1 << nNs) - 1);
        const int e = tile_e[mt]; u.pm = mt; u.pn = pn; u.pb = (e << nNs) + pn; u.aux = e * M + (mt - ts[e]) * 256; return true; }
    __device__ __forceinline__ unsigned arow(int ord, int r) const { return (unsigned)tokl[ord * 256 + r]; }
};
__device__ __forceinline__ GroupedOrder grouped_setup(const unsigned* cnt, const int* list, LAS unsigned char* lds, bool need_tok, int nNs, int G, int c, int tid, int lane, int wave) {
    LAS int* ts = (LAS int*)(lds + L_TS); LAS int* ne = (LAS int*)(lds + L_NE); LAS int* te = (LAS int*)(lds + L_TE); LAS int* tokl = (LAS int*)(lds + L_TOK);
    __syncthreads();
    if (wave == 0) {
        const unsigned n = lane < 32 ? __hip_atomic_load(cnt + lane * 64, RLX_AGENT) : 0u; const int tiles = (int)((n + 255u) >> 8); int incl = tiles;
#pragma unroll
        for (int o = 1; o < 32; o <<= 1) { const int t = __shfl_up(incl, o); if (lane >= o) incl += t; }
        const int excl = incl - tiles;
        if (lane < 32) { ts[lane] = excl; ne[lane] = (int)n; for (int k = 0; k < tiles; ++k) te[excl + k] = lane; }
        if (lane == 31) ts[32] = incl;
    }
    __syncthreads();
    GroupedOrder S; S.nNs = nNs; S.G = G; S.c = c; S.ntu = ts[32] << nNs; S.tile_e = te; S.tokl = tokl; S.ts = ts;
    if (need_tok) {
        for (int i = 0; i < MAXGU; ++i) { const int L = i * G + c; if (L >= S.ntu) break; const int mt = L >> nNs, e = te[mt];
            if (tid < 256) { const int slot = (mt - ts[e]) * 256 + tid; tokl[i * 256 + tid] = slot < ne[e] ? list[(size_t)e * M + slot] : 0; } }
        if (S.ntu > MAXGU * G) S.ntu = MAXGU * G;
        __syncthreads();
    }
    return S;
}

enum { I_X = 0, I_P, I_POS, I_NMIX, I_NFFN, I_CW1, I_CB1, I_CDW, I_CBDW, I_CLNG, I_CLNB, I_CW2, I_CB2, I_WQKV, I_LAM, I_SUBLN, I_WO,
       I_WRG, I_BRG, I_WRE, I_BRE, I_WG, I_WU, I_WDN, I_PNORM, I_PWG, I_PWP, I_FNORM, N_IN };
struct Args { const void* in[N_IN]; float* out; unsigned char* ws; int ph_lo, ph_hi; };

typedef const __attribute__((address_space(4))) Args* KArgP;
#define PH_IDS() const int tid = pg8::ltid(wave), lane = tid & 63, gtid = vcu * (NWAVES * 64) + tid; (void)lane; (void)gtid
__device__ __forceinline__ KArgP kargs() { KArgP k = (KArgP)__builtin_amdgcn_kernarg_segment_ptr(); asm volatile("" : "+s"(k)); return k; }
#define IN_F(k) ((const float*)ka->in[k])
#define WSP(off) ((bf16*)(ka->ws + (off)))
#define SLOT(i) ((bf16*)(ka->ws + WS_S0 + (size_t)(i) * WS_SS))
#define IN(k) (lo <= (k) && (k) < hi)
#ifndef MK_DUP
#define MK_DUP -1
#endif
#define DUPLOOP(k) _Pragma("nounroll") for (int rep_ = 0; rep_ < ((k) == MK_DUP ? 2 : 1); ++rep_)
#ifdef MK_PROBE
#define CW_TS 12288
#define SEAM(k) do { if (IN(k) && IN((k) + 1)) xcd_barrier(bar); if (blockIdx.x == 0 && threadIdx.x == 0) __hip_atomic_store((unsigned*)(kargs()->ws + WS_CTL) + CW_TS + (k) + 1, (unsigned)__builtin_amdgcn_s_memrealtime(), RLX_AGENT); } while (0)
#else
#define SEAM(k) do { if (IN(k) && IN((k) + 1)) xcd_barrier(bar); } while (0)
#endif
#define XBA ((bf16*)ka->out)
#define XBB ((bf16*)ka->out + (size_t)M * D)
#define SSQ(k) ((float*)(ka->ws + WS_SSQ) + (size_t)(k) * M * 16)
#define ACTB ((bf16*)(ka->ws + WS_S0 + 3 * WS_SS + 16 * MiB))
#define CNT(l) ((unsigned*)(ka->ws + WS_CTL) + CW_CNT + (l) * 32 * 64)
template <int l>
__device__ __forceinline__ void layer_tail(LAS unsigned char* lds, const XcdBarrier& bar, int lo, int hi, int wave, int G, int bx, int vcu, int gw, int NGW, int NTHR) {
    constexpr int pb = l ? 14 : 4;
    LAS float* scr = (LAS float*)(lds + RING_OFF + wave * 16384);
    if (IN(pb)) DUPLOOP(pb) {
        const bool split = (G == 256);
        if (!split || bx < 128) { KArgP ka = kargs(); pg8::Gemm g{l ? XBB : XBA, WSP(WS_WR) + (size_t)l * 256 * D, M, 256, D}; pg8::StaticOrder S; S.init(M, 256, G, bx);
            pg8::EpiLogits E{(float*)(ka->ws + WS_LOG), SSQ(l ? 4 : 1)};
            pg8::gemm_phase<pg8::EpiLogits, pg8::StaticOrder, true, false>(lds + RING_OFF, g, S, E, wave); }
        if (!split || bx >= 128) { KArgP ka = kargs(); pg8::Gemm g{WSP(WS_P16) + (size_t)l * M * PLED, WSP(WS_WPP) + (size_t)l * D * PLED, M, D, PLED}; pg8::StaticOrder S; S.init(M, D, split ? 128 : G, split ? bx - 128 : bx);
            pg8::EpiBf16 E{l ? SLOT(0) : SLOT(4), D};
            pg8::gemm_phase<pg8::EpiBf16, pg8::StaticOrder, true, false>(lds + RING_OFF, g, S, E, wave); }
    }
    SEAM(pb);
    if (IN(pb + 1)) { KArgP ka = kargs(); PH_IDS(); select_phase((const float*)(ka->ws + WS_LOG), IN_F(I_BRG) + l * 4, IN_F(I_BRE) + l * 32, SSQ(l ? 4 : 1), CNT(l),
                                   (int*)(ka->ws + WS_LIST), (float*)(ka->ws + WS_RP), (i32x4*)(ka->ws + WS_TI), (f32x2*)(ka->ws + WS_TW), (LAS int*)(lds + L_HIST), vcu, G, tid); }
    SEAM(pb + 1);
    if (IN(pb + 2)) DUPLOOP(pb + 2) { KArgP ka = kargs(); PH_IDS(); const GroupedOrder S = grouped_setup(CNT(l), (const int*)(ka->ws + WS_LIST), lds, true, 1, G, bx, tid, lane, wave);
        pg8::Gemm g{l ? XBB : XBA, WSP(l ? WS_WGU1 : WS_WGU), M, 512, D}; pg8::EpiGU E{ACTB, (const float*)(ka->ws + WS_RP)};
        pg8::gemm_phase<pg8::EpiGU, GroupedOrder, true, true>(lds + RING_OFF, g, S, E, wave);
        if (l == 0) {
            const int nbusy = S.ntu > 2 * G ? S.ntu - 2 * G : 0, nfree = G - nbusy;
            if (nfree <= 0 || bx >= nbusy) { const int w0 = (nfree > 0 ? bx - nbusy : bx) * NWAVES + wave, nw = (nfree > 0 ? nfree : G) * NWAVES;
                LAS float* scr2 = (LAS float*)(lds + RING_OFF + wave * 16384);
                for (int it = w0; it < MOE_ITEMS; it += nw) moe_item(IN_F(I_WG), IN_F(I_WU), IN_F(I_WDN), IN_F(I_NFFN) + D, 1, WSP(WS_WGU1), WSP(WS_WD1), it, scr2, lane); } }
    }
    SEAM(pb + 2);
    if (IN(pb + 3)) DUPLOOP(pb + 3) { KArgP ka = kargs(); PH_IDS(); const GroupedOrder S = grouped_setup(CNT(l), (const int*)(ka->ws + WS_LIST), lds, false, 2, G, bx, tid, lane, wave);
        pg8::Gemm g{ACTB, WSP(l ? WS_WD1 : WS_WD), PADROWS, D, FE}; pg8::EpiBf16 E{SLOT(1), D};
        pg8::gemm_phase<pg8::EpiBf16, GroupedOrder, true, false>(lds + RING_OFF, g, S, E, wave); }
    SEAM(pb + 3);
    if (IN(pb + 4)) DUPLOOP(pb + 4) {
        { KArgP ka = kargs(); PH_IDS(); row_moe(l ? XBB : XBA, l ? SLOT(4) : XBA, SLOT(1), (const i32x4*)(ka->ws + WS_TI), (const f32x2*)(ka->ws + WS_TW), CNT(l), SSQ(l ? 5 : 2), gw, NGW, lane); }
    }
    SEAM(pb + 4);
    if (IN(pb + 5)) DUPLOOP(pb + 5) {
        if (l == 0) { KArgP ka = kargs(); PH_IDS(); pg8::Gemm g{XBA, WSP(WS_WPG), M, D, D}; pg8::StaticOrder S; S.init(M, D, G, bx);
          pg8::EpiPle<false> E{XBA, SLOT(4), XBB, nullptr, SSQ(2), SSQ(3)};
          pg8::gemm_phase<pg8::EpiPle<false>, pg8::StaticOrder, true, false>(lds + RING_OFF, g, S, E, wave); }
        else { KArgP ka = kargs(); PH_IDS(); pg8::Gemm g{SLOT(4), WSP(WS_WPG) + (size_t)D * D, M, D, D}; pg8::StaticOrder S; S.init(M, D, G, bx);
          pg8::EpiPle<true> E{SLOT(4), SLOT(0), nullptr, ka->out, SSQ(5), SSQ(6)};
          pg8::gemm_phase<pg8::EpiPle<true>, pg8::StaticOrder, true, false>(lds + RING_OFF, g, S, E, wave); }
    }
    SEAM(pb + 5);
}
__global__ void __launch_bounds__(NWAVES * 64, 2) mk_fwd(Args args) {
    extern __shared__ __attribute__((aligned(16))) unsigned char lds_raw[];
    LAS unsigned char* lds = (LAS unsigned char*)lds_raw;
    const int tid0 = threadIdx.x, wave = __builtin_amdgcn_readfirstlane(tid0 >> 6);
    const int G = gridDim.x; const int bx = blockIdx.x; const int vcu = (G % 8 == 0) ? (bx % 8) * (G / 8) + bx / 8 : bx;
    const int gw = vcu * NWAVES + wave, NGW = G * NWAVES, NTHR = G * NWAVES * 64;
    gu32* ctl = (gu32*)(args.ws + WS_CTL);
    for (int u = tid0; u < (LDS_BYTES - LDSCTL_OFF) / 4; u += NWAVES * 64) ((LAS unsigned*)(lds + LDSCTL_OFF))[u] = 0u;
    __syncthreads();
    XcdBarrier bar = xcd_barrier_post((unsigned*)ctl + CW_BAR, (volatile LAS unsigned*)(lds + L_MISC) + 8);
    const int lo = args.ph_lo, hi = args.ph_hi;
#ifdef MK_PROBE
    if (blockIdx.x == 0 && threadIdx.x == 0) __hip_atomic_store((unsigned*)(args.ws + WS_CTL) + CW_TS, (unsigned)__builtin_amdgcn_s_memrealtime(), RLX_AGENT);
#endif
    LAS float* scr = (LAS float*)(lds + RING_OFF + wave * 16384);

    if (IN(0)) DUPLOOP(0) {
        constexpr int I1 = 16 * 64, I2 = 16 * 32, I3 = 16 * 96, I4 = 16 * 32, I5 = 16 * 32, I6 = 4 * 32;
        constexpr int NIT = I1 + I2 + I3 + I4 + 2 * I5 + 2 * I6;
        { KArgP ka = kargs(); PH_IDS();
          for (int it = gw; it < NIT + MOE_ITEMS; it += NGW) {
            int r = it;
            if (r < I1) { tr_plain<true>(IN_F(I_CW1), D, 2048, WSP(WS_WPW1), r, IN_F(I_NMIX), scr, lane); continue; } r -= I1;
            if (r < I2) { tr_plain(IN_F(I_CW2), D, D, WSP(WS_WPW2), r, nullptr, scr, lane); continue; } r -= I2;
            if (r < I3) { tr_plain(IN_F(I_WQKV), D, NQKV, WSP(WS_WQKV), r, IN_F(I_NMIX) + D, scr, lane); continue; } r -= I3;
            if (r < I4) { tr_plain(IN_F(I_WO), D, D, WSP(WS_WO), r, nullptr, scr, lane); continue; } r -= I4;
            if (r < 2 * I5) { const int l = r / I5; tr_plain(IN_F(I_PWG) + (size_t)l * D * D, D, D, WSP(WS_WPG) + (size_t)l * D * D, r % I5, IN_F(I_PNORM) + l * D, scr, lane); continue; } r -= 2 * I5;
            if (r < 2 * I6) { const int l = r / I6; tr_plain(IN_F(I_PWP) + (size_t)l * PLED * D, PLED, D, WSP(WS_WPP) + (size_t)l * D * PLED, r % I6, nullptr, scr, lane); continue; } r -= 2 * I6;
            moe_item(IN_F(I_WG), IN_F(I_WU), IN_F(I_WDN), IN_F(I_NFFN), 0, WSP(WS_WGU), WSP(WS_WD), r, scr, lane);
          } }
        { KArgP ka = kargs(); PH_IDS(); const float* wrg = IN_F(I_WRG); const float* wre = IN_F(I_WRE); const float* gf = IN_F(I_NFFN); bf16* Wr = WSP(WS_WR);
          for (int idx = gtid; idx < 2 * 256 * 1024; idx += NTHR) { const int l = idx >> 18, row = (idx >> 10) & 255, k = idx & 1023; float v = 0.f;
              if (row < 4) v = wrg[((size_t)l * D + k) * 4 + row]; else if (row < 36) { const int g = (row - 4) >> 3, e = (row - 4) & 7; v = wre[(((size_t)l * 4 + g) * D + k) * 8 + e]; }
              Wr[idx] = (bf16)f2bf(v * gf[l * D + k]); } }
        { KArgP ka = kargs(); PH_IDS(); const f32x4* p4 = (const f32x4*)ka->in[I_P]; u32x2* o = (u32x2*)WSP(WS_P16);
          for (int idx = gtid; idx < 2 * M * PLED / 4; idx += NTHR) { const f32x4 v = p4[idx]; o[idx] = (u32x2){pk2(v.x, v.y), pk2(v.z, v.w)}; } }
        { KArgP ka = kargs(); PH_IDS(); row_cvt(IN_F(I_X), XBA, SSQ(0), gw, NGW, lane); }
    }
    SEAM(0);
    if (IN(1)) DUPLOOP(1) { KArgP ka = kargs(); PH_IDS(); pg8::Gemm g{XBA, WSP(WS_WPW1), M, 2048, D}; pg8::StaticOrder S; S.init(M, 2048, G, bx);
        pg8::EpiGLU E{SLOT(0), IN_F(I_CB1), SSQ(0)};
        pg8::gemm_phase<pg8::EpiGLU, pg8::StaticOrder, true, false>(lds + RING_OFF, g, S, E, wave); }
    SEAM(1);
    if (IN(2)) DUPLOOP(2) { KArgP ka = kargs(); PH_IDS(); conv_phase(SLOT(0), SLOT(1), IN_F(I_CDW), IN_F(I_CBDW), IN_F(I_CLNG), IN_F(I_CLNB), lds + RING_OFF, vcu, G, tid, lane, wave); }
    SEAM(2);
    if (IN(3)) { KArgP ka = kargs(); PH_IDS(); pg8::Gemm g{SLOT(1), WSP(WS_WPW2), M, D, D}; pg8::StaticOrder S; S.init(M, D, G, bx);
        pg8::EpiRes E{XBA, IN_F(I_CB2), SSQ(1)};
        pg8::gemm_phase<pg8::EpiRes, pg8::StaticOrder, true, false>(lds + RING_OFF, g, S, E, wave); }
    SEAM(3);
#ifdef MK_XBAR
    xcd_barrier(bar); xcd_barrier(bar); xcd_barrier(bar); xcd_barrier(bar); xcd_barrier(bar); xcd_barrier(bar); xcd_barrier(bar); xcd_barrier(bar); xcd_barrier(bar); xcd_barrier(bar);
#endif
    layer_tail<0>(lds, bar, lo, hi, wave, G, bx, vcu, gw, NGW, NTHR);
    if (IN(10)) DUPLOOP(10) { KArgP ka = kargs(); PH_IDS(); pg8::Gemm g{XBB, WSP(WS_WQKV), M, NQKV, D}; pg8::StaticOrder S; S.init(M, NQKV, G, bx);
        pg8::EpiQKV E{SLOT(0), (size_t)(WS_SS / 2), SSQ(3), (const int*)ka->in[I_POS], attn3::C2};
        pg8::gemm_phase<pg8::EpiQKV, pg8::StaticOrder, true, false>(lds + RING_OFF, g, S, E, wave); }
    SEAM(10);
    if (IN(11)) DUPLOOP(11) { KArgP ka = kargs(); const attn3::Tensors AT{(const attn3::bf16*)SLOT(0), (const attn3::bf16*)SLOT(1), (const attn3::bf16*)SLOT(2), (attn3::bf16*)SLOT(3), (attn3::bf16*)SLOT(4)};
        attn3::attn_phase<8>((char*)lds_raw + RING_OFF, AT, vcu, G, wave); }
    SEAM(11);
    if (IN(12)) DUPLOOP(12) { KArgP ka = kargs(); PH_IDS(); combine_phase(SLOT(3), SLOT(4), SLOT(0), IN_F(I_LAM), IN_F(I_SUBLN), gw, NGW, lane); }
    SEAM(12);
    if (IN(13)) { KArgP ka = kargs(); PH_IDS(); pg8::Gemm g{SLOT(0), WSP(WS_WO), M, D, D}; pg8::StaticOrder S; S.init(M, D, G, bx);
        pg8::EpiRes E{XBB, nullptr, SSQ(4)};
        pg8::gemm_phase<pg8::EpiRes, pg8::StaticOrder, true, false>(lds + RING_OFF, g, S, E, wave); }
    SEAM(13);
    layer_tail<1>(lds, bar, lo, hi, wave, G, bx, vcu, gw, NGW, NTHR);
    if (IN(20)) { KArgP ka = kargs(); PH_IDS(); row_final(ka->out, SSQ(6), IN_F(I_FNORM), gw, NGW, lane);
#ifdef MK_PROBE
        { __syncthreads(); const unsigned* ts = (const unsigned*)(ka->ws + WS_CTL) + CW_TS;
          const float us1 = (float)(__hip_atomic_load(ts + MK_PROBE_B1, RLX_AGENT) - __hip_atomic_load(ts + MK_PROBE_A1, RLX_AGENT)) * 0.01f, us2 = (float)(__hip_atomic_load(ts + MK_PROBE_B2, RLX_AGENT) - __hip_atomic_load(ts + MK_PROBE_A2, RLX_AGENT)) * 0.01f;
          const float sc = 1.f + us1 / (float)(MK_PROBE_S1);
          VM_WAIT(); __syncthreads();
          for (int m = gw; m < M; m += NGW) { GAS f32x4* xr = (GAS f32x4*)(ka->out + (size_t)m * D) + lane;
              for (int j = 0; j < 4; ++j) { f32x4 v = xr[64 * j]; v = v * sc; if (m == 0 && j == 0 && lane == 0) v.x = us2 * (float)(MK_PROBE_S2); xr[64 * j] = v; } } }
#endif
    }
#undef IN
#undef SEAM
}

extern "C" void kernel_launch(void* const* d_in, const int* in_sizes, int n_in, void* d_out, int out_size, void* d_ws, size_t ws_size, hipStream_t stream) {
    static int grid = 0;
    if (grid == 0) {
        if (n_in != N_IN || in_sizes[0] != M * D || out_size != M * D || ws_size < WS_END) { fprintf(stderr, "kernel_launch: unexpected problem: n_in %d in0 %d out %d ws %zu (need %zu); nothing launched\n", n_in, n_in > 0 ? in_sizes[0] : -1, out_size, ws_size, (size_t)WS_END); grid = -1; return; }
        int dev = 0, cus = 0, per_cu = 0;
        if (hipGetDevice(&dev) != hipSuccess || hipDeviceGetAttribute(&cus, hipDeviceAttributeMultiprocessorCount, dev) != hipSuccess) { grid = -1; return; }
        if (hipFuncSetAttribute((const void*)mk_fwd, hipFuncAttributeMaxDynamicSharedMemorySize, LDS_BYTES) != hipSuccess) { fprintf(stderr, "kernel_launch: hipFuncSetAttribute failed\n"); grid = -1; return; }
        if (hipOccupancyMaxActiveBlocksPerMultiprocessor(&per_cu, (const void*)mk_fwd, NWAVES * 64, LDS_BYTES) != hipSuccess || per_cu < 1) { fprintf(stderr, "kernel_launch: occupancy query says %d\n", per_cu); }
        (void)hipGetLastError();
        grid = cus;
        if (grid > 256) grid = 256;
    }
    if (grid < 0) return;
    if (hipMemsetAsync((char*)d_ws + WS_CTL, 0, CTL_ZERO_BYTES, stream) != hipSuccess) return;
    Args a{};
    for (int i = 0; i < N_IN; ++i) a.in[i] = d_in[i];
    a.out = (float*)d_out; a.ws = (unsigned char*)d_ws;
#if MK_SPLIT
    for (int ph = 0; ph < NPHASE; ++ph) { a.ph_lo = ph; a.ph_hi = ph + 1; hipLaunchKernelGGL(mk_fwd, dim3(grid), dim3(NWAVES * 64), LDS_BYTES, stream, a); }
#else
    a.ph_lo = 0; a.ph_hi = NPHASE; hipLaunchKernelGGL(mk_fwd, dim3(grid), dim3(NWAVES * 64), LDS_BYTES, stream, a);
#endif
}
```

```cpp
#include <hip/hip_runtime.h>
#include <hip/hip_bf16.h>
#include <cstdio>
#include <cstdint>
#include <cmath>

#ifndef MK_SPLIT
#define MK_SPLIT 0
#endif

namespace pg8 {
#define PG8_LAS __attribute__((address_space(3)))
typedef unsigned short bf16_t;
typedef short bf16x8 __attribute__((ext_vector_type(8)));
typedef float f32x4 __attribute__((ext_vector_type(4)));
typedef unsigned u32x4 __attribute__((ext_vector_type(4)));
constexpr int BM = 256, BK = 64, HALF = 128, HTB = HALF * BK * 2  , STAGE_BYTES = 8 * HTB, NXCD = 8, WGM = 8;

__host__ __device__ __forceinline__ int lds_byte(int r, int c) { const int st = (r >> 4) * 2 + (c >> 5), rr = r & 15, cc = c & 31, ob = rr * 64 + cc * 2; return st * 1024 + (ob ^ (((ob >> 9) & 1) << 5)); }
__host__ __device__ __forceinline__ void stage_rc(int b, int& R, int& C) { const int st = b / 1024, sb = b % 1024, swz = sb ^ (((sb >> 9) & 1) << 5); R = (st >> 1) * 16 + swz / 64; C = (st & 1) * 32 + (swz % 64) / 2; }
__host__ __device__ __forceinline__ int perm32(int rho) { const int n = rho >> 4, i = rho & 15; return 8 * (i >> 2) + 4 * n + (i & 3); }

__device__ __forceinline__ int ltid(int wave) { int t; asm volatile("v_mbcnt_lo_u32_b32 %0, -1, 0\n\tv_mbcnt_hi_u32_b32 %0, -1, %0" : "=&v"(t)); return wave * 64 + t; }
struct Unit { int pm, pn, pb, aux; };
struct Gemm { const bf16_t* A; const bf16_t* Bt; int M, N, K; };

struct StaticOrder {
    int nM, nN, nwg, G, c;
    __host__ __device__ void init(int M, int N, int G_, int c_) { nM = M / BM; nN = N / BM; nwg = nM * nN; G = G_; c = c_; }
    __host__ __device__ bool next(int i, Unit& u) const {
        const long L = (long)i * G + c; if (L >= nwg) return false;
        int wgid = (int)L; { const int q = nwg / NXCD, r = nwg % NXCD, xcd = wgid % NXCD, off = wgid / NXCD; wgid = (xcd < r ? xcd * (q + 1) : r * (q + 1) + (xcd - r) * q) + off; }
        const int nig = WGM * nN, gid = wgid / nig, fm = gid * WGM, gsz = (nM - fm) < WGM ? (nM - fm) : WGM;
        u.pm = fm + ((wgid % nig) % gsz); u.pn = (wgid % nig) / gsz; u.pb = u.pn; u.aux = 0; return true;
    }
    __device__ __forceinline__ unsigned arow(int, int) const { return 0u; }
};

__device__ __forceinline__ unsigned cvt_pk_bf16(float lo, float hi) { unsigned r; asm volatile("v_cvt_pk_bf16_f32 %0, %1, %2" : "=v"(r) : "v"(lo), "v"(hi)); return r; }

typedef float f32x2e __attribute__((ext_vector_type(2)));
__device__ __forceinline__ float bf_lo(unsigned u) { return __builtin_bit_cast(float, u << 16); }
__device__ __forceinline__ float bf_hi(unsigned u) { return __builtin_bit_cast(float, u & 0xffff0000u); }
__device__ __forceinline__ float sigm_f(float x) { return __builtin_amdgcn_rcpf(1.f + __expf(-x)); }
__device__ __forceinline__ float silu_f(float x) { return x * sigm_f(x); }
__device__ __forceinline__ float ss_sum(const float* ssp, int row) { const f32x4* p = (const f32x4*)(ssp + (size_t)row * 16); const f32x4 a = p[0], b = p[1], c = p[2], d = p[3];
    return (((a[0] + a[1]) + (a[2] + a[3])) + ((b[0] + b[1]) + (b[2] + b[3]))) + (((c[0] + c[1]) + (c[2] + c[3])) + ((d[0] + d[1]) + (d[2] + d[3]))); }
__device__ __forceinline__ float rs_of(const float* ssp, int row) { return 1.f / sqrtf(ss_sum(ssp, row) * (1.f / 1024.f) + 1e-6f); }
__device__ __forceinline__ float rs_of_q(const float* ssp, int row, int fq) { const f32x4 a = *((const f32x4*)(ssp + (size_t)row * 16) + fq); float s = (a[0] + a[1]) + (a[2] + a[3]);
    s += __shfl_xor(s, 16); s += __shfl_xor(s, 32); return 1.f / sqrtf(s * (1.f / 1024.f) + 1e-6f); }
__device__ __forceinline__ u32x4 pack8(const f32x4& v0, const f32x4& v1) { u32x4 w; w.x = cvt_pk_bf16(v0[0], v0[1]); w.y = cvt_pk_bf16(v0[2], v0[3]); w.z = cvt_pk_bf16(v1[0], v1[1]); w.w = cvt_pk_bf16(v1[2], v1[3]); return w; }
__device__ __forceinline__ void unpack8(const u32x4& w, f32x4& v0, f32x4& v1) { v0 = (f32x4){bf_lo(w.x), bf_hi(w.x), bf_lo(w.y), bf_hi(w.y)}; v1 = (f32x4){bf_lo(w.z), bf_hi(w.z), bf_lo(w.w), bf_hi(w.w)}; }
__device__ __forceinline__ float sumsq8(const f32x4& a, const f32x4& b) { return (a[0] * a[0] + a[1] * a[1]) + (a[2] * a[2] + a[3] * a[3]) + (b[0] * b[0] + b[1] * b[1]) + (b[2] * b[2] + b[3] * b[3]); }
__device__ __forceinline__ void ss_put(float* ssp, int row, int slot, float part, int fq) { part += __shfl_xor(part, 16); part += __shfl_xor(part, 32); if (fq == 0) ssp[(size_t)row * 16 + slot] = part; }

struct EpiBf16 {
    static constexpr bool PERM = true;
    bf16_t* O; int ldc;
    __device__ __forceinline__ void operator()(const f32x4 (&acc)[2][2][4][2], const Unit& u, int wr, int wc, int fr, int fq) const {
        const int row0 = u.pm * BM + wr * 64 + fr, col0 = u.pn * BM + wc * 32 + 8 * fq;
#pragma unroll
        for (int ai = 0; ai < 2; ++ai)
#pragma unroll
            for (int m = 0; m < 4; ++m) { bf16_t* rowp = O + (size_t)(row0 + ai * HALF + m * 16) * ldc + col0;
#pragma unroll
                for (int bj = 0; bj < 2; ++bj) *(u32x4*)(rowp + bj * HALF) = pack8(acc[ai][bj][m][0], acc[ai][bj][m][1]); }
    }
};
struct EpiGLU {
    static constexpr bool PERM = true;
    bf16_t* O; const float* bias; const float* ss;
    __device__ __forceinline__ void operator()(const f32x4 (&acc)[2][2][4][2], const Unit& u, int wr, int wc, int fr, int fq) const {
        const int row0 = u.pm * BM + wr * 64 + fr, c0 = u.pn * HALF + wc * 32 + 8 * fq;
        const f32x4 ba0 = *(const f32x4*)(bias + c0), ba1 = *(const f32x4*)(bias + c0 + 4), bg0 = *(const f32x4*)(bias + 1024 + c0), bg1 = *(const f32x4*)(bias + 1024 + c0 + 4);
        float rr[2][4];
#pragma unroll
        for (int ai = 0; ai < 2; ++ai)
#pragma unroll
            for (int m = 0; m < 4; ++m) rr[ai][m] = rs_of_q(ss, row0 + ai * HALF + m * 16, fq);
#pragma unroll
        for (int ai = 0; ai < 2; ++ai)
#pragma unroll
            for (int m = 0; m < 4; ++m) { const int row = row0 + ai * HALF + m * 16; const float r = rr[ai][m];
                const f32x4 a0 = acc[ai][0][m][0] * r + ba0, a1 = acc[ai][0][m][1] * r + ba1, g0 = acc[ai][1][m][0] * r + bg0, g1 = acc[ai][1][m][1] * r + bg1;
                const f32x4 v0 = {a0[0] * sigm_f(g0[0]), a0[1] * sigm_f(g0[1]), a0[2] * sigm_f(g0[2]), a0[3] * sigm_f(g0[3])}, v1 = {a1[0] * sigm_f(g1[0]), a1[1] * sigm_f(g1[1]), a1[2] * sigm_f(g1[2]), a1[3] * sigm_f(g1[3])};
                *(u32x4*)(O + (size_t)row * 1024 + c0) = pack8(v0, v1); }
    }
};
struct EpiRes {
    static constexpr bool PERM = true;
    bf16_t* X; const float* bias; float* ss;
    __device__ __forceinline__ void operator()(const f32x4 (&acc)[2][2][4][2], const Unit& u, int wr, int wc, int fr, int fq) const {
        const int row0 = u.pm * BM + wr * 64 + fr, col0 = u.pn * BM + wc * 32 + 8 * fq;
        f32x4 bv[2][2];
#pragma unroll
        for (int bj = 0; bj < 2; ++bj)
#pragma unroll
            for (int n = 0; n < 2; ++n) bv[bj][n] = bias ? *(const f32x4*)(bias + col0 + bj * HALF + 4 * n) : (f32x4){0.f, 0.f, 0.f, 0.f};
#pragma unroll
        for (int ai = 0; ai < 2; ++ai) {
            u32x4 xo[4][2];
#pragma unroll
            for (int m = 0; m < 4; ++m)
#pragma unroll
                for (int bj = 0; bj < 2; ++bj) xo[m][bj] = *(const u32x4*)(X + (size_t)(row0 + ai * HALF + m * 16) * 1024 + col0 + bj * HALF);
#pragma unroll
            for (int m = 0; m < 4; ++m) { const int row = row0 + ai * HALF + m * 16; bf16_t* rowp = X + (size_t)row * 1024 + col0; float part = 0.f;
#pragma unroll
                for (int bj = 0; bj < 2; ++bj) { f32x4 x0, x1; unpack8(xo[m][bj], x0, x1);
                    const f32x4 v0 = acc[ai][bj][m][0] + bv[bj][0] + x0, v1 = acc[ai][bj][m][1] + bv[bj][1] + x1; part += sumsq8(v0, v1);
                    *(u32x4*)(rowp + bj * HALF) = pack8(v0, v1); }
                ss_put(ss, row, u.pn * 4 + wc, part, fq); } }
    }
};
template <bool F32OUT> struct EpiPle {
    static constexpr bool PERM = true;
    const bf16_t* Xin; const bf16_t* P; bf16_t* Xo; float* Fo; const float* ssin; float* ssout;
    __device__ __forceinline__ void operator()(const f32x4 (&acc)[2][2][4][2], const Unit& u, int wr, int wc, int fr, int fq) const {
        const int row0 = u.pm * BM + wr * 64 + fr, col0 = u.pn * BM + wc * 32 + 8 * fq;
#pragma unroll
        for (int ai = 0; ai < 2; ++ai) {
            u32x4 xo[4][2], po[4][2]; float rr[4];
#pragma unroll
            for (int m = 0; m < 4; ++m) { const size_t off = (size_t)(row0 + ai * HALF + m * 16) * 1024 + col0; rr[m] = rs_of_q(ssin, row0 + ai * HALF + m * 16, fq);
#pragma unroll
                for (int bj = 0; bj < 2; ++bj) { xo[m][bj] = *(const u32x4*)(Xin + off + bj * HALF); po[m][bj] = *(const u32x4*)(P + off + bj * HALF); } }
#pragma unroll
            for (int m = 0; m < 4; ++m) { const int row = row0 + ai * HALF + m * 16; const size_t off = (size_t)row * 1024 + col0; const float r = rr[m]; float part = 0.f;
#pragma unroll
                for (int bj = 0; bj < 2; ++bj) { f32x4 x0, x1, p0, p1; unpack8(xo[m][bj], x0, x1); unpack8(po[m][bj], p0, p1);
                    const f32x4 a0 = acc[ai][bj][m][0] * r, a1 = acc[ai][bj][m][1] * r;
                    const f32x4 v0 = {x0[0] + sigm_f(a0[0]) * p0[0], x0[1] + sigm_f(a0[1]) * p0[1], x0[2] + sigm_f(a0[2]) * p0[2], x0[3] + sigm_f(a0[3]) * p0[3]};
                    const f32x4 v1 = {x1[0] + sigm_f(a1[0]) * p1[0], x1[1] + sigm_f(a1[1]) * p1[1], x1[2] + sigm_f(a1[2]) * p1[2], x1[3] + sigm_f(a1[3]) * p1[3]};
                    part += sumsq8(v0, v1);
                    if (F32OUT) { *(f32x4*)(Fo + off + bj * HALF) = v0; *(f32x4*)(Fo + off + bj * HALF + 4) = v1; } else *(u32x4*)(Xo + off + bj * HALF) = pack8(v0, v1); }
                ss_put(ssout, row, u.pn * 4 + wc, part, fq); } }
    }
};
struct EpiLogits {
    static constexpr bool PERM = false;
    float* O; const float* ss;
    __device__ __forceinline__ void operator()(const f32x4 (&acc)[2][2][4][2], const Unit& u, int wr, int wc, int fr, int fq) const {
        if (wc < 2) {
            const int row0 = u.pm * BM + wr * 64 + fr;
            float rr[2][4];
#pragma unroll
            for (int ai = 0; ai < 2; ++ai)
#pragma unroll
                for (int m = 0; m < 4; ++m) rr[ai][m] = rs_of_q(ss, row0 + ai * HALF + m * 16, fq);
#pragma unroll
            for (int ai = 0; ai < 2; ++ai)
#pragma unroll
                for (int m = 0; m < 4; ++m) { const int row = row0 + ai * HALF + m * 16;
#pragma unroll
                    for (int n = 0; n < 2; ++n) *(f32x4*)(O + (size_t)row * 64 + wc * 32 + n * 16 + 4 * fq) = acc[ai][0][m][n] * rr[ai][m]; }
        }
    }
};
struct EpiGU {
    static constexpr bool PERM = true;
    bf16_t* O; const float* rp;
    __device__ __forceinline__ void operator()(const f32x4 (&acc)[2][2][4][2], const Unit& u, int wr, int wc, int fr, int fq) const {
        const int trow0 = wr * 64 + fr, col0 = u.pn * HALF + wc * 32 + 8 * fq;
        float rr[2][4];
#pragma unroll
        for (int ai = 0; ai < 2; ++ai)
#pragma unroll
            for (int m = 0; m < 4; ++m) rr[ai][m] = rp[(size_t)u.aux + trow0 + ai * HALF + m * 16];
#pragma unroll
        for (int ai = 0; ai < 2; ++ai)
#pragma unroll
            for (int m = 0; m < 4; ++m) { const int trow = trow0 + ai * HALF + m * 16; const float r = rr[ai][m];
                const f32x4 g0 = acc[ai][0][m][0] * r, g1 = acc[ai][0][m][1] * r, u0 = acc[ai][1][m][0] * r, u1 = acc[ai][1][m][1] * r;
                const f32x4 v0 = {silu_f(g0[0]) * u0[0], silu_f(g0[1]) * u0[1], silu_f(g0[2]) * u0[2], silu_f(g0[3]) * u0[3]}, v1 = {silu_f(g1[0]) * u1[0], silu_f(g1[1]) * u1[1], silu_f(g1[2]) * u1[2], silu_f(g1[3]) * u1[3]};
                *(u32x4*)(O + (size_t)(u.pm * BM + trow) * 256 + col0) = pack8(v0, v1); }
    }
};
struct EpiQKV {
    static constexpr bool PERM = true;
    bf16_t* O; size_t stride; const float* ss; const int* pos; float scaleq;
    __device__ __forceinline__ void operator()(const f32x4 (&acc)[2][2][4][2], const Unit& u, int wr, int wc, int fr, int fq) const {
        const int t = (u.pn * BM) >> 10, colt = (u.pn * BM) & 1023, row0 = u.pm * BM + wr * 64 + fr, col0 = colt + wc * 32 + 8 * fq;
        bf16_t* base = O + (size_t)t * stride; const float sc = (t == 0) ? scaleq : 1.f; const bool roped = (t < 2) && ((wc & 1) == 0);
        float rr[2][4]; int pp[2][4];
#pragma unroll
        for (int ai = 0; ai < 2; ++ai)
#pragma unroll
            for (int m = 0; m < 4; ++m) { rr[ai][m] = rs_of_q(ss, row0 + ai * HALF + m * 16, fq) * sc; pp[ai][m] = pos[row0 + ai * HALF + m * 16]; }
#pragma unroll
        for (int ai = 0; ai < 2; ++ai)
#pragma unroll
            for (int m = 0; m < 4; ++m) { const int row = row0 + ai * HALF + m * 16; const float r = rr[ai][m];
                float cs[8], sn[8];
                if (roped) { const float fp = (float)pp[ai][m];
#pragma unroll
                    for (int i = 0; i < 8; ++i) { const float invf = __builtin_powf(500000.0f, -(float)i / 8.0f); const float ang = fp * invf, rev = ang * 0.15915494309189535f, fr_ = rev - __builtin_floorf(rev);
                        sn[i] = __builtin_amdgcn_sinf(fr_); cs[i] = __builtin_amdgcn_cosf(fr_); if (fq == 0) sn[i] = -sn[i]; } }
#pragma unroll
                for (int bj = 0; bj < 2; ++bj) { f32x4 v0 = acc[ai][bj][m][0] * r, v1 = acc[ai][bj][m][1] * r;
                    if (roped) { float pv[8];
#pragma unroll
                        for (int i = 0; i < 4; ++i) { pv[i] = __shfl_xor(v0[i], 16); pv[4 + i] = __shfl_xor(v1[i], 16); }
                        if (fq < 2) {
#pragma unroll
                            for (int i = 0; i < 4; ++i) { v0[i] = v0[i] * cs[i] + pv[i] * sn[i]; v1[i] = v1[i] * cs[4 + i] + pv[4 + i] * sn[4 + i]; } } }
                    *(u32x4*)(base + (size_t)row * 1024 + col0 + bj * HALF) = pack8(v0, v1); } }
    }
};

template <class Epi, class Sched, bool ALIGN_EPI, bool GATHER>
__device__ __forceinline__ void gemm_phase(PG8_LAS unsigned char* lds, const Gemm g, const Sched& S, const Epi& E, int wave_) {
    const int tid = ltid(wave_), wid = wave_, lane = tid & 63, wr = wid >> 2, wc = wid & 3, fr = lane & 15, fq = lane >> 4;
    const int K = g.K, nt = K / BK;
    unsigned voffA[2], voffB[2]; int sR[2], sC[2];
#pragma unroll
    for (int i = 0; i < 2; ++i) { int R, C; stage_rc(tid * 16 + i * 8192, R, C); const int Rb = Epi::PERM ? ((R & ~31) + perm32(R & 31)) : R;
        sR[i] = R; sC[i] = C; voffA[i] = (unsigned)(R * K + C) * 2u; voffB[i] = (unsigned)(Rb * K + C) * 2u; }
    const size_t kstep = (size_t)(BK * 2);
    const size_t hstep = (size_t)HALF * K * 2;
    const size_t tstep = 2 * hstep;
    const unsigned ldsw = (unsigned)wid * 1024u;
    const int aoff = lds_byte(wr * 64 + fr, fq * 8), boff = lds_byte(wc * 32 + fr, fq * 8);
#define PG8_SA(b, h) (((b) * 2 + (h)) * HTB)
#define PG8_SB(b, h) ((4 + (b) * 2 + (h)) * HTB)
#define PG8_STAGE(bufoff, gbase, voff) do { _Pragma("unroll") for (int _i = 0; _i < 2; ++_i) \
        __builtin_amdgcn_global_load_lds((const unsigned*)((const char*)(gbase) + (voff)[_i]), (PG8_LAS unsigned*)(lds + (bufoff) + ldsw + _i * 8192), 16, 0, 0); } while (0)
#define PG8_STAGE_A(bufoff, base, kb, h, vv) do { _Pragma("unroll") for (int _i = 0; _i < 2; ++_i) { \
        const char* _p = GATHER ? ((const char*)g.A + (kb) + (vv)[h][_i]) : ((const char*)(base) + (kb) + (size_t)(h) * hstep + voffA[_i]); \
        __builtin_amdgcn_global_load_lds((const unsigned*)_p, (PG8_LAS unsigned*)(lds + (bufoff) + ldsw + _i * 8192), 16, 0, 0); } } while (0)
#define PG8_GOFF(vv, ord) do { _Pragma("unroll") for (int _h = 0; _h < 2; ++_h) _Pragma("unroll") for (int _i = 0; _i < 2; ++_i) \
        (vv)[_h][_i] = S.arow((ord), _h * HALF + sR[_i]) * (unsigned)(K * 2) + (unsigned)(sC[_i] * 2); } while (0)
#define PG8_LDA(dst, b, h) do { _Pragma("unroll") for (int m = 0; m < 4; ++m) _Pragma("unroll") for (int k = 0; k < 2; ++k) dst[m][k] = *(const PG8_LAS bf16x8*)(lds + PG8_SA(b, h) + aoff + m * 2048 + k * 1024); } while (0)
#define PG8_LDB(dst, b, h) do { _Pragma("unroll") for (int n = 0; n < 2; ++n) _Pragma("unroll") for (int k = 0; k < 2; ++k) dst[n][k] = *(const PG8_LAS bf16x8*)(lds + PG8_SB(b, h) + boff + n * 2048 + k * 1024); } while (0)
#define PG8_MMA(ai, bj, At, Bt) do { __builtin_amdgcn_s_setprio(1); _Pragma("unroll") for (int m = 0; m < 4; ++m) _Pragma("unroll") for (int n = 0; n < 2; ++n) _Pragma("unroll") for (int k = 0; k < 2; ++k) \
        acc[ai][bj][m][n] = __builtin_amdgcn_mfma_f32_16x16x32_bf16(Bt[n][k], At[m][k], acc[ai][bj][m][n], 0, 0, 0); __builtin_amdgcn_s_setprio(0); } while (0)
#define PG8_WAIT_V(n) asm volatile("s_waitcnt vmcnt(" #n ")" ::: "memory")
#define PG8_WAIT_L(n) asm volatile("s_waitcnt lgkmcnt(" #n ")" ::: "memory")
#define PG8_BAR __builtin_amdgcn_s_barrier()
#define PG8_SCHED __builtin_amdgcn_sched_barrier(0)
    Unit cur, nxt; int ui = 0;
    if (!S.next(0, cur)) return;
    f32x4 acc[2][2][4][2];
#pragma unroll
    for (int a = 0; a < 2; ++a)
#pragma unroll
        for (int b = 0; b < 2; ++b)
#pragma unroll
            for (int m = 0; m < 4; ++m)
#pragma unroll
                for (int n = 0; n < 2; ++n) acc[a][b][m][n] = (f32x4){0.f, 0.f, 0.f, 0.f};
    bf16x8 At[4][2], B0[2][2], B1[2][2];
    unsigned vA[2][2] = {{0u, 0u}, {0u, 0u}}, vN[2][2] = {{0u, 0u}, {0u, 0u}}, vS[2][2] = {{0u, 0u}, {0u, 0u}};
    if constexpr (GATHER) { PG8_GOFF(vA, 0); }
    const char* cA = GATHER ? (const char*)g.A : (const char*)g.A + (size_t)cur.pm * tstep; const char* cB = (const char*)g.Bt + (size_t)cur.pb * tstep;
    PG8_STAGE(PG8_SB(0, 0), cB, voffB); PG8_STAGE(PG8_SB(0, 1), cB + hstep, voffB); PG8_STAGE_A(PG8_SA(0, 0), cA, 0, 0, vA); PG8_STAGE_A(PG8_SA(0, 1), cA, 0, 1, vA);
    if (wr == 1) PG8_BAR;
    PG8_WAIT_V(2); PG8_BAR;
    PG8_STAGE(PG8_SB(1, 0), cB + kstep, voffB); PG8_STAGE_A(PG8_SA(1, 0), cA, kstep, 0, vA); PG8_STAGE(PG8_SB(1, 1), cB + hstep + kstep, voffB);
    PG8_WAIT_V(6); PG8_BAR;
    for (;;) {
        const bool has_next = S.next(ui + 1, nxt);
        if constexpr (GATHER) { if (has_next) { PG8_GOFF(vN, ui + 1); } else { _Pragma("unroll") for (int _h = 0; _h < 2; ++_h) _Pragma("unroll") for (int _i = 0; _i < 2; ++_i) vN[_h][_i] = vA[_h][_i]; } }
        const char* nA = (has_next && !GATHER) ? (const char*)g.A + (size_t)nxt.pm * tstep : cA; const char* nB = has_next ? (const char*)g.Bt + (size_t)nxt.pb * tstep : cB;
        for (int t = 0; t < nt; t += 2) {
            const bool last = (t == nt - 2);
            const size_t kb1 = (size_t)(t + 1) * kstep, kb2 = last ? (size_t)0 : (size_t)(t + 2) * kstep, kb3 = kb2 + kstep;
            const char* sA = last ? nA : cA; const char* b2 = last ? nB : cB + (size_t)(t + 2) * kstep; const char* b3 = b2 + kstep;
            if constexpr (GATHER) { _Pragma("unroll") for (int _h = 0; _h < 2; ++_h) _Pragma("unroll") for (int _i = 0; _i < 2; ++_i) vS[_h][_i] = last ? vN[_h][_i] : vA[_h][_i]; }
            PG8_LDB(B0, 0, 0); PG8_LDB(B1, 0, 1); PG8_SCHED; PG8_LDA(At, 0, 0); PG8_STAGE_A(PG8_SA(1, 1), cA, kb1, 1, vA);
            PG8_WAIT_V(8); PG8_WAIT_L(0); PG8_BAR; PG8_MMA(0, 0, At, B0); PG8_MMA(0, 1, At, B1); PG8_BAR; PG8_SCHED;
            PG8_LDA(At, 0, 1); PG8_STAGE(PG8_SB(0, 0), b2, voffB); PG8_STAGE(PG8_SB(0, 1), b2 + hstep, voffB); PG8_STAGE_A(PG8_SA(0, 0), sA, kb2, 0, vS);
            PG8_WAIT_V(8); PG8_WAIT_L(0); PG8_BAR; PG8_MMA(1, 0, At, B0); PG8_MMA(1, 1, At, B1); PG8_BAR; PG8_SCHED;
            PG8_LDB(B0, 1, 0); PG8_LDB(B1, 1, 1); PG8_SCHED; PG8_LDA(At, 1, 0); PG8_STAGE_A(PG8_SA(0, 1), sA, kb2, 1, vS);
            PG8_WAIT_V(8); PG8_WAIT_L(0); PG8_BAR; PG8_MMA(0, 0, At, B0); PG8_MMA(0, 1, At, B1); PG8_BAR; PG8_SCHED;
            PG8_LDA(At, 1, 1); PG8_STAGE(PG8_SB(1, 0), b3, voffB); PG8_STAGE(PG8_SB(1, 1), b3 + hstep, voffB); PG8_STAGE_A(PG8_SA(1, 0), sA, kb3, 0, vS);
            PG8_WAIT_V(8); PG8_WAIT_L(0); PG8_BAR; PG8_MMA(1, 0, At, B0); PG8_MMA(1, 1, At, B1); PG8_BAR; PG8_SCHED;
        }
        if constexpr (ALIGN_EPI) { if (wr == 0) PG8_BAR; }
        E(acc, cur, wr, wc, fr, fq);
        if (!has_next) break;
#pragma unroll
        for (int a = 0; a < 2; ++a)
#pragma unroll
            for (int b = 0; b < 2; ++b)
#pragma unroll
                for (int m = 0; m < 4; ++m)
#pragma unroll
                    for (int n = 0; n < 2; ++n) acc[a][b][m][n] = (f32x4){0.f, 0.f, 0.f, 0.f};
        cur = nxt; cA = nA; cB = nB; ++ui;
        if constexpr (GATHER) { _Pragma("unroll") for (int _h = 0; _h < 2; ++_h) _Pragma("unroll") for (int _i = 0; _i < 2; ++_i) vA[_h][_i] = vN[_h][_i]; }
        if constexpr (ALIGN_EPI) { if (wr == 1) PG8_BAR; }
    }
    PG8_WAIT_V(0);
    if constexpr (!ALIGN_EPI) { if (wr == 0) PG8_BAR; }
    PG8_BAR;
#undef PG8_SA
#undef PG8_SB
#undef PG8_STAGE
#undef PG8_STAGE_A
#undef PG8_GOFF
#undef PG8_LDA
#undef PG8_LDB
#undef PG8_MMA
#undef PG8_WAIT_V
#undef PG8_WAIT_L
#undef PG8_BAR
#undef PG8_SCHED
}
}

#include <hip/hip_bf16.h>
#include <cmath>
namespace attn3 {
using bf16=__hip_bfloat16;
using bf16x8=__attribute__((ext_vector_type(8)))short;
using s16x4=__attribute__((ext_vector_type(4)))short;
using f32x16=__attribute__((ext_vector_type(16)))float;
using u32x4=__attribute__((ext_vector_type(4)))unsigned;
constexpr int BATCH=8,SEQ=4096,D=64,DV=128,DM=1024;
constexpr int NW=8,QBLK=32,QB=QBLK*NW,KVBLK=64,NQB=SEQ/QB;
__device__ __forceinline__ int crow(int r,int hi){return (r&3)+8*(r>>2)+4*hi;}
#define SBAR() __builtin_amdgcn_sched_barrier(0)
__device__ __forceinline__ void cmask(f32x16&p0,f32x16&p1,int jb,int qrel,int hi){
  const float NEG=-INFINITY; int kb=64*jb+4*hi;
  #pragma unroll
  for(int r=0;r<16;++r){int kv=kb+(r&3)+8*(r>>2); if(kv>qrel)p0[r]=NEG; if(kv+32>qrel)p1[r]=NEG;}
}

constexpr int NSLOT=3, SLOTB=8192;
constexpr int VSLOTB=2*SLOTB;
constexpr int LDS_K=0, LDS_V=NSLOT*SLOTB, LDS_WS=LDS_V+NSLOT*VSLOTB, LDS_OST=LDS_WS+NW*64*4, LDS_BYTES=LDS_OST+NW*4096;
constexpr float C2=0.125f*1.4426950408889634f;
__device__ __forceinline__ void glds16(const void*gsrc,unsigned lds_dst){unsigned keep;
  asm volatile("s_mov_b32 %0, m0\n\ts_mov_b32 m0, %2\n\ts_nop 0\n\tglobal_load_lds_dwordx4 %1, off\n\ts_mov_b32 m0, %0":"=&s"(keep):"v"(gsrc),"s"(lds_dst):"memory");}
__device__ __forceinline__ float max3f(float a,float b,float c){float r;asm("v_max3_f32 %0, %1, %2, %3":"=v"(r):"v"(a),"v"(b),"v"(c));return r;}
__device__ __forceinline__ float max2f(float a,float b){float r;asm("v_max_f32_e32 %0, %1, %2":"=v"(r):"v"(a),"v"(b));return r;}
__device__ __forceinline__ float fadd_s(float a,float b){float r;asm("v_add_f32_e32 %0, %1, %2":"=v"(r):"v"(a),"v"(b));return r;}
__device__ __forceinline__ float fsub_s(float a,float b){float r;asm("v_sub_f32_e32 %0, %1, %2":"=v"(r):"v"(a),"v"(b));return r;}
typedef float f32x2_t __attribute__((ext_vector_type(2))); typedef __bf16 bf16x2_t __attribute__((ext_vector_type(2)));
__device__ __forceinline__ unsigned cvtpk_s(float lo,float hi){f32x2_t v={lo,hi};bf16x2_t b=__builtin_convertvector(v,bf16x2_t);return __builtin_bit_cast(unsigned,b);}
#define WAIT_BAR(N) asm volatile("s_waitcnt vmcnt(" #N ") lgkmcnt(0)\n\ts_barrier":::"memory")

__device__ __forceinline__ void qkt(f32x16&p0,f32x16&p1,const char*Kslot,const bf16x8*qr,int r32,int hi){
  const char*kb=Kslot+hi*1024+r32*16; const f32x16 z=f32x16{};
  #pragma unroll
  for(int d0=0;d0<4;++d0){
    const bf16x8 b0=*reinterpret_cast<const bf16x8*>(kb+d0*2048);
    const bf16x8 b1=*reinterpret_cast<const bf16x8*>(kb+d0*2048+512);
    if(d0==0){p0=__builtin_amdgcn_mfma_f32_32x32x16_bf16(b0,qr[0],z,0,0,0);p1=__builtin_amdgcn_mfma_f32_32x32x16_bf16(b1,qr[0],z,0,0,0);}
    else{p0=__builtin_amdgcn_mfma_f32_32x32x16_bf16(b0,qr[d0],p0,0,0,0);p1=__builtin_amdgcn_mfma_f32_32x32x16_bf16(b1,qr[d0],p1,0,0,0);}}
}
typedef __attribute__((address_space(3))) const char* lds_cptr;
typedef short v4i16_t __attribute__((ext_vector_type(4)));
__device__ __forceinline__ void kload8(bf16x8*kf,lds_cptr kp){
  kf[0]=*(const __attribute__((address_space(3))) bf16x8*)(kp);      kf[1]=*(const __attribute__((address_space(3))) bf16x8*)(kp+512);
  kf[2]=*(const __attribute__((address_space(3))) bf16x8*)(kp+2048); kf[3]=*(const __attribute__((address_space(3))) bf16x8*)(kp+2560);
  kf[4]=*(const __attribute__((address_space(3))) bf16x8*)(kp+4096); kf[5]=*(const __attribute__((address_space(3))) bf16x8*)(kp+4608);
  kf[6]=*(const __attribute__((address_space(3))) bf16x8*)(kp+6144); kf[7]=*(const __attribute__((address_space(3))) bf16x8*)(kp+6656);
}
__device__ __forceinline__ void kload2(bf16x8*kf,lds_cptr kp,int j){ kf[2*j]=*(const __attribute__((address_space(3))) bf16x8*)(kp+j*2048); kf[2*j+1]=*(const __attribute__((address_space(3))) bf16x8*)(kp+j*2048+512); }
__device__ __forceinline__ s16x4 vtr(lds_cptr p){ return __builtin_bit_cast(s16x4,__builtin_amdgcn_ds_read_tr16_b64_v4i16((__attribute__((address_space(3))) v4i16_t*)p)); }
__device__ __forceinline__ float rowmax(const f32x16&p0,const f32x16&p1){
  float a=max3f(p0[0],p0[1],p1[0]),b=max3f(p0[2],p0[3],p1[1]);a=max3f(a,p1[2],p1[3]);
  #pragma unroll
  for(int r=4;r<16;r+=4){a=max3f(a,p0[r],p0[r+1]);b=max3f(b,p0[r+2],p0[r+3]);a=max3f(a,p1[r],p1[r+1]);b=max3f(b,p1[r+2],p1[r+3]);}
  const float m=max2f(a,b);
  auto rr=__builtin_amdgcn_permlane32_swap(__float_as_uint(m),__float_as_uint(m),false,false);
  return max2f(__uint_as_float(rr[0]),__uint_as_float(rr[1]));
}

#define ATTN_STORE16(p,v) (*(u32x4*)(p)=(v))
template<int THRL> __device__ __forceinline__ void attn_unit(int b,int hc,int qb,const bf16*Q,const bf16*__restrict__ K,const bf16*__restrict__ V,bf16*O,char*shm,int wave_,int mode,float*stash,float lam,const float(&gsub)[4]){
  const int wid=wave_; const int tid=pg8::ltid(wid); const int lane=tid&63,r32=lane&31,hi=lane>>5;
  const long rowbase=(long)b*SEQ; const int q0=qb*QB;
  const bf16*Qw=Q+(rowbase+q0+wid*QBLK)*DM+hc*D;
  const bf16*Kh=K+rowbase*DM+hc*D,*Vh=V+rowbase*DM+(hc>>1)*DV;
  const unsigned lds0=(unsigned)(uintptr_t)shm;
  float*wsf=(float*)(shm+LDS_WS)+wid*64;
  const bf16*ksrc=Kh+(long)lane*DM+wid*8;
  const bf16*vsrc=Vh+(long)(16*(wid&3)+(lane>>2))*DM+(wid>>2)*32+(lane&3)*8;
  const unsigned kdst=lds0+LDS_K+wid*1024, vdst=lds0+LDS_V+wid*1024;
  #define DMA_K(t,slot) glds16(ksrc+(long)(t)*KVBLK*DM,(unsigned)__builtin_amdgcn_readfirstlane(kdst+(slot)))
  #define DMA_V(t,slot) do{ glds16(vsrc+(long)(t)*KVBLK*DM,(unsigned)__builtin_amdgcn_readfirstlane(vdst+2*(slot))); glds16(vsrc+(long)(t)*KVBLK*DM+64,(unsigned)__builtin_amdgcn_readfirstlane(vdst+2*(slot)+8192)); }while(0)
  const char*Kbase=shm+LDS_K; bf16x8 kf[8];
  const lds_cptr shm3=(lds_cptr)shm; const lds_cptr kp0=shm3+LDS_K+hi*1024+r32*16; const lds_cptr vp0=shm3+LDS_V+((lane>>4)&1)*32+(lane&3)*8+(4*hi+((lane&15)>>2))*64;
  const int NT=(q0+QB)/KVBLK;
  bf16x8 qr[4];
  #pragma unroll
  for(int d0=0;d0<4;++d0)qr[d0]=*reinterpret_cast<const bf16x8*>(&Qw[(long)r32*DM+d0*16+hi*8]);
  DMA_K(0,0);DMA_V(0,0);DMA_K(1,SLOTB);DMA_K(2,2*SLOTB);
  float mhat=0.f,l_reg=0.f;f32x16 o[4];o[0]=f32x16{};o[1]=f32x16{};o[2]=f32x16{};o[3]=f32x16{};
  const int qrel=wid*QBLK+r32;
  #define CMASK(P0,P1,t) do{int jb_=(t)-(NT-4); if(jb_>=0)cmask(P0,P1,jb_,qrel,hi);}while(0)
  bool resc=false;
  #define RESC() do{ if(resc){ asm volatile("s_waitcnt lgkmcnt(0)":::"memory"); \
      _Pragma("unroll") for(int d_=0;d_<4;++d_) _Pragma("unroll") for(int r=0;r<16;++r)o[d_][r]*=wsf[crow(r,hi)]; } }while(0)
  f32x16 pA0,pA1,pB0,pB1;
  int sl_prev=0,sl_cur=0,sl_next=SLOTB;
  #define ROT() do{sl_prev=sl_cur;sl_cur=sl_next;sl_next=(sl_next==(NSLOT-1)*SLOTB)?0:sl_next+SLOTB;}while(0)
  WAIT_BAR(4);
  qkt(pA0,pA1,Kbase,qr,r32,hi);asm volatile("s_nop 15\n\ts_nop 7":"+v"(pA0),"+v"(pA1));CMASK(pA0,pA1,0);
  { const float rm=rowmax(pA0,pA1); mhat=rm;
    _Pragma("unroll") for(int r=0;r<16;++r)pA0[r]=__builtin_amdgcn_exp2f(fsub_s(pA0[r],mhat));
    _Pragma("unroll") for(int r=0;r<16;++r)pA1[r]=__builtin_amdgcn_exp2f(fsub_s(pA1[r],mhat)); }
  WAIT_BAR(0);
  DMA_K(3,0);DMA_V(1,SLOTB);
  ROT();
  kload8(kf,kp0+sl_cur);
  WAIT_BAR(3);
  s16x4 vlo[8],vhi[8]; u32x4 pw0,pw1,pw2,pw3;
  #define PKW(P,B) cvtpk_s(P[B],P[B+1])
  #define PAF(k) __builtin_bit_cast(bf16x8,pw##k)
  #define VFS(i) (bf16x8){vlo[i][0],vlo[i][1],vlo[i][2],vlo[i][3],vhi[i][0],vhi[i][1],vhi[i][2],vhi[i][3]}
  #define PIN(x) asm volatile("":"+v"(x))
  #define MX3(a,b,c) __builtin_fmaxf(__builtin_fmaxf((a),(b)),(c))
  #define GAPA(MF,A0,A1,A2,A3,W0,W1,PW) do{ MF; sacc+=A0; sacc+=A1; sacc+=A2; sacc+=A3; PIN(sacc); W0; W1; PIN(PW); SBAR(); }while(0)
  #define EX(v) __builtin_amdgcn_exp2f(v)
  #define GAPB(MF,X,B) do{ MF; X[B]=EX(X[B]-mhat); X[B+1]=EX(X[B+1]-mhat); PIN(X); SBAR(); }while(0)
  #define VRDS(s,db,ks) do{ vlo[s]=vtr(vp_+((db)*4096+(ks)*1024)); vhi[s]=vtr(vp_+((db)*4096+(ks)*1024+512)); }while(0)
  #define KRD(G,j) do{ if(G){ kload2(kf,kp0+sl_next,j); SBAR(); } }while(0)
  #define MF32(a,b,c) __builtin_amdgcn_mfma_f32_32x32x16_bf16(a,b,c,0,0,0)
  #define STEP(C0,C1,P0,P1,t,GK,GV,GL) do{ SBAR(); \
    const lds_cptr vp_=vp0+2*sl_prev; const f32x16 z_=f32x16{}; \
    VRDS(0,0,0); SBAR(); float sacc=(P0[0]+P0[1]); \
    GAPA(C0=MF32(kf[0],qr[0],z_), P0[2],P0[3],P0[4],P0[5],     pw0[0]=PKW(P0,0), pw0[1]=PKW(P0,2), pw0); \
    VRDS(1,1,0); SBAR(); GAPA(C1=MF32(kf[1],qr[0],z_), P0[6],P0[7],P0[8],P0[9],     pw0[2]=PKW(P0,4), pw0[3]=PKW(P0,6), pw0); \
    VRDS(2,2,0); SBAR(); GAPA(C0=MF32(kf[2],qr[1],C0),   P0[10],P0[11],P0[12],P0[13], pw1[0]=PKW(P0,8), pw1[1]=PKW(P0,10), pw1); \
    VRDS(3,3,0); SBAR(); GAPA(C1=MF32(kf[3],qr[1],C1),   P0[14],P0[15],P1[0],P1[1],   pw1[2]=PKW(P0,12),pw1[3]=PKW(P0,14), pw1); \
    VRDS(4,0,1); SBAR(); GAPA(C0=MF32(kf[4],qr[2],C0),   P1[2],P1[3],P1[4],P1[5],     pw2[0]=PKW(P1,0), pw2[1]=PKW(P1,2), pw2); \
    VRDS(5,1,1); SBAR(); GAPA(C1=MF32(kf[5],qr[2],C1),   P1[6],P1[7],P1[8],P1[9],     pw2[2]=PKW(P1,4), pw2[3]=PKW(P1,6), pw2); \
    VRDS(6,2,1); SBAR(); GAPA(C0=MF32(kf[6],qr[3],C0),   P1[10],P1[11],P1[12],P1[13], pw3[0]=PKW(P1,8), pw3[1]=PKW(P1,10), pw3); \
    VRDS(7,3,1); SBAR(); GAPA(C1=MF32(kf[7],qr[3],C1),   P1[14],P1[15],0.f,0.f,       pw3[2]=PKW(P1,12),pw3[3]=PKW(P1,14), pw3); \
    l_reg+=sacc; \
    if(GK){DMA_K((t)+3,sl_cur);} if(GV){DMA_V((t)+1,sl_next);} \
    CMASK(C0,C1,t); \
    { float a=MX3(C0[0],C0[1],C1[0]),b=MX3(C0[2],C0[3],C1[1]); a=MX3(a,C1[2],C1[3]); \
      _Pragma("unroll") for(int r=4;r<16;r+=4){a=MX3(a,C0[r],C0[r+1]);b=MX3(b,C0[r+2],C0[r+3]);a=MX3(a,C1[r],C1[r+1]);b=MX3(b,C1[r+2],C1[r+3]);} \
      float rm=__builtin_fmaxf(a,b); { auto rr=__builtin_amdgcn_permlane32_swap(__float_as_uint(rm),__float_as_uint(rm),false,false); rm=__builtin_fmaxf(__uint_as_float(rr[0]),__uint_as_float(rr[1])); } \
      resc=false; const float dlt=rm-mhat; \
      if(__builtin_expect(__any(dlt>(float)THRL),0)){ const float dl=__builtin_fmaxf(dlt,0.f); mhat+=dl; \
        const float f=__builtin_amdgcn_exp2f(-dl); l_reg*=f; if(hi==0)wsf[r32]=f; resc=true; } } \
    SBAR(); \
    GAPB(o[0]=MF32(PAF(0),VFS(0),o[0]), C0,0); \
    VRDS(0,0,2); SBAR(); GAPB(o[1]=MF32(PAF(0),VFS(1),o[1]), C0,2); \
    VRDS(1,1,2); SBAR(); GAPB(o[2]=MF32(PAF(0),VFS(2),o[2]), C0,4); \
    VRDS(2,2,2); SBAR(); GAPB(o[3]=MF32(PAF(0),VFS(3),o[3]), C0,6); \
    VRDS(3,3,2); SBAR(); GAPB(o[0]=MF32(PAF(1),VFS(4),o[0]), C0,8); \
    VRDS(4,0,3); SBAR(); GAPB(o[1]=MF32(PAF(1),VFS(5),o[1]), C0,10); \
    VRDS(5,1,3); SBAR(); GAPB(o[2]=MF32(PAF(1),VFS(6),o[2]), C0,12); \
    VRDS(6,2,3); SBAR(); GAPB(o[3]=MF32(PAF(1),VFS(7),o[3]), C0,14); \
    VRDS(7,3,3); SBAR(); GAPB(o[0]=MF32(PAF(2),VFS(0),o[0]), C1,0); \
    KRD(GL,0); GAPB(o[1]=MF32(PAF(2),VFS(1),o[1]), C1,2); \
    KRD(GL,1); GAPB(o[2]=MF32(PAF(2),VFS(2),o[2]), C1,4); \
    KRD(GL,2); GAPB(o[3]=MF32(PAF(2),VFS(3),o[3]), C1,6); \
    KRD(GL,3); GAPB(o[0]=MF32(PAF(3),VFS(4),o[0]), C1,8); \
    GAPB(o[1]=MF32(PAF(3),VFS(5),o[1]), C1,10); \
    GAPB(o[2]=MF32(PAF(3),VFS(6),o[2]), C1,12); \
    GAPB(o[3]=MF32(PAF(3),VFS(7),o[3]), C1,14); \
    }while(0)
  int t=1;
  #undef CMASK
  #define CMASK(P0,P1,t) do{}while(0)
  for(;t+5<NT;t+=2){
    STEP(pB0,pB1,pA0,pA1,t,true,true,true);     WAIT_BAR(3); RESC(); ROT();
    STEP(pA0,pA1,pB0,pB1,t+1,true,true,true);   WAIT_BAR(3); RESC(); ROT();
  }
  #undef CMASK
  #define CMASK(P0,P1,t) do{int jb_=(t)-(NT-4); if(jb_>=0)cmask(P0,P1,jb_,qrel,hi);}while(0)
  #define ENDW(tt) do{ if((tt)+3<NT){WAIT_BAR(3);} else if((tt)+2<NT){WAIT_BAR(2);} else {WAIT_BAR(0);} }while(0)
  for(;t+1<NT;t+=2){
    STEP(pB0,pB1,pA0,pA1,t,(t+3<NT),(t+1<NT),(t+1<NT));       ENDW(t);   RESC(); ROT();
    STEP(pA0,pA1,pB0,pB1,t+1,(t+4<NT),(t+2<NT),(t+2<NT));     ENDW(t+1); RESC(); ROT();
  }
  STEP(pB0,pB1,pA0,pA1,NT-1,false,false,false); RESC();
  { float sacc=pB0[0]+pB0[1]; _Pragma("unroll") for(int r=2;r<16;++r)sacc+=pB0[r]; _Pragma("unroll") for(int r=0;r<16;++r)sacc+=pB1[r]; l_reg+=sacc;
    pw0=(u32x4){PKW(pB0,0),PKW(pB0,2),PKW(pB0,4),PKW(pB0,6)};pw1=(u32x4){PKW(pB0,8),PKW(pB0,10),PKW(pB0,12),PKW(pB0,14)};pw2=(u32x4){PKW(pB1,0),PKW(pB1,2),PKW(pB1,4),PKW(pB1,6)};pw3=(u32x4){PKW(pB1,8),PKW(pB1,10),PKW(pB1,12),PKW(pB1,14)};
    SBAR(); const lds_cptr vp_=vp0+2*sl_cur;
    #define DRAIN_KS(ks) do{ VRDS(0,0,ks); VRDS(1,1,ks); VRDS(2,2,ks); VRDS(3,3,ks); \
      o[0]=MF32(PAF(ks),VFS(0),o[0]); o[1]=MF32(PAF(ks),VFS(1),o[1]); o[2]=MF32(PAF(ks),VFS(2),o[2]); o[3]=MF32(PAF(ks),VFS(3),o[3]); SBAR(); }while(0)
    DRAIN_KS(0); DRAIN_KS(1); DRAIN_KS(2); DRAIN_KS(3);
    #undef DRAIN_KS
  }
  #undef PKW
  #undef PAF
  #undef VFS
  #undef PIN
  #undef MX3
  #undef GAPA
  #undef GAPB
  #undef EX
  #undef VRDS
  #undef KRD
  #undef MF32
  #undef STEP
  #undef ENDW
  {auto rr=__builtin_amdgcn_permlane32_swap(__float_as_uint(l_reg),__float_as_uint(l_reg),false,false);l_reg=__uint_as_float(rr[0])+__uint_as_float(rr[1]);}
  if(hi==0)wsf[32+r32]=l_reg;asm volatile("s_waitcnt lgkmcnt(0)":::"memory");
  float rli[16];
  #pragma unroll
  for(int r=0;r<16;++r)rli[r]=__builtin_amdgcn_rcpf(wsf[32+crow(r,hi)]);
  #pragma unroll
  for(int d0=0;d0<4;++d0)
    #pragma unroll
    for(int r=0;r<16;++r)o[d0][r]*=rli[r];
  if(mode==0){
    float*st=stash+tid;
    #pragma unroll
    for(int d0=0;d0<4;++d0)
      #pragma unroll
      for(int r=0;r<16;++r)st[(d0*16+r)*512]=o[d0][r];
  } else {
    const float*st=stash+tid; float ssq[16];
    #pragma unroll
    for(int r=0;r<16;++r)ssq[r]=0.f;
    #pragma unroll
    for(int d0=0;d0<4;++d0)
      #pragma unroll
      for(int r=0;r<16;++r){ const float v=st[(d0*16+r)*512]-lam*o[d0][r]; o[d0][r]=v; ssq[r]+=v*v; }
    #pragma unroll
    for(int r=0;r<16;++r){ float s=ssq[r];
      s+=__builtin_bit_cast(float,__builtin_amdgcn_ds_swizzle(__builtin_bit_cast(int,s),0x041F)); s+=__builtin_bit_cast(float,__builtin_amdgcn_ds_swizzle(__builtin_bit_cast(int,s),0x081F));
      s+=__builtin_bit_cast(float,__builtin_amdgcn_ds_swizzle(__builtin_bit_cast(int,s),0x101F)); s+=__builtin_bit_cast(float,__builtin_amdgcn_ds_swizzle(__builtin_bit_cast(int,s),0x201F));
      s+=__builtin_bit_cast(float,__builtin_amdgcn_ds_swizzle(__builtin_bit_cast(int,s),0x401F));
      ssq[r]=1.f/sqrtf(s*(1.f/128.f)+1e-6f); }
    #pragma unroll
    for(int d0=0;d0<4;++d0)
      #pragma unroll
      for(int r=0;r<16;++r)o[d0][r]*=ssq[r]*gsub[d0];
    bf16*Ow=O+(rowbase+q0+wid*QBLK)*DM+(hc>>1)*DV;
    bf16*stg=(bf16*)(shm+LDS_OST)+wid*2048;
    #pragma unroll
    for(int hh=0;hh<2;++hh){
      #pragma unroll
      for(int r=0;r<16;++r){const int orow=crow(r,hi);
        #pragma unroll
        for(int d0=0;d0<2;++d0)stg[orow*64+d0*32+r32]=__float2bfloat16(o[2*hh+d0][r]);}
      asm volatile("s_waitcnt lgkmcnt(0)":::"memory");
      #pragma unroll
      for(int i=0;i<4;++i){const int row=i*8+(lane>>3),ch=lane&7; const u32x4 v=*(const u32x4*)(stg+row*64+ch*8); ATTN_STORE16(Ow+(long)row*DM+hh*64+ch*8,v);}
      asm volatile("s_waitcnt lgkmcnt(0)":::"memory"); }
  }
  asm volatile("s_waitcnt lgkmcnt(0)\n\ts_barrier":::"memory");
  #undef DMA_K
  #undef DMA_V
  #undef CMASK
  #undef RESC
  #undef ROT
}
constexpr int ATTN_LDS_BYTES=LDS_BYTES;
struct Tensors { const bf16* Q; const bf16* K; const bf16* V; bf16* OC; float* stash; const float* lamp; const float* subln; };
template<int THRL=8> __device__ __forceinline__ void attn_phase(char*lds,const Tensors&T,int vcu,int G,int wave_,float lam_init){
  const int lane=pg8::ltid(0)&63;
  float l1=T.lamp[lane]*T.lamp[64+lane],l2=T.lamp[128+lane]*T.lamp[192+lane];
  #pragma unroll
  for(int o_=1;o_<64;o_<<=1){l1+=__shfl_xor(l1,o_);l2+=__shfl_xor(l2,o_);}
  const float lam=__expf(l1)-__expf(l2)+lam_init;
  float gsub[4];
  #pragma unroll
  for(int d0=0;d0<4;++d0)gsub[d0]=T.subln[d0*32+(lane&31)]*(1.0f-lam_init);
  float*stash=T.stash+(size_t)blockIdx.x*(256*128);
  for(int L=vcu;L<8*8*8;L+=G){ const int bh=L>>3,p=L&7,b=bh>>3,h=bh&7;
    attn_unit<THRL>(b,2*h,p,T.Q,T.K,T.V,T.OC,lds,wave_,0,stash,lam,gsub);
    attn_unit<THRL>(b,2*h+1,p,T.Q,T.K,T.V,T.OC,lds,wave_,1,stash,lam,gsub);
    attn_unit<THRL>(b,2*h,15-p,T.Q,T.K,T.V,T.OC,lds,wave_,0,stash,lam,gsub);
    attn_unit<THRL>(b,2*h+1,15-p,T.Q,T.K,T.V,T.OC,lds,wave_,1,stash,lam,gsub); }
}
#undef SBAR
#undef WAIT_BAR
}
#define GAS __attribute__((address_space(1)))
#define LAS __attribute__((address_space(3)))
typedef unsigned short bf16;
typedef unsigned v4u __attribute__((ext_vector_type(4)));
typedef float f32x4 __attribute__((ext_vector_type(4)));
typedef short bf16x8 __attribute__((ext_vector_type(8)));
typedef GAS unsigned gu32;
typedef GAS unsigned long long gu64;
#define RLX_AGENT __ATOMIC_RELAXED, __HIP_MEMORY_SCOPE_AGENT
#define LDS_WAIT() asm volatile("s_waitcnt lgkmcnt(0)" ::: "memory")
#define VM_WAIT() asm volatile("s_waitcnt vmcnt(0)" ::: "memory")
__device__ __forceinline__ unsigned long long rt() { return __builtin_amdgcn_s_memrealtime(); }
__device__ __forceinline__ unsigned f2bf(float f) { unsigned u = __builtin_bit_cast(unsigned, f); return (u + 0x7fffu + ((u >> 16) & 1u)) >> 16; }
__device__ __forceinline__ unsigned pk2(float lo, float hi) { return f2bf(lo) | (f2bf(hi) << 16); }

#define XB_TMO      128
#define XB_XCNT(j)  (256  + 64 * (j))
#define XB_XSUB(j)  (1280 + 64 * (j))
#define XB_XGEN(j)  (2304 + 64 * (j))
#define XB_TOP      3328
#define XB_TOPGEN   3392
#define XCD_BAR_WORDS 3456
#define XB_SPIN_CAP (1u << 18)

__device__ __forceinline__ unsigned xb_ld(unsigned* p)              { return __hip_atomic_load(p, __ATOMIC_RELAXED, __HIP_MEMORY_SCOPE_AGENT); }
__device__ __forceinline__ unsigned xb_add(unsigned* p, unsigned v) { return __hip_atomic_fetch_add(p, v, __ATOMIC_RELAXED, __HIP_MEMORY_SCOPE_AGENT); }
__device__ __forceinline__ unsigned xb_xcc_id() { return (unsigned)__builtin_amdgcn_s_getreg((3 << 11) | 20) & 0xFu; }
#define XB_SPIN(cond, bar) do { unsigned _sp = 0; while (cond) { __builtin_amdgcn_s_sleep(1); \
    if ((++_sp & 255u) == 0u) { if (xb_ld(&(bar)[XB_TMO])) break; if (_sp > XB_SPIN_CAP) { atomicAdd(&(bar)[XB_TMO], 1u); break; } } } } while (0)

struct XcdBarrier {
    unsigned* bar; unsigned x;
    volatile LAS unsigned* st;
};

__device__ __forceinline__ XcdBarrier xcd_barrier_post(unsigned* bar, volatile LAS unsigned* st) {
    XcdBarrier b; b.bar = bar; b.x = xb_xcc_id(); b.st = st;
    if (threadIdx.x == 0) (void)xb_add(&bar[XB_XCNT(b.x)], 1u);
    return b;
}
__device__ __forceinline__ void xcd_barrier_complete(unsigned* bar, unsigned x, unsigned& nloc, unsigned& nx) {
    const unsigned G = gridDim.x * gridDim.y * gridDim.z;
    unsigned sum, cnt, mine, sp = 0u;
    for (;;) {
        sum = 0u; cnt = 0u; mine = 0u;
#pragma unroll
        for (unsigned j = 0; j < 16; ++j) { const unsigned c = xb_ld(&bar[XB_XCNT(j)]); sum += c; cnt += (c > 0u) ? 1u : 0u; mine = (j == x) ? c : mine; }
        if (sum == G) break;
        __builtin_amdgcn_s_sleep(1);
        if ((++sp & 255u) == 0u) { if (xb_ld(&bar[XB_TMO])) break; if (sp > XB_SPIN_CAP) { atomicAdd(&bar[XB_TMO], 1u); break; } }
    }
    nloc = mine > 0u ? mine : 1u; nx = cnt > 0u ? cnt : 1u;
}

__device__ __forceinline__ void xcd_barrier(const XcdBarrier& b) {
    asm volatile("s_waitcnt vmcnt(0)" ::: "memory");
    __syncthreads();
    if (threadIdx.x == 0) {
        unsigned* bar = b.bar;
        __builtin_amdgcn_s_waitcnt(0);
        unsigned nloc = b.st[0], nx = b.st[1];
        if (nloc == 0u) { xcd_barrier_complete(bar, b.x, nloc, nx); b.st[0] = nloc; b.st[1] = nx; }
        const unsigned old = xb_add(&bar[XB_XSUB(b.x)], 1u);
        const unsigned gen = old / nloc;
        if (old + 1u == (gen + 1u) * nloc) {
            __builtin_amdgcn_fence(__ATOMIC_RELEASE, "agent");
            asm volatile("s_waitcnt vmcnt(0)" ::: "memory");
            const unsigned og = xb_add(&bar[XB_TOP], 1u);
            const unsigned tg = og / nx;
            if (og + 1u == (tg + 1u) * nx) xb_add(&bar[XB_TOPGEN], 1u);
            else XB_SPIN(xb_ld(&bar[XB_TOPGEN]) == tg, bar);
            __builtin_amdgcn_fence(__ATOMIC_ACQUIRE, "agent");
            xb_add(&bar[XB_XGEN(b.x)], 1u);
            asm volatile("s_waitcnt vmcnt(0)" ::: "memory");
        } else {
            XB_SPIN(xb_ld(&bar[XB_XGEN(b.x)]) == gen, bar);
            __builtin_amdgcn_fence(__ATOMIC_ACQUIRE, "agent");
            asm volatile("s_waitcnt vmcnt(0)" ::: "memory");
        }
    }
    __syncthreads();
}

constexpr int NWAVES = 8;
constexpr int BATCH = 8, SEQ = 4096, D = 1024, M = BATCH * SEQ;
constexpr int NEXP = 32, FE = 256, PLED = 256, CWID = 31, NQKV = 3072;
constexpr float EPS = 1e-6f;
constexpr int NPHASE = 21;
constexpr int PADROWS = 73728;
constexpr float LAM_INIT = 0.35550906759096926f;

constexpr size_t MiB = 1u << 20;
constexpr size_t WS_CTL = 0, CTL_ZERO_BYTES = 1 * MiB;
constexpr size_t WS_SSQ = 439 * MiB;
constexpr size_t WS_TI = 2 * MiB, WS_TW = WS_TI + 512 * 1024;
constexpr size_t WS_LIST = 3 * MiB;
constexpr size_t WS_RP = 7 * MiB;
constexpr size_t WS_LOG = 11 * MiB;
constexpr size_t WS_WPW1 = 19 * MiB, WS_WPW2 = 23 * MiB, WS_WQKV = 25 * MiB, WS_WO = 31 * MiB, WS_WR = 33 * MiB, WS_WPG = 34 * MiB, WS_WPP = 38 * MiB;
constexpr size_t WS_WGU = 39 * MiB, WS_WD = 71 * MiB;
constexpr size_t WS_P16 = 87 * MiB;
constexpr size_t WS_S0 = 119 * MiB, WS_SS = 64 * MiB;
constexpr size_t WS_WGU1 = WS_SSQ + 14 * MiB, WS_WD1 = WS_WGU1 + 32 * MiB;
constexpr size_t WS_END = WS_WD1 + 16 * MiB;
static_assert(WS_S0 + 5 * WS_SS == WS_SSQ, "d_ws map");
constexpr int CW_BAR = 4096;
constexpr int CW_CNT = 8192;
constexpr int RING_OFF = 0, RING_BYTES = 131072;
constexpr int LDSCTL_OFF = RING_BYTES;
constexpr int L_MISC = LDSCTL_OFF, L_TS = LDSCTL_OFF + 128, L_NE = LDSCTL_OFF + 384, L_TE = LDSCTL_OFF + 512, L_TOK = LDSCTL_OFF + 2048, L_HIST = LDSCTL_OFF + 10240;
constexpr int MAXGU = 8;
constexpr int LDS_BYTES = 147456;


typedef float f32x2 __attribute__((ext_vector_type(2)));
typedef unsigned u32x2 __attribute__((ext_vector_type(2)));
typedef int i32x4 __attribute__((ext_vector_type(4)));
__device__ __forceinline__ float bflo(unsigned u) { return __builtin_bit_cast(float, u << 16); }
__device__ __forceinline__ float bfhi(unsigned u) { return __builtin_bit_cast(float, u & 0xffff0000u); }
__device__ __forceinline__ float sigmoid_f(float x) { return __builtin_amdgcn_rcpf(1.f + __expf(-x)); }
__device__ __forceinline__ float wave_sum(float v) {
#pragma unroll
    for (int o = 1; o < 64; o <<= 1) v += __shfl_xor(v, o);
    return v;
}
__device__ __forceinline__ void tr_item(const float* W, int N, bf16* WT, int Kd, int k0, int n0, int drow0, const float* gk, LAS float* scr, int lane) {
#pragma unroll 8
    for (int i = 0; i < 32; ++i) { const int kk = 2 * i + (lane >> 5); scr[kk * 33 + (lane & 31)] = W[(size_t)(k0 + kk) * N + n0 + (lane & 31)]; }
    LDS_WAIT(); asm volatile("" ::: "memory");
    const int c = lane & 7;
    f32x4 g0 = {1.f, 1.f, 1.f, 1.f}, g1 = {1.f, 1.f, 1.f, 1.f};
    if (gk) { g0 = *(const f32x4*)(gk + k0 + 8 * c); g1 = *(const f32x4*)(gk + k0 + 8 * c + 4); }
#pragma unroll
    for (int j = 0; j < 4; ++j) { const int n = (lane >> 3) + 8 * j; const LAS float* s = scr + (8 * c) * 33 + n;
        v4u o; o.x = pk2(s[0 * 33] * g0.x, s[1 * 33] * g0.y); o.y = pk2(s[2 * 33] * g0.z, s[3 * 33] * g0.w); o.z = pk2(s[4 * 33] * g1.x, s[5 * 33] * g1.y); o.w = pk2(s[6 * 33] * g1.z, s[7 * 33] * g1.w);
        *(GAS v4u*)(WT + (size_t)(drow0 + n) * Kd + k0 + 8 * c) = o; }
    LDS_WAIT(); asm volatile("" ::: "memory");
}
template <bool GLU_IL = false>
__device__ __forceinline__ void tr_plain(const float* W, int K, int N, bf16* WT, int item, const float* gk, LAS float* scr, int lane) {
    const int nblk = N / 32, kb = item / nblk, nb = item % nblk, n0 = 32 * nb; int drow0 = n0;
    if (GLU_IL) { const int h = n0 >> 10, c = n0 & 1023; drow0 = (c >> 7) * 256 + h * 128 + (c & 127); }
    tr_item(W, N, WT, K, 64 * kb, n0, drow0, gk, scr, lane);
}
constexpr int MOE_ITEMS = 32 * 384;
__device__ __forceinline__ void moe_item(const float* wg, const float* wu, const float* wd, const float* gk, int l, bf16* WGU, bf16* WD, int item, LAS float* scr, int lane) {
    const int ge = item / 384, r = item % 384, which = r / 128, sub = r % 128; const size_t eo = (size_t)(l * 32 + ge) * 262144;
    if (which < 2) { const int kb = sub / 8, nb = sub % 8, n0 = 32 * nb; const int drow0 = (n0 / 128) * 256 + (n0 % 128) + (which ? 128 : 0);
        tr_item((which ? wu : wg) + eo, 256, WGU + (size_t)ge * 512 * 1024, 1024, 64 * kb, n0, drow0, gk, scr, lane); }
    else { const int kb = sub / 32, nb = sub % 32; tr_item(wd + eo, 1024, WD + (size_t)ge * 1024 * 256, 256, 64 * kb, 32 * nb, 32 * nb, nullptr, scr, lane); }
}

__device__ __forceinline__ void row_cvt(const float* x, bf16* XB, float* ss, int gw, int NGW, int lane) {
    for (int m0 = gw; m0 < M; m0 += 2 * NGW) {
        f32x4 v[2][4]; const bool two = m0 + NGW < M;
#pragma unroll
        for (int h = 0; h < 2; ++h) { const int m = (h && two) ? m0 + NGW : m0; const GAS f32x4* xr = (const GAS f32x4*)(x + (size_t)m * D) + lane;
#pragma unroll
            for (int j = 0; j < 4; ++j) v[h][j] = xr[64 * j]; }
#pragma unroll
        for (int h = 0; h < 2; ++h) { if (h && !two) break; const int m = h ? m0 + NGW : m0; GAS u32x2* xo = (GAS u32x2*)(XB + (size_t)m * D) + lane; float s = 0.f;
#pragma unroll
            for (int j = 0; j < 4; ++j) { s += (v[h][j].x * v[h][j].x + v[h][j].y * v[h][j].y) + (v[h][j].z * v[h][j].z + v[h][j].w * v[h][j].w); xo[64 * j] = (u32x2){pk2(v[h][j].x, v[h][j].y), pk2(v[h][j].z, v[h][j].w)}; }
            s = wave_sum(s); if (lane < 16) ss[(size_t)m * 16 + lane] = lane ? 0.f : s; }
    }
}
__device__ __forceinline__ void row_moe(const bf16* Xi, bf16* Xo, const bf16* YP, const i32x4* TI, const f32x2* TW, const unsigned* cnt, float* ss, int gw, int NGW, int lane) {
    int ts;
    { const unsigned n = lane < 32 ? __hip_atomic_load(cnt + lane * 64, RLX_AGENT) : 0u; const int tiles = (int)((n + 255u) >> 8); int incl = tiles;
#pragma unroll
      for (int o = 1; o < 32; o <<= 1) { const int t = __shfl_up(incl, o); if (lane >= o) incl += t; }
      ts = incl - tiles; }
    i32x4 ti[2]; f32x2 tw[2];
#pragma unroll
    for (int h = 0; h < 2; ++h) { int m = gw + h * NGW; m = m < M ? m : gw; ti[h] = TI[m]; tw[h] = TW[m]; }
    for (int m0 = gw; m0 < M; m0 += 2 * NGW) {
        const bool two = m0 + NGW < M;
        i32x4 tin[2]; f32x2 twn[2];
#pragma unroll
        for (int h = 0; h < 2; ++h) { int m = m0 + 2 * NGW + h * NGW; m = m < M ? m : gw; tin[h] = TI[m]; twn[h] = TW[m]; }
        u32x2 x[2][4], a[2][4], c[2][4];
#pragma unroll
        for (int h = 0; h < 2; ++h) { const int m = (h && two) ? m0 + NGW : m0;
            const int r1 = __shfl(ts, ti[h].x) * 256 + ti[h].y, r2 = __shfl(ts, ti[h].z) * 256 + ti[h].w;
            const GAS u32x2* xr = (const GAS u32x2*)(Xi + (size_t)m * D) + lane; const GAS u32x2* y1 = (const GAS u32x2*)(YP + (size_t)r1 * D) + lane; const GAS u32x2* y2 = (const GAS u32x2*)(YP + (size_t)r2 * D) + lane;
#pragma unroll
            for (int j = 0; j < 4; ++j) { x[h][j] = xr[64 * j]; a[h][j] = y1[64 * j]; c[h][j] = y2[64 * j]; } }
#pragma unroll
        for (int h = 0; h < 2; ++h) { if (h && !two) break; const int m = h ? m0 + NGW : m0; GAS u32x2* xo = (GAS u32x2*)(Xo + (size_t)m * D) + lane; float s = 0.f;
#pragma unroll
            for (int j = 0; j < 4; ++j) {
                const f32x4 v = (f32x4){bflo(x[h][j].x), bfhi(x[h][j].x), bflo(x[h][j].y), bfhi(x[h][j].y)} + (f32x4){bflo(a[h][j].x), bfhi(a[h][j].x), bflo(a[h][j].y), bfhi(a[h][j].y)} * tw[h].x
                              + (f32x4){bflo(c[h][j].x), bfhi(c[h][j].x), bflo(c[h][j].y), bfhi(c[h][j].y)} * tw[h].y;
                s += (v.x * v.x + v.y * v.y) + (v.z * v.z + v.w * v.w); xo[64 * j] = (u32x2){pk2(v.x, v.y), pk2(v.z, v.w)}; }
            s = wave_sum(s); if (lane < 16) ss[(size_t)m * 16 + lane] = lane ? 0.f : s; }
#pragma unroll
        for (int h = 0; h < 2; ++h) { ti[h] = tin[h]; tw[h] = twn[h]; }
    }
}
__device__ __forceinline__ void row_final(float* out, const float* ss, const float* gain, int gw, int NGW, int lane) {
    f32x4 gv[4];
#pragma unroll
    for (int j = 0; j < 4; ++j) gv[j] = *((const f32x4*)gain + lane + 64 * j);
    for (int m0 = gw; m0 < M; m0 += 2 * NGW) {
        const bool two = m0 + NGW < M; f32x4 v[2][4]; float r[2];
#pragma unroll
        for (int h = 0; h < 2; ++h) { const int m = (h && two) ? m0 + NGW : m0; const GAS f32x4* xr = (const GAS f32x4*)(out + (size_t)m * D) + lane; r[h] = pg8::rs_of(ss, m);
#pragma unroll
            for (int j = 0; j < 4; ++j) v[h][j] = xr[64 * j]; }
#pragma unroll
        for (int h = 0; h < 2; ++h) { if (h && !two) break; const int m = h ? m0 + NGW : m0; GAS f32x4* xo = (GAS f32x4*)(out + (size_t)m * D) + lane;
#pragma unroll
            for (int j = 0; j < 4; ++j) xo[64 * j] = v[h][j] * r[h] * gv[j]; }
    }
}

__device__ __forceinline__ void conv_phase(const bf16* U, bf16* C, const float* wdw, const float* bdw, const float* lng, const float* lnb, LAS unsigned char* lds, int vcu, int G, int tid, int lane, int wave) {
    constexpr int RUN = 128, NGRP = (RUN + CWID - 1) / CWID;
    const int c0 = 2 * tid;
    f32x2 w[CWID];
#pragma unroll
    for (int j = 0; j < CWID; ++j) w[j] = *(const f32x2*)(wdw + j * D + c0);
    const f32x2 bd = *(const f32x2*)(bdw + c0);
    LAS unsigned* yb = (LAS unsigned*)lds;
    for (int run = vcu; run < M / RUN; run += G) {
        const int b = run / (SEQ / RUN), t0 = (run % (SEQ / RUN)) * RUN; const size_t rb = (size_t)b * SEQ;
        const bf16* Ub = U + rb * D + c0;
        f32x2 win[CWID]; unsigned raw[CWID], rawn[CWID];
        win[0] = (f32x2){0.f, 0.f};
#pragma unroll
        for (int s = 1; s < CWID; ++s) { const int tau = t0 - CWID + s; const int tc = tau < 0 ? 0 : tau;
            const unsigned ua = *(const GAS unsigned*)(Ub + (size_t)tc * D);
            win[s] = tau < 0 ? (f32x2){0.f, 0.f} : (f32x2){bflo(ua), bfhi(ua)}; }
#pragma unroll
        for (int s = 0; s < CWID; ++s) raw[s] = *(const GAS unsigned*)(Ub + (size_t)(t0 + s) * D);
#pragma unroll 1
        for (int g = 0; g < NGRP; ++g) {
            const int tg = t0 + g * CWID, n = (RUN - g * CWID) < CWID ? (RUN - g * CWID) : CWID;
#pragma unroll
            for (int s = 0; s < CWID; ++s) { int tn = tg + CWID + s; tn = tn > t0 + RUN - 1 ? t0 + RUN - 1 : tn; rawn[s] = *(const GAS unsigned*)(Ub + (size_t)tn * D); }
#pragma unroll
            for (int s = 0; s < CWID; ++s) { if (s < n) {
                win[s] = (f32x2){bflo(raw[s]), bfhi(raw[s])};
                f32x2 a = bd;
#pragma unroll
                for (int j = 0; j < CWID; ++j) a += w[j] * win[(s + 1 + j) % CWID];
                yb[s * 512 + tid] = pk2(a.x, a.y); } }
            LDS_WAIT(); __syncthreads();
#pragma unroll 1
            for (int rr = 0; rr < 4; ++rr) { const int r = wave * 4 + rr; if (r < n) {
                const v4u p0 = *(const LAS v4u*)(lds + r * 2048 + lane * 16), p1 = *(const LAS v4u*)(lds + r * 2048 + 1024 + lane * 16);
                float x[16] = {bflo(p0.x), bfhi(p0.x), bflo(p0.y), bfhi(p0.y), bflo(p0.z), bfhi(p0.z), bflo(p0.w), bfhi(p0.w), bflo(p1.x), bfhi(p1.x), bflo(p1.y), bfhi(p1.y), bflo(p1.z), bfhi(p1.z), bflo(p1.w), bfhi(p1.w)};
                float s = 0.f;
#pragma unroll
                for (int i = 0; i < 16; ++i) s += x[i];
                const float mu = wave_sum(s) * (1.f / D); float q = 0.f;
#pragma unroll
                for (int i = 0; i < 16; ++i) { x[i] -= mu; q += x[i] * x[i]; }
                const float rs = 1.f / sqrtf(wave_sum(q) * (1.f / D) + EPS);
                unsigned o[8];
#pragma unroll
                for (int hh = 0; hh < 2; ++hh) { const f32x4 g0 = *(const f32x4*)(lng + hh * 512 + lane * 8), g1 = *(const f32x4*)(lng + hh * 512 + lane * 8 + 4), b0 = *(const f32x4*)(lnb + hh * 512 + lane * 8), b1 = *(const f32x4*)(lnb + hh * 512 + lane * 8 + 4);
                    float y[8] = {x[hh * 8 + 0] * rs * g0.x + b0.x, x[hh * 8 + 1] * rs * g0.y + b0.y, x[hh * 8 + 2] * rs * g0.z + b0.z, x[hh * 8 + 3] * rs * g0.w + b0.w,
                                  x[hh * 8 + 4] * rs * g1.x + b1.x, x[hh * 8 + 5] * rs * g1.y + b1.y, x[hh * 8 + 6] * rs * g1.z + b1.z, x[hh * 8 + 7] * rs * g1.w + b1.w};
#pragma unroll
                    for (int i = 0; i < 4; ++i) o[hh * 4 + i] = pk2(y[2 * i] * sigmoid_f(y[2 * i]), y[2 * i + 1] * sigmoid_f(y[2 * i + 1])); }
                bf16* cr = C + (rb + tg + r) * D;
                *(GAS v4u*)(cr + lane * 8) = (v4u){o[0], o[1], o[2], o[3]}; *(GAS v4u*)(cr + 512 + lane * 8) = (v4u){o[4], o[5], o[6], o[7]}; } }
            LDS_WAIT(); __syncthreads();
#pragma unroll
            for (int s = 0; s < CWID; ++s) raw[s] = rawn[s];
        }
    }
}

__device__ __forceinline__ void combine_phase(const bf16* O0, const bf16* O1, bf16* OC, const float* lamp, const float* subln, int gw, int NGW, int lane) {
    const float l1 = wave_sum(lamp[lane] * lamp[64 + lane]), l2 = wave_sum(lamp[128 + lane] * lamp[192 + lane]);
    const float lam = __expf(l1) - __expf(l2) + LAM_INIT;
    float gsc[16];
#pragma unroll
    for (int i = 0; i < 16; ++i) gsc[i] = subln[(lane & 7) * 16 + i] * (1.0f - LAM_INIT);
    for (int m0 = gw; m0 < M; m0 += 2 * NGW) {
        const bool two = m0 + NGW < M; v4u a0[2], a1[2], b0[2], b1[2];
#pragma unroll
        for (int h = 0; h < 2; ++h) { const int m = (h && two) ? m0 + NGW : m0;
            a0[h] = *(const GAS v4u*)(O0 + (size_t)m * D + lane * 16); a1[h] = *(const GAS v4u*)(O0 + (size_t)m * D + lane * 16 + 8);
            b0[h] = *(const GAS v4u*)(O1 + (size_t)m * D + lane * 16); b1[h] = *(const GAS v4u*)(O1 + (size_t)m * D + lane * 16 + 8); }
#pragma unroll
        for (int h = 0; h < 2; ++h) { if (h && !two) break; const int m = h ? m0 + NGW : m0;
            const unsigned ua[8] = {a0[h].x, a0[h].y, a0[h].z, a0[h].w, a1[h].x, a1[h].y, a1[h].z, a1[h].w}, ub[8] = {b0[h].x, b0[h].y, b0[h].z, b0[h].w, b1[h].x, b1[h].y, b1[h].z, b1[h].w};
            float o[16]; float ss = 0.f;
#pragma unroll
            for (int i = 0; i < 8; ++i) { o[2 * i] = bflo(ua[i]) - lam * bflo(ub[i]); o[2 * i + 1] = bfhi(ua[i]) - lam * bfhi(ub[i]); ss += o[2 * i] * o[2 * i] + o[2 * i + 1] * o[2 * i + 1]; }
            ss += __shfl_xor(ss, 1); ss += __shfl_xor(ss, 2); ss += __shfl_xor(ss, 4);
            const float r = 1.f / sqrtf(ss * (1.f / 128.f) + EPS);
            unsigned w[8];
#pragma unroll
            for (int i = 0; i < 8; ++i) w[i] = pk2(o[2 * i] * r * gsc[2 * i], o[2 * i + 1] * r * gsc[2 * i + 1]);
            *(GAS v4u*)(OC + (size_t)m * D + lane * 16) = (v4u){w[0], w[1], w[2], w[3]}; *(GAS v4u*)(OC + (size_t)m * D + lane * 16 + 8) = (v4u){w[4], w[5], w[6], w[7]}; }
    }
}

__device__ __forceinline__ void select_phase(const float* LOG, const float* brg, const float* bre, const float* ss, unsigned* cnt, int* list, float* RP, i32x4* TI, f32x2* TW, LAS int* lh, int vcu, int G, int tid) {
    for (int base = vcu * 128; base < M; base += G * 128) {
        if (tid < 32) lh[tid] = 0;
        __syncthreads();
        const int t = base + tid; int E1 = 0, E2 = 0, r1 = 0, r2 = 0; float w1 = 0.f, w2 = 0.f;
        if (tid < 128) {
            const f32x4 g4 = *(const GAS f32x4*)(LOG + (size_t)t * 64);
            const float gl[4] = {g4.x + brg[0], g4.y + brg[1], g4.z + brg[2], g4.w + brg[3]};
            int gi = 0; float gm = gl[0];
#pragma unroll
            for (int j = 1; j < 4; ++j) if (gl[j] > gm) { gm = gl[j]; gi = j; }
            float den = 0.f;
#pragma unroll
            for (int j = 0; j < 4; ++j) den += __expf(gl[j] - gm);
            const float gw_ = 1.f / den;
            const f32x4 ea = *(const GAS f32x4*)(LOG + (size_t)t * 64 + 4 + gi * 8), eb = *(const GAS f32x4*)(LOG + (size_t)t * 64 + 8 + gi * 8);
            const f32x4 ba = *(const f32x4*)(bre + gi * 8), bb = *(const f32x4*)(bre + gi * 8 + 4);
            const float el[8] = {ea.x + ba.x, ea.y + ba.y, ea.z + ba.z, ea.w + ba.w, eb.x + bb.x, eb.y + bb.y, eb.z + bb.z, eb.w + bb.w};
            int i1 = 0; float v1 = el[0];
#pragma unroll
            for (int j = 1; j < 8; ++j) if (el[j] > v1) { v1 = el[j]; i1 = j; }
            int i2 = -1; float v2 = -INFINITY;
#pragma unroll
            for (int j = 0; j < 8; ++j) if (j != i1 && (i2 < 0 || el[j] > v2)) { v2 = el[j]; i2 = j; }
            const float e2 = __expf(v2 - v1); const float p1 = 1.f / (1.f + e2);
            w1 = p1 * gw_; w2 = (e2 * p1) * gw_; E1 = gi * 8 + i1; E2 = gi * 8 + i2;
            r1 = __hip_atomic_fetch_add(lh + E1, 1, __ATOMIC_RELAXED, __HIP_MEMORY_SCOPE_WORKGROUP); r2 = __hip_atomic_fetch_add(lh + E2, 1, __ATOMIC_RELAXED, __HIP_MEMORY_SCOPE_WORKGROUP);
        }
        __syncthreads();
        if (tid < 32) { const int c = lh[tid]; int bs = 0; if (c) bs = (int)__hip_atomic_fetch_add(cnt + tid * 64, (unsigned)c, RLX_AGENT); lh[32 + tid] = bs; }
        __syncthreads();
        if (tid < 128) { const int s1 = lh[32 + E1] + r1, s2 = lh[32 + E2] + r2;
            const float r = pg8::rs_of(ss, t);
            list[(size_t)E1 * M + s1] = t; list[(size_t)E2 * M + s2] = t; RP[(size_t)E1 * M + s1] = r; RP[(size_t)E2 * M + s2] = r; TI[t] = (i32x4){E1, s1, E2, s2}; TW[t] = (f32x2){w1, w2}; }
        __syncthreads();
    }
}

struct GroupedOrder {
    int nNs, G, c, ntu;
    const LAS int* tile_e; const LAS int* tokl; const LAS int* ts;
    __device__ __forceinline__ bool next(int i, pg8::Unit& u) const { const int L = i * G + c; if (L >= ntu) return false; const int mt = L >> nNs, pn = L & ((1 << nNs) - 1);
        const int e = tile_e[mt]; u.pm = mt; u.pn = pn; u.pb = (e << nNs) + pn; u.aux = e * M + (mt - ts[e]) * 256; return true; }
    __device__ __forceinline__ unsigned arow(int ord, int r) const { return (unsigned)tokl[ord * 256 + r]; }
};
__device__ __forceinline__ GroupedOrder grouped_setup(const unsigned* cnt, const int* list, LAS unsigned char* lds, bool need_tok, int nNs, int G, int c, int tid, int lane, int wave) {
    LAS int* ts = (LAS int*)(lds + L_TS); LAS int* ne = (LAS int*)(lds + L_NE); LAS int* te = (LAS int*)(lds + L_TE); LAS int* tokl = (LAS int*)(lds + L_TOK);
    __syncthreads();
    if (wave == 0) {
        const unsigned n = lane < 32 ? __hip_atomic_load(cnt + lane * 64, RLX_AGENT) : 0u; const int tiles = (int)((n + 255u) >> 8); int incl = tiles;
#pragma unroll
        for (int o = 1; o < 32; o <<= 1) { const int t = __shfl_up(incl, o); if (lane >= o) incl += t; }
        const int excl = incl - tiles;
        if (lane < 32) { ts[lane] = excl; ne[lane] = (int)n; for (int k = 0; k < tiles; ++k) te[excl + k] = lane; }
        if (lane == 31) ts[32] = incl;
    }
    __syncthreads();
    GroupedOrder S; S.nNs = nNs; S.G = G; S.c = c; S.ntu = ts[32] << nNs; S.tile_e = te; S.tokl = tokl; S.ts = ts;
    if (need_tok) {
        for (int i = 0; i < MAXGU; ++i) { const int L = i * G + c; if (L >= S.ntu) break; const int mt = L >> nNs, e = te[mt];
            if (tid < 256) { const int slot = (mt - ts[e]) * 256 + tid; tokl[i * 256 + tid] = slot < ne[e] ? list[(size_t)e * M + slot] : 0; } }
        if (S.ntu > MAXGU * G) S.ntu = MAXGU * G;
        __syncthreads();
    }
    return S;
}

enum { I_X = 0, I_P, I_POS, I_NMIX, I_NFFN, I_CW1, I_CB1, I_CDW, I_CBDW, I_CLNG, I_CLNB, I_CW2, I_CB2, I_WQKV, I_LAM, I_SUBLN, I_WO,
       I_WRG, I_BRG, I_WRE, I_BRE, I_WG, I_WU, I_WDN, I_PNORM, I_PWG, I_PWP, I_FNORM, N_IN };
struct Args { const void* in[N_IN]; float* out; unsigned char* ws; int ph_lo, ph_hi; };

typedef const __attribute__((address_space(4))) Args* KArgP;
#define PH_IDS() const int tid = pg8::ltid(wave), lane = tid & 63, gtid = vcu * (NWAVES * 64) + tid; (void)lane; (void)gtid
__device__ __forceinline__ KArgP kargs() { KArgP k = (KArgP)__builtin_amdgcn_kernarg_segment_ptr(); asm volatile("" : "+s"(k)); return k; }
#define IN_F(k) ((const float*)ka->in[k])
#define WSP(off) ((bf16*)(ka->ws + (off)))
#define SLOT(i) ((bf16*)(ka->ws + WS_S0 + (size_t)(i) * WS_SS))
#define IN(k) (lo <= (k) && (k) < hi)
#ifndef MK_DUP
#define MK_DUP -1
#endif
#define DUPLOOP(k) _Pragma("nounroll") for (int rep_ = 0; rep_ < ((k) == MK_DUP ? 2 : 1); ++rep_)
#ifdef MK_PROBE
#define CW_TS 12288
#define SEAM(k) do { if (IN(k) && IN((k) + 1)) xcd_barrier(bar); if (blockIdx.x == 0 && threadIdx.x == 0) __hip_atomic_store((unsigned*)(kargs()->ws + WS_CTL) + CW_TS + (k) + 1, (unsigned)__builtin_amdgcn_s_memrealtime(), RLX_AGENT); } while (0)
#else
#define SEAM(k) do { if (IN(k) && IN((k) + 1)) xcd_barrier(bar); } while (0)
#endif
#define XBA ((bf16*)ka->out)
#define XBB ((bf16*)ka->out + (size_t)M * D)
#define SSQ(k) ((float*)(ka->ws + WS_SSQ) + (size_t)(k) * M * 16)
#define ACTB ((bf16*)(ka->ws + WS_S0 + 3 * WS_SS + 16 * MiB))
#define CNT(l) ((unsigned*)(ka->ws + WS_CTL) + CW_CNT + (l) * 32 * 64)
template <int l>
__device__ __forceinline__ void layer_tail(LAS unsigned char* lds, const XcdBarrier& bar, int lo, int hi, int wave, int G, int bx, int vcu, int gw, int NGW, int NTHR) {
    constexpr int pb = l ? 14 : 4;
    LAS float* scr = (LAS float*)(lds + RING_OFF + wave * 16384);
    if (IN(pb)) DUPLOOP(pb) {
        const bool split = (G == 256);
        if (!split || bx < 128) { KArgP ka = kargs(); pg8::Gemm g{l ? XBB : XBA, WSP(WS_WR) + (size_t)l * 256 * D, M, 256, D}; pg8::StaticOrder S; S.init(M, 256, G, bx);
            pg8::EpiLogits E{(float*)(ka->ws + WS_LOG), SSQ(l ? 4 : 1)};
            pg8::gemm_phase<pg8::EpiLogits, pg8::StaticOrder, true, false>(lds + RING_OFF, g, S, E, wave); }
        if (!split || bx >= 128) { KArgP ka = kargs(); pg8::Gemm g{WSP(WS_P16) + (size_t)l * M * PLED, WSP(WS_WPP) + (size_t)l * D * PLED, M, D, PLED}; pg8::StaticOrder S; S.init(M, D, split ? 128 : G, split ? bx - 128 : bx);
            pg8::EpiBf16 E{l ? SLOT(0) : SLOT(4), D};
            pg8::gemm_phase<pg8::EpiBf16, pg8::StaticOrder, true, false>(lds + RING_OFF, g, S, E, wave); }
    }
    SEAM(pb);
    if (IN(pb + 1)) { KArgP ka = kargs(); PH_IDS(); select_phase((const float*)(ka->ws + WS_LOG), IN_F(I_BRG) + l * 4, IN_F(I_BRE) + l * 32, SSQ(l ? 4 : 1), CNT(l),
                                   (int*)(ka->ws + WS_LIST), (float*)(ka->ws + WS_RP), (i32x4*)(ka->ws + WS_TI), (f32x2*)(ka->ws + WS_TW), (LAS int*)(lds + L_HIST), vcu, G, tid); }
    SEAM(pb + 1);
    if (IN(pb + 2)) DUPLOOP(pb + 2) { KArgP ka = kargs(); PH_IDS(); const GroupedOrder S = grouped_setup(CNT(l), (const int*)(ka->ws + WS_LIST), lds, true, 1, G, bx, tid, lane, wave);
        pg8::Gemm g{l ? XBB : XBA, WSP(l ? WS_WGU1 : WS_WGU), M, 512, D}; pg8::EpiGU E{ACTB, (const float*)(ka->ws + WS_RP)};
        pg8::gemm_phase<pg8::EpiGU, GroupedOrder, true, true>(lds + RING_OFF, g, S, E, wave);
        if (l == 0) {
            const int nbusy = S.ntu > 2 * G ? S.ntu - 2 * G : 0, nfree = G - nbusy;
            if (nfree <= 0 || bx >= nbusy) { const int w0 = (nfree > 0 ? bx - nbusy : bx) * NWAVES + wave, nw = (nfree > 0 ? nfree : G) * NWAVES;
                LAS float* scr2 = (LAS float*)(lds + RING_OFF + wave * 16384);
                for (int it = w0; it < MOE_ITEMS; it += nw) moe_item(IN_F(I_WG), IN_F(I_WU), IN_F(I_WDN), IN_F(I_NFFN) + D, 1, WSP(WS_WGU1), WSP(WS_WD1), it, scr2, lane); } }
    }
    SEAM(pb + 2);
    if (IN(pb + 3)) DUPLOOP(pb + 3) { KArgP ka = kargs(); PH_IDS(); const GroupedOrder S = grouped_setup(CNT(l), (const int*)(ka->ws + WS_LIST), lds, false, 2, G, bx, tid, lane, wave);
        pg8::Gemm g{ACTB, WSP(l ? WS_WD1 : WS_WD), PADROWS, D, FE}; pg8::EpiBf16 E{SLOT(1), D};
        pg8::gemm_phase<pg8::EpiBf16, GroupedOrder, true, false>(lds + RING_OFF, g, S, E, wave); }
    SEAM(pb + 3);
    if (IN(pb + 4)) DUPLOOP(pb + 4) {
        { KArgP ka = kargs(); PH_IDS(); row_moe(l ? XBB : XBA, l ? SLOT(4) : XBA, SLOT(1), (const i32x4*)(ka->ws + WS_TI), (const f32x2*)(ka->ws + WS_TW), CNT(l), SSQ(l ? 5 : 2), gw, NGW, lane); }
    }
    SEAM(pb + 4);
    if (IN(pb + 5)) DUPLOOP(pb + 5) {
        if (l == 0) { KArgP ka = kargs(); PH_IDS(); pg8::Gemm g{XBA, WSP(WS_WPG), M, D, D}; pg8::StaticOrder S; S.init(M, D, G, bx);
          pg8::EpiPle<false> E{XBA, SLOT(4), XBB, nullptr, SSQ(2), SSQ(3)};
          pg8::gemm_phase<pg8::EpiPle<false>, pg8::StaticOrder, true, false>(lds + RING_OFF, g, S, E, wave); }
        else { KArgP ka = kargs(); PH_IDS(); pg8::Gemm g{SLOT(4), WSP(WS_WPG) + (size_t)D * D, M, D, D}; pg8::StaticOrder S; S.init(M, D, G, bx);
          pg8::EpiPle<true> E{SLOT(4), SLOT(0), nullptr, ka->out, SSQ(5), SSQ(6)};
          pg8::gemm_phase<pg8::EpiPle<true>, pg8::StaticOrder, true, false>(lds + RING_OFF, g, S, E, wave); }
    }
    SEAM(pb + 5);
}
__global__ void __launch_bounds__(NWAVES * 64, 2) mk_fwd(Args args) {
    extern __shared__ __attribute__((aligned(16))) unsigned char lds_raw[];
    LAS unsigned char* lds = (LAS unsigned char*)lds_raw;
    const int tid0 = threadIdx.x, wave = __builtin_amdgcn_readfirstlane(tid0 >> 6);
    const int G = gridDim.x; const int bx = blockIdx.x; const int vcu = (G % 8 == 0) ? (bx % 8) * (G / 8) + bx / 8 : bx;
    const int gw = vcu * NWAVES + wave, NGW = G * NWAVES, NTHR = G * NWAVES * 64;
    gu32* ctl = (gu32*)(args.ws + WS_CTL);
    for (int u = tid0; u < (LDS_BYTES - LDSCTL_OFF) / 4; u += NWAVES * 64) ((LAS unsigned*)(lds + LDSCTL_OFF))[u] = 0u;
    __syncthreads();
    XcdBarrier bar = xcd_barrier_post((unsigned*)ctl + CW_BAR, (volatile LAS unsigned*)(lds + L_MISC) + 8);
    const int lo = args.ph_lo, hi = args.ph_hi;
#ifdef MK_PROBE
    if (blockIdx.x == 0 && threadIdx.x == 0) __hip_atomic_store((unsigned*)(args.ws + WS_CTL) + CW_TS, (unsigned)__builtin_amdgcn_s_memrealtime(), RLX_AGENT);
#endif
    LAS float* scr = (LAS float*)(lds + RING_OFF + wave * 16384);

    if (IN(0)) DUPLOOP(0) {
        constexpr int I1 = 16 * 64, I2 = 16 * 32, I3 = 16 * 96, I4 = 16 * 32, I5 = 16 * 32, I6 = 4 * 32;
        constexpr int NIT = I1 + I2 + I3 + I4 + 2 * I5 + 2 * I6;
        { KArgP ka = kargs(); PH_IDS();
          for (int it = gw; it < NIT + MOE_ITEMS; it += NGW) {
            int r = it;
            if (r < I1) { tr_plain<true>(IN_F(I_CW1), D, 2048, WSP(WS_WPW1), r, IN_F(I_NMIX), scr, lane); continue; } r -= I1;
            if (r < I2) { tr_plain(IN_F(I_CW2), D, D, WSP(WS_WPW2), r, nullptr, scr, lane); continue; } r -= I2;
            if (r < I3) { tr_plain(IN_F(I_WQKV), D, NQKV, WSP(WS_WQKV), r, IN_F(I_NMIX) + D, scr, lane); continue; } r -= I3;
            if (r < I4) { tr_plain(IN_F(I_WO), D, D, WSP(WS_WO), r, nullptr, scr, lane); continue; } r -= I4;
            if (r < 2 * I5) { const int l = r / I5; tr_plain(IN_F(I_PWG) + (size_t)l * D * D, D, D, WSP(WS_WPG) + (size_t)l * D * D, r % I5, IN_F(I_PNORM) + l * D, scr, lane); continue; } r -= 2 * I5;
            if (r < 2 * I6) { const int l = r / I6; tr_plain(IN_F(I_PWP) + (size_t)l * PLED * D, PLED, D, WSP(WS_WPP) + (size_t)l * D * PLED, r % I6, nullptr, scr, lane); continue; } r -= 2 * I6;
            moe_item(IN_F(I_WG), IN_F(I_WU), IN_F(I_WDN), IN_F(I_NFFN), 0, WSP(WS_WGU), WSP(WS_WD), r, scr, lane);
          } }
        { KArgP ka = kargs(); PH_IDS(); const float* wrg = IN_F(I_WRG); const float* wre = IN_F(I_WRE); const float* gf = IN_F(I_NFFN); bf16* Wr = WSP(WS_WR);
          for (int idx = gtid; idx < 2 * 256 * 1024; idx += NTHR) { const int l = idx >> 18, row = (idx >> 10) & 255, k = idx & 1023; float v = 0.f;
              if (row < 4) v = wrg[((size_t)l * D + k) * 4 + row]; else if (row < 36) { const int g = (row - 4) >> 3, e = (row - 4) & 7; v = wre[(((size_t)l * 4 + g) * D + k) * 8 + e]; }
              Wr[idx] = (bf16)f2bf(v * gf[l * D + k]); } }
        { KArgP ka = kargs(); PH_IDS(); const f32x4* p4 = (const f32x4*)ka->in[I_P]; u32x2* o = (u32x2*)WSP(WS_P16);
          for (int idx = gtid; idx < 2 * M * PLED / 4; idx += NTHR) { const f32x4 v = p4[idx]; o[idx] = (u32x2){pk2(v.x, v.y), pk2(v.z, v.w)}; } }
        { KArgP ka = kargs(); PH_IDS(); row_cvt(IN_F(I_X), XBA, SSQ(0), gw, NGW, lane); }
    }
    SEAM(0);
    if (IN(1)) DUPLOOP(1) { KArgP ka = kargs(); PH_IDS(); pg8::Gemm g{XBA, WSP(WS_WPW1), M, 2048, D}; pg8::StaticOrder S; S.init(M, 2048, G, bx);
        pg8::EpiGLU E{SLOT(0), IN_F(I_CB1), SSQ(0)};
        pg8::gemm_phase<pg8::EpiGLU, pg8::StaticOrder, true, false>(lds + RING_OFF, g, S, E, wave); }
    SEAM(1);
    if (IN(2)) DUPLOOP(2) { KArgP ka = kargs(); PH_IDS(); conv_phase(SLOT(0), SLOT(1), IN_F(I_CDW), IN_F(I_CBDW), IN_F(I_CLNG), IN_F(I_CLNB), lds + RING_OFF, vcu, G, tid, lane, wave); }
    SEAM(2);
    if (IN(3)) { KArgP ka = kargs(); PH_IDS(); pg8::Gemm g{SLOT(1), WSP(WS_WPW2), M, D, D}; pg8::StaticOrder S; S.init(M, D, G, bx);
        pg8::EpiRes E{XBA, IN_F(I_CB2), SSQ(1)};
        pg8::gemm_phase<pg8::EpiRes, pg8::StaticOrder, true, false>(lds + RING_OFF, g, S, E, wave); }
    SEAM(3);
#ifdef MK_XBAR
    xcd_barrier(bar); xcd_barrier(bar); xcd_barrier(bar); xcd_barrier(bar); xcd_barrier(bar); xcd_barrier(bar); xcd_barrier(bar); xcd_barrier(bar); xcd_barrier(bar); xcd_barrier(bar);
#endif
    layer_tail<0>(lds, bar, lo, hi, wave, G, bx, vcu, gw, NGW, NTHR);
    if (IN(10)) DUPLOOP(10) { KArgP ka = kargs(); PH_IDS(); pg8::Gemm g{XBB, WSP(WS_WQKV), M, NQKV, D}; pg8::StaticOrder S; S.init(M, NQKV, G, bx);
        pg8::EpiQKV E{SLOT(0), (size_t)(WS_SS / 2), SSQ(3), (const int*)ka->in[I_POS], attn3::C2};
        pg8::gemm_phase<pg8::EpiQKV, pg8::StaticOrder, true, false>(lds + RING_OFF, g, S, E, wave); }
    SEAM(10);
    if (IN(11)) DUPLOOP(11) { KArgP ka = kargs(); const attn3::Tensors AT{(const attn3::bf16*)SLOT(0), (const attn3::bf16*)SLOT(1), (const attn3::bf16*)SLOT(2), (attn3::bf16*)SLOT(0), (float*)SLOT(3), IN_F(I_LAM), IN_F(I_SUBLN)};
        attn3::attn_phase<8>((char*)lds_raw + RING_OFF, AT, vcu, G, wave, LAM_INIT); }
    if (IN(11) && IN(13)) xcd_barrier(bar);
    if (IN(13)) { KArgP ka = kargs(); PH_IDS(); pg8::Gemm g{SLOT(0), WSP(WS_WO), M, D, D}; pg8::StaticOrder S; S.init(M, D, G, bx);
        pg8::EpiRes E{XBB, nullptr, SSQ(4)};
        pg8::gemm_phase<pg8::EpiRes, pg8::StaticOrder, true, false>(lds + RING_OFF, g, S, E, wave); }
    SEAM(13);
    layer_tail<1>(lds, bar, lo, hi, wave, G, bx, vcu, gw, NGW, NTHR);
    if (IN(20)) { KArgP ka = kargs(); PH_IDS(); row_final(ka->out, SSQ(6), IN_F(I_FNORM), gw, NGW, lane);
#ifdef MK_PROBE
        { __syncthreads(); const unsigned* ts = (const unsigned*)(ka->ws + WS_CTL) + CW_TS;
          const float us1 = (float)(__hip_atomic_load(ts + MK_PROBE_B1, RLX_AGENT) - __hip_atomic_load(ts + MK_PROBE_A1, RLX_AGENT)) * 0.01f, us2 = (float)(__hip_atomic_load(ts + MK_PROBE_B2, RLX_AGENT) - __hip_atomic_load(ts + MK_PROBE_A2, RLX_AGENT)) * 0.01f;
          const float sc = 1.f + us1 / (float)(MK_PROBE_S1);
          VM_WAIT(); __syncthreads();
          for (int m = gw; m < M; m += NGW) { GAS f32x4* xr = (GAS f32x4*)(ka->out + (size_t)m * D) + lane;
              for (int j = 0; j < 4; ++j) { f32x4 v = xr[64 * j]; v = v * sc; if (m == 0 && j == 0 && lane == 0) v.x = us2 * (float)(MK_PROBE_S2); xr[64 * j] = v; } } }
#endif
    }
#undef IN
#undef SEAM
}

extern "C" void kernel_launch(void* const* d_in, const int* in_sizes, int n_in, void* d_out, int out_size, void* d_ws, size_t ws_size, hipStream_t stream) {
    static int grid = 0;
    if (grid == 0) {
        if (n_in != N_IN || in_sizes[0] != M * D || out_size != M * D || ws_size < WS_END) { fprintf(stderr, "kernel_launch: unexpected problem: n_in %d in0 %d out %d ws %zu (need %zu); nothing launched\n", n_in, n_in > 0 ? in_sizes[0] : -1, out_size, ws_size, (size_t)WS_END); grid = -1; return; }
        int dev = 0, cus = 0, per_cu = 0;
        if (hipGetDevice(&dev) != hipSuccess || hipDeviceGetAttribute(&cus, hipDeviceAttributeMultiprocessorCount, dev) != hipSuccess) { grid = -1; return; }
        if (hipFuncSetAttribute((const void*)mk_fwd, hipFuncAttributeMaxDynamicSharedMemorySize, LDS_BYTES) != hipSuccess) { fprintf(stderr, "kernel_launch: hipFuncSetAttribute failed\n"); grid = -1; return; }
        if (hipOccupancyMaxActiveBlocksPerMultiprocessor(&per_cu, (const void*)mk_fwd, NWAVES * 64, LDS_BYTES) != hipSuccess || per_cu < 1) { fprintf(stderr, "kernel_launch: occupancy query says %d\n", per_cu); }
        (void)hipGetLastError();
        grid = cus;
        if (grid > 256) grid = 256;
    }
    if (grid < 0) return;
    if (hipMemsetAsync((char*)d_ws + WS_CTL, 0, CTL_ZERO_BYTES, stream) != hipSuccess) return;
    Args a{};
    for (int i = 0; i < N_IN; ++i) a.in[i] = d_in[i];
    a.out = (float*)d_out; a.ws = (unsigned char*)d_ws;
#if MK_SPLIT
    for (int ph = 0; ph < NPHASE; ++ph) { a.ph_lo = ph; a.ph_hi = ph + 1; hipLaunchKernelGGL(mk_fwd, dim3(grid), dim3(NWAVES * 64), LDS_BYTES, stream, a); }
#else
    a.ph_lo = 0; a.ph_hi = NPHASE; hipLaunchKernelGGL(mk_fwd, dim3(grid), dim3(NWAVES * 64), LDS_BYTES, stream, a);
#endif
}
```

```cpp
#include <hip/hip_runtime.h>
#include <hip/hip_bf16.h>
#include <cstdio>
#include <cstdint>
#include <cmath>

#ifndef MK_SPLIT
#define MK_SPLIT 0
#endif

namespace pg8 {
#define PG8_LAS __attribute__((address_space(3)))
typedef unsigned short bf16_t;
typedef short bf16x8 __attribute__((ext_vector_type(8)));
typedef float f32x4 __attribute__((ext_vector_type(4)));
typedef unsigned u32x4 __attribute__((ext_vector_type(4)));
constexpr int BM = 256, BK = 64, HALF = 128, HTB = HALF * BK * 2  , STAGE_BYTES = 8 * HTB, NXCD = 8, WGM = 8;

__host__ __device__ __forceinline__ int lds_byte(int r, int c) { const int st = (r >> 4) * 2 + (c >> 5), rr = r & 15, cc = c & 31, ob = rr * 64 + cc * 2; return st * 1024 + (ob ^ (((ob >> 9) & 1) << 5)); }
__host__ __device__ __forceinline__ void stage_rc(int b, int& R, int& C) { const int st = b / 1024, sb = b % 1024, swz = sb ^ (((sb >> 9) & 1) << 5); R = (st >> 1) * 16 + swz / 64; C = (st & 1) * 32 + (swz % 64) / 2; }
__host__ __device__ __forceinline__ int perm32(int rho) { const int n = rho >> 4, i = rho & 15; return 8 * (i >> 2) + 4 * n + (i & 3); }

__device__ __forceinline__ int ltid(int wave) { int t; asm volatile("v_mbcnt_lo_u32_b32 %0, -1, 0\n\tv_mbcnt_hi_u32_b32 %0, -1, %0" : "=&v"(t)); return wave * 64 + t; }
struct Unit { int pm, pn, pb, aux; };
struct Gemm { const bf16_t* A; const bf16_t* Bt; int M, N, K; };

struct StaticOrder {
    int nM, nN, nwg, G, c;
    __host__ __device__ void init(int M, int N, int G_, int c_) { nM = M / BM; nN = N / BM; nwg = nM * nN; G = G_; c = c_; }
    __host__ __device__ bool next(int i, Unit& u) const {
        const long L = (long)i * G + c; if (L >= nwg) return false;
        int wgid = (int)L; { const int q = nwg / NXCD, r = nwg % NXCD, xcd = wgid % NXCD, off = wgid / NXCD; wgid = (xcd < r ? xcd * (q + 1) : r * (q + 1) + (xcd - r) * q) + off; }
        const int nig = WGM * nN, gid = wgid / nig, fm = gid * WGM, gsz = (nM - fm) < WGM ? (nM - fm) : WGM;
        u.pm = fm + ((wgid % nig) % gsz); u.pn = (wgid % nig) / gsz; u.pb = u.pn; u.aux = 0; return true;
    }
    __device__ __forceinline__ unsigned arow(int, int) const { return 0u; }
};

__device__ __forceinline__ unsigned cvt_pk_bf16(float lo, float hi) { unsigned r; asm volatile("v_cvt_pk_bf16_f32 %0, %1, %2" : "=v"(r) : "v"(lo), "v"(hi)); return r; }

typedef float f32x2e __attribute__((ext_vector_type(2)));
__device__ __forceinline__ float bf_lo(unsigned u) { return __builtin_bit_cast(float, u << 16); }
__device__ __forceinline__ float bf_hi(unsigned u) { return __builtin_bit_cast(float, u & 0xffff0000u); }
__device__ __forceinline__ float sigm_f(float x) { return __builtin_amdgcn_rcpf(1.f + __expf(-x)); }
__device__ __forceinline__ float silu_f(float x) { return x * sigm_f(x); }
__device__ __forceinline__ float ss_sum(const float* ssp, int row) { const f32x4* p = (const f32x4*)(ssp + (size_t)row * 16); const f32x4 a = p[0], b = p[1], c = p[2], d = p[3];
    return (((a[0] + a[1]) + (a[2] + a[3])) + ((b[0] + b[1]) + (b[2] + b[3]))) + (((c[0] + c[1]) + (c[2] + c[3])) + ((d[0] + d[1]) + (d[2] + d[3]))); }
__device__ __forceinline__ float rs_of(const float* ssp, int row) { return 1.f / sqrtf(ss_sum(ssp, row) * (1.f / 1024.f) + 1e-6f); }
__device__ __forceinline__ float rs_of_q(const float* ssp, int row, int fq) { const f32x4 a = *((const f32x4*)(ssp + (size_t)row * 16) + fq); float s = (a[0] + a[1]) + (a[2] + a[3]);
    s += __shfl_xor(s, 16); s += __shfl_xor(s, 32); return 1.f / sqrtf(s * (1.f / 1024.f) + 1e-6f); }
__device__ __forceinline__ u32x4 pack8(const f32x4& v0, const f32x4& v1) { u32x4 w; w.x = cvt_pk_bf16(v0[0], v0[1]); w.y = cvt_pk_bf16(v0[2], v0[3]); w.z = cvt_pk_bf16(v1[0], v1[1]); w.w = cvt_pk_bf16(v1[2], v1[3]); return w; }
__device__ __forceinline__ void unpack8(const u32x4& w, f32x4& v0, f32x4& v1) { v0 = (f32x4){bf_lo(w.x), bf_hi(w.x), bf_lo(w.y), bf_hi(w.y)}; v1 = (f32x4){bf_lo(w.z), bf_hi(w.z), bf_lo(w.w), bf_hi(w.w)}; }
__device__ __forceinline__ float sumsq8(const f32x4& a, const f32x4& b) { return (a[0] * a[0] + a[1] * a[1]) + (a[2] * a[2] + a[3] * a[3]) + (b[0] * b[0] + b[1] * b[1]) + (b[2] * b[2] + b[3] * b[3]); }
__device__ __forceinline__ void ss_put(float* ssp, int row, int slot, float part, int fq) { part += __shfl_xor(part, 16); part += __shfl_xor(part, 32); if (fq == 0) ssp[(size_t)row * 16 + slot] = part; }

struct EpiBf16 {
    static constexpr bool PERM = true;
    bf16_t* O; int ldc;
    __device__ __forceinline__ void operator()(const f32x4 (&acc)[2][2][4][2], const Unit& u, int wr, int wc, int fr, int fq) const {
        const int row0 = u.pm * BM + wr * 64 + fr, col0 = u.pn * BM + wc * 32 + 8 * fq;
#pragma unroll
        for (int ai = 0; ai < 2; ++ai)
#pragma unroll
            for (int m = 0; m < 4; ++m) { bf16_t* rowp = O + (size_t)(row0 + ai * HALF + m * 16) * ldc + col0;
#pragma unroll
                for (int bj = 0; bj < 2; ++bj) *(u32x4*)(rowp + bj * HALF) = pack8(acc[ai][bj][m][0], acc[ai][bj][m][1]); }
    }
};
struct EpiGLU {
    static constexpr bool PERM = true;
    bf16_t* O; const float* bias; const float* ss;
    __device__ __forceinline__ void operator()(const f32x4 (&acc)[2][2][4][2], const Unit& u, int wr, int wc, int fr, int fq) const {
        const int row0 = u.pm * BM + wr * 64 + fr, c0 = u.pn * HALF + wc * 32 + 8 * fq;
        const f32x4 ba0 = *(const f32x4*)(bias + c0), ba1 = *(const f32x4*)(bias + c0 + 4), bg0 = *(const f32x4*)(bias + 1024 + c0), bg1 = *(const f32x4*)(bias + 1024 + c0 + 4);
        float rr[2][4];
#pragma unroll
        for (int ai = 0; ai < 2; ++ai)
#pragma unroll
            for (int m = 0; m < 4; ++m) rr[ai][m] = rs_of_q(ss, row0 + ai * HALF + m * 16, fq);
#pragma unroll
        for (int ai = 0; ai < 2; ++ai)
#pragma unroll
            for (int m = 0; m < 4; ++m) { const int row = row0 + ai * HALF + m * 16; const float r = rr[ai][m];
                const f32x4 a0 = acc[ai][0][m][0] * r + ba0, a1 = acc[ai][0][m][1] * r + ba1, g0 = acc[ai][1][m][0] * r + bg0, g1 = acc[ai][1][m][1] * r + bg1;
                const f32x4 v0 = {a0[0] * sigm_f(g0[0]), a0[1] * sigm_f(g0[1]), a0[2] * sigm_f(g0[2]), a0[3] * sigm_f(g0[3])}, v1 = {a1[0] * sigm_f(g1[0]), a1[1] * sigm_f(g1[1]), a1[2] * sigm_f(g1[2]), a1[3] * sigm_f(g1[3])};
                *(u32x4*)(O + (size_t)row * 1024 + c0) = pack8(v0, v1); }
    }
};
struct EpiRes {
    static constexpr bool PERM = true;
    bf16_t* X; const float* bias; float* ss;
    __device__ __forceinline__ void operator()(const f32x4 (&acc)[2][2][4][2], const Unit& u, int wr, int wc, int fr, int fq) const {
        const int row0 = u.pm * BM + wr * 64 + fr, col0 = u.pn * BM + wc * 32 + 8 * fq;
        f32x4 bv[2][2];
#pragma unroll
        for (int bj = 0; bj < 2; ++bj)
#pragma unroll
            for (int n = 0; n < 2; ++n) bv[bj][n] = bias ? *(const f32x4*)(bias + col0 + bj * HALF + 4 * n) : (f32x4){0.f, 0.f, 0.f, 0.f};
#pragma unroll
        for (int ai = 0; ai < 2; ++ai) {
            u32x4 xo[4][2];
#pragma unroll
            for (int m = 0; m < 4; ++m)
#pragma unroll
                for (int bj = 0; bj < 2; ++bj) xo[m][bj] = *(const u32x4*)(X + (size_t)(row0 + ai * HALF + m * 16) * 1024 + col0 + bj * HALF);
#pragma unroll
            for (int m = 0; m < 4; ++m) { const int row = row0 + ai * HALF + m * 16; bf16_t* rowp = X + (size_t)row * 1024 + col0; float part = 0.f;
#pragma unroll
                for (int bj = 0; bj < 2; ++bj) { f32x4 x0, x1; unpack8(xo[m][bj], x0, x1);
                    const f32x4 v0 = acc[ai][bj][m][0] + bv[bj][0] + x0, v1 = acc[ai][bj][m][1] + bv[bj][1] + x1; part += sumsq8(v0, v1);
                    *(u32x4*)(rowp + bj * HALF) = pack8(v0, v1); }
                ss_put(ss, row, u.pn * 4 + wc, part, fq); } }
    }
};
template <bool F32OUT> struct EpiPle {
    static constexpr bool PERM = true;
    const bf16_t* Xin; const bf16_t* P; bf16_t* Xo; float* Fo; const float* ssin; float* ssout;
    __device__ __forceinline__ void operator()(const f32x4 (&acc)[2][2][4][2], const Unit& u, int wr, int wc, int fr, int fq) const {
        const int row0 = u.pm * BM + wr * 64 + fr, col0 = u.pn * BM + wc * 32 + 8 * fq;
#pragma unroll
        for (int ai = 0; ai < 2; ++ai) {
            u32x4 xo[4][2], po[4][2]; float rr[4];
#pragma unroll
            for (int m = 0; m < 4; ++m) { const size_t off = (size_t)(row0 + ai * HALF + m * 16) * 1024 + col0; rr[m] = rs_of_q(ssin, row0 + ai * HALF + m * 16, fq);
#pragma unroll
                for (int bj = 0; bj < 2; ++bj) { xo[m][bj] = *(const u32x4*)(Xin + off + bj * HALF); po[m][bj] = *(const u32x4*)(P + off + bj * HALF); } }
#pragma unroll
            for (int m = 0; m < 4; ++m) { const int row = row0 + ai * HALF + m * 16; const size_t off = (size_t)row * 1024 + col0; const float r = rr[m]; float part = 0.f;
#pragma unroll
                for (int bj = 0; bj < 2; ++bj) { f32x4 x0, x1, p0, p1; unpack8(xo[m][bj], x0, x1); unpack8(po[m][bj], p0, p1);
                    const f32x4 a0 = acc[ai][bj][m][0] * r, a1 = acc[ai][bj][m][1] * r;
                    const f32x4 v0 = {x0[0] + sigm_f(a0[0]) * p0[0], x0[1] + sigm_f(a0[1]) * p0[1], x0[2] + sigm_f(a0[2]) * p0[2], x0[3] + sigm_f(a0[3]) * p0[3]};
                    const f32x4 v1 = {x1[0] + sigm_f(a1[0]) * p1[0], x1[1] + sigm_f(a1[1]) * p1[1], x1[2] + sigm_f(a1[2]) * p1[2], x1[3] + sigm_f(a1[3]) * p1[3]};
                    part += sumsq8(v0, v1);
                    if (F32OUT) { *(f32x4*)(Fo + off + bj * HALF) = v0; *(f32x4*)(Fo + off + bj * HALF + 4) = v1; } else *(u32x4*)(Xo + off + bj * HALF) = pack8(v0, v1); }
                ss_put(ssout, row, u.pn * 4 + wc, part, fq); } }
    }
};
struct EpiLogits {
    static constexpr bool PERM = false;
    float* O; const float* ss;
    __device__ __forceinline__ void operator()(const f32x4 (&acc)[2][2][4][2], const Unit& u, int wr, int wc, int fr, int fq) const {
        if (wc < 2) {
            const int row0 = u.pm * BM + wr * 64 + fr;
            float rr[2][4];
#pragma unroll
            for (int ai = 0; ai < 2; ++ai)
#pragma unroll
                for (int m = 0; m < 4; ++m) rr[ai][m] = rs_of_q(ss, row0 + ai * HALF + m * 16, fq);
#pragma unroll
            for (int ai = 0; ai < 2; ++ai)
#pragma unroll
                for (int m = 0; m < 4; ++m) { const int row = row0 + ai * HALF + m * 16;
#pragma unroll
                    for (int n = 0; n < 2; ++n) *(f32x4*)(O + (size_t)row * 64 + wc * 32 + n * 16 + 4 * fq) = acc[ai][0][m][n] * rr[ai][m]; }
        }
    }
};
struct EpiGU {
    static constexpr bool PERM = true;
    bf16_t* O; const float* rp;
    __device__ __forceinline__ void operator()(const f32x4 (&acc)[2][2][4][2], const Unit& u, int wr, int wc, int fr, int fq) const {
        const int trow0 = wr * 64 + fr, col0 = u.pn * HALF + wc * 32 + 8 * fq;
        float rr[2][4];
#pragma unroll
        for (int ai = 0; ai < 2; ++ai)
#pragma unroll
            for (int m = 0; m < 4; ++m) rr[ai][m] = rp[(size_t)u.aux + trow0 + ai * HALF + m * 16];
#pragma unroll
        for (int ai = 0; ai < 2; ++ai)
#pragma unroll
            for (int m = 0; m < 4; ++m) { const int trow = trow0 + ai * HALF + m * 16; const float r = rr[ai][m];
                const f32x4 g0 = acc[ai][0][m][0] * r, g1 = acc[ai][0][m][1] * r, u0 = acc[ai][1][m][0] * r, u1 = acc[ai][1][m][1] * r;
                const f32x4 v0 = {silu_f(g0[0]) * u0[0], silu_f(g0[1]) * u0[1], silu_f(g0[2]) * u0[2], silu_f(g0[3]) * u0[3]}, v1 = {silu_f(g1[0]) * u1[0], silu_f(g1[1]) * u1[1], silu_f(g1[2]) * u1[2], silu_f(g1[3]) * u1[3]};
                *(u32x4*)(O + (size_t)(u.pm * BM + trow) * 256 + col0) = pack8(v0, v1); }
    }
};
struct EpiQKV {
    static constexpr bool PERM = true;
    bf16_t* O; size_t stride; const float* ss; const int* pos; float scaleq;
    __device__ __forceinline__ void operator()(const f32x4 (&acc)[2][2][4][2], const Unit& u, int wr, int wc, int fr, int fq) const {
        const int t = (u.pn * BM) >> 10, colt = (u.pn * BM) & 1023, row0 = u.pm * BM + wr * 64 + fr, col0 = colt + wc * 32 + 8 * fq;
        bf16_t* base = O + (size_t)t * stride; const float sc = (t == 0) ? scaleq : 1.f; const bool roped = (t < 2) && ((wc & 1) == 0);
        float rr[2][4]; int pp[2][4];
#pragma unroll
        for (int ai = 0; ai < 2; ++ai)
#pragma unroll
            for (int m = 0; m < 4; ++m) { rr[ai][m] = rs_of_q(ss, row0 + ai * HALF + m * 16, fq) * sc; pp[ai][m] = pos[row0 + ai * HALF + m * 16]; }
#pragma unroll
        for (int ai = 0; ai < 2; ++ai)
#pragma unroll
            for (int m = 0; m < 4; ++m) { const int row = row0 + ai * HALF + m * 16; const float r = rr[ai][m];
                float cs[8], sn[8];
                if (roped) { const float fp = (float)pp[ai][m];
#pragma unroll
                    for (int i = 0; i < 8; ++i) { const float invf = __builtin_powf(500000.0f, -(float)i / 8.0f); const float ang = fp * invf, rev = ang * 0.15915494309189535f, fr_ = rev - __builtin_floorf(rev);
                        sn[i] = __builtin_amdgcn_sinf(fr_); cs[i] = __builtin_amdgcn_cosf(fr_); if (fq == 0) sn[i] = -sn[i]; } }
#pragma unroll
                for (int bj = 0; bj < 2; ++bj) { f32x4 v0 = acc[ai][bj][m][0] * r, v1 = acc[ai][bj][m][1] * r;
                    if (roped) { float pv[8];
#pragma unroll
                        for (int i = 0; i < 4; ++i) { pv[i] = __shfl_xor(v0[i], 16); pv[4 + i] = __shfl_xor(v1[i], 16); }
                        if (fq < 2) {
#pragma unroll
                            for (int i = 0; i < 4; ++i) { v0[i] = v0[i] * cs[i] + pv[i] * sn[i]; v1[i] = v1[i] * cs[4 + i] + pv[4 + i] * sn[4 + i]; } } }
                    *(u32x4*)(base + (size_t)row * 1024 + col0 + bj * HALF) = pack8(v0, v1); } }
    }
};

template <class Epi, class Sched, bool ALIGN_EPI, bool GATHER>
__device__ __forceinline__ void gemm_phase(PG8_LAS unsigned char* lds, const Gemm g, const Sched& S, const Epi& E, int wave_) {
    const int tid = ltid(wave_), wid = wave_, lane = tid & 63, wr = wid >> 2, wc = wid & 3, fr = lane & 15, fq = lane >> 4;
    const int K = g.K, nt = K / BK;
    unsigned voffA[2], voffB[2]; int sR[2], sC[2];
#pragma unroll
    for (int i = 0; i < 2; ++i) { int R, C; stage_rc(tid * 16 + i * 8192, R, C); const int Rb = Epi::PERM ? ((R & ~31) + perm32(R & 31)) : R;
        sR[i] = R; sC[i] = C; voffA[i] = (unsigned)(R * K + C) * 2u; voffB[i] = (unsigned)(Rb * K + C) * 2u; }
    const size_t kstep = (size_t)(BK * 2);
    const size_t hstep = (size_t)HALF * K * 2;
    const size_t tstep = 2 * hstep;
    const unsigned ldsw = (unsigned)wid * 1024u;
    const int aoff = lds_byte(wr * 64 + fr, fq * 8), boff = lds_byte(wc * 32 + fr, fq * 8);
#define PG8_SA(b, h) (((b) * 2 + (h)) * HTB)
#define PG8_SB(b, h) ((4 + (b) * 2 + (h)) * HTB)
#define PG8_STAGE(bufoff, gbase, voff) do { _Pragma("unroll") for (int _i = 0; _i < 2; ++_i) \
        __builtin_amdgcn_global_load_lds((const unsigned*)((const char*)(gbase) + (voff)[_i]), (PG8_LAS unsigned*)(lds + (bufoff) + ldsw + _i * 8192), 16, 0, 0); } while (0)
#define PG8_STAGE_A(bufoff, base, kb, h, vv) do { _Pragma("unroll") for (int _i = 0; _i < 2; ++_i) { \
        const char* _p = GATHER ? ((const char*)g.A + (kb) + (vv)[h][_i]) : ((const char*)(base) + (kb) + (size_t)(h) * hstep + voffA[_i]); \
        __builtin_amdgcn_global_load_lds((const unsigned*)_p, (PG8_LAS unsigned*)(lds + (bufoff) + ldsw + _i * 8192), 16, 0, 0); } } while (0)
#define PG8_GOFF(vv, ord) do { _Pragma("unroll") for (int _h = 0; _h < 2; ++_h) _Pragma("unroll") for (int _i = 0; _i < 2; ++_i) \
        (vv)[_h][_i] = S.arow((ord), _h * HALF + sR[_i]) * (unsigned)(K * 2) + (unsigned)(sC[_i] * 2); } while (0)
#define PG8_LDA(dst, b, h) do { _Pragma("unroll") for (int m = 0; m < 4; ++m) _Pragma("unroll") for (int k = 0; k < 2; ++k) dst[m][k] = *(const PG8_LAS bf16x8*)(lds + PG8_SA(b, h) + aoff + m * 2048 + k * 1024); } while (0)
#define PG8_LDB(dst, b, h) do { _Pragma("unroll") for (int n = 0; n < 2; ++n) _Pragma("unroll") for (int k = 0; k < 2; ++k) dst[n][k] = *(const PG8_LAS bf16x8*)(lds + PG8_SB(b, h) + boff + n * 2048 + k * 1024); } while (0)
#define PG8_MMA(ai, bj, At, Bt) do { __builtin_amdgcn_s_setprio(1); _Pragma("unroll") for (int m = 0; m < 4; ++m) _Pragma("unroll") for (int n = 0; n < 2; ++n) _Pragma("unroll") for (int k = 0; k < 2; ++k) \
        acc[ai][bj][m][n] = __builtin_amdgcn_mfma_f32_16x16x32_bf16(Bt[n][k], At[m][k], acc[ai][bj][m][n], 0, 0, 0); __builtin_amdgcn_s_setprio(0); } while (0)
#define PG8_WAIT_V(n) asm volatile("s_waitcnt vmcnt(" #n ")" ::: "memory")
#define PG8_WAIT_L(n) asm volatile("s_waitcnt lgkmcnt(" #n ")" ::: "memory")
#define PG8_BAR __builtin_amdgcn_s_barrier()
#define PG8_SCHED __builtin_amdgcn_sched_barrier(0)
    Unit cur, nxt; int ui = 0;
    if (!S.next(0, cur)) return;
    f32x4 acc[2][2][4][2];
#pragma unroll
    for (int a = 0; a < 2; ++a)
#pragma unroll
        for (int b = 0; b < 2; ++b)
#pragma unroll
            for (int m = 0; m < 4; ++m)
#pragma unroll
                for (int n = 0; n < 2; ++n) acc[a][b][m][n] = (f32x4){0.f, 0.f, 0.f, 0.f};
    bf16x8 At[4][2], B0[2][2], B1[2][2];
    unsigned vA[2][2] = {{0u, 0u}, {0u, 0u}}, vN[2][2] = {{0u, 0u}, {0u, 0u}}, vS[2][2] = {{0u, 0u}, {0u, 0u}};
    if constexpr (GATHER) { PG8_GOFF(vA, 0); }
    const char* cA = GATHER ? (const char*)g.A : (const char*)g.A + (size_t)cur.pm * tstep; const char* cB = (const char*)g.Bt + (size_t)cur.pb * tstep;
    PG8_STAGE(PG8_SB(0, 0), cB, voffB); PG8_STAGE(PG8_SB(0, 1), cB + hstep, voffB); PG8_STAGE_A(PG8_SA(0, 0), cA, 0, 0, vA); PG8_STAGE_A(PG8_SA(0, 1), cA, 0, 1, vA);
    if (wr == 1) PG8_BAR;
    PG8_WAIT_V(2); PG8_BAR;
    PG8_STAGE(PG8_SB(1, 0), cB + kstep, voffB); PG8_STAGE_A(PG8_SA(1, 0), cA, kstep, 0, vA); PG8_STAGE(PG8_SB(1, 1), cB + hstep + kstep, voffB);
    PG8_WAIT_V(6); PG8_BAR;
    for (;;) {
        const bool has_next = S.next(ui + 1, nxt);
        if constexpr (GATHER) { if (has_next) { PG8_GOFF(vN, ui + 1); } else { _Pragma("unroll") for (int _h = 0; _h < 2; ++_h) _Pragma("unroll") for (int _i = 0; _i < 2; ++_i) vN[_h][_i] = vA[_h][_i]; } }
        const char* nA = (has_next && !GATHER) ? (const char*)g.A + (size_t)nxt.pm * tstep : cA; const char* nB = has_next ? (const char*)g.Bt + (size_t)nxt.pb * tstep : cB;
        for (int t = 0; t < nt; t += 2) {
            const bool last = (t == nt - 2);
            const size_t kb1 = (size_t)(t + 1) * kstep, kb2 = last ? (size_t)0 : (size_t)(t + 2) * kstep, kb3 = kb2 + kstep;
            const char* sA = last ? nA : cA; const char* b2 = last ? nB : cB + (size_t)(t + 2) * kstep; const char* b3 = b2 + kstep;
            if constexpr (GATHER) { _Pragma("unroll") for (int _h = 0; _h < 2; ++_h) _Pragma("unroll") for (int _i = 0; _i < 2; ++_i) vS[_h][_i] = last ? vN[_h][_i] : vA[_h][_i]; }
            PG8_LDB(B0, 0, 0); PG8_LDB(B1, 0, 1); PG8_SCHED; PG8_LDA(At, 0, 0); PG8_STAGE_A(PG8_SA(1, 1), cA, kb1, 1, vA);
            PG8_WAIT_V(8); PG8_WAIT_L(0); PG8_BAR; PG8_MMA(0, 0, At, B0); PG8_MMA(0, 1, At, B1); PG8_BAR; PG8_SCHED;
            PG8_LDA(At, 0, 1); PG8_STAGE(PG8_SB(0, 0), b2, voffB); PG8_STAGE(PG8_SB(0, 1), b2 + hstep, voffB); PG8_STAGE_A(PG8_SA(0, 0), sA, kb2, 0, vS);
            PG8_WAIT_V(8); PG8_WAIT_L(0); PG8_BAR; PG8_MMA(1, 0, At, B0); PG8_MMA(1, 1, At, B1); PG8_BAR; PG8_SCHED;
            PG8_LDB(B0, 1, 0); PG8_LDB(B1, 1, 1); PG8_SCHED; PG8_LDA(At, 1, 0); PG8_STAGE_A(PG8_SA(0, 1), sA, kb2, 1, vS);
            PG8_WAIT_V(8); PG8_WAIT_L(0); PG8_BAR; PG8_MMA(0, 0, At, B0); PG8_MMA(0, 1, At, B1); PG8_BAR; PG8_SCHED;
            PG8_LDA(At, 1, 1); PG8_STAGE(PG8_SB(1, 0), b3, voffB); PG8_STAGE(PG8_SB(1, 1), b3 + hstep, voffB); PG8_STAGE_A(PG8_SA(1, 0), sA, kb3, 0, vS);
            PG8_WAIT_V(8); PG8_WAIT_L(0); PG8_BAR; PG8_MMA(1, 0, At, B0); PG8_MMA(1, 1, At, B1); PG8_BAR; PG8_SCHED;
        }
        if constexpr (ALIGN_EPI) { if (wr == 0) PG8_BAR; }
        E(acc, cur, wr, wc, fr, fq);
        if (!has_next) break;
#pragma unroll
        for (int a = 0; a < 2; ++a)
#pragma unroll
            for (int b = 0; b < 2; ++b)
#pragma unroll
                for (int m = 0; m < 4; ++m)
#pragma unroll
                    for (int n = 0; n < 2; ++n) acc[a][b][m][n] = (f32x4){0.f, 0.f, 0.f, 0.f};
        cur = nxt; cA = nA; cB = nB; ++ui;
        if constexpr (GATHER) { _Pragma("unroll") for (int _h = 0; _h < 2; ++_h) _Pragma("unroll") for (int _i = 0; _i < 2; ++_i) vA[_h][_i] = vN[_h][_i]; }
        if constexpr (ALIGN_EPI) { if (wr == 1) PG8_BAR; }
    }
    PG8_WAIT_V(0);
    if constexpr (!ALIGN_EPI) { if (wr == 0) PG8_BAR; }
    PG8_BAR;
#undef PG8_SA
#undef PG8_SB
#undef PG8_STAGE
#undef PG8_STAGE_A
#undef PG8_GOFF
#undef PG8_LDA
#undef PG8_LDB
#undef PG8_MMA
#undef PG8_WAIT_V
#undef PG8_WAIT_L
#undef PG8_BAR
#undef PG8_SCHED
}
}

#include <hip/hip_bf16.h>
#include <cmath>
namespace attn3 {
using bf16=__hip_bfloat16;
using bf16x8=__attribute__((ext_vector_type(8)))short;
using s16x4=__attribute__((ext_vector_type(4)))short;
using f32x16=__attribute__((ext_vector_type(16)))float;
using u32x4=__attribute__((ext_vector_type(4)))unsigned;
constexpr int BATCH=8,SEQ=4096,D=64,DV=128,DM=1024;
constexpr int NW=8,QBLK=32,QB=QBLK*NW,KVBLK=64,NQB=SEQ/QB;
__device__ __forceinline__ int crow(int r,int hi){return (r&3)+8*(r>>2)+4*hi;}
#define SBAR() __builtin_amdgcn_sched_barrier(0)
__device__ __forceinline__ void cmask(f32x16&p0,f32x16&p1,int jb,int qrel,int hi){
  const float NEG=-INFINITY; int kb=64*jb+4*hi;
  #pragma unroll
  for(int r=0;r<16;++r){int kv=kb+(r&3)+8*(r>>2); if(kv>qrel)p0[r]=NEG; if(kv+32>qrel)p1[r]=NEG;}
}

constexpr int NSLOT=3, SLOTB=8192;
constexpr int VSLOTB=2*SLOTB;
constexpr int LDS_K=0, LDS_V=NSLOT*SLOTB, LDS_WS=LDS_V+NSLOT*VSLOTB, LDS_OST=LDS_WS+NW*64*4, LDS_BYTES=LDS_OST+NW*4096;
constexpr float C2=0.125f*1.4426950408889634f;
__device__ __forceinline__ void glds16(const void*gsrc,unsigned lds_dst){unsigned keep;
  asm volatile("s_mov_b32 %0, m0\n\ts_mov_b32 m0, %2\n\ts_nop 0\n\tglobal_load_lds_dwordx4 %1, off\n\ts_mov_b32 m0, %0":"=&s"(keep):"v"(gsrc),"s"(lds_dst):"memory");}
__device__ __forceinline__ float max3f(float a,float b,float c){float r;asm("v_max3_f32 %0, %1, %2, %3":"=v"(r):"v"(a),"v"(b),"v"(c));return r;}
__device__ __forceinline__ float max2f(float a,float b){float r;asm("v_max_f32_e32 %0, %1, %2":"=v"(r):"v"(a),"v"(b));return r;}
__device__ __forceinline__ float fadd_s(float a,float b){float r;asm("v_add_f32_e32 %0, %1, %2":"=v"(r):"v"(a),"v"(b));return r;}
__device__ __forceinline__ float fsub_s(float a,float b){float r;asm("v_sub_f32_e32 %0, %1, %2":"=v"(r):"v"(a),"v"(b));return r;}
typedef float f32x2_t __attribute__((ext_vector_type(2))); typedef __bf16 bf16x2_t __attribute__((ext_vector_type(2)));
__device__ __forceinline__ unsigned cvtpk_s(float lo,float hi){f32x2_t v={lo,hi};bf16x2_t b=__builtin_convertvector(v,bf16x2_t);return __builtin_bit_cast(unsigned,b);}
#define WAIT_BAR(N) asm volatile("s_waitcnt vmcnt(" #N ") lgkmcnt(0)\n\ts_barrier":::"memory")

__device__ __forceinline__ void qkt(f32x16&p0,f32x16&p1,const char*Kslot,const bf16x8*qr,int r32,int hi){
  const char*kb=Kslot+hi*1024+r32*16; const f32x16 z=f32x16{};
  #pragma unroll
  for(int d0=0;d0<4;++d0){
    const bf16x8 b0=*reinterpret_cast<const bf16x8*>(kb+d0*2048);
    const bf16x8 b1=*reinterpret_cast<const bf16x8*>(kb+d0*2048+512);
    if(d0==0){p0=__builtin_amdgcn_mfma_f32_32x32x16_bf16(b0,qr[0],z,0,0,0);p1=__builtin_amdgcn_mfma_f32_32x32x16_bf16(b1,qr[0],z,0,0,0);}
    else{p0=__builtin_amdgcn_mfma_f32_32x32x16_bf16(b0,qr[d0],p0,0,0,0);p1=__builtin_amdgcn_mfma_f32_32x32x16_bf16(b1,qr[d0],p1,0,0,0);}}
}
typedef __attribute__((address_space(3))) const char* lds_cptr;
typedef short v4i16_t __attribute__((ext_vector_type(4)));
__device__ __forceinline__ void kload8(bf16x8*kf,lds_cptr kp){
  kf[0]=*(const __attribute__((address_space(3))) bf16x8*)(kp);      kf[1]=*(const __attribute__((address_space(3))) bf16x8*)(kp+512);
  kf[2]=*(const __attribute__((address_space(3))) bf16x8*)(kp+2048); kf[3]=*(const __attribute__((address_space(3))) bf16x8*)(kp+2560);
  kf[4]=*(const __attribute__((address_space(3))) bf16x8*)(kp+4096); kf[5]=*(const __attribute__((address_space(3))) bf16x8*)(kp+4608);
  kf[6]=*(const __attribute__((address_space(3))) bf16x8*)(kp+6144); kf[7]=*(const __attribute__((address_space(3))) bf16x8*)(kp+6656);
}
__device__ __forceinline__ void kload2(bf16x8*kf,lds_cptr kp,int j){ kf[2*j]=*(const __attribute__((address_space(3))) bf16x8*)(kp+j*2048); kf[2*j+1]=*(const __attribute__((address_space(3))) bf16x8*)(kp+j*2048+512); }
__device__ __forceinline__ s16x4 vtr(lds_cptr p){ return __builtin_bit_cast(s16x4,__builtin_amdgcn_ds_read_tr16_b64_v4i16((__attribute__((address_space(3))) v4i16_t*)p)); }
__device__ __forceinline__ float rowmax(const f32x16&p0,const f32x16&p1){
  float a=max3f(p0[0],p0[1],p1[0]),b=max3f(p0[2],p0[3],p1[1]);a=max3f(a,p1[2],p1[3]);
  #pragma unroll
  for(int r=4;r<16;r+=4){a=max3f(a,p0[r],p0[r+1]);b=max3f(b,p0[r+2],p0[r+3]);a=max3f(a,p1[r],p1[r+1]);b=max3f(b,p1[r+2],p1[r+3]);}
  const float m=max2f(a,b);
  auto rr=__builtin_amdgcn_permlane32_swap(__float_as_uint(m),__float_as_uint(m),false,false);
  return max2f(__uint_as_float(rr[0]),__uint_as_float(rr[1]));
}

#define ATTN_STORE16(p,v) (*(u32x4*)(p)=(v))
template<int THRL> __device__ __forceinline__ void attn_unit(int b,int hc,int qb,const bf16*Q,const bf16*__restrict__ K,const bf16*__restrict__ V,bf16*O,char*shm,int wave_,int mode,float*stash,float lam,const float(&gsub)[4]){
  const int wid=wave_; const int tid=pg8::ltid(wid); const int lane=tid&63,r32=lane&31,hi=lane>>5;
  const long rowbase=(long)b*SEQ; const int q0=qb*QB;
  const bf16*Qw=Q+(rowbase+q0+wid*QBLK)*DM+hc*D;
  const bf16*Kh=K+rowbase*DM+hc*D,*Vh=V+rowbase*DM+(hc>>1)*DV;
  const unsigned lds0=(unsigned)(uintptr_t)shm;
  float*wsf=(float*)(shm+LDS_WS)+wid*64;
  const bf16*ksrc=Kh+(long)lane*DM+wid*8;
  const bf16*vsrc=Vh+(long)(16*(wid&3)+(lane>>2))*DM+(wid>>2)*32+(lane&3)*8;
  const unsigned kdst=lds0+LDS_K+wid*1024, vdst=lds0+LDS_V+wid*1024;
  #define DMA_K(t,slot) glds16(ksrc+(long)(t)*KVBLK*DM,(unsigned)__builtin_amdgcn_readfirstlane(kdst+(slot)))
  #define DMA_V(t,slot) do{ glds16(vsrc+(long)(t)*KVBLK*DM,(unsigned)__builtin_amdgcn_readfirstlane(vdst+2*(slot))); glds16(vsrc+(long)(t)*KVBLK*DM+64,(unsigned)__builtin_amdgcn_readfirstlane(vdst+2*(slot)+8192)); }while(0)
  const char*Kbase=shm+LDS_K; bf16x8 kf[8];
  const lds_cptr shm3=(lds_cptr)shm; const lds_cptr kp0=shm3+LDS_K+hi*1024+r32*16; const lds_cptr vp0=shm3+LDS_V+((lane>>4)&1)*32+(lane&3)*8+(4*hi+((lane&15)>>2))*64;
  const int NT=(q0+QB)/KVBLK;
  bf16x8 qr[4];
  #pragma unroll
  for(int d0=0;d0<4;++d0)qr[d0]=*reinterpret_cast<const bf16x8*>(&Qw[(long)r32*DM+d0*16+hi*8]);
  DMA_K(0,0);DMA_V(0,0);DMA_K(1,SLOTB);DMA_K(2,2*SLOTB);
  float mhat=0.f,l_reg=0.f;f32x16 o[4];o[0]=f32x16{};o[1]=f32x16{};o[2]=f32x16{};o[3]=f32x16{};
  const int qrel=wid*QBLK+r32;
  #define CMASK(P0,P1,t) do{int jb_=(t)-(NT-4); if(jb_>=0)cmask(P0,P1,jb_,qrel,hi);}while(0)
  bool resc=false;
  #define RESC() do{ if(resc){ asm volatile("s_waitcnt lgkmcnt(0)":::"memory"); \
      _Pragma("unroll") for(int d_=0;d_<4;++d_) _Pragma("unroll") for(int r=0;r<16;++r)o[d_][r]*=wsf[crow(r,hi)]; } }while(0)
  f32x16 pA0,pA1,pB0,pB1;
  int sl_prev=0,sl_cur=0,sl_next=SLOTB;
  #define ROT() do{sl_prev=sl_cur;sl_cur=sl_next;sl_next=(sl_next==(NSLOT-1)*SLOTB)?0:sl_next+SLOTB;}while(0)
  WAIT_BAR(4);
  qkt(pA0,pA1,Kbase,qr,r32,hi);asm volatile("s_nop 15\n\ts_nop 7":"+v"(pA0),"+v"(pA1));CMASK(pA0,pA1,0);
  { const float rm=rowmax(pA0,pA1); mhat=rm;
    _Pragma("unroll") for(int r=0;r<16;++r)pA0[r]=__builtin_amdgcn_exp2f(fsub_s(pA0[r],mhat));
    _Pragma("unroll") for(int r=0;r<16;++r)pA1[r]=__builtin_amdgcn_exp2f(fsub_s(pA1[r],mhat)); }
  WAIT_BAR(0);
  DMA_K(3,0);DMA_V(1,SLOTB);
  ROT();
  kload8(kf,kp0+sl_cur);
  WAIT_BAR(3);
  s16x4 vlo[8],vhi[8]; u32x4 pw0,pw1,pw2,pw3;
  #define PKW(P,B) cvtpk_s(P[B],P[B+1])
  #define PAF(k) __builtin_bit_cast(bf16x8,pw##k)
  #define VFS(i) (bf16x8){vlo[i][0],vlo[i][1],vlo[i][2],vlo[i][3],vhi[i][0],vhi[i][1],vhi[i][2],vhi[i][3]}
  #define PIN(x) asm volatile("":"+v"(x))
  #define MX3(a,b,c) __builtin_fmaxf(__builtin_fmaxf((a),(b)),(c))
  #define GAPA(MF,A0,A1,A2,A3,W0,W1,PW) do{ MF; sacc+=A0; sacc+=A1; sacc+=A2; sacc+=A3; PIN(sacc); W0; W1; PIN(PW); SBAR(); }while(0)
  #define EX(v) __builtin_amdgcn_exp2f(v)
  #define GAPB(MF,X,B) do{ MF; X[B]=EX(X[B]-mhat); X[B+1]=EX(X[B+1]-mhat); PIN(X); SBAR(); }while(0)
  #define VRDS(s,db,ks) do{ vlo[s]=vtr(vp_+((db)*4096+(ks)*1024)); vhi[s]=vtr(vp_+((db)*4096+(ks)*1024+512)); }while(0)
  #define KRD(G,j) do{ if(G){ kload2(kf,kp0+sl_next,j); SBAR(); } }while(0)
  #define MF32(a,b,c) __builtin_amdgcn_mfma_f32_32x32x16_bf16(a,b,c,0,0,0)
  #define STEP(C0,C1,P0,P1,t,GK,GV,GL) do{ SBAR(); \
    const lds_cptr vp_=vp0+2*sl_prev; const f32x16 z_=f32x16{}; \
    VRDS(0,0,0); SBAR(); float sacc=(P0[0]+P0[1]); \
    GAPA(C0=MF32(kf[0],qr[0],z_), P0[2],P0[3],P0[4],P0[5],     pw0[0]=PKW(P0,0), pw0[1]=PKW(P0,2), pw0); \
    VRDS(1,1,0); SBAR(); GAPA(C1=MF32(kf[1],qr[0],z_), P0[6],P0[7],P0[8],P0[9],     pw0[2]=PKW(P0,4), pw0[3]=PKW(P0,6), pw0); \
    VRDS(2,2,0); SBAR(); GAPA(C0=MF32(kf[2],qr[1],C0),   P0[10],P0[11],P0[12],P0[13], pw1[0]=PKW(P0,8), pw1[1]=PKW(P0,10), pw1); \
    VRDS(3,3,0); SBAR(); GAPA(C1=MF32(kf[3],qr[1],C1),   P0[14],P0[15],P1[0],P1[1],   pw1[2]=PKW(P0,12),pw1[3]=PKW(P0,14), pw1); \
    VRDS(4,0,1); SBAR(); GAPA(C0=MF32(kf[4],qr[2],C0),   P1[2],P1[3],P1[4],P1[5],     pw2[0]=PKW(P1,0), pw2[1]=PKW(P1,2), pw2); \
    VRDS(5,1,1); SBAR(); GAPA(C1=MF32(kf[5],qr[2],C1),   P1[6],P1[7],P1[8],P1[9],     pw2[2]=PKW(P1,4), pw2[3]=PKW(P1,6), pw2); \
    VRDS(6,2,1); SBAR(); GAPA(C0=MF32(kf[6],qr[3],C0),   P1[10],P1[11],P1[12],P1[13], pw3[0]=PKW(P1,8), pw3[1]=PKW(P1,10), pw3); \
    VRDS(7,3,1); SBAR(); GAPA(C1=MF32(kf[7],qr[3],C1),   P1[14],P1[15],0.f,0.f,       pw3[2]=PKW(P1,12),pw3[3]=PKW(P1,14), pw3); \
    l_reg+=sacc; \
    if(GK){DMA_K((t)+3,sl_cur);} if(GV){DMA_V((t)+1,sl_next);} \
    CMASK(C0,C1,t); \
    { float a=MX3(C0[0],C0[1],C1[0]),b=MX3(C0[2],C0[3],C1[1]); a=MX3(a,C1[2],C1[3]); \
      _Pragma("unroll") for(int r=4;r<16;r+=4){a=MX3(a,C0[r],C0[r+1]);b=MX3(b,C0[r+2],C0[r+3]);a=MX3(a,C1[r],C1[r+1]);b=MX3(b,C1[r+2],C1[r+3]);} \
      float rm=__builtin_fmaxf(a,b); { auto rr=__builtin_amdgcn_permlane32_swap(__float_as_uint(rm),__float_as_uint(rm),false,false); rm=__builtin_fmaxf(__uint_as_float(rr[0]),__uint_as_float(rr[1])); } \
      resc=false; const float dlt=rm-mhat; \
      if(__builtin_expect(__any(dlt>(float)THRL),0)){ const float dl=__builtin_fmaxf(dlt,0.f); mhat+=dl; \
        const float f=__builtin_amdgcn_exp2f(-dl); l_reg*=f; if(hi==0)wsf[r32]=f; resc=true; } } \
    SBAR(); \
    GAPB(o[0]=MF32(PAF(0),VFS(0),o[0]), C0,0); \
    VRDS(0,0,2); SBAR(); GAPB(o[1]=MF32(PAF(0),VFS(1),o[1]), C0,2); \
    VRDS(1,1,2); SBAR(); GAPB(o[2]=MF32(PAF(0),VFS(2),o[2]), C0,4); \
    VRDS(2,2,2); SBAR(); GAPB(o[3]=MF32(PAF(0),VFS(3),o[3]), C0,6); \
    VRDS(3,3,2); SBAR(); GAPB(o[0]=MF32(PAF(1),VFS(4),o[0]), C0,8); \
    VRDS(4,0,3); SBAR(); GAPB(o[1]=MF32(PAF(1),VFS(5),o[1]), C0,10); \
    VRDS(5,1,3); SBAR(); GAPB(o[2]=MF32(PAF(1),VFS(6),o[2]), C0,12); \
    VRDS(6,2,3); SBAR(); GAPB(o[3]=MF32(PAF(1),VFS(7),o[3]), C0,14); \
    VRDS(7,3,3); SBAR(); GAPB(o[0]=MF32(PAF(2),VFS(0),o[0]), C1,0); \
    KRD(GL,0); GAPB(o[1]=MF32(PAF(2),VFS(1),o[1]), C1,2); \
    KRD(GL,1); GAPB(o[2]=MF32(PAF(2),VFS(2),o[2]), C1,4); \
    KRD(GL,2); GAPB(o[3]=MF32(PAF(2),VFS(3),o[3]), C1,6); \
    KRD(GL,3); GAPB(o[0]=MF32(PAF(3),VFS(4),o[0]), C1,8); \
    GAPB(o[1]=MF32(PAF(3),VFS(5),o[1]), C1,10); \
    GAPB(o[2]=MF32(PAF(3),VFS(6),o[2]), C1,12); \
    GAPB(o[3]=MF32(PAF(3),VFS(7),o[3]), C1,14); \
    }while(0)
  int t=1;
  #undef CMASK
  #define CMASK(P0,P1,t) do{}while(0)
  for(;t+5<NT;t+=2){
    STEP(pB0,pB1,pA0,pA1,t,true,true,true);     WAIT_BAR(3); RESC(); ROT();
    STEP(pA0,pA1,pB0,pB1,t+1,true,true,true);   WAIT_BAR(3); RESC(); ROT();
  }
  #undef CMASK
  #define CMASK(P0,P1,t) do{int jb_=(t)-(NT-4); if(jb_>=0)cmask(P0,P1,jb_,qrel,hi);}while(0)
  #define ENDW(tt) do{ if((tt)+3<NT){WAIT_BAR(3);} else if((tt)+2<NT){WAIT_BAR(2);} else {WAIT_BAR(0);} }while(0)
  for(;t+1<NT;t+=2){
    STEP(pB0,pB1,pA0,pA1,t,(t+3<NT),(t+1<NT),(t+1<NT));       ENDW(t);   RESC(); ROT();
    STEP(pA0,pA1,pB0,pB1,t+1,(t+4<NT),(t+2<NT),(t+2<NT));     ENDW(t+1); RESC(); ROT();
  }
  STEP(pB0,pB1,pA0,pA1,NT-1,false,false,false); RESC();
  { float sacc=pB0[0]+pB0[1]; _Pragma("unroll") for(int r=2;r<16;++r)sacc+=pB0[r]; _Pragma("unroll") for(int r=0;r<16;++r)sacc+=pB1[r]; l_reg+=sacc;
    pw0=(u32x4){PKW(pB0,0),PKW(pB0,2),PKW(pB0,4),PKW(pB0,6)};pw1=(u32x4){PKW(pB0,8),PKW(pB0,10),PKW(pB0,12),PKW(pB0,14)};pw2=(u32x4){PKW(pB1,0),PKW(pB1,2),PKW(pB1,4),PKW(pB1,6)};pw3=(u32x4){PKW(pB1,8),PKW(pB1,10),PKW(pB1,12),PKW(pB1,14)};
    SBAR(); const lds_cptr vp_=vp0+2*sl_cur;
    #define DRAIN_KS(ks) do{ VRDS(0,0,ks); VRDS(1,1,ks); VRDS(2,2,ks); VRDS(3,3,ks); \
      o[0]=MF32(PAF(ks),VFS(0),o[0]); o[1]=MF32(PAF(ks),VFS(1),o[1]); o[2]=MF32(PAF(ks),VFS(2),o[2]); o[3]=MF32(PAF(ks),VFS(3),o[3]); SBAR(); }while(0)
    DRAIN_KS(0); DRAIN_KS(1); DRAIN_KS(2); DRAIN_KS(3);
    #undef DRAIN_KS
  }
  #undef PKW
  #undef PAF
  #undef VFS
  #undef PIN
  #undef MX3
  #undef GAPA
  #undef GAPB
  #undef EX
  #undef VRDS
  #undef KRD
  #undef MF32
  #undef STEP
  #undef ENDW
  {auto rr=__builtin_amdgcn_permlane32_swap(__float_as_uint(l_reg),__float_as_uint(l_reg),false,false);l_reg=__uint_as_float(rr[0])+__uint_as_float(rr[1]);}
  if(hi==0)wsf[32+r32]=l_reg;asm volatile("s_waitcnt lgkmcnt(0)":::"memory");
  float rli[16];
  #pragma unroll
  for(int r=0;r<16;++r)rli[r]=__builtin_amdgcn_rcpf(wsf[32+crow(r,hi)]);
  #pragma unroll
  for(int d0=0;d0<4;++d0)
    #pragma unroll
    for(int r=0;r<16;++r)o[d0][r]*=rli[r];
  if(mode==0){
    float*st=stash+tid;
    #pragma unroll
    for(int d0=0;d0<4;++d0)
      #pragma unroll
      for(int r=0;r<16;++r)st[(d0*16+r)*512]=o[d0][r];
  } else {
    const float*st=stash+tid; float ssq[16];
    #pragma unroll
    for(int r=0;r<16;++r)ssq[r]=0.f;
    #pragma unroll
    for(int d0=0;d0<4;++d0)
      #pragma unroll
      for(int r=0;r<16;++r){ const float v=st[(d0*16+r)*512]-lam*o[d0][r]; o[d0][r]=v; ssq[r]+=v*v; }
    #pragma unroll
    for(int r=0;r<16;++r){ float s=ssq[r];
      s+=__builtin_bit_cast(float,__builtin_amdgcn_ds_swizzle(__builtin_bit_cast(int,s),0x041F)); s+=__builtin_bit_cast(float,__builtin_amdgcn_ds_swizzle(__builtin_bit_cast(int,s),0x081F));
      s+=__builtin_bit_cast(float,__builtin_amdgcn_ds_swizzle(__builtin_bit_cast(int,s),0x101F)); s+=__builtin_bit_cast(float,__builtin_amdgcn_ds_swizzle(__builtin_bit_cast(int,s),0x201F));
      s+=__builtin_bit_cast(float,__builtin_amdgcn_ds_swizzle(__builtin_bit_cast(int,s),0x401F));
      ssq[r]=1.f/sqrtf(s*(1.f/128.f)+1e-6f); }
    #pragma unroll
    for(int d0=0;d0<4;++d0)
      #pragma unroll
      for(int r=0;r<16;++r)o[d0][r]*=ssq[r]*gsub[d0];
    bf16*Ow=O+(rowbase+q0+wid*QBLK)*DM+(hc>>1)*DV;
    bf16*stg=(bf16*)(shm+LDS_OST)+wid*2048;
    #pragma unroll
    for(int hh=0;hh<2;++hh){
      #pragma unroll
      for(int r=0;r<16;++r){const int orow=crow(r,hi);
        #pragma unroll
        for(int d0=0;d0<2;++d0)stg[orow*64+d0*32+r32]=__float2bfloat16(o[2*hh+d0][r]);}
      asm volatile("s_waitcnt lgkmcnt(0)":::"memory");
      #pragma unroll
      for(int i=0;i<4;++i){const int row=i*8+(lane>>3),ch=lane&7; const u32x4 v=*(const u32x4*)(stg+row*64+ch*8); ATTN_STORE16(Ow+(long)row*DM+hh*64+ch*8,v);}
      asm volatile("s_waitcnt lgkmcnt(0)":::"memory"); }
  }
  asm volatile("s_waitcnt lgkmcnt(0)\n\ts_barrier":::"memory");
  #undef DMA_K
  #undef DMA_V
  #undef CMASK
  #undef RESC
  #undef ROT
}
constexpr int ATTN_LDS_BYTES=LDS_BYTES;
struct Tensors { const bf16* Q; const bf16* K; const bf16* V; bf16* OC; float* stash; const float* lamp; const float* subln; };
template<int THRL=8> __device__ __forceinline__ void attn_phase(char*lds,const Tensors&T,int vcu,int G,int wave_,float lam_init){
  const int lane=pg8::ltid(0)&63;
  float l1=T.lamp[lane]*T.lamp[64+lane],l2=T.lamp[128+lane]*T.lamp[192+lane];
  #pragma unroll
  for(int o_=1;o_<64;o_<<=1){l1+=__shfl_xor(l1,o_);l2+=__shfl_xor(l2,o_);}
  const float lam=__expf(l1)-__expf(l2)+lam_init;
  float gsub[4];
  #pragma unroll
  for(int d0=0;d0<4;++d0)gsub[d0]=T.subln[d0*32+(lane&31)]*(1.0f-lam_init);
  float*stash=T.stash+(size_t)blockIdx.x*(256*128);
  for(int L=vcu;L<8*8*8;L+=G){ const int bh=L>>3,p=L&7,b=bh>>3,h=bh&7;
    attn_unit<THRL>(b,2*h,p,T.Q,T.K,T.V,T.OC,lds,wave_,0,stash,lam,gsub);
    attn_unit<THRL>(b,2*h+1,p,T.Q,T.K,T.V,T.OC,lds,wave_,1,stash,lam,gsub);
    attn_unit<THRL>(b,2*h,15-p,T.Q,T.K,T.V,T.OC,lds,wave_,0,stash,lam,gsub);
    attn_unit<THRL>(b,2*h+1,15-p,T.Q,T.K,T.V,T.OC,lds,wave_,1,stash,lam,gsub); }
}
#undef SBAR
#undef WAIT_BAR
}
#define GAS __attribute__((address_space(1)))
#define LAS __attribute__((address_space(3)))
typedef unsigned short bf16;
typedef unsigned v4u __attribute__((ext_vector_type(4)));
typedef float f32x4 __attribute__((ext_vector_type(4)));
typedef short bf16x8 __attribute__((ext_vector_type(8)));
typedef GAS unsigned gu32;
typedef GAS unsigned long long gu64;
#define RLX_AGENT __ATOMIC_RELAXED, __HIP_MEMORY_SCOPE_AGENT
#define LDS_WAIT() asm volatile("s_waitcnt lgkmcnt(0)" ::: "memory")
#define VM_WAIT() asm volatile("s_waitcnt vmcnt(0)" ::: "memory")
__device__ __forceinline__ unsigned long long rt() { return __builtin_amdgcn_s_memrealtime(); }
__device__ __forceinline__ unsigned f2bf(float f) { unsigned u = __builtin_bit_cast(unsigned, f); return (u + 0x7fffu + ((u >> 16) & 1u)) >> 16; }
__device__ __forceinline__ unsigned pk2(float lo, float hi) { return f2bf(lo) | (f2bf(hi) << 16); }

#define XB_TMO      128
#define XB_XCNT(j)  (256  + 64 * (j))
#define XB_XSUB(j)  (1280 + 64 * (j))
#define XB_XGEN(j)  (2304 + 64 * (j))
#define XB_TOP      3328
#define XB_TOPGEN   3392
#define XCD_BAR_WORDS 3456
#define XB_SPIN_CAP (1u << 18)

__device__ __forceinline__ unsigned xb_ld(unsigned* p)              { return __hip_atomic_load(p, __ATOMIC_RELAXED, __HIP_MEMORY_SCOPE_AGENT); }
__device__ __forceinline__ unsigned xb_add(unsigned* p, unsigned v) { return __hip_atomic_fetch_add(p, v, __ATOMIC_RELAXED, __HIP_MEMORY_SCOPE_AGENT); }
__device__ __forceinline__ unsigned xb_xcc_id() { return (unsigned)__builtin_amdgcn_s_getreg((3 << 11) | 20) & 0xFu; }
#define XB_SPIN(cond, bar) do { unsigned _sp = 0; while (cond) { __builtin_amdgcn_s_sleep(1); \
    if ((++_sp & 255u) == 0u) { if (xb_ld(&(bar)[XB_TMO])) break; if (_sp > XB_SPIN_CAP) { atomicAdd(&(bar)[XB_TMO], 1u); break; } } } } while (0)

struct XcdBarrier {
    unsigned* bar; unsigned x;
    volatile LAS unsigned* st;
};

__device__ __forceinline__ XcdBarrier xcd_barrier_post(unsigned* bar, volatile LAS unsigned* st) {
    XcdBarrier b; b.bar = bar; b.x = xb_xcc_id(); b.st = st;
    if (threadIdx.x == 0) (void)xb_add(&bar[XB_XCNT(b.x)], 1u);
    return b;
}
__device__ __forceinline__ void xcd_barrier_complete(unsigned* bar, unsigned x, unsigned& nloc, unsigned& nx) {
    const unsigned G = gridDim.x * gridDim.y * gridDim.z;
    unsigned sum, cnt, mine, sp = 0u;
    for (;;) {
        sum = 0u; cnt = 0u; mine = 0u;
#pragma unroll
        for (unsigned j = 0; j < 16; ++j) { const unsigned c = xb_ld(&bar[XB_XCNT(j)]); sum += c; cnt += (c > 0u) ? 1u : 0u; mine = (j == x) ? c : mine; }
        if (sum == G) break;
        __builtin_amdgcn_s_sleep(1);
        if ((++sp & 255u) == 0u) { if (xb_ld(&bar[XB_TMO])) break; if (sp > XB_SPIN_CAP) { atomicAdd(&bar[XB_TMO], 1u); break; } }
    }
    nloc = mine > 0u ? mine : 1u; nx = cnt > 0u ? cnt : 1u;
}

__device__ __forceinline__ void xcd_barrier(const XcdBarrier& b) {
    asm volatile("s_waitcnt vmcnt(0)" ::: "memory");
    __syncthreads();
    if (threadIdx.x == 0) {
        unsigned* bar = b.bar;
        __builtin_amdgcn_s_waitcnt(0);
        unsigned nloc = b.st[0], nx = b.st[1];
        if (nloc == 0u) { xcd_barrier_complete(bar, b.x, nloc, nx); b.st[0] = nloc; b.st[1] = nx; }
        const unsigned old = xb_add(&bar[XB_XSUB(b.x)], 1u);
        const unsigned gen = old / nloc;
        if (old + 1u == (gen + 1u) * nloc) {
            __builtin_amdgcn_fence(__ATOMIC_RELEASE, "agent");
            asm volatile("s_waitcnt vmcnt(0)" ::: "memory");
            const unsigned og = xb_add(&bar[XB_TOP], 1u);
            const unsigned tg = og / nx;
            if (og + 1u == (tg + 1u) * nx) xb_add(&bar[XB_TOPGEN], 1u);
            else XB_SPIN(xb_ld(&bar[XB_TOPGEN]) == tg, bar);
            __builtin_amdgcn_fence(__ATOMIC_ACQUIRE, "agent");
            xb_add(&bar[XB_XGEN(b.x)], 1u);
            asm volatile("s_waitcnt vmcnt(0)" ::: "memory");
        } else {
            XB_SPIN(xb_ld(&bar[XB_XGEN(b.x)]) == gen, bar);
            __builtin_amdgcn_fence(__ATOMIC_ACQUIRE, "agent");
            asm volatile("s_waitcnt vmcnt(0)" ::: "memory");
        }
    }
    __syncthreads();
}

constexpr int NWAVES = 8;
constexpr int BATCH = 8, SEQ = 4096, D = 1024, M = BATCH * SEQ;
constexpr int NEXP = 32, FE = 256, PLED = 256, CWID = 31, NQKV = 3072;
constexpr float EPS = 1e-6f;
constexpr int NPHASE = 21;
constexpr int PADROWS = 73728;
constexpr float LAM_INIT = 0.35550906759096926f;

constexpr size_t MiB = 1u << 20;
constexpr size_t WS_CTL = 0, CTL_ZERO_BYTES = 1 * MiB;
constexpr size_t WS_SSQ = 439 * MiB;
constexpr size_t WS_TI = 2 * MiB, WS_TW = WS_TI + 512 * 1024;
constexpr size_t WS_LIST = 3 * MiB;
constexpr size_t WS_RP = 7 * MiB;
constexpr size_t WS_LOG = 11 * MiB;
constexpr size_t WS_WPW1 = 19 * MiB, WS_WPW2 = 23 * MiB, WS_WQKV = 25 * MiB, WS_WO = 31 * MiB, WS_WR = 33 * MiB, WS_WPG = 34 * MiB, WS_WPP = 38 * MiB;
constexpr size_t WS_WGU = 39 * MiB, WS_WD = 71 * MiB;
constexpr size_t WS_P16 = 87 * MiB;
constexpr size_t WS_S0 = 119 * MiB, WS_SS = 64 * MiB;
constexpr size_t WS_WGU1 = WS_SSQ + 14 * MiB, WS_WD1 = WS_WGU1 + 32 * MiB;
constexpr size_t WS_END = WS_WD1 + 16 * MiB;
static_assert(WS_S0 + 5 * WS_SS == WS_SSQ, "d_ws map");
constexpr int CW_BAR = 4096;
constexpr int CW_CNT = 8192;
constexpr int RING_OFF = 0, RING_BYTES = 131072;
constexpr int LDSCTL_OFF = RING_BYTES;
constexpr int L_MISC = LDSCTL_OFF, L_TS = LDSCTL_OFF + 128, L_NE = LDSCTL_OFF + 384, L_TE = LDSCTL_OFF + 512, L_TOK = LDSCTL_OFF + 2048, L_HIST = LDSCTL_OFF + 10240;
constexpr int MAXGU = 8;
constexpr int LDS_BYTES = 147456;


typedef float f32x2 __attribute__((ext_vector_type(2)));
typedef unsigned u32x2 __attribute__((ext_vector_type(2)));
typedef int i32x4 __attribute__((ext_vector_type(4)));
__device__ __forceinline__ float bflo(unsigned u) { return __builtin_bit_cast(float, u << 16); }
__device__ __forceinline__ float bfhi(unsigned u) { return __builtin_bit_cast(float, u & 0xffff0000u); }
__device__ __forceinline__ float sigmoid_f(float x) { return __builtin_amdgcn_rcpf(1.f + __expf(-x)); }
__device__ __forceinline__ float wave_sum(float v) {
#pragma unroll
    for (int o = 1; o < 64; o <<= 1) v += __shfl_xor(v, o);
    return v;
}
__device__ __forceinline__ void tr_item(const float* W, int N, bf16* WT, int Kd, int k0, int n0, int drow0, const float* gk, LAS float* scr, int lane) {
#pragma unroll 8
    for (int i = 0; i < 32; ++i) { const int kk = 2 * i + (lane >> 5); scr[kk * 33 + (lane & 31)] = W[(size_t)(k0 + kk) * N + n0 + (lane & 31)]; }
    LDS_WAIT(); asm volatile("" ::: "memory");
    const int c = lane & 7;
    f32x4 g0 = {1.f, 1.f, 1.f, 1.f}, g1 = {1.f, 1.f, 1.f, 1.f};
    if (gk) { g0 = *(const f32x4*)(gk + k0 + 8 * c); g1 = *(const f32x4*)(gk + k0 + 8 * c + 4); }
#pragma unroll
    for (int j = 0; j < 4; ++j) { const int n = (lane >> 3) + 8 * j; const LAS float* s = scr + (8 * c) * 33 + n;
        v4u o; o.x = pk2(s[0 * 33] * g0.x, s[1 * 33] * g0.y); o.y = pk2(s[2 * 33] * g0.z, s[3 * 33] * g0.w); o.z = pk2(s[4 * 33] * g1.x, s[5 * 33] * g1.y); o.w = pk2(s[6 * 33] * g1.z, s[7 * 33] * g1.w);
        *(GAS v4u*)(WT + (size_t)(drow0 + n) * Kd + k0 + 8 * c) = o; }
    LDS_WAIT(); asm volatile("" ::: "memory");
}
template <bool GLU_IL = false>
__device__ __forceinline__ void tr_plain(const float* W, int K, int N, bf16* WT, int item, const float* gk, LAS float* scr, int lane) {
    const int nblk = N / 32, kb = item / nblk, nb = item % nblk, n0 = 32 * nb; int drow0 = n0;
    if (GLU_IL) { const int h = n0 >> 10, c = n0 & 1023; drow0 = (c >> 7) * 256 + h * 128 + (c & 127); }
    tr_item(W, N, WT, K, 64 * kb, n0, drow0, gk, scr, lane);
}
constexpr int MOE_ITEMS = 32 * 384;
__device__ __forceinline__ void moe_item(const float* wg, const float* wu, const float* wd, const float* gk, int l, bf16* WGU, bf16* WD, int item, LAS float* scr, int lane) {
    const int ge = item / 384, r = item % 384, which = r / 128, sub = r % 128; const size_t eo = (size_t)(l * 32 + ge) * 262144;
    if (which < 2) { const int kb = sub / 8, nb = sub % 8, n0 = 32 * nb; const int drow0 = (n0 / 128) * 256 + (n0 % 128) + (which ? 128 : 0);
        tr_item((which ? wu : wg) + eo, 256, WGU + (size_t)ge * 512 * 1024, 1024, 64 * kb, n0, drow0, gk, scr, lane); }
    else { const int kb = sub / 32, nb = sub % 32; tr_item(wd + eo, 1024, WD + (size_t)ge * 1024 * 256, 256, 64 * kb, 32 * nb, 32 * nb, nullptr, scr, lane); }
}

__device__ __forceinline__ void row_cvt(const float* x, bf16* XB, float* ss, int gw, int NGW, int lane) {
    for (int m0 = gw; m0 < M; m0 += 2 * NGW) {
        f32x4 v[2][4]; const bool two = m0 + NGW < M;
#pragma unroll
        for (int h = 0; h < 2; ++h) { const int m = (h && two) ? m0 + NGW : m0; const GAS f32x4* xr = (const GAS f32x4*)(x + (size_t)m * D) + lane;
#pragma unroll
            for (int j = 0; j < 4; ++j) v[h][j] = xr[64 * j]; }
#pragma unroll
        for (int h = 0; h < 2; ++h) { if (h && !two) break; const int m = h ? m0 + NGW : m0; GAS u32x2* xo = (GAS u32x2*)(XB + (size_t)m * D) + lane; float s = 0.f;
#pragma unroll
            for (int j = 0; j < 4; ++j) { s += (v[h][j].x * v[h][j].x + v[h][j].y * v[h][j].y) + (v[h][j].z * v[h][j].z + v[h][j].w * v[h][j].w); xo[64 * j] = (u32x2){pk2(v[h][j].x, v[h][j].y), pk2(v[h][j].z, v[h][j].w)}; }
            s = wave_sum(s); if (lane < 16) ss[(size_t)m * 16 + lane] = lane ? 0.f : s; }
    }
}
__device__ __forceinline__ void row_moe(const bf16* Xi, bf16* Xo, const bf16* YP, const i32x4* TI, const f32x2* TW, const unsigned* cnt, float* ss, int gw, int NGW, int lane) {
    int ts;
    { const unsigned n = lane < 32 ? __hip_atomic_load(cnt + lane * 64, RLX_AGENT) : 0u; const int tiles = (int)((n + 255u) >> 8); int incl = tiles;
#pragma unroll
      for (int o = 1; o < 32; o <<= 1) { const int t = __shfl_up(incl, o); if (lane >= o) incl += t; }
      ts = incl - tiles; }
    i32x4 ti[2]; f32x2 tw[2];
#pragma unroll
    for (int h = 0; h < 2; ++h) { int m = gw + h * NGW; m = m < M ? m : gw; ti[h] = TI[m]; tw[h] = TW[m]; }
    for (int m0 = gw; m0 < M; m0 += 2 * NGW) {
        const bool two = m0 + NGW < M;
        i32x4 tin[2]; f32x2 twn[2];
#pragma unroll
        for (int h = 0; h < 2; ++h) { int m = m0 + 2 * NGW + h * NGW; m = m < M ? m : gw; tin[h] = TI[m]; twn[h] = TW[m]; }
        u32x2 x[2][4], a[2][4], c[2][4];
#pragma unroll
        for (int h = 0; h < 2; ++h) { const int m = (h && two) ? m0 + NGW : m0;
            const int r1 = __shfl(ts, ti[h].x) * 256 + ti[h].y, r2 = __shfl(ts, ti[h].z) * 256 + ti[h].w;
            const GAS u32x2* xr = (const GAS u32x2*)(Xi + (size_t)m * D) + lane; const GAS u32x2* y1 = (const GAS u32x2*)(YP + (size_t)r1 * D) + lane; const GAS u32x2* y2 = (const GAS u32x2*)(YP + (size_t)r2 * D) + lane;
#pragma unroll
            for (int j = 0; j < 4; ++j) { x[h][j] = xr[64 * j]; a[h][j] = y1[64 * j]; c[h][j] = y2[64 * j]; } }
#pragma unroll
        for (int h = 0; h < 2; ++h) { if (h && !two) break; const int m = h ? m0 + NGW : m0; GAS u32x2* xo = (GAS u32x2*)(Xo + (size_t)m * D) + lane; float s = 0.f;
#pragma unroll
            for (int j = 0; j < 4; ++j) {
                const f32x4 v = (f32x4){bflo(x[h][j].x), bfhi(x[h][j].x), bflo(x[h][j].y), bfhi(x[h][j].y)} + (f32x4){bflo(a[h][j].x), bfhi(a[h][j].x), bflo(a[h][j].y), bfhi(a[h][j].y)} * tw[h].x
                              + (f32x4){bflo(c[h][j].x), bfhi(c[h][j].x), bflo(c[h][j].y), bfhi(c[h][j].y)} * tw[h].y;
                s += (v.x * v.x + v.y * v.y) + (v.z * v.z + v.w * v.w); xo[64 * j] = (u32x2){pk2(v.x, v.y), pk2(v.z, v.w)}; }
            s = wave_sum(s); if (lane < 16) ss[(size_t)m * 16 + lane] = lane ? 0.f : s; }
#pragma unroll
        for (int h = 0; h < 2; ++h) { ti[h] = tin[h]; tw[h] = twn[h]; }
    }
}
__device__ __forceinline__ void row_final(const bf16* X, float* out, const float* ss, const float* gain, int gw, int NGW, int lane) {
    f32x4 gv[4];
#pragma unroll
    for (int j = 0; j < 4; ++j) gv[j] = *((const f32x4*)gain + lane + 64 * j);
    for (int m0 = gw; m0 < M; m0 += 2 * NGW) {
        const bool two = m0 + NGW < M; u32x2 v[2][4]; float r[2];
#pragma unroll
        for (int h = 0; h < 2; ++h) { const int m = (h && two) ? m0 + NGW : m0; const GAS u32x2* xr = (const GAS u32x2*)(X + (size_t)m * D) + lane; r[h] = pg8::rs_of(ss, m);
#pragma unroll
            for (int j = 0; j < 4; ++j) v[h][j] = xr[64 * j]; }
#pragma unroll
        for (int h = 0; h < 2; ++h) { if (h && !two) break; const int m = h ? m0 + NGW : m0; GAS f32x4* xo = (GAS f32x4*)(out + (size_t)m * D) + lane;
#pragma unroll
            for (int j = 0; j < 4; ++j) xo[64 * j] = (f32x4){bflo(v[h][j].x), bfhi(v[h][j].x), bflo(v[h][j].y), bfhi(v[h][j].y)} * r[h] * gv[j]; }
    }
}

__device__ __forceinline__ void conv_phase(const bf16* U, bf16* C, const float* wdw, const float* bdw, const float* lng, const float* lnb, LAS unsigned char* lds, int vcu, int G, int tid, int lane, int wave) {
    constexpr int RUN = 128, NGRP = (RUN + CWID - 1) / CWID;
    const int c0 = 2 * tid;
    f32x2 w[CWID];
#pragma unroll
    for (int j = 0; j < CWID; ++j) w[j] = *(const f32x2*)(wdw + j * D + c0);
    const f32x2 bd = *(const f32x2*)(bdw + c0);
    LAS unsigned* yb = (LAS unsigned*)lds;
    for (int run = vcu; run < M / RUN; run += G) {
        const int b = run / (SEQ / RUN), t0 = (run % (SEQ / RUN)) * RUN; const size_t rb = (size_t)b * SEQ;
        const bf16* Ub = U + rb * D + c0;
        f32x2 win[CWID]; unsigned raw[CWID], rawn[CWID];
        win[0] = (f32x2){0.f, 0.f};
#pragma unroll
        for (int s = 1; s < CWID; ++s) { const int tau = t0 - CWID + s; const int tc = tau < 0 ? 0 : tau;
            const unsigned ua = *(const GAS unsigned*)(Ub + (size_t)tc * D);
            win[s] = tau < 0 ? (f32x2){0.f, 0.f} : (f32x2){bflo(ua), bfhi(ua)}; }
#pragma unroll
        for (int s = 0; s < CWID; ++s) raw[s] = *(const GAS unsigned*)(Ub + (size_t)(t0 + s) * D);
#pragma unroll 1
        for (int g = 0; g < NGRP; ++g) {
            const int tg = t0 + g * CWID, n = (RUN - g * CWID) < CWID ? (RUN - g * CWID) : CWID;
#pragma unroll
            for (int s = 0; s < CWID; ++s) { int tn = tg + CWID + s; tn = tn > t0 + RUN - 1 ? t0 + RUN - 1 : tn; rawn[s] = *(const GAS unsigned*)(Ub + (size_t)tn * D); }
#pragma unroll
            for (int s = 0; s < CWID; ++s) { if (s < n) {
                win[s] = (f32x2){bflo(raw[s]), bfhi(raw[s])};
                f32x2 a = bd;
#pragma unroll
                for (int j = 0; j < CWID; ++j) a += w[j] * win[(s + 1 + j) % CWID];
                yb[s * 512 + tid] = pk2(a.x, a.y); } }
            LDS_WAIT(); __syncthreads();
#pragma unroll 1
            for (int rr = 0; rr < 4; ++rr) { const int r = wave * 4 + rr; if (r < n) {
                const v4u p0 = *(const LAS v4u*)(lds + r * 2048 + lane * 16), p1 = *(const LAS v4u*)(lds + r * 2048 + 1024 + lane * 16);
                float x[16] = {bflo(p0.x), bfhi(p0.x), bflo(p0.y), bfhi(p0.y), bflo(p0.z), bfhi(p0.z), bflo(p0.w), bfhi(p0.w), bflo(p1.x), bfhi(p1.x), bflo(p1.y), bfhi(p1.y), bflo(p1.z), bfhi(p1.z), bflo(p1.w), bfhi(p1.w)};
                float s = 0.f;
#pragma unroll
                for (int i = 0; i < 16; ++i) s += x[i];
                const float mu = wave_sum(s) * (1.f / D); float q = 0.f;
#pragma unroll
                for (int i = 0; i < 16; ++i) { x[i] -= mu; q += x[i] * x[i]; }
                const float rs = 1.f / sqrtf(wave_sum(q) * (1.f / D) + EPS);
                unsigned o[8];
#pragma unroll
                for (int hh = 0; hh < 2; ++hh) { const f32x4 g0 = *(const f32x4*)(lng + hh * 512 + lane * 8), g1 = *(const f32x4*)(lng + hh * 512 + lane * 8 + 4), b0 = *(const f32x4*)(lnb + hh * 512 + lane * 8), b1 = *(const f32x4*)(lnb + hh * 512 + lane * 8 + 4);
                    float y[8] = {x[hh * 8 + 0] * rs * g0.x + b0.x, x[hh * 8 + 1] * rs * g0.y + b0.y, x[hh * 8 + 2] * rs * g0.z + b0.z, x[hh * 8 + 3] * rs * g0.w + b0.w,
                                  x[hh * 8 + 4] * rs * g1.x + b1.x, x[hh * 8 + 5] * rs * g1.y + b1.y, x[hh * 8 + 6] * rs * g1.z + b1.z, x[hh * 8 + 7] * rs * g1.w + b1.w};
#pragma unroll
                    for (int i = 0; i < 4; ++i) o[hh * 4 + i] = pk2(y[2 * i] * sigmoid_f(y[2 * i]), y[2 * i + 1] * sigmoid_f(y[2 * i + 1])); }
                bf16* cr = C + (rb + tg + r) * D;
                *(GAS v4u*)(cr + lane * 8) = (v4u){o[0], o[1], o[2], o[3]}; *(GAS v4u*)(cr + 512 + lane * 8) = (v4u){o[4], o[5], o[6], o[7]}; } }
            LDS_WAIT(); __syncthreads();
#pragma unroll
            for (int s = 0; s < CWID; ++s) raw[s] = rawn[s];
        }
    }
}

__device__ __forceinline__ void combine_phase(const bf16* O0, const bf16* O1, bf16* OC, const float* lamp, const float* subln, int gw, int NGW, int lane) {
    const float l1 = wave_sum(lamp[lane] * lamp[64 + lane]), l2 = wave_sum(lamp[128 + lane] * lamp[192 + lane]);
    const float lam = __expf(l1) - __expf(l2) + LAM_INIT;
    float gsc[16];
#pragma unroll
    for (int i = 0; i < 16; ++i) gsc[i] = subln[(lane & 7) * 16 + i] * (1.0f - LAM_INIT);
    for (int m0 = gw; m0 < M; m0 += 2 * NGW) {
        const bool two = m0 + NGW < M; v4u a0[2], a1[2], b0[2], b1[2];
#pragma unroll
        for (int h = 0; h < 2; ++h) { const int m = (h && two) ? m0 + NGW : m0;
            a0[h] = *(const GAS v4u*)(O0 + (size_t)m * D + lane * 16); a1[h] = *(const GAS v4u*)(O0 + (size_t)m * D + lane * 16 + 8);
            b0[h] = *(const GAS v4u*)(O1 + (size_t)m * D + lane * 16); b1[h] = *(const GAS v4u*)(O1 + (size_t)m * D + lane * 16 + 8); }
#pragma unroll
        for (int h = 0; h < 2; ++h) { if (h && !two) break; const int m = h ? m0 + NGW : m0;
            const unsigned ua[8] = {a0[h].x, a0[h].y, a0[h].z, a0[h].w, a1[h].x, a1[h].y, a1[h].z, a1[h].w}, ub[8] = {b0[h].x, b0[h].y, b0[h].z, b0[h].w, b1[h].x, b1[h].y, b1[h].z, b1[h].w};
            float o[16]; float ss = 0.f;
#pragma unroll
            for (int i = 0; i < 8; ++i) { o[2 * i] = bflo(ua[i]) - lam * bflo(ub[i]); o[2 * i + 1] = bfhi(ua[i]) - lam * bfhi(ub[i]); ss += o[2 * i] * o[2 * i] + o[2 * i + 1] * o[2 * i + 1]; }
            ss += __shfl_xor(ss, 1); ss += __shfl_xor(ss, 2); ss += __shfl_xor(ss, 4);
            const float r = 1.f / sqrtf(ss * (1.f / 128.f) + EPS);
            unsigned w[8];
#pragma unroll
            for (int i = 0; i < 8; ++i) w[i] = pk2(o[2 * i] * r * gsc[2 * i], o[2 * i + 1] * r * gsc[2 * i + 1]);
            *(GAS v4u*)(OC + (size_t)m * D + lane * 16) = (v4u){w[0], w[1], w[2], w[3]}; *(GAS v4u*)(OC + (size_t)m * D + lane * 16 + 8) = (v4u){w[4], w[5], w[6], w[7]}; }
    }
}

__device__ __forceinline__ float ld_coh(const float* p) { return __builtin_bit_cast(float, __hip_atomic_load((const unsigned*)p, RLX_AGENT)); }
__device__ __forceinline__ void select_tokens(int base, const float* LOG, const float* brg, const float* bre, const float* ss, unsigned* cnt, int* list, float* RP, i32x4* TI, f32x2* TW, LAS int* lh, int tid) {
    __syncthreads();
    if (tid < 32) lh[tid] = 0;
    __syncthreads();
    const int t = base + tid; int E1 = 0, E2 = 0, r1 = 0, r2 = 0; float w1 = 0.f, w2 = 0.f;
    if (tid < 256) {
        const float* lg = LOG + (size_t)t * 64;
        const float gl[4] = {ld_coh(lg) + brg[0], ld_coh(lg + 1) + brg[1], ld_coh(lg + 2) + brg[2], ld_coh(lg + 3) + brg[3]};
        int gi = 0; float gm = gl[0];
#pragma unroll
        for (int j = 1; j < 4; ++j) if (gl[j] > gm) { gm = gl[j]; gi = j; }
        float den = 0.f;
#pragma unroll
        for (int j = 0; j < 4; ++j) den += __expf(gl[j] - gm);
        const float gw_ = 1.f / den;
        const float* le = lg + 4 + gi * 8; const f32x4 ba = *(const f32x4*)(bre + gi * 8), bb = *(const f32x4*)(bre + gi * 8 + 4);
        const float el[8] = {ld_coh(le) + ba.x, ld_coh(le + 1) + ba.y, ld_coh(le + 2) + ba.z, ld_coh(le + 3) + ba.w, ld_coh(le + 4) + bb.x, ld_coh(le + 5) + bb.y, ld_coh(le + 6) + bb.z, ld_coh(le + 7) + bb.w};
        int i1 = 0; float v1 = el[0];
#pragma unroll
        for (int j = 1; j < 8; ++j) if (el[j] > v1) { v1 = el[j]; i1 = j; }
        int i2 = -1; float v2 = -INFINITY;
#pragma unroll
        for (int j = 0; j < 8; ++j) if (j != i1 && (i2 < 0 || el[j] > v2)) { v2 = el[j]; i2 = j; }
        const float e2 = __expf(v2 - v1); const float p1 = 1.f / (1.f + e2);
        w1 = p1 * gw_; w2 = (e2 * p1) * gw_; E1 = gi * 8 + i1; E2 = gi * 8 + i2;
        r1 = __hip_atomic_fetch_add(lh + E1, 1, __ATOMIC_RELAXED, __HIP_MEMORY_SCOPE_WORKGROUP); r2 = __hip_atomic_fetch_add(lh + E2, 1, __ATOMIC_RELAXED, __HIP_MEMORY_SCOPE_WORKGROUP);
    }
    __syncthreads();
    if (tid < 32) { const int c = lh[tid]; int bs = 0; if (c) bs = (int)__hip_atomic_fetch_add(cnt + tid * 64, (unsigned)c, RLX_AGENT); lh[32 + tid] = bs; }
    __syncthreads();
    if (tid < 256) { const int s1 = lh[32 + E1] + r1, s2 = lh[32 + E2] + r2;
        const float r = pg8::rs_of(ss, t);
        list[(size_t)E1 * M + s1] = t; list[(size_t)E2 * M + s2] = t; RP[(size_t)E1 * M + s1] = r; RP[(size_t)E2 * M + s2] = r; TI[t] = (i32x4){E1, s1, E2, s2}; TW[t] = (f32x2){w1, w2}; }
}

struct GroupedOrder {
    int nNs, G, c, ntu;
    const LAS int* tile_e; const LAS int* tokl; const LAS int* ts;
    __device__ __forceinline__ bool next(int i, pg8::Unit& u) const { const int L = i * G + c; if (L >= ntu) return false; const int mt = L >> nNs, pn = L & ((1 << nNs) - 1);
        const int e = tile_e[mt]; u.pm = mt; u.pn = pn; u.pb = (e << nNs) + pn; u.aux = e * M + (mt - ts[e]) * 256; return true; }
    __device__ __forceinline__ unsigned arow(int ord, int r) const { return (unsigned)tokl[ord * 256 + r]; }
};
__device__ __forceinline__ GroupedOrder grouped_setup(const unsigned* cnt, const int* list, LAS unsigned char* lds, bool need_tok, int nNs, int G, int c, int tid, int lane, int wave) {
    LAS int* ts = (LAS int*)(lds + L_TS); LAS int* ne = (LAS int*)(lds + L_NE); LAS int* te = (LAS int*)(lds + L_TE); LAS int* tokl = (LAS int*)(lds + L_TOK);
    __syncthreads();
    if (wave == 0) {
        const unsigned n = lane < 32 ? __hip_atomic_load(cnt + lane * 64, RLX_AGENT) : 0u; const int tiles = (int)((n + 255u) >> 8); int incl = tiles;
#pragma unroll
        for (int o = 1; o < 32; o <<= 1) { const int t = __shfl_up(incl, o); if (lane >= o) incl += t; }
        const int excl = incl - tiles;
        if (lane < 32) { ts[lane] = excl; ne[lane] = (int)n; for (int k = 0; k < tiles; ++k) te[excl + k] = lane; }
        if (lane == 31) ts[32] = incl;
    }
    __syncthreads();
    GroupedOrder S; S.nNs = nNs; S.G = G; S.c = c; S.ntu = ts[32] << nNs; S.tile_e = te; S.tokl = tokl; S.ts = ts;
    if (need_tok) {
        for (int i = 0; i < MAXGU; ++i) { const int L = i * G + c; if (L >= S.ntu) break; const int mt = L >> nNs, e = te[mt];
            if (tid < 256) { const int slot = (mt - ts[e]) * 256 + tid; tokl[i * 256 + tid] = slot < ne[e] ? list[(size_t)e * M + slot] : 0; } }
        if (S.ntu > MAXGU * G) S.ntu = MAXGU * G;
        __syncthreads();
    }
    return S;
}

enum { I_X = 0, I_P, I_POS, I_NMIX, I_NFFN, I_CW1, I_CB1, I_CDW, I_CBDW, I_CLNG, I_CLNB, I_CW2, I_CB2, I_WQKV, I_LAM, I_SUBLN, I_WO,
       I_WRG, I_BRG, I_WRE, I_BRE, I_WG, I_WU, I_WDN, I_PNORM, I_PWG, I_PWP, I_FNORM, N_IN };
struct Args { const void* in[N_IN]; float* out; unsigned char* ws; int ph_lo, ph_hi; };

typedef const __attribute__((address_space(4))) Args* KArgP;
#define PH_IDS() const int tid = pg8::ltid(wave), lane = tid & 63, gtid = vcu * (NWAVES * 64) + tid; (void)lane; (void)gtid
__device__ __forceinline__ KArgP kargs() { KArgP k = (KArgP)__builtin_amdgcn_kernarg_segment_ptr(); asm volatile("" : "+s"(k)); return k; }
#define IN_F(k) ((const float*)ka->in[k])
#define WSP(off) ((bf16*)(ka->ws + (off)))
#define SLOT(i) ((bf16*)(ka->ws + WS_S0 + (size_t)(i) * WS_SS))
#define IN(k) (lo <= (k) && (k) < hi)
#ifndef MK_DUP
#define MK_DUP -1
#endif
#define DUPLOOP(k) _Pragma("nounroll") for (int rep_ = 0; rep_ < ((k) == MK_DUP ? 2 : 1); ++rep_)
#ifdef MK_PROBE
#define CW_TS 12288
#define SEAM(k) do { if (IN(k) && IN((k) + 1)) xcd_barrier(bar); if (blockIdx.x == 0 && threadIdx.x == 0) __hip_atomic_store((unsigned*)(kargs()->ws + WS_CTL) + CW_TS + (k) + 1, (unsigned)__builtin_amdgcn_s_memrealtime(), RLX_AGENT); } while (0)
#else
#define SEAM(k) do { if (IN(k) && IN((k) + 1)) xcd_barrier(bar); } while (0)
#endif
#define XBA ((bf16*)ka->out)
#define XBB ((bf16*)ka->out + (size_t)M * D)
#define SSQ(k) ((float*)(ka->ws + WS_SSQ) + (size_t)(k) * M * 16)
#define ACTB ((bf16*)(ka->ws + WS_S0 + 3 * WS_SS + 16 * MiB))
#define CNT(l) ((unsigned*)(ka->ws + WS_CTL) + CW_CNT + (l) * 32 * 64)
template <int l>
__device__ __forceinline__ void layer_tail(LAS unsigned char* lds, const XcdBarrier& bar, int lo, int hi, int wave, int G, int bx, int vcu, int gw, int NGW, int NTHR) {
    constexpr int pb = l ? 14 : 4;
    LAS float* scr = (LAS float*)(lds + RING_OFF + wave * 16384);
    if (IN(pb)) DUPLOOP(pb) {
        const bool split = (G == 256);
        if (!split || bx < 128) { KArgP ka = kargs(); pg8::Gemm g{l ? XBB : XBA, WSP(WS_WR) + (size_t)l * 256 * D, M, 256, D}; pg8::StaticOrder S; S.init(M, 256, G, bx);
            pg8::EpiLogits E{(float*)(ka->ws + WS_LOG), SSQ(l ? 4 : 1)};
            pg8::gemm_phase<pg8::EpiLogits, pg8::StaticOrder, true, false>(lds + RING_OFF, g, S, E, wave);
            VM_WAIT(); const int tid = pg8::ltid(wave); pg8::Unit u;
            for (int i = 0; S.next(i, u); ++i)
                select_tokens(u.pm * 256, (const float*)(ka->ws + WS_LOG), IN_F(I_BRG) + l * 4, IN_F(I_BRE) + l * 32, SSQ(l ? 4 : 1), CNT(l), (int*)(ka->ws + WS_LIST), (float*)(ka->ws + WS_RP),
                              (i32x4*)(ka->ws + WS_TI), (f32x2*)(ka->ws + WS_TW), (LAS int*)(lds + L_HIST), tid); }
        if (!split || bx >= 128) { KArgP ka = kargs(); pg8::Gemm g{WSP(WS_P16) + (size_t)l * M * PLED, WSP(WS_WPP) + (size_t)l * D * PLED, M, D, PLED}; pg8::StaticOrder S; S.init(M, D, split ? 128 : G, split ? bx - 128 : bx);
            pg8::EpiBf16 E{l ? SLOT(0) : SLOT(4), D};
            pg8::gemm_phase<pg8::EpiBf16, pg8::StaticOrder, true, false>(lds + RING_OFF, g, S, E, wave); }
    }
    if (IN(pb) && IN(pb + 2)) xcd_barrier(bar);
    if (IN(pb + 2)) DUPLOOP(pb + 2) { KArgP ka = kargs(); PH_IDS(); const GroupedOrder S = grouped_setup(CNT(l), (const int*)(ka->ws + WS_LIST), lds, true, 1, G, bx, tid, lane, wave);
        pg8::Gemm g{l ? XBB : XBA, WSP(l ? WS_WGU1 : WS_WGU), M, 512, D}; pg8::EpiGU E{ACTB, (const float*)(ka->ws + WS_RP)};
        pg8::gemm_phase<pg8::EpiGU, GroupedOrder, true, true>(lds + RING_OFF, g, S, E, wave);
        if (l == 0) {
            const int nbusy = S.ntu > 2 * G ? S.ntu - 2 * G : 0, nfree = G - nbusy;
            if (nfree <= 0 || bx >= nbusy) { const int w0 = (nfree > 0 ? bx - nbusy : bx) * NWAVES + wave, nw = (nfree > 0 ? nfree : G) * NWAVES;
                LAS float* scr2 = (LAS float*)(lds + RING_OFF + wave * 16384);
                for (int it = w0; it < MOE_ITEMS; it += nw) moe_item(IN_F(I_WG), IN_F(I_WU), IN_F(I_WDN), IN_F(I_NFFN) + D, 1, WSP(WS_WGU1), WSP(WS_WD1), it, scr2, lane); } }
    }
    SEAM(pb + 2);
    if (IN(pb + 3)) DUPLOOP(pb + 3) { KArgP ka = kargs(); PH_IDS(); const GroupedOrder S = grouped_setup(CNT(l), (const int*)(ka->ws + WS_LIST), lds, false, 2, G, bx, tid, lane, wave);
        pg8::Gemm g{ACTB, WSP(l ? WS_WD1 : WS_WD), PADROWS, D, FE}; pg8::EpiBf16 E{SLOT(1), D};
        pg8::gemm_phase<pg8::EpiBf16, GroupedOrder, true, false>(lds + RING_OFF, g, S, E, wave); }
    SEAM(pb + 3);
    if (IN(pb + 4)) DUPLOOP(pb + 4) {
        { KArgP ka = kargs(); PH_IDS(); row_moe(l ? XBB : XBA, l ? SLOT(4) : XBA, SLOT(1), (const i32x4*)(ka->ws + WS_TI), (const f32x2*)(ka->ws + WS_TW), CNT(l), SSQ(l ? 5 : 2), gw, NGW, lane); }
    }
    SEAM(pb + 4);
    if (IN(pb + 5)) DUPLOOP(pb + 5) {
        if (l == 0) { KArgP ka = kargs(); PH_IDS(); pg8::Gemm g{XBA, WSP(WS_WPG), M, D, D}; pg8::StaticOrder S; S.init(M, D, G, bx);
          pg8::EpiPle<false> E{XBA, SLOT(4), XBB, nullptr, SSQ(2), SSQ(3)};
          pg8::gemm_phase<pg8::EpiPle<false>, pg8::StaticOrder, true, false>(lds + RING_OFF, g, S, E, wave); }
        else { KArgP ka = kargs(); PH_IDS(); pg8::Gemm g{SLOT(4), WSP(WS_WPG) + (size_t)D * D, M, D, D}; pg8::StaticOrder S; S.init(M, D, G, bx);
          pg8::EpiPle<false> E{SLOT(4), SLOT(0), SLOT(1), nullptr, SSQ(5), SSQ(6)};
          pg8::gemm_phase<pg8::EpiPle<false>, pg8::StaticOrder, true, false>(lds + RING_OFF, g, S, E, wave); }
    }
    SEAM(pb + 5);
}
__global__ void __launch_bounds__(NWAVES * 64, 2) mk_fwd(Args args) {
    extern __shared__ __attribute__((aligned(16))) unsigned char lds_raw[];
    LAS unsigned char* lds = (LAS unsigned char*)lds_raw;
    const int tid0 = threadIdx.x, wave = __builtin_amdgcn_readfirstlane(tid0 >> 6);
    const int G = gridDim.x; const int bx = blockIdx.x; const int vcu = (G % 8 == 0) ? (bx % 8) * (G / 8) + bx / 8 : bx;
    const int gw = vcu * NWAVES + wave, NGW = G * NWAVES, NTHR = G * NWAVES * 64;
    gu32* ctl = (gu32*)(args.ws + WS_CTL);
    for (int u = tid0; u < (LDS_BYTES - LDSCTL_OFF) / 4; u += NWAVES * 64) ((LAS unsigned*)(lds + LDSCTL_OFF))[u] = 0u;
    __syncthreads();
    XcdBarrier bar = xcd_barrier_post((unsigned*)ctl + CW_BAR, (volatile LAS unsigned*)(lds + L_MISC) + 8);
    const int lo = args.ph_lo, hi = args.ph_hi;
#ifdef MK_PROBE
    if (blockIdx.x == 0 && threadIdx.x == 0) __hip_atomic_store((unsigned*)(args.ws + WS_CTL) + CW_TS, (unsigned)__builtin_amdgcn_s_memrealtime(), RLX_AGENT);
#endif
    LAS float* scr = (LAS float*)(lds + RING_OFF + wave * 16384);

    if (IN(0)) DUPLOOP(0) {
        constexpr int I1 = 16 * 64, I2 = 16 * 32, I3 = 16 * 96, I4 = 16 * 32, I5 = 16 * 32, I6 = 4 * 32;
        constexpr int NIT = I1 + I2 + I3 + I4 + 2 * I5 + 2 * I6;
        { KArgP ka = kargs(); PH_IDS();
          for (int it = gw; it < NIT + MOE_ITEMS; it += NGW) {
            int r = it;
            if (r < I1) { tr_plain<true>(IN_F(I_CW1), D, 2048, WSP(WS_WPW1), r, IN_F(I_NMIX), scr, lane); continue; } r -= I1;
            if (r < I2) { tr_plain(IN_F(I_CW2), D, D, WSP(WS_WPW2), r, nullptr, scr, lane); continue; } r -= I2;
            if (r < I3) { tr_plain(IN_F(I_WQKV), D, NQKV, WSP(WS_WQKV), r, IN_F(I_NMIX) + D, scr, lane); continue; } r -= I3;
            if (r < I4) { tr_plain(IN_F(I_WO), D, D, WSP(WS_WO), r, nullptr, scr, lane); continue; } r -= I4;
            if (r < 2 * I5) { const int l = r / I5; tr_plain(IN_F(I_PWG) + (size_t)l * D * D, D, D, WSP(WS_WPG) + (size_t)l * D * D, r % I5, IN_F(I_PNORM) + l * D, scr, lane); continue; } r -= 2 * I5;
            if (r < 2 * I6) { const int l = r / I6; tr_plain(IN_F(I_PWP) + (size_t)l * PLED * D, PLED, D, WSP(WS_WPP) + (size_t)l * D * PLED, r % I6, nullptr, scr, lane); continue; } r -= 2 * I6;
            moe_item(IN_F(I_WG), IN_F(I_WU), IN_F(I_WDN), IN_F(I_NFFN), 0, WSP(WS_WGU), WSP(WS_WD), r, scr, lane);
          } }
        { KArgP ka = kargs(); PH_IDS(); const float* wrg = IN_F(I_WRG); const float* wre = IN_F(I_WRE); const float* gf = IN_F(I_NFFN); bf16* Wr = WSP(WS_WR);
          for (int idx = gtid; idx < 2 * 256 * 1024; idx += NTHR) { const int l = idx >> 18, row = (idx >> 10) & 255, k = idx & 1023; float v = 0.f;
              if (row < 4) v = wrg[((size_t)l * D + k) * 4 + row]; else if (row < 36) { const int g = (row - 4) >> 3, e = (row - 4) & 7; v = wre[(((size_t)l * 4 + g) * D + k) * 8 + e]; }
              Wr[idx] = (bf16)f2bf(v * gf[l * D + k]); } }
        { KArgP ka = kargs(); PH_IDS(); const f32x4* p4 = (const f32x4*)ka->in[I_P]; u32x2* o = (u32x2*)WSP(WS_P16);
          for (int idx = gtid; idx < 2 * M * PLED / 4; idx += NTHR) { const f32x4 v = p4[idx]; o[idx] = (u32x2){pk2(v.x, v.y), pk2(v.z, v.w)}; } }
        { KArgP ka = kargs(); PH_IDS(); row_cvt(IN_F(I_X), XBA, SSQ(0), gw, NGW, lane); }
    }
    SEAM(0);
    if (IN(1)) DUPLOOP(1) { KArgP ka = kargs(); PH_IDS(); pg8::Gemm g{XBA, WSP(WS_WPW1), M, 2048, D}; pg8::StaticOrder S; S.init(M, 2048, G, bx);
        pg8::EpiGLU E{SLOT(0), IN_F(I_CB1), SSQ(0)};
        pg8::gemm_phase<pg8::EpiGLU, pg8::StaticOrder, true, false>(lds + RING_OFF, g, S, E, wave); }
    SEAM(1);
    if (IN(2)) DUPLOOP(2) { KArgP ka = kargs(); PH_IDS(); conv_phase(SLOT(0), SLOT(1), IN_F(I_CDW), IN_F(I_CBDW), IN_F(I_CLNG), IN_F(I_CLNB), lds + RING_OFF, vcu, G, tid, lane, wave); }
    SEAM(2);
    if (IN(3)) { KArgP ka = kargs(); PH_IDS(); pg8::Gemm g{SLOT(1), WSP(WS_WPW2), M, D, D}; pg8::StaticOrder S; S.init(M, D, G, bx);
        pg8::EpiRes E{XBA, IN_F(I_CB2), SSQ(1)};
        pg8::gemm_phase<pg8::EpiRes, pg8::StaticOrder, true, false>(lds + RING_OFF, g, S, E, wave); }
    SEAM(3);
#ifdef MK_XBAR
    xcd_barrier(bar); xcd_barrier(bar); xcd_barrier(bar); xcd_barrier(bar); xcd_barrier(bar); xcd_barrier(bar); xcd_barrier(bar); xcd_barrier(bar); xcd_barrier(bar); xcd_barrier(bar);
#endif
    layer_tail<0>(lds, bar, lo, hi, wave, G, bx, vcu, gw, NGW, NTHR);
    if (IN(10)) DUPLOOP(10) { KArgP ka = kargs(); PH_IDS(); pg8::Gemm g{XBB, WSP(WS_WQKV), M, NQKV, D}; pg8::StaticOrder S; S.init(M, NQKV, G, bx);
        pg8::EpiQKV E{SLOT(0), (size_t)(WS_SS / 2), SSQ(3), (const int*)ka->in[I_POS], attn3::C2};
        pg8::gemm_phase<pg8::EpiQKV, pg8::StaticOrder, true, false>(lds + RING_OFF, g, S, E, wave); }
    SEAM(10);
    if (IN(11)) DUPLOOP(11) { KArgP ka = kargs(); const attn3::Tensors AT{(const attn3::bf16*)SLOT(0), (const attn3::bf16*)SLOT(1), (const attn3::bf16*)SLOT(2), (attn3::bf16*)SLOT(0), (float*)SLOT(3), IN_F(I_LAM), IN_F(I_SUBLN)};
        attn3::attn_phase<8>((char*)lds_raw + RING_OFF, AT, vcu, G, wave, LAM_INIT); }
    if (IN(11) && IN(13)) xcd_barrier(bar);
    if (IN(13)) { KArgP ka = kargs(); PH_IDS(); pg8::Gemm g{SLOT(0), WSP(WS_WO), M, D, D}; pg8::StaticOrder S; S.init(M, D, G, bx);
        pg8::EpiRes E{XBB, nullptr, SSQ(4)};
        pg8::gemm_phase<pg8::EpiRes, pg8::StaticOrder, true, false>(lds + RING_OFF, g, S, E, wave); }
    SEAM(13);
    layer_tail<1>(lds, bar, lo, hi, wave, G, bx, vcu, gw, NGW, NTHR);
    if (IN(20)) { KArgP ka = kargs(); PH_IDS(); row_final(SLOT(1), ka->out, SSQ(6), IN_F(I_FNORM), gw, NGW, lane);
#ifdef MK_PROBE
        { __syncthreads(); const unsigned* ts = (const unsigned*)(ka->ws + WS_CTL) + CW_TS;
          const float us1 = (float)(__hip_atomic_load(ts + MK_PROBE_B1, RLX_AGENT) - __hip_atomic_load(ts + MK_PROBE_A1, RLX_AGENT)) * 0.01f, us2 = (float)(__hip_atomic_load(ts + MK_PROBE_B2, RLX_AGENT) - __hip_atomic_load(ts + MK_PROBE_A2, RLX_AGENT)) * 0.01f;
          const float sc = 1.f + us1 / (float)(MK_PROBE_S1);
          VM_WAIT(); __syncthreads();
          for (int m = gw; m < M; m += NGW) { GAS f32x4* xr = (GAS f32x4*)(ka->out + (size_t)m * D) + lane;
              for (int j = 0; j < 4; ++j) { f32x4 v = xr[64 * j]; v = v * sc; if (m == 0 && j == 0 && lane == 0) v.x = us2 * (float)(MK_PROBE_S2); xr[64 * j] = v; } } }
#endif
    }
#undef IN
#undef SEAM
}

extern "C" void kernel_launch(void* const* d_in, const int* in_sizes, int n_in, void* d_out, int out_size, void* d_ws, size_t ws_size, hipStream_t stream) {
    static int grid = 0;
    if (grid == 0) {
        if (n_in != N_IN || in_sizes[0] != M * D || out_size != M * D || ws_size < WS_END) { fprintf(stderr, "kernel_launch: unexpected problem: n_in %d in0 %d out %d ws %zu (need %zu); nothing launched\n", n_in, n_in > 0 ? in_sizes[0] : -1, out_size, ws_size, (size_t)WS_END); grid = -1; return; }
        int dev = 0, cus = 0, per_cu = 0;
        if (hipGetDevice(&dev) != hipSuccess || hipDeviceGetAttribute(&cus, hipDeviceAttributeMultiprocessorCount, dev) != hipSuccess) { grid = -1; return; }
        if (hipFuncSetAttribute((const void*)mk_fwd, hipFuncAttributeMaxDynamicSharedMemorySize, LDS_BYTES) != hipSuccess) { fprintf(stderr, "kernel_launch: hipFuncSetAttribute failed\n"); grid = -1; return; }
        if (hipOccupancyMaxActiveBlocksPerMultiprocessor(&per_cu, (const void*)mk_fwd, NWAVES * 64, LDS_BYTES) != hipSuccess || per_cu < 1) { fprintf(stderr, "kernel_launch: occupancy query says %d\n", per_cu); }
        (void)hipGetLastError();
        grid = cus;
        if (grid > 256) grid = 256;
    }
    if (grid < 0) return;
    if (hipMemsetAsync((char*)d_ws + WS_CTL, 0, CTL_ZERO_BYTES, stream) != hipSuccess) return;
    Args a{};
    for (int i = 0; i < N_IN; ++i) a.in[i] = d_in[i];
    a.out = (float*)d_out; a.ws = (unsigned char*)d_ws;
#if MK_SPLIT
    for (int ph = 0; ph < NPHASE; ++ph) { a.ph_lo = ph; a.ph_hi = ph + 1; hipLaunchKernelGGL(mk_fwd, dim3(grid), dim3(NWAVES * 64), LDS_BYTES, stream, a); }
#else
    a.ph_lo = 0; a.ph_hi = NPHASE; hipLaunchKernelGGL(mk_fwd, dim3(grid), dim3(NWAVES * 64), LDS_BYTES, stream, a);
#endif
}
```
